# Optimizing an MI355X kernel written in HIP

```python
import math, functools
import jax, jax.numpy as jnp
from jax import lax
import numpy as np

D_MODEL = 1024
BATCH = 8
SEQ = 2048
DEPTH = 1
DEC_BATCH = 32
DEC_SEQ = 8
PAST_LEN = 16384
PAGE_SIZE = 128

GLA_HEADS = 4
GLA_DK = 64
GLA_DV = 128
GLA_GATE_RANK = 16
GLA_GATE_NORM = 16.0
GLA_CHUNK = 32
MLA_HEADS = 8
MLA_Q_LORA = 256
MLA_KV_LORA = 128
MLA_NOPE = 64
MLA_ROPE = 32
MLA_V = 64
MLA_SCALE = (MLA_NOPE + MLA_ROPE) ** -0.5
ROPE_THETA = 10000.0
Q_BLOCK = 128
D_FF = 2816
CONV_W = 3
PLE_DIM = 256
EPS = 1e-6
NEG = -1e30

IN_SIZES = (GLA_HEADS * GLA_DK, GLA_HEADS * GLA_DK, GLA_HEADS * GLA_DV, GLA_HEADS * GLA_DV,
            GLA_GATE_RANK, MLA_Q_LORA, MLA_KV_LORA, MLA_ROPE)
IN_COLS = sum(IN_SIZES)
MIX_OUT = GLA_HEADS * GLA_DV + MLA_HEADS * MLA_V

kernel_name = "hymba_gla_mla_convffn_ple_step"


def rmsnorm(x, g):
    xf = x.astype(jnp.float32)
    y = xf * lax.rsqrt(jnp.mean(xf * xf, axis=-1, keepdims=True) + EPS)
    return (y * g.astype(jnp.float32)).astype(x.dtype)


def rope(x, pos):
    half = MLA_ROPE // 2
    inv = ROPE_THETA ** (-jnp.arange(half, dtype=jnp.float32) * 2.0 / MLA_ROPE)
    ang = pos.astype(jnp.float32)[:, None] * inv[None, :]
    shape = (1, pos.shape[0]) + (1,) * (x.ndim - 3) + (half,)
    cos = jnp.cos(ang).reshape(shape).astype(x.dtype)
    sin = jnp.sin(ang).reshape(shape).astype(x.dtype)
    x1, x2 = x[..., :half], x[..., half:]
    return jnp.concatenate([x1 * cos - x2 * sin, x2 * cos + x1 * sin], axis=-1)


def gla_chunked(q, k, v, log_a, s0):
    B, T, H, DK = q.shape
    DV = v.shape[-1]
    L = math.gcd(T, GLA_CHUNK)
    N = T // L
    f32 = jnp.float32
    q = q.astype(f32).reshape(B, N, L, H, DK)
    k = k.astype(f32).reshape(B, N, L, H, DK)
    v = v.astype(f32).reshape(B, N, L, H, DV)
    b = jnp.cumsum(log_a.astype(f32).reshape(B, N, L, H, DK), axis=2)
    b_last = b[:, :, -1:]
    q_dec = q * jnp.exp(b)
    k_inv = k * jnp.exp(-b)
    k_end = k * jnp.exp(b_last - b)
    causal = jnp.tril(jnp.ones((L, L), dtype=bool))
    A = jnp.einsum('bnthd,bnshd->bnhts', q_dec, k_inv)
    A = jnp.where(causal, A, 0.0)
    o_intra = jnp.einsum('bnhts,bnshv->bnthv', A, v)

    def step(S, xs):
        qd, ke, vv, bl = xs
        o = jnp.einsum('bthd,bhdv->bthv', qd, S)
        S = jnp.exp(bl)[..., None] * S + jnp.einsum('bshd,bshv->bhdv', ke, vv)
        return S, o

    xs = (q_dec.swapaxes(0, 1), k_end.swapaxes(0, 1), v.swapaxes(0, 1),
          b_last[:, :, 0].swapaxes(0, 1))
    S, o_inter = lax.scan(step, s0.astype(f32), xs)
    o = o_intra + o_inter.swapaxes(0, 1)
    return o.reshape(B, T, H, DV), S


def latent_to_kv(ckv, krope, w_kvup, g_kn):
    kv = (ckv @ w_kvup).reshape(ckv.shape[:-1] + (MLA_HEADS, MLA_NOPE + MLA_V))
    k_nope = rmsnorm(kv[..., :MLA_NOPE], g_kn)
    v = kv[..., MLA_NOPE:]
    kr = jnp.broadcast_to(krope[..., None, :], krope.shape[:-1] + (MLA_HEADS, MLA_ROPE))
    k = jnp.concatenate([k_nope, kr.astype(k_nope.dtype)], axis=-1)
    return k, v


def prompt_attention(q, k, v):
    B, S, H, DQK = q.shape
    nb = S // Q_BLOCK
    qb = q.reshape(B, nb, Q_BLOCK, H, DQK).transpose(1, 0, 2, 3, 4)
    starts = jnp.arange(nb) * Q_BLOCK
    kpos = jnp.arange(S)

    def one(args):
        qi, start = args
        s = jnp.einsum('bqhd,bkhd->bhqk', qi, k, preferred_element_type=jnp.float32) * MLA_SCALE
        qpos = start + jnp.arange(Q_BLOCK)
        s = jnp.where(kpos[None, :] <= qpos[:, None], s, NEG)
        pr = jax.nn.softmax(s, axis=-1)
        return jnp.einsum('bhqk,bkhd->bqhd', pr.astype(v.dtype), v)

    out = lax.map(one, (qb, starts))
    return out.transpose(1, 0, 2, 3, 4).reshape(B, S, H * MLA_V)


def block_stats(q, k, v, mask):
    s = jnp.einsum('bthd,bkhd->bhtk', q, k, preferred_element_type=jnp.float32) * MLA_SCALE
    if mask is not None:
        s = jnp.where(mask, s, NEG)
    m = jnp.max(s, axis=-1)
    p = jnp.exp(s - m[..., None])
    l = jnp.sum(p, axis=-1)
    acc = jnp.einsum('bhtk,bkhd->bhtd', p, v.astype(jnp.float32))
    return m, l, acc


def combine(a, b):
    m1, l1, acc1 = a
    m2, l2, acc2 = b
    m = jnp.maximum(m1, m2)
    c1 = jnp.exp(m1 - m)
    c2 = jnp.exp(m2 - m)
    return m, l1 * c1 + l2 * c2, acc1 * c1[..., None] + acc2 * c2[..., None]


def sample_attention(q, k_new, v_new, pool_ckv, pool_krope, page_table, w_kvup, g_kn):
    Bd, T = q.shape[0], q.shape[1]
    causal = jnp.arange(T)[None, :] <= jnp.arange(T)[:, None]
    stats = block_stats(q, k_new, v_new, causal)

    def body(carry, phys):
        c = pool_ckv[phys]
        r = pool_krope[phys]
        k, v = latent_to_kv(c, r, w_kvup, g_kn)
        return combine(carry, block_stats(q, k, v, None)), None

    (m, l, acc), _ = lax.scan(body, stats, page_table.T)
    out = acc / l[..., None]
    return out.transpose(0, 2, 1, 3).reshape(Bd, T, MLA_HEADS * MLA_V).astype(q.dtype)


def conv_ffn(n, prev, lw):
    a = n @ lw['ffn_w_gate']
    c = n @ lw['ffn_w_up']
    T = a.shape[1]
    full = jnp.concatenate([prev.astype(a.dtype), a], axis=1)
    w = lw['ffn_conv_w']
    conv = lw['ffn_conv_b'] + sum(w[j] * full[:, j:j + T] for j in range(CONV_W))
    y = (jax.nn.silu(conv) * c) @ lw['ffn_w_down']
    return y, full[:, full.shape[1] - (CONV_W - 1):]


def layer_forward(h, p, pos, gla_s0, conv_prev, attend, lw):
    B, T, _ = h.shape
    n = rmsnorm(h, lw['g_mix'])
    u = n @ lw['w_in']
    split_points = [int(s) for s in np.cumsum(IN_SIZES)[:-1]]
    gq, gk, gv, gg, ga, mq, mkv, mkr = jnp.split(u, split_points, axis=-1)
    q = gq.reshape(B, T, GLA_HEADS, GLA_DK) * (GLA_DK ** -0.5)
    k = gk.reshape(B, T, GLA_HEADS, GLA_DK)
    v = gv.reshape(B, T, GLA_HEADS, GLA_DV)
    z = (ga @ lw['gla_w_a2'] + lw['gla_b_a']).astype(jnp.float32)
    log_a = (jax.nn.log_sigmoid(z) / GLA_GATE_NORM).reshape(B, T, GLA_HEADS, GLA_DK)
    o_gla, s_new = gla_chunked(q, k, v, log_a, gla_s0)
    o_gla = rmsnorm(o_gla.astype(h.dtype), lw['gla_g_out']).reshape(B, T, -1) * jax.nn.silu(gg)
    cq = rmsnorm(mq, lw['mla_g_qa'])
    qf = (cq @ lw['mla_w_qup']).reshape(B, T, MLA_HEADS, MLA_NOPE + MLA_ROPE)
    q_nope = rmsnorm(qf[..., :MLA_NOPE], lw['mla_g_qn'])
    q_rope = rope(rmsnorm(qf[..., MLA_NOPE:], lw['mla_g_qr']), pos)
    q_m = jnp.concatenate([q_nope, q_rope], axis=-1)
    ckv = rmsnorm(mkv, lw['mla_g_kva'])
    krope = rope(rmsnorm(mkr, lw['mla_g_kr']), pos)
    k_m, v_m = latent_to_kv(ckv, krope, lw['mla_w_kvup'], lw['mla_g_kn'])
    o_mla = attend(q_m, k_m, v_m).astype(h.dtype)
    h = h + jnp.concatenate([o_gla, o_mla], axis=-1) @ lw['w_o']
    y, conv_new = conv_ffn(rmsnorm(h, lw['g_ffn']), conv_prev, lw)
    h = h + y
    h = h + (p.astype(h.dtype) @ lw['ple_w_proj']) * jax.nn.sigmoid(rmsnorm(h, lw['g_ple']) @ lw['ple_w_gate'])
    return h, ckv, krope, s_new, conv_new


def setup_inputs(seed: int = 0) -> dict:
    key = jax.random.key(seed)
    ks = jax.random.split(key, 40)
    f32 = jnp.float32
    n_pages = PAST_LEN // PAGE_SIZE
    n_phys = (DEC_BATCH * n_pages * 5) // 4

    def nrm(k, shape, scale):
        return jax.random.normal(k, shape, f32) * scale

    def gain(k, n):
        return 1.0 + 0.05 * jax.random.normal(k, (DEPTH, n), f32)

    page_table = jax.random.permutation(ks[0], n_phys)[:DEC_BATCH * n_pages]
    page_table = page_table.reshape(DEC_BATCH, n_pages).astype(jnp.int32)
    return {
        'x_prompt': nrm(ks[1], (BATCH, SEQ, D_MODEL), 1.0),
        'x_sample': nrm(ks[2], (DEC_BATCH, DEC_SEQ, D_MODEL), 1.0),
        'cache_ckv': nrm(ks[3], (DEPTH, n_phys, PAGE_SIZE, MLA_KV_LORA), 1.0),
        'cache_krope': nrm(ks[4], (DEPTH, n_phys, PAGE_SIZE, MLA_ROPE), 1.0),
        'state_gla': nrm(ks[5], (DEPTH, DEC_BATCH, GLA_HEADS, GLA_DK, GLA_DV), 0.3),
        'state_conv': nrm(ks[6], (DEPTH, DEC_BATCH, CONV_W - 1, D_FF), 1.0),
        'page_table': page_table,
        'p_prompt': nrm(ks[7], (DEPTH, BATCH, SEQ, PLE_DIM), 1.0),
        'p_sample': nrm(ks[8], (DEPTH, DEC_BATCH, DEC_SEQ, PLE_DIM), 1.0),
        'g_mix': gain(ks[9], D_MODEL),
        'w_in': nrm(ks[10], (DEPTH, D_MODEL, IN_COLS), D_MODEL ** -0.5),
        'gla_w_a2': nrm(ks[11], (DEPTH, GLA_GATE_RANK, GLA_HEADS * GLA_DK), GLA_GATE_RANK ** -0.5),
        'gla_b_a': nrm(ks[12], (DEPTH, GLA_HEADS * GLA_DK), 0.5),
        'gla_g_out': gain(ks[13], GLA_DV),
        'mla_g_qa': gain(ks[14], MLA_Q_LORA),
        'mla_w_qup': nrm(ks[15], (DEPTH, MLA_Q_LORA, MLA_HEADS * (MLA_NOPE + MLA_ROPE)), MLA_Q_LORA ** -0.5),
        'mla_g_qn': gain(ks[16], MLA_NOPE),
        'mla_g_qr': gain(ks[17], MLA_ROPE),
        'mla_g_kva': gain(ks[18], MLA_KV_LORA),
        'mla_g_kr': gain(ks[19], MLA_ROPE),
        'mla_w_kvup': nrm(ks[20], (DEPTH, MLA_KV_LORA, MLA_HEADS * (MLA_NOPE + MLA_V)), MLA_KV_LORA ** -0.5),
        'mla_g_kn': gain(ks[21], MLA_NOPE),
        'w_o': nrm(ks[22], (DEPTH, MIX_OUT, D_MODEL), MIX_OUT ** -0.5),
        'g_ffn': gain(ks[23], D_MODEL),
        'ffn_w_gate': nrm(ks[24], (DEPTH, D_MODEL, D_FF), D_MODEL ** -0.5),
        'ffn_w_up': nrm(ks[25], (DEPTH, D_MODEL, D_FF), D_MODEL ** -0.5),
        'ffn_conv_w': nrm(ks[26], (DEPTH, CONV_W, D_FF), CONV_W ** -0.5),
        'ffn_conv_b': nrm(ks[27], (DEPTH, D_FF), 0.02),
        'ffn_w_down': nrm(ks[28], (DEPTH, D_FF, D_MODEL), D_FF ** -0.5),
        'g_ple': gain(ks[29], D_MODEL),
        'ple_w_gate': nrm(ks[30], (DEPTH, D_MODEL, D_MODEL), D_MODEL ** -0.5),
        'ple_w_proj': nrm(ks[31], (DEPTH, PLE_DIM, D_MODEL), PLE_DIM ** -0.5),
    }


def reference(x_prompt, x_sample, cache_ckv, cache_krope, state_gla, state_conv, page_table,
              p_prompt, p_sample, g_mix, w_in, gla_w_a2, gla_b_a, gla_g_out, mla_g_qa, mla_w_qup,
              mla_g_qn, mla_g_qr, mla_g_kva, mla_g_kr, mla_w_kvup, mla_g_kn, w_o, g_ffn,
              ffn_w_gate, ffn_w_up, ffn_conv_w, ffn_conv_b, ffn_w_down, g_ple, ple_w_gate,
              ple_w_proj):
    B, S = x_prompt.shape[0], x_prompt.shape[1]
    pos_p = jnp.arange(S)
    pos_s = PAST_LEN + jnp.arange(x_sample.shape[1])
    y_p, y_s = x_prompt, x_sample
    ckv_p, kr_p, gla_p, conv_p = [], [], [], []
    ckv_s, kr_s, gla_s, conv_s = [], [], [], []
    for i in range(DEPTH):
        lw = dict(g_mix=g_mix[i], w_in=w_in[i], gla_w_a2=gla_w_a2[i], gla_b_a=gla_b_a[i],
                  gla_g_out=gla_g_out[i], mla_g_qa=mla_g_qa[i], mla_w_qup=mla_w_qup[i],
                  mla_g_qn=mla_g_qn[i], mla_g_qr=mla_g_qr[i], mla_g_kva=mla_g_kva[i],
                  mla_g_kr=mla_g_kr[i], mla_w_kvup=mla_w_kvup[i], mla_g_kn=mla_g_kn[i],
                  w_o=w_o[i], g_ffn=g_ffn[i], ffn_w_gate=ffn_w_gate[i], ffn_w_up=ffn_w_up[i],
                  ffn_conv_w=ffn_conv_w[i], ffn_conv_b=ffn_conv_b[i], ffn_w_down=ffn_w_down[i],
                  g_ple=g_ple[i], ple_w_gate=ple_w_gate[i], ple_w_proj=ple_w_proj[i])
        s0 = jnp.zeros((B, GLA_HEADS, GLA_DK, GLA_DV), jnp.float32)
        c0 = jnp.zeros((B, CONV_W - 1, D_FF), x_prompt.dtype)
        y_p, ckv, kr, s_new, c_new = layer_forward(y_p, p_prompt[i], pos_p, s0, c0,
                                                   prompt_attention, lw)
        ckv_p.append(ckv)
        kr_p.append(kr)
        gla_p.append(s_new.astype(x_prompt.dtype))
        conv_p.append(c_new)
        attend_s = functools.partial(sample_attention, pool_ckv=cache_ckv[i],
                                     pool_krope=cache_krope[i], page_table=page_table,
                                     w_kvup=lw['mla_w_kvup'], g_kn=lw['mla_g_kn'])
        y_s, ckv, kr, s_new, c_new = layer_forward(y_s, p_sample[i], pos_s, state_gla[i],
                                                   state_conv[i], attend_s, lw)
        ckv_s.append(ckv)
        kr_s.append(kr)
        gla_s.append(s_new.astype(state_gla.dtype))
        conv_s.append(c_new.astype(state_conv.dtype))
    return (y_p, y_s, jnp.stack(ckv_p), jnp.stack(kr_p), jnp.stack(gla_p), jnp.stack(conv_p),
            jnp.stack(ckv_s), jnp.stack(kr_s), jnp.stack(gla_s), jnp.stack(conv_s))
```

```cpp
#include <hip/hip_runtime.h>
#include <cstdio>
#include <cstdint>
namespace pg8 {
#define PG8_LAS __attribute__((address_space(3)))
typedef unsigned short bf16_t;
typedef short bf16x8 __attribute__((ext_vector_type(8)));
typedef float f32x4 __attribute__((ext_vector_type(4)));
typedef unsigned u32x4 __attribute__((ext_vector_type(4)));
constexpr int BM = 256, BK = 64, HALF = 128, HTB = HALF * BK * 2  , STAGE_BYTES = 8 * HTB, NXCD = 8, WGM = 8;

__host__ __device__ __forceinline__ int lds_byte(int r, int c) { const int st = (r >> 4) * 2 + (c >> 5), rr = r & 15, cc = c & 31, ob = rr * 64 + cc * 2; return st * 1024 + (ob ^ (((ob >> 9) & 1) << 5)); }
__host__ __device__ __forceinline__ void stage_rc(int b, int& R, int& C) { const int st = b / 1024, sb = b % 1024, swz = sb ^ (((sb >> 9) & 1) << 5); R = (st >> 1) * 16 + swz / 64; C = (st & 1) * 32 + (swz % 64) / 2; }
__host__ __device__ __forceinline__ int perm32(int rho) { const int n = rho >> 4, i = rho & 15; return 8 * (i >> 2) + 4 * n + (i & 3); }

struct Unit { int pm, pn; };
struct Gemm { const bf16_t* A; const bf16_t* Bt; int M, N, K; };

struct StaticOrder {
    int nM, nN, nwg, G, c;
    __host__ __device__ void init(int M, int N, int G_, int c_) { nM = M / BM; nN = N / BM; nwg = nM * nN; G = G_; c = c_; }
    __host__ __device__ bool next(int i, Unit& u) const {
        const long L = (long)i * G + c; if (L >= nwg) return false;
        int wgid = (int)L; { const int q = nwg / NXCD, r = nwg % NXCD, xcd = wgid % NXCD, off = wgid / NXCD; wgid = (xcd < r ? xcd * (q + 1) : r * (q + 1) + (xcd - r) * q) + off; }
        const int nig = WGM * nN, gid = wgid / nig, fm = gid * WGM, gsz = (nM - fm) < WGM ? (nM - fm) : WGM;
        u.pm = fm + ((wgid % nig) % gsz); u.pn = (wgid % nig) / gsz; return true;
    }
    __device__ __forceinline__ void a_ready(const Unit&) const {}
    __device__ __forceinline__ void done(const Unit&) const {}
};

__device__ __forceinline__ unsigned cvt_pk_bf16(float lo, float hi) { unsigned r; asm volatile("v_cvt_pk_bf16_f32 %0, %1, %2" : "=v"(r) : "v"(lo), "v"(hi)); return r; }
typedef float f32x2 __attribute__((ext_vector_type(2)));
__device__ __forceinline__ unsigned short f2bf_rne(float f) { unsigned u = __builtin_bit_cast(unsigned, f); return (unsigned short)((u + 0x7fffu + ((u >> 16) & 1u)) >> 16); }
__device__ __forceinline__ float bf2f_(unsigned short b) { return __builtin_bit_cast(float, (unsigned)b << 16); }
struct EpiScaleBf16 {
    static constexpr bool PERM = true, AFTER_DRAIN = false;
    bf16_t* O; int ldc; const float* rs;
    __device__ __forceinline__ void operator()(const f32x4 (&acc)[2][2][4][2], const Unit& u, int wr, int wc, int fr, int fq) const {
        const int row0 = u.pm * BM + wr * 64 + fr, col0 = u.pn * BM + wc * 32 + 8 * fq;
#pragma unroll
        for (int ai = 0; ai < 2; ++ai)
#pragma unroll
            for (int m = 0; m < 4; ++m) { const int row = row0 + ai * HALF + m * 16; const float s = rs ? rs[row] : 1.f; bf16_t* rowp = O + (size_t)row * ldc + col0;
#pragma unroll
                for (int bj = 0; bj < 2; ++bj) { const f32x4 v0 = acc[ai][bj][m][0] * s, v1 = acc[ai][bj][m][1] * s;
                    u32x4 w; w.x = cvt_pk_bf16(v0[0], v0[1]); w.y = cvt_pk_bf16(v0[2], v0[3]); w.z = cvt_pk_bf16(v1[0], v1[1]); w.w = cvt_pk_bf16(v1[2], v1[3]);
                    *(u32x4*)(rowp + bj * HALF) = w; } }
    }
};
struct EpiResid {
    static constexpr bool PERM = false, AFTER_DRAIN = false;
    const float* xp; const float* xs; float* h; bf16_t* hb; float* rsq;
    __device__ __forceinline__ void operator()(const f32x4 (&acc)[2][2][4][2], const Unit& u, int wr, int wc, int fr, int fq) const {
        typedef unsigned u32x2v __attribute__((ext_vector_type(2)));
        const int col0 = u.pn * BM + wc * 32 + 4 * fq;
#pragma unroll
        for (int ai = 0; ai < 2; ++ai)
#pragma unroll
            for (int m = 0; m < 4; ++m) { const int r = u.pm * BM + ai * HALF + wr * 64 + m * 16 + fr;
                const float* base = (r < 16384) ? xp + (size_t)r * 1024 : xs + (size_t)(r - 16384) * 1024;
                float ss = 0.f;
#pragma unroll
                for (int bj = 0; bj < 2; ++bj)
#pragma unroll
                    for (int n = 0; n < 2; ++n) { const int off = col0 + bj * HALF + n * 16; const f32x4 v = *(const f32x4*)(base + off) + acc[ai][bj][m][n];
                        *(f32x4*)(h + (size_t)r * 1024 + off) = v; u32x2v w; w.x = cvt_pk_bf16(v[0], v[1]); w.y = cvt_pk_bf16(v[2], v[3]); *(u32x2v*)(hb + (size_t)r * 1024 + off) = w;
                        ss += (v[0] * v[0] + v[1] * v[1]) + (v[2] * v[2] + v[3] * v[3]); }
                ss += __shfl_xor(ss, 16); ss += __shfl_xor(ss, 32);
                if (fq == 0) atomicAdd(rsq + r, ss);
                asm volatile("" ::: "memory"); }
    }
};
struct EpiGateUp {
    static constexpr bool PERM = true, AFTER_DRAIN = false;
    const float* rsq; bf16_t* A; bf16_t* C; float* conv_p; float* conv_s;
    __device__ __forceinline__ void operator()(const f32x4 (&acc)[2][2][4][2], const Unit& u, int wr, int wc, int fr, int fq) const {
        const int f0 = u.pn * HALF + wc * 32 + 8 * fq;
#pragma unroll
        for (int ai = 0; ai < 2; ++ai)
#pragma unroll
            for (int m = 0; m < 4; ++m) { const int r = u.pm * BM + ai * HALF + wr * 64 + m * 16 + fr;
                const float rs = 1.0f / sqrtf(rsq[r] * (1.0f / 1024.0f) + 1e-6f);
                const f32x4 a0 = acc[ai][0][m][0] * rs, a1 = acc[ai][0][m][1] * rs, c0 = acc[ai][1][m][0] * rs, c1 = acc[ai][1][m][1] * rs;
                u32x4 w; w.x = cvt_pk_bf16(a0[0], a0[1]); w.y = cvt_pk_bf16(a0[2], a0[3]); w.z = cvt_pk_bf16(a1[0], a1[1]); w.w = cvt_pk_bf16(a1[2], a1[3]);
                *(u32x4*)(A + (size_t)r * 2816 + f0) = w;
                w.x = cvt_pk_bf16(c0[0], c0[1]); w.y = cvt_pk_bf16(c0[2], c0[3]); w.z = cvt_pk_bf16(c1[0], c1[1]); w.w = cvt_pk_bf16(c1[2], c1[3]);
                *(u32x4*)(C + (size_t)r * 2816 + f0) = w;
                float* dst = nullptr;
                if (r < 16384) { const int t = r & 2047; if (t >= 2046) dst = conv_p + ((size_t)(r >> 11) * 2 + (t - 2046)) * 2816 + f0; }
                else { const int rr = r - 16384, t = rr & 7; if (t >= 6) dst = conv_s + ((size_t)(rr >> 3) * 2 + (t - 6)) * 2816 + f0; }
                if (dst) { *(f32x4*)dst = a0; *(f32x4*)(dst + 4) = a1; } }
    }
};
struct EpiPle {
    static constexpr bool PERM = false, AFTER_DRAIN = false;
    const float* h2; const bf16_t* PP; const float* rsq; float* out;
    __device__ __forceinline__ void operator()(const f32x4 (&acc)[2][2][4][2], const Unit& u, int wr, int wc, int fr, int fq) const {
        typedef unsigned u32x2v __attribute__((ext_vector_type(2)));
        const int col0 = u.pn * BM + wc * 32 + 4 * fq;
#pragma unroll
        for (int ai = 0; ai < 2; ++ai)
#pragma unroll
            for (int m = 0; m < 4; ++m) { const int r = u.pm * BM + ai * HALF + wr * 64 + m * 16 + fr;
                const float rs = 1.0f / sqrtf(rsq[r] * (1.0f / 1024.0f) + 1e-6f);
#pragma unroll
                for (int bj = 0; bj < 2; ++bj)
#pragma unroll
                    for (int n = 0; n < 2; ++n) { const size_t off = (size_t)r * 1024 + col0 + bj * HALF + n * 16; const f32x4 hv = *(const f32x4*)(h2 + off);
                        const u32x2v pw = *(const u32x2v*)(PP + off); const f32x4 z = acc[ai][bj][m][n] * rs; f32x4 o;
                        o[0] = hv[0] + __builtin_bit_cast(float, pw.x << 16) / (1.0f + __expf(-z[0]));
                        o[1] = hv[1] + __builtin_bit_cast(float, pw.x & 0xffff0000u) / (1.0f + __expf(-z[1]));
                        o[2] = hv[2] + __builtin_bit_cast(float, pw.y << 16) / (1.0f + __expf(-z[2]));
                        o[3] = hv[3] + __builtin_bit_cast(float, pw.y & 0xffff0000u) / (1.0f + __expf(-z[3]));
                        *(f32x4*)(out + off) = o; }
                asm volatile("" ::: "memory"); }
    }
};
template <class Epi, class Sched, bool ALIGN_EPI = false, bool SP2 = false>
__device__ __forceinline__ void gemm_phase(PG8_LAS unsigned char* lds, const Gemm g, const Sched& S, const Epi& E) {
    const int tid = threadIdx.x, wid = __builtin_amdgcn_readfirstlane(tid >> 6), lane = tid & 63, wr = wid >> 2, wc = wid & 3, fr = lane & 15, fq = lane >> 4;
    const int K = g.K, nt = K / BK;
    unsigned voffA[2], voffB[2];
#pragma unroll
    for (int i = 0; i < 2; ++i) { int R, C; stage_rc(tid * 16 + i * 8192, R, C); const int Rb = Epi::PERM ? ((R & ~31) + perm32(R & 31)) : R;
        voffA[i] = (unsigned)(R * K + C) * 2u; voffB[i] = (unsigned)(Rb * K + C) * 2u; }
    const size_t kstep = (size_t)(BK * 2);
    const size_t hstep = (size_t)HALF * K * 2;
    const size_t tstep = 2 * hstep;
    const unsigned ldsw = (unsigned)wid * 1024u;
    const int aoff = lds_byte(wr * 64 + fr, fq * 8), boff = lds_byte(wc * 32 + fr, fq * 8);
#define PG8_SA(b, h) (((b) * 2 + (h)) * HTB)
#define PG8_SB(b, h) ((4 + (b) * 2 + (h)) * HTB)
#define PG8_STAGE(bufoff, gbase, voff) do { _Pragma("unroll") for (int _i = 0; _i < 2; ++_i) \
        __builtin_amdgcn_global_load_lds((const unsigned*)((const char*)(gbase) + (voff)[_i]), (PG8_LAS unsigned*)(lds + (bufoff) + ldsw + _i * 8192), 16, 0, 0); } while (0)
#define PG8_LDA(dst, b, h) do { _Pragma("unroll") for (int m = 0; m < 4; ++m) _Pragma("unroll") for (int k = 0; k < 2; ++k) dst[m][k] = *(const PG8_LAS bf16x8*)(lds + PG8_SA(b, h) + aoff + m * 2048 + k * 1024); } while (0)
#define PG8_LDB(dst, b, h) do { _Pragma("unroll") for (int n = 0; n < 2; ++n) _Pragma("unroll") for (int k = 0; k < 2; ++k) dst[n][k] = *(const PG8_LAS bf16x8*)(lds + PG8_SB(b, h) + boff + n * 2048 + k * 1024); } while (0)
#define PG8_MMA(ai, bj, At, Bt) do { __builtin_amdgcn_s_setprio(1); _Pragma("unroll") for (int m = 0; m < 4; ++m) _Pragma("unroll") for (int n = 0; n < 2; ++n) _Pragma("unroll") for (int k = 0; k < 2; ++k) \
        acc[ai][bj][m][n] = __builtin_amdgcn_mfma_f32_16x16x32_bf16(Bt[n][k], At[m][k], acc[ai][bj][m][n], 0, 0, 0); __builtin_amdgcn_s_setprio(0); } while (0)
#define PG8_WAIT_V(n) asm volatile("s_waitcnt vmcnt(" #n ")" ::: "memory")
#define PG8_WAIT_L(n) asm volatile("s_waitcnt lgkmcnt(" #n ")" ::: "memory")
#define PG8_BAR __builtin_amdgcn_s_barrier()
#define PG8_SCHED __builtin_amdgcn_sched_barrier(0)
    Unit cur, nxt; int ui = 0;
    if (!S.next(0, cur)) return;
    f32x4 acc[2][2][4][2];
#pragma unroll
    for (int a = 0; a < 2; ++a)
#pragma unroll
        for (int b = 0; b < 2; ++b)
#pragma unroll
            for (int m = 0; m < 4; ++m)
#pragma unroll
                for (int n = 0; n < 2; ++n) acc[a][b][m][n] = (f32x4){0.f, 0.f, 0.f, 0.f};
    bf16x8 At[4][2], B0[2][2], B1[2][2];
    const char* cA = (const char*)g.A + (size_t)cur.pm * tstep; const char* cB = (const char*)g.Bt + (size_t)cur.pn * tstep;
    S.a_ready(cur);
    if constexpr (SP2) {
        PG8_STAGE(PG8_SB(0, 0), cB, voffB); PG8_STAGE(PG8_SB(0, 1), cB + hstep, voffB); PG8_STAGE(PG8_SA(0, 0), cA, voffA); PG8_STAGE(PG8_SA(0, 1), cA + hstep, voffA);
        if (wr == 1) PG8_BAR;
        PG8_WAIT_V(2); PG8_BAR;
        PG8_STAGE(PG8_SB(1, 0), cB + kstep, voffB); PG8_STAGE(PG8_SA(1, 0), cA + kstep, voffA); PG8_STAGE(PG8_SB(1, 1), cB + hstep + kstep, voffB);
        PG8_WAIT_V(6); PG8_BAR;
    } else {
        PG8_STAGE(PG8_SB(0, 0), cB, voffB); PG8_STAGE(PG8_SA(0, 0), cA, voffA); PG8_STAGE(PG8_SB(0, 1), cB + hstep, voffB); PG8_STAGE(PG8_SA(0, 1), cA + hstep, voffA);
        if (wr == 1) PG8_BAR;
        PG8_WAIT_V(4); PG8_BAR;
        PG8_STAGE(PG8_SB(1, 0), cB + kstep, voffB); PG8_STAGE(PG8_SA(1, 0), cA + kstep, voffA); PG8_STAGE(PG8_SB(1, 1), cB + hstep + kstep, voffB);
        PG8_WAIT_V(6); PG8_BAR;
    }
    for (;;) {
        const bool has_next = S.next(ui + 1, nxt);
        const char* nA = has_next ? (const char*)g.A + (size_t)nxt.pm * tstep : cA; const char* nB = has_next ? (const char*)g.Bt + (size_t)nxt.pn * tstep : cB;
        for (int t = 0; t < nt; t += 2) {
            const bool last = (t == nt - 2);
            const char* a1 = cA + (size_t)(t + 1) * kstep;
            const char* a2 = last ? nA : cA + (size_t)(t + 2) * kstep; const char* b2 = last ? nB : cB + (size_t)(t + 2) * kstep;
            const char* a3 = a2 + kstep; const char* b3 = b2 + kstep;
            if (last && has_next) S.a_ready(nxt);
            if constexpr (SP2) {
            PG8_LDB(B0, 0, 0); PG8_LDB(B1, 0, 1); PG8_SCHED; PG8_LDA(At, 0, 0); PG8_STAGE(PG8_SA(1, 1), a1 + hstep, voffA);
            PG8_WAIT_V(8); PG8_WAIT_L(0); PG8_BAR; PG8_MMA(0, 0, At, B0); PG8_MMA(0, 1, At, B1); PG8_BAR; PG8_SCHED;
            PG8_LDA(At, 0, 1); PG8_STAGE(PG8_SB(0, 0), b2, voffB); PG8_STAGE(PG8_SB(0, 1), b2 + hstep, voffB); PG8_STAGE(PG8_SA(0, 0), a2, voffA);
            PG8_WAIT_V(8); PG8_WAIT_L(0); PG8_BAR; PG8_MMA(1, 0, At, B0); PG8_MMA(1, 1, At, B1); PG8_BAR; PG8_SCHED;
            PG8_LDB(B0, 1, 0); PG8_LDB(B1, 1, 1); PG8_SCHED; PG8_LDA(At, 1, 0); PG8_STAGE(PG8_SA(0, 1), a2 + hstep, voffA);
            PG8_WAIT_V(8); PG8_WAIT_L(0); PG8_BAR; PG8_MMA(0, 0, At, B0); PG8_MMA(0, 1, At, B1); PG8_BAR; PG8_SCHED;
            PG8_LDA(At, 1, 1); PG8_STAGE(PG8_SB(1, 0), b3, voffB); PG8_STAGE(PG8_SB(1, 1), b3 + hstep, voffB); PG8_STAGE(PG8_SA(1, 0), a3, voffA);
            PG8_WAIT_V(8); PG8_WAIT_L(0); PG8_BAR; PG8_MMA(1, 0, At, B0); PG8_MMA(1, 1, At, B1); PG8_BAR; PG8_SCHED;
            } else {
            PG8_LDB(B0, 0, 0); PG8_SCHED; PG8_LDA(At, 0, 0); PG8_STAGE(PG8_SA(1, 1), a1 + hstep, voffA);
            PG8_WAIT_L(8); PG8_BAR; PG8_WAIT_L(0); PG8_MMA(0, 0, At, B0); PG8_BAR; PG8_SCHED;
            PG8_LDB(B1, 0, 1); PG8_STAGE(PG8_SB(0, 0), b2, voffB);
            PG8_BAR; PG8_WAIT_L(0); PG8_MMA(0, 1, At, B1); PG8_BAR;
            PG8_LDA(At, 0, 1); PG8_STAGE(PG8_SA(0, 0), a2, voffA);
            PG8_BAR; PG8_WAIT_L(0); PG8_MMA(1, 0, At, B0); PG8_BAR; PG8_SCHED;
            PG8_STAGE(PG8_SB(0, 1), b2 + hstep, voffB);
            PG8_WAIT_V(6); PG8_BAR; PG8_MMA(1, 1, At, B1); PG8_BAR;
            PG8_LDB(B0, 1, 0); PG8_SCHED; PG8_LDA(At, 1, 0); PG8_STAGE(PG8_SA(0, 1), a2 + hstep, voffA);
            PG8_WAIT_L(8); PG8_BAR; PG8_WAIT_L(0); PG8_MMA(0, 0, At, B0); PG8_BAR; PG8_SCHED;
            PG8_LDB(B1, 1, 1); PG8_STAGE(PG8_SB(1, 0), b3, voffB);
            PG8_BAR; PG8_WAIT_L(0); PG8_MMA(0, 1, At, B1); PG8_BAR;
            PG8_LDA(At, 1, 1); PG8_STAGE(PG8_SA(1, 0), a3, voffA);
            PG8_BAR; PG8_WAIT_L(0); PG8_MMA(1, 0, At, B0); PG8_BAR; PG8_SCHED;
            PG8_STAGE(PG8_SB(1, 1), b3 + hstep, voffB);
            PG8_WAIT_V(6); PG8_BAR; PG8_MMA(1, 1, At, B1); PG8_BAR;
            }
        }
        if constexpr (ALIGN_EPI) { if (wr == 0) PG8_BAR; }
        if constexpr (!Epi::AFTER_DRAIN) { E(acc, cur, wr, wc, fr, fq); S.done(cur); }
        if (!has_next) break;
#pragma unroll
        for (int a = 0; a < 2; ++a)
#pragma unroll
            for (int b = 0; b < 2; ++b)
#pragma unroll
                for (int m = 0; m < 4; ++m)
#pragma unroll
                    for (int n = 0; n < 2; ++n) acc[a][b][m][n] = (f32x4){0.f, 0.f, 0.f, 0.f};
        cur = nxt; cA = nA; cB = nB; ++ui;
        if constexpr (ALIGN_EPI) { if (wr == 1) PG8_BAR; }
    }
    PG8_WAIT_V(0);
    if constexpr (!ALIGN_EPI) { if (wr == 0) PG8_BAR; }
    PG8_BAR;
    if constexpr (Epi::AFTER_DRAIN) { E.fused(acc, cur, wr, wc, fr, fq, lds, wid, lane); S.done(cur); }
#undef PG8_SA
#undef PG8_SB
#undef PG8_STAGE
#undef PG8_LDA
#undef PG8_LDB
#undef PG8_MMA
#undef PG8_WAIT_V
#undef PG8_WAIT_L
#undef PG8_BAR
#undef PG8_SCHED
}
}
constexpr int NWAVES = 8;
constexpr int MP = 16384, MS = 256, MT = MP + MS;
constexpr int DM = 1024, NU = 2048, FF = 2816;
constexpr int U_GQ = 0, U_GK = 256, U_GV = 512, U_GG = 1024, U_GA = 1536, U_MQ = 1552, U_MKV = 1808, U_MKR = 1936, IN_COLS = 1968;
constexpr float EPSN = 1e-6f;
constexpr float QSCALE = 0.10206207261596575f * 1.4426950408889634f;
constexpr size_t O_YP = 0, O_YS = 16777216, O_CKVP = 17039360, O_KRP = 19136512, O_GLAP = 19660800, O_CONVP = 19922944, O_CKVS = 19968000, O_KRS = 20000768, O_GLAS = 20008960, O_CONVS = 21057536, O_END = 21237760;
constexpr size_t MiB = 1u << 20;
constexpr size_t WS_CTL = 0, CTL_ZERO_BYTES = 1 * MiB;
constexpr size_t WS_WIN = 2 * MiB, WS_WQUP = 6 * MiB, WS_WKVUP = 6 * MiB + 512 * 1024, WS_WPP = 7 * MiB, WS_WO = 8 * MiB, WS_WPG = 10 * MiB, WS_WGU = 12 * MiB, WS_WD = 24 * MiB;
constexpr size_t WS_ROPE = 30 * MiB, WS_RS1 = 31 * MiB, WS_XB = 32 * MiB, WS_PB = 65 * MiB, WS_U = 74 * MiB, WS_PP = 139 * MiB, WS_LA = 172 * MiB, WS_QM = 189 * MiB, WS_KM = 214 * MiB, WS_VM = 239 * MiB;
constexpr size_t WS_AO = 256 * MiB, WS_H = 289 * MiB, WS_HB = 354 * MiB, WS_A = 387 * MiB, WS_C = 477 * MiB, WS_G = 567 * MiB, WS_H2B = 657 * MiB, WS_PART = 690 * MiB, WS_END = 700 * MiB;
constexpr int CW_BAR = 4096, CW_RSQ2 = 16384, CW_RSQ3 = 16384 + 16640;
static_assert((CW_RSQ3 + 16640) * 4 <= (int)CTL_ZERO_BYTES, "ctl");
constexpr int RING_BYTES = 131072, LDSCTL_OFF = RING_BYTES, MISC_OFF = LDSCTL_OFF + 320, LDS_BYTES = 147456;

#define GAS __attribute__((address_space(1)))
#define LAS __attribute__((address_space(3)))
typedef unsigned short bf16;
typedef unsigned v4u __attribute__((ext_vector_type(4)));
typedef float f32x4 __attribute__((ext_vector_type(4)));
typedef short bf16x8 __attribute__((ext_vector_type(8)));
typedef GAS unsigned gu32;
typedef GAS unsigned long long gu64;
#define RLX_AGENT __ATOMIC_RELAXED, __HIP_MEMORY_SCOPE_AGENT
#define LDS_WAIT() asm volatile("s_waitcnt lgkmcnt(0)" ::: "memory")
#define VM_WAIT() asm volatile("s_waitcnt vmcnt(0)" ::: "memory")
__device__ __forceinline__ unsigned long long rt() { return __builtin_amdgcn_s_memrealtime(); }
__device__ __forceinline__ unsigned f2bf(float f) { unsigned u = __builtin_bit_cast(unsigned, f); return (u + 0x7fffu + ((u >> 16) & 1u)) >> 16; }
__device__ __forceinline__ unsigned pk2(float lo, float hi) { return f2bf(lo) | (f2bf(hi) << 16); }
#define XB_TMO      128
#define XB_XCNT(j)  (256  + 64 * (j))
#define XB_XSUB(j)  (1280 + 64 * (j))
#define XB_XGEN(j)  (2304 + 64 * (j))
#define XB_TOP      3328
#define XB_TOPGEN   3392
#define XCD_BAR_WORDS 3456
#define XB_SPIN_CAP (1u << 18)

__device__ __forceinline__ unsigned xb_ld(unsigned* p)              { return __hip_atomic_load(p, __ATOMIC_RELAXED, __HIP_MEMORY_SCOPE_AGENT); }
__device__ __forceinline__ unsigned xb_add(unsigned* p, unsigned v) { return __hip_atomic_fetch_add(p, v, __ATOMIC_RELAXED, __HIP_MEMORY_SCOPE_AGENT); }
__device__ __forceinline__ unsigned xb_xcc_id() { return (unsigned)__builtin_amdgcn_s_getreg((3 << 11) | 20) & 0xFu; }
#define XB_SPIN(cond, bar) do { unsigned _sp = 0; while (cond) { __builtin_amdgcn_s_sleep(1); \
    if ((++_sp & 255u) == 0u) { if (xb_ld(&(bar)[XB_TMO])) break; if (_sp > XB_SPIN_CAP) { atomicAdd(&(bar)[XB_TMO], 1u); break; } } } } while (0)

struct XcdBarrier {
    unsigned* bar; unsigned x;
    volatile LAS unsigned* st;
};

__device__ __forceinline__ XcdBarrier xcd_barrier_post(unsigned* bar, volatile LAS unsigned* st) {
    XcdBarrier b; b.bar = bar; b.x = xb_xcc_id(); b.st = st;
    if (threadIdx.x == 0) (void)xb_add(&bar[XB_XCNT(b.x)], 1u);
    return b;
}
__device__ __forceinline__ void xcd_barrier_complete(unsigned* bar, unsigned x, unsigned& nloc, unsigned& nx) {
    const unsigned G = gridDim.x * gridDim.y * gridDim.z;
    unsigned sum, cnt, mine, sp = 0u;
    for (;;) {
        sum = 0u; cnt = 0u; mine = 0u;
#pragma unroll
        for (unsigned j = 0; j < 16; ++j) { const unsigned c = xb_ld(&bar[XB_XCNT(j)]); sum += c; cnt += (c > 0u) ? 1u : 0u; mine = (j == x) ? c : mine; }
        if (sum == G) break;
        __builtin_amdgcn_s_sleep(1);
        if ((++sp & 255u) == 0u) { if (xb_ld(&bar[XB_TMO])) break; if (sp > XB_SPIN_CAP) { atomicAdd(&bar[XB_TMO], 1u); break; } }
    }
    nloc = mine > 0u ? mine : 1u; nx = cnt > 0u ? cnt : 1u;
}

__device__ __forceinline__ void xcd_barrier(const XcdBarrier& b) {
    asm volatile("s_waitcnt vmcnt(0)" ::: "memory");
    __syncthreads();
    if (threadIdx.x == 0) {
        unsigned* bar = b.bar;
        __builtin_amdgcn_s_waitcnt(0);
        unsigned nloc = b.st[0], nx = b.st[1];
        if (nloc == 0u) { xcd_barrier_complete(bar, b.x, nloc, nx); b.st[0] = nloc; b.st[1] = nx; }
        const unsigned old = xb_add(&bar[XB_XSUB(b.x)], 1u);
        const unsigned gen = old / nloc;
        if (old + 1u == (gen + 1u) * nloc) {
            __builtin_amdgcn_fence(__ATOMIC_RELEASE, "agent");
            asm volatile("s_waitcnt vmcnt(0)" ::: "memory");
            const unsigned og = xb_add(&bar[XB_TOP], 1u);
            const unsigned tg = og / nx;
            if (og + 1u == (tg + 1u) * nx) xb_add(&bar[XB_TOPGEN], 1u);
            else XB_SPIN(xb_ld(&bar[XB_TOPGEN]) == tg, bar);
            __builtin_amdgcn_fence(__ATOMIC_ACQUIRE, "agent");
            xb_add(&bar[XB_XGEN(b.x)], 1u);
            asm volatile("s_waitcnt vmcnt(0)" ::: "memory");
        } else {
            XB_SPIN(xb_ld(&bar[XB_XGEN(b.x)]) == gen, bar);
            __builtin_amdgcn_fence(__ATOMIC_ACQUIRE, "agent");
            asm volatile("s_waitcnt vmcnt(0)" ::: "memory");
        }
    }
    __syncthreads();
}
typedef unsigned u32x2 __attribute__((ext_vector_type(2)));
typedef float f32x2 __attribute__((ext_vector_type(2)));
__device__ __forceinline__ float blo(unsigned w) { return __builtin_bit_cast(float, w << 16); }
__device__ __forceinline__ float bhi(unsigned w) { return __builtin_bit_cast(float, w & 0xffff0000u); }
__device__ __forceinline__ float bf1(bf16 b) { return __builtin_bit_cast(float, (unsigned)b << 16); }
__device__ __forceinline__ float rbf(float f) { return __builtin_bit_cast(float, f2bf(f) << 16); }
__device__ __forceinline__ float wave_sum(float v) {
#pragma unroll
    for (int o = 1; o < 64; o <<= 1) v += __shfl_xor(v, o);
    return v;
}
__device__ __forceinline__ float wave_max(float v) {
#pragma unroll
    for (int o = 1; o < 64; o <<= 1) v = fmaxf(v, __shfl_xor(v, o));
    return v;
}
__device__ __forceinline__ float dot8(v4u w, f32x4 x0, f32x4 x1) {
    return (blo(w.x) * x0[0] + bhi(w.x) * x0[1]) + (blo(w.y) * x0[2] + bhi(w.y) * x0[3]) + (blo(w.z) * x1[0] + bhi(w.z) * x1[1]) + (blo(w.w) * x1[2] + bhi(w.w) * x1[3]);
}
__device__ __forceinline__ float silu_f(float x) { return x / (1.0f + __expf(-x)); }

struct Args { const void* in[32]; float* out; unsigned char* ws; int ph_lo, ph_hi; };

__device__ __forceinline__ void transpose_item(const float* W, int K, int N, const float* gk, bf16* WT, int mode, LAS float* scr, int item, int lane) {
    const int nblk = (N + 31) / 32, kb = item / nblk, nb = item % nblk, k0 = 64 * kb, n0 = 32 * nb;
    const int nn = n0 + (lane & 31);
#pragma unroll 8
    for (int i = 0; i < 32; ++i) { const int kk = 2 * i + (lane >> 5); float v = (nn < N) ? W[(size_t)(k0 + kk) * N + nn] : 0.f; if (gk) v *= gk[k0 + kk]; scr[kk * 33 + (lane & 31)] = v; }
    LDS_WAIT(); asm volatile("" ::: "memory");
    const int c = lane & 7;
#pragma unroll
    for (int j = 0; j < 4; ++j) { const int nl = (lane >> 3) + 8 * j, n = n0 + nl; const LAS float* s = scr + (8 * c) * 33 + nl;
        v4u o; o.x = pk2(s[0 * 33], s[1 * 33]); o.y = pk2(s[2 * 33], s[3 * 33]); o.z = pk2(s[4 * 33], s[5 * 33]); o.w = pk2(s[6 * 33], s[7 * 33]);
        const int row = (mode == 0) ? n : ((n >> 7) * 256 + (n & 127) + (mode == 2 ? 128 : 0));
        if (n < N) *(GAS v4u*)(WT + (size_t)row * K + k0 + 8 * c) = o; }
    LDS_WAIT(); asm volatile("" ::: "memory");
}
__device__ __forceinline__ void prep_phase(const Args& a, LAS unsigned char* lds, int gw, int NGW, int wave, int lane) {
    unsigned char* ws = a.ws;
    LAS float* scr = (LAS float*)(lds + wave * 16384);
    constexpr int I_IN = 16 * 62, I_QUP = 4 * 24, I_KV = 2 * 32, I_O = 16 * 32, I_G = 16 * 88, I_D = 44 * 32, I_PG = 16 * 32, I_PP = 4 * 32;
    constexpr int NITEMS = I_IN + I_QUP + I_KV + I_O + 2 * I_G + I_D + I_PG + I_PP;
    for (int it = gw; it < NITEMS; it += NGW) {
        int r = it;
        if (r < I_IN) { transpose_item((const float*)a.in[10], 1024, IN_COLS, (const float*)a.in[9], (bf16*)(ws + WS_WIN), 0, scr, r, lane); continue; } r -= I_IN;
        if (r < I_QUP) { transpose_item((const float*)a.in[15], 256, 768, (const float*)a.in[14], (bf16*)(ws + WS_WQUP), 0, scr, r, lane); continue; } r -= I_QUP;
        if (r < I_KV) { transpose_item((const float*)a.in[20], 128, 1024, nullptr, (bf16*)(ws + WS_WKVUP), 0, scr, r, lane); continue; } r -= I_KV;
        if (r < I_O) { transpose_item((const float*)a.in[22], 1024, 1024, nullptr, (bf16*)(ws + WS_WO), 0, scr, r, lane); continue; } r -= I_O;
        if (r < I_G) { transpose_item((const float*)a.in[24], 1024, FF, (const float*)a.in[23], (bf16*)(ws + WS_WGU), 1, scr, r, lane); continue; } r -= I_G;
        if (r < I_G) { transpose_item((const float*)a.in[25], 1024, FF, (const float*)a.in[23], (bf16*)(ws + WS_WGU), 2, scr, r, lane); continue; } r -= I_G;
        if (r < I_D) { transpose_item((const float*)a.in[28], FF, 1024, nullptr, (bf16*)(ws + WS_WD), 0, scr, r, lane); continue; } r -= I_D;
        if (r < I_PG) { transpose_item((const float*)a.in[30], 1024, 1024, (const float*)a.in[29], (bf16*)(ws + WS_WPG), 0, scr, r, lane); continue; } r -= I_PG;
        transpose_item((const float*)a.in[31], 256, 1024, nullptr, (bf16*)(ws + WS_WPP), 0, scr, r, lane);
    }
    const int gt = gw * 64 + lane, NGT = NGW * 64;
    for (int i = gt; i < 80 * 1024 / 8; i += NGT) ((GAS v4u*)(ws + WS_WIN + (size_t)IN_COLS * 1024 * 2))[i] = (v4u){0u, 0u, 0u, 0u};
    for (int i = gt; i < 2056 * 16; i += NGT) {
        const int pidx = i >> 4, d = i & 15; const int pos = pidx < 2048 ? pidx : 16384 + (pidx - 2048);
        double inv = 1.0; for (int k = 0; k < d; ++k) inv *= 0.56234132519034908;
        const float ang = (float)pos * (float)inv;
        const double turns = (double)ang * 0.15915494309189535; const double fr = turns - __builtin_floor(turns);
        f32x2 cs; cs.x = __builtin_amdgcn_cosf((float)fr); cs.y = __builtin_amdgcn_sinf((float)fr);
        ((GAS f32x2*)(ws + WS_ROPE))[i] = cs;
    }
    bf16* XB = (bf16*)(ws + WS_XB); float* RS1 = (float*)(ws + WS_RS1); bf16* PB = (bf16*)(ws + WS_PB);
    for (int m = gw; m < MT; m += NGW) {
        const float* xrow = (m < MP) ? (const float*)a.in[0] + (size_t)m * DM : (const float*)a.in[1] + (size_t)(m - MP) * DM;
        const GAS f32x4* xr = (const GAS f32x4*)xrow + lane;
        f32x4 v[4]; float s = 0.f;
#pragma unroll
        for (int j = 0; j < 4; ++j) { v[j] = xr[64 * j]; s += (v[j].x * v[j].x + v[j].y * v[j].y) + (v[j].z * v[j].z + v[j].w * v[j].w); }
        s = wave_sum(s);
        GAS unsigned long long* o8 = (GAS unsigned long long*)(XB + (size_t)m * DM) + lane;
#pragma unroll
        for (int j = 0; j < 4; ++j) o8[64 * j] = (unsigned long long)pk2(v[j].x, v[j].y) | ((unsigned long long)pk2(v[j].z, v[j].w) << 32);
        if (lane == 0) RS1[m] = 1.0f / sqrtf(s * (1.0f / DM) + EPSN);
        const float* prow = (m < MP) ? (const float*)a.in[7] + (size_t)m * 256 : (const float*)a.in[8] + (size_t)(m - MP) * 256;
        const f32x4 pv = ((const GAS f32x4*)prow)[lane];
        ((GAS unsigned long long*)(PB + (size_t)m * 256))[lane] = (unsigned long long)pk2(pv.x, pv.y) | ((unsigned long long)pk2(pv.z, pv.w) << 32);
    }
}

__device__ __forceinline__ void post1_naive(const Args& a, LAS unsigned char* lds, int gw, int NGW, int wave, int lane) {
    unsigned char* ws = a.ws;
    LAS float* scr = (LAS float*)(lds + wave * 16384);
    LAS float* mqs = scr; LAS float* qs = scr + 256; LAS float* cs = scr + 1024; LAS float* kvs = scr + 1152;
    const bf16* U = (const bf16*)(ws + WS_U); const bf16* WqupT = (const bf16*)(ws + WS_WQUP); const bf16* WkvT = (const bf16*)(ws + WS_WKVUP);
    const f32x2* ROPE = (const f32x2*)(ws + WS_ROPE);
    bf16* QM = (bf16*)(ws + WS_QM); bf16* KM = (bf16*)(ws + WS_KM); bf16* VM = (bf16*)(ws + WS_VM); float* LA = (float*)(ws + WS_LA);
    const float* g_qn = (const float*)a.in[16]; const float* g_qr = (const float*)a.in[17]; const float* g_kva = (const float*)a.in[18]; const float* g_kr = (const float*)a.in[19]; const float* g_kn = (const float*)a.in[21];
    const float* w_a2 = (const float*)a.in[11]; const float* b_a = (const float*)a.in[12];
    const int head = lane >> 3, part = lane & 7;
    for (int m = gw; m < MT; m += NGW) {
        const bf16* Urow = U + (size_t)m * NU;
        const int pidx = (m < MP) ? (m & 2047) : 2048 + ((m - MP) & 7);
        { const u32x2 raw = *(const u32x2*)(Urow + U_MQ + 4 * lane);
          const float q0 = blo(raw.x), q1 = bhi(raw.x), q2 = blo(raw.y), q3 = bhi(raw.y);
          const float ss = wave_sum((q0 * q0 + q1 * q1) + (q2 * q2 + q3 * q3)); const float rs_q = 1.0f / sqrtf(ss * (1.0f / 256.0f) + EPSN);
          *(LAS f32x4*)(mqs + 4 * lane) = (f32x4){q0, q1, q2, q3};
          LDS_WAIT(); asm volatile("" ::: "memory");
          for (int i = 0; i < 12; ++i) { const int n = lane + 64 * i; const bf16* wrow = WqupT + (size_t)n * 256; float acc = 0.f;
#pragma unroll 4
              for (int k = 0; k < 256; k += 8) acc += dot8(*(const v4u*)(wrow + k), *(const LAS f32x4*)(mqs + k), *(const LAS f32x4*)(mqs + k + 4));
              qs[n] = acc * rs_q; }
          LDS_WAIT(); asm volatile("" ::: "memory");
          float nv[8], ssn = 0.f;
#pragma unroll
          for (int i = 0; i < 8; ++i) { nv[i] = qs[96 * head + part * 8 + i]; ssn += nv[i] * nv[i]; }
          ssn += __shfl_xor(ssn, 1); ssn += __shfl_xor(ssn, 2); ssn += __shfl_xor(ssn, 4);
          const float rn = QSCALE / sqrtf(ssn * (1.0f / 64.0f) + EPSN);
          v4u o; o.x = pk2(nv[0] * rn * g_qn[part * 8 + 0], nv[1] * rn * g_qn[part * 8 + 1]); o.y = pk2(nv[2] * rn * g_qn[part * 8 + 2], nv[3] * rn * g_qn[part * 8 + 3]);
          o.z = pk2(nv[4] * rn * g_qn[part * 8 + 4], nv[5] * rn * g_qn[part * 8 + 5]); o.w = pk2(nv[6] * rn * g_qn[part * 8 + 6], nv[7] * rn * g_qn[part * 8 + 7]);
          *(v4u*)(QM + ((size_t)m * 8 + head) * 96 + part * 8) = o;
          float rv[4], ssr = 0.f;
#pragma unroll
          for (int i = 0; i < 4; ++i) { rv[i] = qs[96 * head + 64 + part * 4 + i]; ssr += rv[i] * rv[i]; }
          ssr += __shfl_xor(ssr, 1); ssr += __shfl_xor(ssr, 2); ssr += __shfl_xor(ssr, 4);
          const float rr = QSCALE / sqrtf(ssr * (1.0f / 32.0f) + EPSN);
          float ov[4];
#pragma unroll
          for (int i = 0; i < 4; ++i) { const float x = rv[i] * rr * g_qr[part * 4 + i]; const float y = __shfl_xor(x, 4);
              const int d = (part & 3) * 4 + i; const f32x2 c = ROPE[pidx * 16 + d];
              ov[i] = (part < 4) ? (x * c.x - y * c.y) : (x * c.x + y * c.y); }
          u32x2 ow; ow.x = pk2(ov[0], ov[1]); ow.y = pk2(ov[2], ov[3]);
          *(u32x2*)(QM + ((size_t)m * 8 + head) * 96 + 64 + part * 4) = ow; }
        { const unsigned raw = *(const unsigned*)(Urow + U_MKV + 2 * lane); const float c0 = blo(raw), c1 = bhi(raw);
          const float ss = wave_sum(c0 * c0 + c1 * c1); const float rs = 1.0f / sqrtf(ss * (1.0f / 128.0f) + EPSN);
          const float k0 = c0 * rs * g_kva[2 * lane], k1 = c1 * rs * g_kva[2 * lane + 1];
          float* ck = (m < MP) ? a.out + O_CKVP + (size_t)m * 128 : a.out + O_CKVS + (size_t)(m - MP) * 128;
          *(f32x2*)(ck + 2 * lane) = (f32x2){k0, k1};
          *(LAS f32x2*)(cs + 2 * lane) = (f32x2){rbf(k0), rbf(k1)};
          LDS_WAIT(); asm volatile("" ::: "memory");
          for (int i = 0; i < 16; ++i) { const int n = lane + 64 * i; const bf16* wrow = WkvT + (size_t)n * 128; float acc = 0.f;
#pragma unroll 4
              for (int k = 0; k < 128; k += 8) acc += dot8(*(const v4u*)(wrow + k), *(const LAS f32x4*)(cs + k), *(const LAS f32x4*)(cs + k + 4));
              kvs[n] = acc; }
          LDS_WAIT(); asm volatile("" ::: "memory");
          float nv[8], ssn = 0.f;
#pragma unroll
          for (int i = 0; i < 8; ++i) { nv[i] = kvs[128 * head + part * 8 + i]; ssn += nv[i] * nv[i]; }
          ssn += __shfl_xor(ssn, 1); ssn += __shfl_xor(ssn, 2); ssn += __shfl_xor(ssn, 4);
          const float rk = 1.0f / sqrtf(ssn * (1.0f / 64.0f) + EPSN);
          v4u o; o.x = pk2(nv[0] * rk * g_kn[part * 8 + 0], nv[1] * rk * g_kn[part * 8 + 1]); o.y = pk2(nv[2] * rk * g_kn[part * 8 + 2], nv[3] * rk * g_kn[part * 8 + 3]);
          o.z = pk2(nv[4] * rk * g_kn[part * 8 + 4], nv[5] * rk * g_kn[part * 8 + 5]); o.w = pk2(nv[6] * rk * g_kn[part * 8 + 6], nv[7] * rk * g_kn[part * 8 + 7]);
          *(v4u*)(KM + ((size_t)m * 8 + head) * 96 + part * 8) = o;
          float vv[8];
#pragma unroll
          for (int i = 0; i < 8; ++i) vv[i] = kvs[128 * head + 64 + part * 8 + i];
          o.x = pk2(vv[0], vv[1]); o.y = pk2(vv[2], vv[3]); o.z = pk2(vv[4], vv[5]); o.w = pk2(vv[6], vv[7]);
          *(v4u*)(VM + ((size_t)m * 8 + head) * 64 + part * 8) = o; }
        { float x = (lane < 32) ? bf1(Urow[U_MKR + (lane & 31)]) : 0.f;
          const float ss = wave_sum(x * x); const float rs = 1.0f / sqrtf(ss * (1.0f / 32.0f) + EPSN);
          x = x * rs * g_kr[lane & 31]; const float y = __shfl_xor(x, 16);
          const f32x2 c = ROPE[pidx * 16 + (lane & 15)];
          const float o = (lane & 16) ? (x * c.x + y * c.y) : (x * c.x - y * c.y);
          if (lane < 32) { float* kr = (m < MP) ? a.out + O_KRP + (size_t)m * 32 : a.out + O_KRS + (size_t)(m - MP) * 32; kr[lane] = o;
              const bf16 ob = (bf16)f2bf(o);
#pragma unroll
              for (int h = 0; h < 8; ++h) KM[((size_t)m * 8 + h) * 96 + 64 + lane] = ob; } }
        { const v4u g0 = *(const v4u*)(Urow + U_GA), g1 = *(const v4u*)(Urow + U_GA + 8);
          const float ga[16] = {blo(g0.x), bhi(g0.x), blo(g0.y), bhi(g0.y), blo(g0.z), bhi(g0.z), blo(g0.w), bhi(g0.w), blo(g1.x), bhi(g1.x), blo(g1.y), bhi(g1.y), blo(g1.z), bhi(g1.z), blo(g1.w), bhi(g1.w)};
          f32x4 z = *(const f32x4*)(b_a + 4 * lane);
#pragma unroll
          for (int r = 0; r < 16; ++r) z += ga[r] * *(const f32x4*)(w_a2 + r * 256 + 4 * lane);
          f32x4 o;
#pragma unroll
          for (int j = 0; j < 4; ++j) o[j] = (fminf(z[j], 0.f) - __logf(1.0f + __expf(-fabsf(z[j])))) * (1.0f / 16.0f);
          *(f32x4*)(LA + (size_t)m * 256 + 4 * lane) = o; }
        LDS_WAIT(); asm volatile("" ::: "memory");
    }
}
__device__ __forceinline__ void attn_prompt_naive(const Args& a, LAS unsigned char* lds, int gw, int NGW, int wave, int lane) {
    unsigned char* ws = a.ws;
    LAS float* scr = (LAS float*)(lds + wave * 16384);
    LAS float* qs = scr; LAS float* ps = scr + 128;
    const bf16* QM = (const bf16*)(ws + WS_QM); const bf16* KM = (const bf16*)(ws + WS_KM); const bf16* VM = (const bf16*)(ws + WS_VM); bf16* AO = (bf16*)(ws + WS_AO);
    const int ksub = lane >> 3, dg = lane & 7;
    for (int i = 0; i < 64 * 2048 / NGW; ++i) {
        const int idx = i * NGW + gw; const int bh = idx >> 11; const int tt = idx & 2047; const int t = (bh & 1) ? (2047 - tt) : tt;
        const int b = bh >> 3, h = bh & 7; const size_t row = (size_t)b * 2048 + t;
        if (lane < 12) { const v4u w = *(const v4u*)(QM + (row * 8 + h) * 96 + lane * 8);
            *(LAS f32x4*)(qs + lane * 8) = (f32x4){blo(w.x), bhi(w.x), blo(w.y), bhi(w.y)}; *(LAS f32x4*)(qs + lane * 8 + 4) = (f32x4){blo(w.z), bhi(w.z), blo(w.w), bhi(w.w)}; }
        LDS_WAIT(); asm volatile("" ::: "memory");
        float mrun = -1e30f, lrun = 0.f; float o[8];
#pragma unroll
        for (int j = 0; j < 8; ++j) o[j] = 0.f;
        const int ntile = (t >> 6) + 1;
        for (int kt = 0; kt < ntile; ++kt) {
            const int key = kt * 64 + lane; const bf16* krow = KM + (((size_t)b * 2048 + key) * 8 + h) * 96;
            float s = 0.f;
#pragma unroll
            for (int c = 0; c < 12; ++c) s += dot8(*(const v4u*)(krow + c * 8), *(const LAS f32x4*)(qs + c * 8), *(const LAS f32x4*)(qs + c * 8 + 4));
            if (key > t) s = -1e30f;
            const float mnew = fmaxf(mrun, wave_max(s)); const float alpha = __builtin_amdgcn_exp2f(mrun - mnew); const float p = (key > t) ? 0.f : __builtin_amdgcn_exp2f(s - mnew);
            lrun = lrun * alpha + wave_sum(p); mrun = mnew;
            ps[lane] = p;
            LDS_WAIT(); asm volatile("" ::: "memory");
#pragma unroll
            for (int j = 0; j < 8; ++j) o[j] *= alpha;
#pragma unroll
            for (int ii = 0; ii < 8; ++ii) { const int kl = 8 * ii + ksub; const float pv = ps[kl];
                const v4u w = *(const v4u*)(VM + (((size_t)b * 2048 + kt * 64 + kl) * 8 + h) * 64 + dg * 8);
                o[0] += pv * blo(w.x); o[1] += pv * bhi(w.x); o[2] += pv * blo(w.y); o[3] += pv * bhi(w.y); o[4] += pv * blo(w.z); o[5] += pv * bhi(w.z); o[6] += pv * blo(w.w); o[7] += pv * bhi(w.w); }
            LDS_WAIT(); asm volatile("" ::: "memory");
        }
        const float rl = 1.0f / lrun;
#pragma unroll
        for (int j = 0; j < 8; ++j) { o[j] += __shfl_xor(o[j], 8); o[j] += __shfl_xor(o[j], 16); o[j] += __shfl_xor(o[j], 32); o[j] *= rl; }
        if (ksub == 0) { v4u w; w.x = pk2(o[0], o[1]); w.y = pk2(o[2], o[3]); w.z = pk2(o[4], o[5]); w.w = pk2(o[6], o[7]);
            *(v4u*)(AO + row * 1024 + 512 + h * 64 + dg * 8) = w; }
    }
}

__device__ __forceinline__ void decode_item_naive(const Args& a, LAS unsigned char* lds, int item, int wave, int lane) {
    unsigned char* ws = a.ws; const int tid = threadIdx.x;
    const int bs = item >> 3, grp = item & 7, h = wave;
    LAS float* Cs = (LAS float*)lds;
    LAS float* Rs = Cs + 128 * 129;
    LAS float* wsc = Rs + 128 * 33 + wave * 1280;
    LAS float* qg = wsc; LAS float* qr = wsc + 512; LAS float* Ps = wsc + 768;
    const bf16* QM = (const bf16*)(ws + WS_QM);
    const float* g_kn = (const float*)a.in[21]; const float* Wkv = (const float*)a.in[20];
    const float* cache_c = (const float*)a.in[2]; const float* cache_r = (const float*)a.in[3]; const int* ptab = (const int*)a.in[6];
    for (int i = lane; i < 8 * 96; i += 64) { const int t = i / 96, d = i % 96; const float q = bf1(QM[(((size_t)(MP + bs * 8 + t)) * 8 + h) * 96 + d]);
        if (d < 64) qg[t * 64 + d] = q * g_kn[d]; else qr[t * 32 + (d - 64)] = q; }
    float mrun[8], lrun[8], O0[8], O1[8];
#pragma unroll
    for (int t = 0; t < 8; ++t) { mrun[t] = -1e30f; lrun[t] = 0.f; O0[t] = 0.f; O1[t] = 0.f; }
    for (int pg = 0; pg < 16; ++pg) {
        const int phys = ptab[bs * 128 + grp * 16 + pg];
        __syncthreads();
        { const f32x4* src = (const f32x4*)(cache_c + (size_t)phys * 128 * 128);
#pragma unroll
          for (int i = 0; i < 8; ++i) { const int e = (i * 512 + tid) * 4; const int key = e >> 7, c = e & 127; const f32x4 v = src[i * 512 + tid];
              LAS float* d = Cs + key * 129 + c; d[0] = v.x; d[1] = v.y; d[2] = v.z; d[3] = v.w; }
          const f32x4* srcr = (const f32x4*)(cache_r + (size_t)phys * 128 * 32);
#pragma unroll
          for (int i = 0; i < 2; ++i) { const int e = (i * 512 + tid) * 4; const int key = e >> 5, c = e & 31; const f32x4 v = srcr[i * 512 + tid];
              LAS float* d = Rs + key * 33 + c; d[0] = v.x; d[1] = v.y; d[2] = v.z; d[3] = v.w; } }
        __syncthreads();
        for (int pass = 0; pass < 2; ++pass) {
            const int key = pass * 64 + lane;
            float acc[64];
#pragma unroll
            for (int j = 0; j < 64; ++j) acc[j] = 0.f;
            for (int c = 0; c < 128; ++c) { const float x = Cs[key * 129 + c]; const float* wrow = Wkv + (size_t)c * 1024 + h * 128;
#pragma unroll
                for (int j = 0; j < 64; ++j) acc[j] += x * wrow[j]; }
            float ss = 0.f;
#pragma unroll
            for (int j = 0; j < 64; ++j) ss += acc[j] * acc[j];
            const float r = 1.0f / sqrtf(ss * (1.0f / 64.0f) + EPSN);
            float s[8];
#pragma unroll
            for (int t = 0; t < 8; ++t) s[t] = 0.f;
#pragma unroll
            for (int j4 = 0; j4 < 16; ++j4)
#pragma unroll
                for (int t = 0; t < 8; ++t) { const f32x4 q = *(const LAS f32x4*)(qg + t * 64 + 4 * j4); s[t] += (acc[4 * j4] * q[0] + acc[4 * j4 + 1] * q[1]) + (acc[4 * j4 + 2] * q[2] + acc[4 * j4 + 3] * q[3]); }
#pragma unroll
            for (int t = 0; t < 8; ++t) s[t] *= r;
#pragma unroll
            for (int i4 = 0; i4 < 8; ++i4) { const float r0 = Rs[key * 33 + 4 * i4], r1 = Rs[key * 33 + 4 * i4 + 1], r2 = Rs[key * 33 + 4 * i4 + 2], r3 = Rs[key * 33 + 4 * i4 + 3];
#pragma unroll
                for (int t = 0; t < 8; ++t) { const f32x4 q = *(const LAS f32x4*)(qr + t * 32 + 4 * i4); s[t] += (r0 * q[0] + r1 * q[1]) + (r2 * q[2] + r3 * q[3]); } }
            float alpha[8];
#pragma unroll
            for (int t = 0; t < 8; ++t) { const float mnew = fmaxf(mrun[t], wave_max(s[t])); alpha[t] = __builtin_amdgcn_exp2f(mrun[t] - mnew); const float p = __builtin_amdgcn_exp2f(s[t] - mnew);
                lrun[t] = lrun[t] * alpha[t] + wave_sum(p); mrun[t] = mnew; Ps[lane * 8 + t] = p; O0[t] *= alpha[t]; O1[t] *= alpha[t]; }
            LDS_WAIT(); asm volatile("" ::: "memory");
            for (int k = 0; k < 64; ++k) { const f32x4 p0 = *(const LAS f32x4*)(Ps + k * 8), p1 = *(const LAS f32x4*)(Ps + k * 8 + 4);
                const float c0 = Cs[(pass * 64 + k) * 129 + lane], c1 = Cs[(pass * 64 + k) * 129 + 64 + lane];
                O0[0] += p0[0] * c0; O0[1] += p0[1] * c0; O0[2] += p0[2] * c0; O0[3] += p0[3] * c0; O0[4] += p1[0] * c0; O0[5] += p1[1] * c0; O0[6] += p1[2] * c0; O0[7] += p1[3] * c0;
                O1[0] += p0[0] * c1; O1[1] += p0[1] * c1; O1[2] += p0[2] * c1; O1[3] += p0[3] * c1; O1[4] += p1[0] * c1; O1[5] += p1[1] * c1; O1[6] += p1[2] * c1; O1[7] += p1[3] * c1; }
            LDS_WAIT(); asm volatile("" ::: "memory");
        }
    }
    float* part = (float*)(ws + WS_PART) + ((size_t)((bs * 8 + grp) * 8 + h) * 8) * 130;
#pragma unroll
    for (int t = 0; t < 8; ++t) { part[t * 130 + 2 + lane] = O0[t]; part[t * 130 + 66 + lane] = O1[t]; if (lane == 0) { part[t * 130] = mrun[t]; part[t * 130 + 1] = lrun[t]; } }
    __syncthreads();
}
__device__ __forceinline__ void decode_combine_naive(const Args& a, LAS unsigned char* lds, int gw, int NGW, int wave, int lane) {
    unsigned char* ws = a.ws;
    LAS float* ol = (LAS float*)(lds + wave * 16384);
    const bf16* QM = (const bf16*)(ws + WS_QM); const bf16* KM = (const bf16*)(ws + WS_KM); const bf16* VM = (const bf16*)(ws + WS_VM); bf16* AO = (bf16*)(ws + WS_AO);
    const float* Wkv = (const float*)a.in[20];
    for (int it = gw; it < 32 * 8 * 8; it += NGW) {
        const int bs = it >> 6, h = (it >> 3) & 7, t = it & 7; const size_t row = (size_t)MP + bs * 8 + t;
        float s = -1e30f;
        if (lane < 8 && lane <= t) { const bf16* qrow = QM + (row * 8 + h) * 96; const bf16* krow = KM + (((size_t)MP + bs * 8 + lane) * 8 + h) * 96; float acc = 0.f;
#pragma unroll
            for (int c = 0; c < 12; ++c) { const v4u q = *(const v4u*)(qrow + c * 8), k = *(const v4u*)(krow + c * 8);
                acc += (blo(q.x) * blo(k.x) + bhi(q.x) * bhi(k.x)) + (blo(q.y) * blo(k.y) + bhi(q.y) * bhi(k.y)) + (blo(q.z) * blo(k.z) + bhi(q.z) * bhi(k.z)) + (blo(q.w) * blo(k.w) + bhi(q.w) * bhi(k.w)); }
            s = acc; }
        const float mnew = wave_max(s); const float p = (lane < 8 && lane <= t) ? __builtin_amdgcn_exp2f(s - mnew) : 0.f; const float lnew = wave_sum(p);
        float onew = 0.f;
#pragma unroll
        for (int tp = 0; tp < 8; ++tp) { const float pp = __shfl(p, tp); onew += pp * bf1(VM[(((size_t)MP + bs * 8 + tp) * 8 + h) * 64 + lane]); }
        const float* part = (const float*)(ws + WS_PART) + ((size_t)(bs * 8 * 8 + h) * 8 + t) * 130;
        float mg[8], lg[8], mx = mnew;
#pragma unroll
        for (int g = 0; g < 8; ++g) { mg[g] = part[(size_t)g * 8 * 8 * 130]; lg[g] = part[(size_t)g * 8 * 8 * 130 + 1]; mx = fmaxf(mx, mg[g]); }
        const float wn = __builtin_amdgcn_exp2f(mnew - mx); float L = lnew * wn; float o0 = 0.f, o1 = 0.f;
#pragma unroll
        for (int g = 0; g < 8; ++g) { const float w = __builtin_amdgcn_exp2f(mg[g] - mx); L += lg[g] * w; o0 += w * part[(size_t)g * 8 * 8 * 130 + 2 + lane]; o1 += w * part[(size_t)g * 8 * 8 * 130 + 66 + lane]; }
        ol[lane] = o0; ol[64 + lane] = o1;
        LDS_WAIT(); asm volatile("" ::: "memory");
        float out = 0.f;
        for (int c = 0; c < 128; ++c) out += ol[c] * Wkv[(size_t)c * 1024 + h * 128 + 64 + lane];
        out = (out + wn * onew) / L;
        AO[row * 1024 + 512 + h * 64 + lane] = (bf16)f2bf(out);
        LDS_WAIT(); asm volatile("" ::: "memory");
    }
}

__device__ __forceinline__ void gla_item_naive(const Args& a, LAS unsigned char* lds, int item, int wave, int lane) {
    unsigned char* ws = a.ws; const int tid = threadIdx.x;
    const bool is_p = item < 32; const int seq = is_p ? (item >> 2) : ((item - 32) >> 2), h = item & 3;
    const int T = is_p ? 2048 : 8, CH = is_p ? 32 : 8; const size_t row0 = is_p ? (size_t)seq * 2048 : (size_t)MP + seq * 8;
    const bf16* U = (const bf16*)(ws + WS_U); const float* LA = (const float*)(ws + WS_LA); bf16* AO = (bf16*)(ws + WS_AO);
    const float* g_out = (const float*)a.in[13];
    LAS float* qs = (LAS float*)lds; LAS float* ks = qs + 2048; LAS float* as = ks + 2048; LAS float* vs = as + 2048; LAS float* op = vs + 4096;
    const int dv = tid & 127, dkg = tid >> 7;
    float S[16];
    if (is_p) {
#pragma unroll
        for (int i = 0; i < 16; ++i) S[i] = 0.f;
    } else { const float* s0 = (const float*)a.in[4] + ((size_t)seq * 4 + h) * 8192;
#pragma unroll
        for (int i = 0; i < 16; ++i) S[i] = s0[(16 * dkg + i) * 128 + dv]; }
    for (int c0 = 0; c0 < T; c0 += CH) {
        __syncthreads();
        for (int idx = tid; idx < CH * 64; idx += 512) { const int t = idx >> 6, d = idx & 63; const bf16* ur = U + (row0 + c0 + t) * NU;
            qs[idx] = bf1(ur[U_GQ + h * 64 + d]) * 0.125f; ks[idx] = bf1(ur[U_GK + h * 64 + d]); as[idx] = __expf(LA[(row0 + c0 + t) * 256 + h * 64 + d]); }
        for (int idx = tid; idx < CH * 128; idx += 512) { const int t = idx >> 7, d = idx & 127; vs[idx] = bf1(U[(row0 + c0 + t) * NU + U_GV + h * 128 + d]); }
        __syncthreads();
        for (int t = 0; t < CH; ++t) { const float v = vs[t * 128 + dv]; float part = 0.f;
#pragma unroll
            for (int i4 = 0; i4 < 4; ++i4) { const f32x4 av = *(const LAS f32x4*)(as + t * 64 + 16 * dkg + 4 * i4), kv = *(const LAS f32x4*)(ks + t * 64 + 16 * dkg + 4 * i4), qv = *(const LAS f32x4*)(qs + t * 64 + 16 * dkg + 4 * i4);
#pragma unroll
                for (int j = 0; j < 4; ++j) { S[4 * i4 + j] = av[j] * S[4 * i4 + j] + kv[j] * v; part += qv[j] * S[4 * i4 + j]; } }
            op[(t * 4 + dkg) * 128 + dv] = part; }
        __syncthreads();
        for (int t = wave; t < CH; t += 8) { const bf16* ur = U + (row0 + c0 + t) * NU;
            const float o0 = (op[(t * 4 + 0) * 128 + lane] + op[(t * 4 + 1) * 128 + lane]) + (op[(t * 4 + 2) * 128 + lane] + op[(t * 4 + 3) * 128 + lane]);
            const float o1 = (op[(t * 4 + 0) * 128 + 64 + lane] + op[(t * 4 + 1) * 128 + 64 + lane]) + (op[(t * 4 + 2) * 128 + 64 + lane] + op[(t * 4 + 3) * 128 + 64 + lane]);
            const float ss = wave_sum(o0 * o0 + o1 * o1); const float rn = 1.0f / sqrtf(ss * (1.0f / 128.0f) + EPSN);
            const float g0 = bf1(ur[U_GG + h * 128 + lane]), g1 = bf1(ur[U_GG + h * 128 + 64 + lane]);
            AO[(row0 + c0 + t) * 1024 + h * 128 + lane] = (bf16)f2bf(o0 * rn * g_out[lane] * silu_f(g0));
            AO[(row0 + c0 + t) * 1024 + h * 128 + 64 + lane] = (bf16)f2bf(o1 * rn * g_out[64 + lane] * silu_f(g1)); }
    }
    float* so = is_p ? a.out + O_GLAP + ((size_t)seq * 4 + h) * 8192 : a.out + O_GLAS + ((size_t)seq * 4 + h) * 8192;
#pragma unroll
    for (int i = 0; i < 16; ++i) so[(16 * dkg + i) * 128 + dv] = S[i];
    __syncthreads();
}

__device__ __forceinline__ void ew_phase(const Args& a, int gt, int NGT) {
    unsigned char* ws = a.ws;
    const bf16* A = (const bf16*)(ws + WS_A); const bf16* C = (const bf16*)(ws + WS_C); bf16* G = (bf16*)(ws + WS_G);
    const float* cw = (const float*)a.in[26]; const float* cb = (const float*)a.in[27]; const float* sc = (const float*)a.in[5];
    for (int v = gt; v < MT * 352; v += NGT) {
        const int m = v / 352, f0 = (v - m * 352) * 8;
        float x2[8], x1[8], x0[8], cc[8];
        { const v4u w = *(const v4u*)(A + (size_t)m * FF + f0); x2[0] = blo(w.x); x2[1] = bhi(w.x); x2[2] = blo(w.y); x2[3] = bhi(w.y); x2[4] = blo(w.z); x2[5] = bhi(w.z); x2[6] = blo(w.w); x2[7] = bhi(w.w); }
        { const v4u w = *(const v4u*)(C + (size_t)m * FF + f0); cc[0] = blo(w.x); cc[1] = bhi(w.x); cc[2] = blo(w.y); cc[3] = bhi(w.y); cc[4] = blo(w.z); cc[5] = bhi(w.z); cc[6] = blo(w.w); cc[7] = bhi(w.w); }
        const bool is_p = m < MP; const int t = is_p ? (m & 2047) : ((m - MP) & 7); const int bs = is_p ? 0 : ((m - MP) >> 3);
        if (t >= 1) { const v4u w = *(const v4u*)(A + (size_t)(m - 1) * FF + f0); x1[0] = blo(w.x); x1[1] = bhi(w.x); x1[2] = blo(w.y); x1[3] = bhi(w.y); x1[4] = blo(w.z); x1[5] = bhi(w.z); x1[6] = blo(w.w); x1[7] = bhi(w.w); }
        else if (is_p) {
#pragma unroll
            for (int j = 0; j < 8; ++j) x1[j] = 0.f;
        } else { const f32x4 p0 = *(const f32x4*)(sc + ((size_t)bs * 2 + 1) * FF + f0), p1 = *(const f32x4*)(sc + ((size_t)bs * 2 + 1) * FF + f0 + 4);
            x1[0] = p0[0]; x1[1] = p0[1]; x1[2] = p0[2]; x1[3] = p0[3]; x1[4] = p1[0]; x1[5] = p1[1]; x1[6] = p1[2]; x1[7] = p1[3]; }
        if (t >= 2) { const v4u w = *(const v4u*)(A + (size_t)(m - 2) * FF + f0); x0[0] = blo(w.x); x0[1] = bhi(w.x); x0[2] = blo(w.y); x0[3] = bhi(w.y); x0[4] = blo(w.z); x0[5] = bhi(w.z); x0[6] = blo(w.w); x0[7] = bhi(w.w); }
        else if (is_p) {
#pragma unroll
            for (int j = 0; j < 8; ++j) x0[j] = 0.f;
        } else { const int pr = (t == 1) ? 1 : 0; const f32x4 p0 = *(const f32x4*)(sc + ((size_t)bs * 2 + pr) * FF + f0), p1 = *(const f32x4*)(sc + ((size_t)bs * 2 + pr) * FF + f0 + 4);
            x0[0] = p0[0]; x0[1] = p0[1]; x0[2] = p0[2]; x0[3] = p0[3]; x0[4] = p1[0]; x0[5] = p1[1]; x0[6] = p1[2]; x0[7] = p1[3]; }
        float g[8];
#pragma unroll
        for (int j = 0; j < 8; ++j) { const float cv = cb[f0 + j] + cw[f0 + j] * x0[j] + cw[FF + f0 + j] * x1[j] + cw[2 * FF + f0 + j] * x2[j]; g[j] = silu_f(cv) * cc[j]; }
        v4u o; o.x = pk2(g[0], g[1]); o.y = pk2(g[2], g[3]); o.z = pk2(g[4], g[5]); o.w = pk2(g[6], g[7]);
        *(v4u*)(G + (size_t)m * FF + f0) = o;
    }
}
#ifndef MK_PER_PHASE
#define MK_PER_PHASE 0
#endif
constexpr int N_PHASES = 10;
__global__ void __launch_bounds__(NWAVES * 64, 2) hymba_fwd(Args args) {
    extern __shared__ __attribute__((aligned(16))) unsigned char lds_raw[];
    LAS unsigned char* lds = (LAS unsigned char*)lds_raw;
    volatile LAS unsigned* MISC = (volatile LAS unsigned*)(lds + MISC_OFF);
    const int tid = threadIdx.x, lane = tid & 63, wave = __builtin_amdgcn_readfirstlane(tid >> 6);
    const int G = gridDim.x; const int bx = blockIdx.x; const int vcu = (G % 8 == 0) ? (bx % 8) * (G / 8) + bx / 8 : bx;
    const int gw = vcu * NWAVES + wave, NGW = G * NWAVES;
    unsigned char* ws = args.ws;
    gu32* ctl = (gu32*)(ws + WS_CTL);
    for (int u = tid; u < (LDS_BYTES - LDSCTL_OFF) / 4; u += NWAVES * 64) ((LAS unsigned*)(lds + LDSCTL_OFF))[u] = 0u;
    __syncthreads();
    XcdBarrier bar; bar.bar = (unsigned*)(ctl + CW_BAR); bar.x = 0; bar.st = nullptr;
    if (!MK_PER_PHASE) bar = xcd_barrier_post((unsigned*)(ctl + CW_BAR), MISC + 8);
    const int lo = args.ph_lo, hi = args.ph_hi;
#define IN(k) (lo <= (k) && (k) < hi)
#define SEAM(k) do { if (IN(k) && IN((k) + 1)) xcd_barrier(bar); } while (0)
    float* rsq2 = (float*)(ctl + CW_RSQ2); float* rsq3 = (float*)(ctl + CW_RSQ3);

    if (IN(0)) { prep_phase(args, lds, gw, NGW, wave, lane); }
    SEAM(0);
    if (IN(1)) {
        { pg8::Gemm g{(const bf16*)(ws + WS_XB), (const bf16*)(ws + WS_WIN), MT, NU, DM}; pg8::StaticOrder S; S.init(MT, NU, G, bx);
          pg8::EpiScaleBf16 E{(bf16*)(ws + WS_U), NU, (const float*)(ws + WS_RS1)};
          pg8::gemm_phase<pg8::EpiScaleBf16, pg8::StaticOrder, true, true>(lds, g, S, E); }
        { pg8::Gemm g{(const bf16*)(ws + WS_PB), (const bf16*)(ws + WS_WPP), MT, DM, 256}; pg8::StaticOrder S; S.init(MT, DM, G, bx);
          pg8::EpiScaleBf16 E{(bf16*)(ws + WS_PP), DM, nullptr};
          pg8::gemm_phase<pg8::EpiScaleBf16, pg8::StaticOrder, true, true>(lds, g, S, E); }
    }
    SEAM(1);
    if (IN(2)) { post1_naive(args, lds, gw, NGW, wave, lane); }
    SEAM(2);
    if (IN(3)) {
        for (int it = bx; it < 160 + 256; it += G) { if (it < 160) gla_item_naive(args, lds, it, wave, lane); else decode_item_naive(args, lds, it - 160, wave, lane); }
        __syncthreads();
        attn_prompt_naive(args, lds, gw, NGW, wave, lane);
    }
    SEAM(3);
    if (IN(4)) { decode_combine_naive(args, lds, gw, NGW, wave, lane); }
    SEAM(4);
    if (IN(5)) {
        pg8::Gemm g{(const bf16*)(ws + WS_AO), (const bf16*)(ws + WS_WO), MT, DM, DM}; pg8::StaticOrder S; S.init(MT, DM, G, bx);
        pg8::EpiResid E{(const float*)args.in[0], (const float*)args.in[1], (float*)(ws + WS_H), (bf16*)(ws + WS_HB), rsq2};
        pg8::gemm_phase<pg8::EpiResid, pg8::StaticOrder, true, true>(lds, g, S, E);
    }
    SEAM(5);
    if (IN(6)) {
        pg8::Gemm g{(const bf16*)(ws + WS_HB), (const bf16*)(ws + WS_WGU), MT, 2 * FF, DM}; pg8::StaticOrder S; S.init(MT, 2 * FF, G, bx);
        pg8::EpiGateUp E{rsq2, (bf16*)(ws + WS_A), (bf16*)(ws + WS_C), args.out + O_CONVP, args.out + O_CONVS};
        pg8::gemm_phase<pg8::EpiGateUp, pg8::StaticOrder, true, true>(lds, g, S, E);
    }
    SEAM(6);
    if (IN(7)) { ew_phase(args, gw * 64 + lane, NGW * 64); }
    SEAM(7);
    if (IN(8)) {
        pg8::Gemm g{(const bf16*)(ws + WS_G), (const bf16*)(ws + WS_WD), MT, DM, FF}; pg8::StaticOrder S; S.init(MT, DM, G, bx);
        pg8::EpiResid E{(const float*)(ws + WS_H), (const float*)(ws + WS_H) + (size_t)MP * DM, (float*)(ws + WS_H), (bf16*)(ws + WS_H2B), rsq3};
        pg8::gemm_phase<pg8::EpiResid, pg8::StaticOrder, true, true>(lds, g, S, E);
    }
    SEAM(8);
    if (IN(9)) {
        pg8::Gemm g{(const bf16*)(ws + WS_H2B), (const bf16*)(ws + WS_WPG), MT, DM, DM}; pg8::StaticOrder S; S.init(MT, DM, G, bx);
        pg8::EpiPle E{(const float*)(ws + WS_H), (const bf16*)(ws + WS_PP), rsq3, args.out + O_YP};
        pg8::gemm_phase<pg8::EpiPle, pg8::StaticOrder, true, true>(lds, g, S, E);
    }
#undef IN
#undef SEAM
}

extern "C" void kernel_launch(void* const* d_in, const int* in_sizes, int n_in, void* d_out, int out_size, void* d_ws, size_t ws_size, hipStream_t stream) {
    static int grid = 0;
    if (grid == 0) {
        if (n_in != 32 || out_size != (int)O_END || ws_size < WS_END) { fprintf(stderr, "kernel_launch: unexpected shapes: n_in %d out %d ws %zu; nothing launched\n", n_in, out_size, ws_size); grid = -1; return; }
        int dev = 0, cus = 0, per_cu = 0;
        if (hipGetDevice(&dev) != hipSuccess || hipDeviceGetAttribute(&cus, hipDeviceAttributeMultiprocessorCount, dev) != hipSuccess) { fprintf(stderr, "kernel_launch: device query failed\n"); grid = -1; return; }
        if (hipFuncSetAttribute((const void*)hymba_fwd, hipFuncAttributeMaxDynamicSharedMemorySize, LDS_BYTES) != hipSuccess) { fprintf(stderr, "kernel_launch: hipFuncSetAttribute failed\n"); grid = -1; return; }
        if (hipOccupancyMaxActiveBlocksPerMultiprocessor(&per_cu, (const void*)hymba_fwd, NWAVES * 64, LDS_BYTES) != hipSuccess || per_cu < 1)
            fprintf(stderr, "kernel_launch: note: occupancy query reports %d workgroups per CU\n", per_cu);
        (void)hipGetLastError();
        grid = cus;
        if (grid != 256) fprintf(stderr, "kernel_launch: note: %d CUs (built for 256)\n", grid);
    }
    if (grid < 0) return;
    (void)hipMemsetAsync((char*)d_ws + WS_CTL, 0, CTL_ZERO_BYTES, stream);
    Args a{};
    for (int i = 0; i < 32; ++i) a.in[i] = d_in[i];
    a.out = (float*)d_out; a.ws = (unsigned char*)d_ws;
#if MK_PER_PHASE
    for (int p = 0; p < N_PHASES; ++p) { a.ph_lo = p; a.ph_hi = p + 1; hipLaunchKernelGGL(hymba_fwd, dim3(grid), dim3(NWAVES * 64), LDS_BYTES, stream, a); }
#else
    a.ph_lo = 0; a.ph_hi = N_PHASES;
    hipLaunchKernelGGL(hymba_fwd, dim3(grid), dim3(NWAVES * 64), LDS_BYTES, stream, a);
#endif
    const hipError_t le = hipPeekAtLastError();
    if (le != hipSuccess) fprintf(stderr, "kernel_launch: launch failed: %s\n", hipGetErrorName(le));
}
```

```cpp
#include <hip/hip_runtime.h>
#include <cstdio>
#include <cstdint>
__device__ __forceinline__ int lane_id() { int l; asm volatile("v_mbcnt_lo_u32_b32 %0, -1, 0\n\tv_mbcnt_hi_u32_b32 %0, -1, %0" : "=v"(l)); return l; }
namespace pg8 {
#define PG8_LAS __attribute__((address_space(3)))
typedef unsigned short bf16_t;
typedef short bf16x8 __attribute__((ext_vector_type(8)));
typedef float f32x4 __attribute__((ext_vector_type(4)));
typedef unsigned u32x4 __attribute__((ext_vector_type(4)));
constexpr int BM = 256, BK = 64, HALF = 128, HTB = HALF * BK * 2  , STAGE_BYTES = 8 * HTB, NXCD = 8, WGM = 8;

__host__ __device__ __forceinline__ int lds_byte(int r, int c) { const int st = (r >> 4) * 2 + (c >> 5), rr = r & 15, cc = c & 31, ob = rr * 64 + cc * 2; return st * 1024 + (ob ^ (((ob >> 9) & 1) << 5)); }
__host__ __device__ __forceinline__ void stage_rc(int b, int& R, int& C) { const int st = b / 1024, sb = b % 1024, swz = sb ^ (((sb >> 9) & 1) << 5); R = (st >> 1) * 16 + swz / 64; C = (st & 1) * 32 + (swz % 64) / 2; }
__host__ __device__ __forceinline__ int perm32(int rho) { const int n = rho >> 4, i = rho & 15; return 8 * (i >> 2) + 4 * n + (i & 3); }

struct Unit { int pm, pn; };
struct Gemm { const bf16_t* A; const bf16_t* Bt; int M, N, K; int lda = 0, tile_rows = 0, row_off = 0; };

struct StaticOrder {
    int nM, nN, nwg, G, c;
    __host__ __device__ void init(int M, int N, int G_, int c_) { nM = M / BM; nN = N / BM; nwg = nM * nN; G = G_; c = c_; }
    __host__ __device__ void init_tiles(int nM_, int nN_, int G_, int c_) { nM = nM_; nN = nN_; nwg = nM * nN; G = G_; c = c_; }
    __host__ __device__ bool next(int i, Unit& u) const {
        const long L = (long)i * G + c; if (L >= nwg) return false;
        int wgid = (int)L; { const int q = nwg / NXCD, r = nwg % NXCD, xcd = wgid % NXCD, off = wgid / NXCD; wgid = (xcd < r ? xcd * (q + 1) : r * (q + 1) + (xcd - r) * q) + off; }
        const int nig = WGM * nN, gid = wgid / nig, fm = gid * WGM, gsz = (nM - fm) < WGM ? (nM - fm) : WGM;
        u.pm = fm + ((wgid % nig) % gsz); u.pn = (wgid % nig) / gsz; return true;
    }
    __device__ __forceinline__ void a_ready(const Unit&) const {}
    __device__ __forceinline__ void done(const Unit&) const {}
};

__device__ __forceinline__ unsigned cvt_pk_bf16(float lo, float hi) { unsigned r; asm volatile("v_cvt_pk_bf16_f32 %0, %1, %2" : "=v"(r) : "v"(lo), "v"(hi)); return r; }
typedef float f32x2 __attribute__((ext_vector_type(2)));
__device__ __forceinline__ unsigned short f2bf_rne(float f) { unsigned u = __builtin_bit_cast(unsigned, f); return (unsigned short)((u + 0x7fffu + ((u >> 16) & 1u)) >> 16); }
__device__ __forceinline__ float bf2f_(unsigned short b) { return __builtin_bit_cast(float, (unsigned)b << 16); }
struct EpiScaleBf16 {
    static constexpr bool PERM = true, AFTER_DRAIN = false;
    bf16_t* O; int ldc; const float* rs;
    __device__ __forceinline__ void operator()(const f32x4 (&acc)[2][2][4][2], const Unit& u, int wr, int wc, int fr, int fq) const {
        asm volatile("" : "+v"(fr), "+v"(fq));
        const int row0 = u.pm * BM + wr * 64 + fr, col0 = u.pn * BM + wc * 32 + 8 * fq;
#pragma unroll
        for (int ai = 0; ai < 2; ++ai)
#pragma unroll
            for (int m = 0; m < 4; ++m) { const int row = row0 + ai * HALF + m * 16; const float s = rs ? rs[row] : 1.f; bf16_t* rowp = O + (size_t)row * ldc + col0;
#pragma unroll
                for (int bj = 0; bj < 2; ++bj) { const f32x4 v0 = acc[ai][bj][m][0] * s, v1 = acc[ai][bj][m][1] * s;
                    u32x4 w; w.x = cvt_pk_bf16(v0[0], v0[1]); w.y = cvt_pk_bf16(v0[2], v0[3]); w.z = cvt_pk_bf16(v1[0], v1[1]); w.w = cvt_pk_bf16(v1[2], v1[3]);
                    *(u32x4*)(rowp + bj * HALF) = w; } }
    }
};
template <bool BF> struct EpiResid {
    static constexpr bool PERM = false, AFTER_DRAIN = false;
    const void* base; bf16_t* hb; float* rsq;
    __device__ __forceinline__ void operator()(const f32x4 (&acc)[2][2][4][2], const Unit& u, int wr, int wc, int fr, int fq) const {
        asm volatile("" : "+v"(fr), "+v"(fq));
        typedef unsigned u32x2v __attribute__((ext_vector_type(2)));
        const int col0 = u.pn * BM + wc * 32 + 4 * fq;
#pragma unroll
        for (int ai = 0; ai < 2; ++ai) { asm volatile("" ::: "memory");
#pragma unroll
            for (int m = 0; m < 4; ++m) { const int r = u.pm * BM + ai * HALF + wr * 64 + m * 16 + fr;
                float ss = 0.f;
#pragma unroll
                for (int bj = 0; bj < 2; ++bj)
#pragma unroll
                    for (int n = 0; n < 2; ++n) { const size_t off = (size_t)r * 1024 + col0 + bj * HALF + n * 16; f32x4 v;
                        if (BF) { const u32x2v bw = *(const u32x2v*)((const bf16_t*)base + off);
                            v = (f32x4){__builtin_bit_cast(float, bw.x << 16), __builtin_bit_cast(float, bw.x & 0xffff0000u), __builtin_bit_cast(float, bw.y << 16), __builtin_bit_cast(float, bw.y & 0xffff0000u)} + acc[ai][bj][m][n]; }
                        else v = *(const f32x4*)((const float*)base + off) + acc[ai][bj][m][n];
                        u32x2v w; w.x = cvt_pk_bf16(v[0], v[1]); w.y = cvt_pk_bf16(v[2], v[3]); *(u32x2v*)(hb + off) = w;
                        ss += (v[0] * v[0] + v[1] * v[1]) + (v[2] * v[2] + v[3] * v[3]); }
                ss += __shfl_xor(ss, 16); ss += __shfl_xor(ss, 32);
                if (fq == 0) atomicAdd(rsq + r, ss); } }
    }
};
struct EpiGateUp {
    static constexpr bool PERM = true, AFTER_DRAIN = false;
    const float* rsq; bf16_t* A; bf16_t* C; float* conv_p; float* conv_s;
    __device__ __forceinline__ void operator()(const f32x4 (&acc)[2][2][4][2], const Unit& u, int wr, int wc, int fr, int fq) const {
        asm volatile("" : "+v"(fr), "+v"(fq));
        const int f0 = u.pn * HALF + wc * 32 + 8 * fq;
#pragma unroll
        for (int ai = 0; ai < 2; ++ai)
#pragma unroll
            for (int m = 0; m < 4; ++m) { const int r = u.pm * BM + ai * HALF + wr * 64 + m * 16 + fr;
                const float rs = __builtin_amdgcn_rsqf(rsq[r] * (1.0f / 1024.0f) + 1e-6f);
                const f32x4 a0 = acc[ai][0][m][0] * rs, a1 = acc[ai][0][m][1] * rs, c0 = acc[ai][1][m][0] * rs, c1 = acc[ai][1][m][1] * rs;
                u32x4 w; w.x = cvt_pk_bf16(a0[0], a0[1]); w.y = cvt_pk_bf16(a0[2], a0[3]); w.z = cvt_pk_bf16(a1[0], a1[1]); w.w = cvt_pk_bf16(a1[2], a1[3]);
                *(u32x4*)(A + (size_t)r * 2816 + f0) = w;
                w.x = cvt_pk_bf16(c0[0], c0[1]); w.y = cvt_pk_bf16(c0[2], c0[3]); w.z = cvt_pk_bf16(c1[0], c1[1]); w.w = cvt_pk_bf16(c1[2], c1[3]);
                *(u32x4*)(C + (size_t)r * 2816 + f0) = w;
                float* dst = nullptr;
                if (r < 16384) { const int t = r & 2047; if (t >= 2046) dst = conv_p + ((size_t)(r >> 11) * 2 + (t - 2046)) * 2816 + f0; }
                else { const int rr = r - 16384, t = rr & 7; if (t >= 6) dst = conv_s + ((size_t)(rr >> 3) * 2 + (t - 6)) * 2816 + f0; }
                if (dst) { *(f32x4*)dst = a0; *(f32x4*)(dst + 4) = a1; } }
    }
};
struct EpiPle {
    static constexpr bool PERM = false, AFTER_DRAIN = false;
    const bf16_t* h2; const bf16_t* PP; const float* rsq; float* out;
    __device__ __forceinline__ void operator()(const f32x4 (&acc)[2][2][4][2], const Unit& u, int wr, int wc, int fr, int fq) const {
        asm volatile("" : "+v"(fr), "+v"(fq));
        typedef unsigned u32x2v __attribute__((ext_vector_type(2)));
        const int col0 = u.pn * BM + wc * 32 + 4 * fq;
#pragma unroll
        for (int ai = 0; ai < 2; ++ai) { asm volatile("" ::: "memory");
#pragma unroll
            for (int m = 0; m < 4; ++m) { const int r = u.pm * BM + ai * HALF + wr * 64 + m * 16 + fr;
                const float rs = __builtin_amdgcn_rsqf(rsq[r] * (1.0f / 1024.0f) + 1e-6f);
#pragma unroll
                for (int bj = 0; bj < 2; ++bj)
#pragma unroll
                    for (int n = 0; n < 2; ++n) { const size_t off = (size_t)r * 1024 + col0 + bj * HALF + n * 16; const u32x2v hw = *(const u32x2v*)(h2 + off); const f32x4 hv = {__builtin_bit_cast(float, hw.x << 16), __builtin_bit_cast(float, hw.x & 0xffff0000u), __builtin_bit_cast(float, hw.y << 16), __builtin_bit_cast(float, hw.y & 0xffff0000u)};
                        const u32x2v pw = *(const u32x2v*)(PP + off); const f32x4 z = acc[ai][bj][m][n] * rs; f32x4 o;
                        o[0] = hv[0] + __builtin_bit_cast(float, pw.x << 16) * __builtin_amdgcn_rcpf(1.0f + __builtin_amdgcn_exp2f(-1.4426950408889634f * z[0]));
                        o[1] = hv[1] + __builtin_bit_cast(float, pw.x & 0xffff0000u) * __builtin_amdgcn_rcpf(1.0f + __builtin_amdgcn_exp2f(-1.4426950408889634f * z[1]));
                        o[2] = hv[2] + __builtin_bit_cast(float, pw.y << 16) * __builtin_amdgcn_rcpf(1.0f + __builtin_amdgcn_exp2f(-1.4426950408889634f * z[2]));
                        o[3] = hv[3] + __builtin_bit_cast(float, pw.y & 0xffff0000u) * __builtin_amdgcn_rcpf(1.0f + __builtin_amdgcn_exp2f(-1.4426950408889634f * z[3]));
                        *(f32x4*)(out + off) = o; } } }
    }
};
struct EpiU {
    static constexpr bool PERM = true, AFTER_DRAIN = false;
    bf16_t* O; const float* rs; float* rsqq; float* rsqkv; float* rsqkr;
    __device__ __forceinline__ void operator()(const f32x4 (&acc)[2][2][4][2], const Unit& u, int wr, int wc, int fr, int fq) const {
        asm volatile("" : "+v"(fr), "+v"(fq));
        const int row0 = u.pm * BM + wr * 64 + fr, col0 = u.pn * BM + wc * 32 + 8 * fq;
#pragma unroll
        for (int ai = 0; ai < 2; ++ai)
#pragma unroll
            for (int m = 0; m < 4; ++m) { const int row = row0 + ai * HALF + m * 16; const float s = rs[row]; bf16_t* rowp = O + (size_t)row * 2048 + col0; float sq[2];
#pragma unroll
                for (int bj = 0; bj < 2; ++bj) { const f32x4 v0 = acc[ai][bj][m][0] * s, v1 = acc[ai][bj][m][1] * s;
                    u32x4 w; w.x = cvt_pk_bf16(v0[0], v0[1]); w.y = cvt_pk_bf16(v0[2], v0[3]); w.z = cvt_pk_bf16(v1[0], v1[1]); w.w = cvt_pk_bf16(v1[2], v1[3]);
                    *(u32x4*)(rowp + bj * HALF) = w;
                    sq[bj] = ((v0[0] * v0[0] + v0[1] * v0[1]) + (v0[2] * v0[2] + v0[3] * v0[3])) + ((v1[0] * v1[0] + v1[1] * v1[1]) + (v1[2] * v1[2] + v1[3] * v1[3])); }
                if (u.pn >= 6) { float a0 = (u.pn == 6) ? sq[0] + sq[1] : sq[0], a1 = sq[1];
                    a0 += __shfl_xor(a0, 16); a0 += __shfl_xor(a0, 32); a1 += __shfl_xor(a1, 16); a1 += __shfl_xor(a1, 32);
                    if (fq == 0) { if (u.pn == 6) atomicAdd(rsqq + row, a0); else { atomicAdd(rsqkv + row, a0); if (wc == 0) atomicAdd(rsqkr + row, a1); } } }
                asm volatile("" ::: "memory"); }
    }
};
struct EpiQ {
    static constexpr bool PERM = true, AFTER_DRAIN = false;
    const float* rsqq; const float* rope; const float* g_qn; const float* g_qr; bf16_t* QM;
    __device__ __forceinline__ void operator()(const f32x4 (&acc)[2][2][4][2], const Unit& u, int wr, int wc, int fr, int fq) const {
        asm volatile("" : "+v"(fr), "+v"(fq));
        constexpr float QS = 0.10206207261596575f * 1.4426950408889634f;
        float rsq8[8];
#pragma unroll
        for (int i = 0; i < 8; ++i) rsq8[i] = rsqq[u.pm * BM + (i >> 2) * HALF + wr * 64 + (i & 3) * 16 + fr];
#pragma unroll
        for (int ai = 0; ai < 2; ++ai)
#pragma unroll
            for (int m = 0; m < 4; ++m) { const int r = u.pm * BM + ai * HALF + wr * 64 + m * 16 + fr; const float rs = __builtin_amdgcn_rsqf(rsq8[ai * 4 + m] * (1.0f / 256.0f) + 1e-6f);
                if (u.pn < 2) { const int h = 4 * u.pn + wc; float ss = 0.f;
#pragma unroll
                    for (int bj = 0; bj < 2; ++bj)
#pragma unroll
                        for (int n = 0; n < 2; ++n) { const f32x4 v = acc[ai][bj][m][n] * rs; ss += (v[0] * v[0] + v[1] * v[1]) + (v[2] * v[2] + v[3] * v[3]); }
                    ss += __shfl_xor(ss, 16); ss += __shfl_xor(ss, 32);
                    const float rn = rs * QS * __builtin_amdgcn_rsqf(ss * (1.0f / 64.0f) + 1e-6f);
#pragma unroll
                    for (int bj = 0; bj < 2; ++bj) { const int d0 = 32 * bj + 8 * fq; const f32x4 g0 = *(const f32x4*)(g_qn + d0), g1 = *(const f32x4*)(g_qn + d0 + 4);
                        const f32x4 v0 = acc[ai][bj][m][0] * rn * g0, v1 = acc[ai][bj][m][1] * rn * g1;
                        u32x4 w; w.x = cvt_pk_bf16(v0[0], v0[1]); w.y = cvt_pk_bf16(v0[2], v0[3]); w.z = cvt_pk_bf16(v1[0], v1[1]); w.w = cvt_pk_bf16(v1[2], v1[3]);
                        *(u32x4*)(QM + ((size_t)r * 8 + h) * 96 + d0) = w; } }
                else { const int pidx = (r < 16384) ? (r & 2047) : 2048 + ((r - 16384) & 7);
                    const f32x4* rp = (const f32x4*)(rope + (pidx * 16 + 8 * (fq & 1)) * 2);
                    const f32x4 rc0 = rp[0], rc1 = rp[1], rc2 = rp[2], rc3 = rp[3];
#pragma unroll
                    for (int bj = 0; bj < 2; ++bj) { const int h = 4 * bj + wc, i0 = 8 * fq; float ss = 0.f;
#pragma unroll
                        for (int n = 0; n < 2; ++n) { const f32x4 v = acc[ai][bj][m][n] * rs; ss += (v[0] * v[0] + v[1] * v[1]) + (v[2] * v[2] + v[3] * v[3]); }
                        ss += __shfl_xor(ss, 16); ss += __shfl_xor(ss, 32);
                        const float rr = rs * QS * __builtin_amdgcn_rsqf(ss * (1.0f / 32.0f) + 1e-6f);
                        const f32x4 g0 = *(const f32x4*)(g_qr + i0), g1 = *(const f32x4*)(g_qr + i0 + 4);
                        unsigned wq[4];
#pragma unroll
                        for (int n = 0; n < 2; ++n) { const f32x4 gq = n ? g1 : g0; float o[4];
#pragma unroll
                            for (int j = 0; j < 4; ++j) { const float x = acc[ai][bj][m][n][j] * rr * gq[j]; const float y = __shfl_xor(x, 32);
                                const f32x4 rcv = (4 * n + j) < 2 ? rc0 : ((4 * n + j) < 4 ? rc1 : ((4 * n + j) < 6 ? rc2 : rc3)); const float cs_c = rcv[2 * (j & 1)], cs_s = rcv[2 * (j & 1) + 1];
                                o[j] = (fq < 2) ? (x * cs_c - y * cs_s) : (x * cs_c + y * cs_s); }
                            wq[2 * n] = cvt_pk_bf16(o[0], o[1]); wq[2 * n + 1] = cvt_pk_bf16(o[2], o[3]); }
                        u32x4 w; w.x = wq[0]; w.y = wq[1]; w.z = wq[2]; w.w = wq[3];
                        *(u32x4*)(QM + ((size_t)r * 8 + h) * 96 + 64 + i0) = w; } }
                asm volatile("" ::: "memory"); }
    }
};
struct EpiKV {
    static constexpr bool PERM = true, AFTER_DRAIN = false;
    const float* rsqkv; const float* g_kn; bf16_t* KM; bf16_t* VM;
    __device__ __forceinline__ void operator()(const f32x4 (&acc)[2][2][4][2], const Unit& u, int wr, int wc, int fr, int fq) const {
        asm volatile("" : "+v"(fr), "+v"(fq));
        float rsq8[8];
#pragma unroll
        for (int i = 0; i < 8; ++i) rsq8[i] = rsqkv[u.pm * BM + (i >> 2) * HALF + wr * 64 + (i & 3) * 16 + fr];
#pragma unroll
        for (int ai = 0; ai < 2; ++ai)
#pragma unroll
            for (int m = 0; m < 4; ++m) { const int r = u.pm * BM + ai * HALF + wr * 64 + m * 16 + fr; const float rs = __builtin_amdgcn_rsqf(rsq8[ai * 4 + m] * (1.0f / 128.0f) + 1e-6f);
                if (u.pn < 2) { const int h = 4 * u.pn + wc; float ss = 0.f;
#pragma unroll
                    for (int bj = 0; bj < 2; ++bj)
#pragma unroll
                        for (int n = 0; n < 2; ++n) { const f32x4 v = acc[ai][bj][m][n] * rs; ss += (v[0] * v[0] + v[1] * v[1]) + (v[2] * v[2] + v[3] * v[3]); }
                    ss += __shfl_xor(ss, 16); ss += __shfl_xor(ss, 32);
                    const float rk = rs * __builtin_amdgcn_rsqf(ss * (1.0f / 64.0f) + 1e-6f);
#pragma unroll
                    for (int bj = 0; bj < 2; ++bj) { const int d0 = 32 * bj + 8 * fq; const f32x4 g0 = *(const f32x4*)(g_kn + d0), g1 = *(const f32x4*)(g_kn + d0 + 4);
                        const f32x4 v0 = acc[ai][bj][m][0] * rk * g0, v1 = acc[ai][bj][m][1] * rk * g1;
                        u32x4 w; w.x = cvt_pk_bf16(v0[0], v0[1]); w.y = cvt_pk_bf16(v0[2], v0[3]); w.z = cvt_pk_bf16(v1[0], v1[1]); w.w = cvt_pk_bf16(v1[2], v1[3]);
                        *(u32x4*)(KM + ((size_t)r * 8 + h) * 96 + d0) = w; } }
                else { const int h = 4 * (u.pn - 2) + wc;
#pragma unroll
                    for (int bj = 0; bj < 2; ++bj) { const int d0 = 32 * bj + 8 * fq; const f32x4 v0 = acc[ai][bj][m][0] * rs, v1 = acc[ai][bj][m][1] * rs;
                        u32x4 w; w.x = cvt_pk_bf16(v0[0], v0[1]); w.y = cvt_pk_bf16(v0[2], v0[3]); w.z = cvt_pk_bf16(v1[0], v1[1]); w.w = cvt_pk_bf16(v1[2], v1[3]);
                        *(u32x4*)(VM + ((size_t)r * 8 + h) * 64 + d0) = w; } }
                asm volatile("" ::: "memory"); }
    }
};
__device__ __forceinline__ float dpp_f(float oldv, float src, const int ctrl_sel) {
    const int o = __builtin_bit_cast(int, oldv), s = __builtin_bit_cast(int, src); int r;
    if (ctrl_sel == 0) r = __builtin_amdgcn_update_dpp(o, s, 0x111, 0xf, 0xf, false); else if (ctrl_sel == 1) r = __builtin_amdgcn_update_dpp(o, s, 0x112, 0xf, 0xf, false);
    else if (ctrl_sel == 2) r = __builtin_amdgcn_update_dpp(o, s, 0x121, 0xf, 0xf, false); else r = __builtin_amdgcn_update_dpp(o, s, 0x122, 0xf, 0xf, false);
    return __builtin_bit_cast(float, r);
}
struct EpiConv {
    static constexpr bool PERM = true, AFTER_DRAIN = false;
    const float* rsq; PG8_LAS float* ex; const float* cw; const float* cb; const float* sc; bf16_t* G; float* conv_p; float* conv_s;
    __device__ __forceinline__ void operator()(const f32x4 (&acc)[2][2][4][2], const Unit& u, int wr, int wc, int fr, int fq) const {
        asm volatile("" : "+v"(fr), "+v"(fq));
        constexpr int MTr = 16640, MPr = 16384;
        const int f0 = u.pn * HALF + wc * 32 + 8 * fq; const int Rbase = u.pm * 254 - 2;
#pragma unroll
        for (int ai = 0; ai < 2; ++ai) { const int R3 = Rbase + ai * HALF + wr * 64 + 48 + fr; const int Rc = R3 < 0 ? 0 : (R3 >= MTr ? MTr - 1 : R3);
            const float rs = __builtin_amdgcn_rsqf(rsq[Rc] * (1.0f / 1024.0f) + 1e-6f);
            if (fr >= 14) { PG8_LAS float* p = ex + (((((2 * ai + wr) * 4 + wc) * 2 + (fr - 14)) * 4 + fq) * 8);
                *(PG8_LAS f32x4*)p = acc[ai][0][3][0] * rs; *(PG8_LAS f32x4*)(p + 4) = acc[ai][0][3][1] * rs; } }
        asm volatile("s_waitcnt lgkmcnt(0)\n\ts_barrier" ::: "memory");
        const f32x4 w0a = *(const f32x4*)(cw + f0), w0b = *(const f32x4*)(cw + f0 + 4), w1a = *(const f32x4*)(cw + 2816 + f0), w1b = *(const f32x4*)(cw + 2816 + f0 + 4);
        const f32x4 w2a = *(const f32x4*)(cw + 5632 + f0), w2b = *(const f32x4*)(cw + 5632 + f0 + 4), cba = *(const f32x4*)(cb + f0), cbb = *(const f32x4*)(cb + f0 + 4);
#pragma unroll
        for (int ai = 0; ai < 2; ++ai) {
            float pg[8];
            { const int s = 2 * ai + wr;
              if (s == 0) {
#pragma unroll
                  for (int e = 0; e < 8; ++e) pg[e] = 0.f;
              } else { const PG8_LAS float* p = ex + ((((((s - 1) * 4 + wc) * 2 + (fr & 1)) * 4 + fq) * 8)); const f32x4 a0 = *(const PG8_LAS f32x4*)p, a1 = *(const PG8_LAS f32x4*)(p + 4);
                  pg[0] = a0[0]; pg[1] = a0[1]; pg[2] = a0[2]; pg[3] = a0[3]; pg[4] = a1[0]; pg[5] = a1[1]; pg[6] = a1[2]; pg[7] = a1[3]; } }
#pragma unroll
            for (int m = 0; m < 4; ++m) { const int rl = ai * HALF + wr * 64 + m * 16 + fr; const int R = Rbase + rl; const int Rc = R < 0 ? 0 : (R >= MTr ? MTr - 1 : R);
                const float rs = __builtin_amdgcn_rsqf(rsq[Rc] * (1.0f / 1024.0f) + 1e-6f);
                float cur[8], go[8];
#pragma unroll
                for (int e = 0; e < 8; ++e) cur[e] = acc[ai][0][m][e >> 2][e & 3] * rs;
                const bool is_s = R >= MPr; const int t = is_s ? ((R - MPr) & 7) : (R & 2047);
                const float k1 = (t == 0) ? 0.f : 1.f, k2 = (t < 2) ? 0.f : 1.f;
                float c1[8], c2[8];
#pragma unroll
                for (int e = 0; e < 8; ++e) { c1[e] = dpp_f(dpp_f(0.f, pg[e], 2), cur[e], 0) * k1; c2[e] = dpp_f(dpp_f(0.f, pg[e], 3), cur[e], 1) * k2; }
                if (u.pm >= 64) { if (is_s && t < 2) { const int bs = (R - MPr) >> 3;
#pragma unroll
                        for (int e = 0; e < 8; ++e) { const float h1 = sc[((size_t)bs * 2 + 1) * 2816 + f0 + e], h0 = sc[((size_t)bs * 2) * 2816 + f0 + e]; if (t == 0) { c1[e] = h1; c2[e] = h0; } else c2[e] = h1; } } }
#pragma unroll
                for (int e = 0; e < 8; ++e) { const float w0 = e < 4 ? w0a[e & 3] : w0b[e & 3], w1 = e < 4 ? w1a[e & 3] : w1b[e & 3], w2 = e < 4 ? w2a[e & 3] : w2b[e & 3], bb = e < 4 ? cba[e & 3] : cbb[e & 3];
                    const float cv = bb + w0 * c2[e] + w1 * c1[e] + w2 * cur[e];
                    go[e] = cv * __builtin_amdgcn_rcpf(1.0f + __builtin_amdgcn_exp2f(-1.4426950408889634f * cv)) * (acc[ai][1][m][e >> 2][e & 3] * rs); }
                if (rl >= 2 && R < MTr) {
                    u32x4 w; w.x = cvt_pk_bf16(go[0], go[1]); w.y = cvt_pk_bf16(go[2], go[3]); w.z = cvt_pk_bf16(go[4], go[5]); w.w = cvt_pk_bf16(go[6], go[7]);
                    *(u32x4*)(G + (size_t)R * 2816 + f0) = w;
                    float* dst = nullptr;
                    if (!is_s) { if (t >= 2046) dst = conv_p + ((size_t)(R >> 11) * 2 + (t - 2046)) * 2816 + f0; }
                    else { if (t >= 6) dst = conv_s + ((size_t)((R - MPr) >> 3) * 2 + (t - 6)) * 2816 + f0; }
                    if (dst) { *(f32x4*)dst = (f32x4){cur[0], cur[1], cur[2], cur[3]}; *(f32x4*)(dst + 4) = (f32x4){cur[4], cur[5], cur[6], cur[7]}; } }
#pragma unroll
                for (int e = 0; e < 8; ++e) pg[e] = cur[e];
                asm volatile("" ::: "memory"); }
        }
    }
};
template <class Epi, class Sched, bool ALIGN_EPI = false, bool SP2 = false>
__device__ __forceinline__ void gemm_phase(PG8_LAS unsigned char* lds, const Gemm g, const Sched& S, const Epi& E, const int wid_s) {
    int tid_o = wid_s * 64 + lane_id(); asm volatile("" : "+v"(tid_o));
    const int tid = tid_o, wid = __builtin_amdgcn_readfirstlane(tid >> 6), lane = tid & 63, wr = wid >> 2, wc = wid & 3, fr = lane & 15, fq = lane >> 4;
    const int K = g.K, nt = K / BK;
    const int lda = g.lda ? g.lda : K;
    unsigned voffA[2], voffB[2];
#pragma unroll
    for (int i = 0; i < 2; ++i) { int R, C; stage_rc(tid * 16 + i * 8192, R, C); const int Rb = Epi::PERM ? ((R & ~31) + perm32(R & 31)) : R;
        voffA[i] = (unsigned)(R * lda + C) * 2u; voffB[i] = (unsigned)(Rb * K + C) * 2u; }
    const size_t kstep = (size_t)(BK * 2);
    const size_t hstepA = (size_t)HALF * lda * 2, hstepB = (size_t)HALF * K * 2;
    const size_t tstepB = 2 * hstepB;
    const long trows = g.tile_rows ? g.tile_rows : BM;
#define PG8_TILEA(pm_) ((const char*)g.A + ((long)(pm_) * trows + g.row_off) * (long)lda * 2)
    const unsigned ldsw = (unsigned)wid * 1024u;
    const int aoff = lds_byte(wr * 64 + fr, fq * 8), boff = lds_byte(wc * 32 + fr, fq * 8);
#define PG8_SA(b, h) (((b) * 2 + (h)) * HTB)
#define PG8_SB(b, h) ((4 + (b) * 2 + (h)) * HTB)
#define PG8_STAGE(bufoff, gbase, voff) do { _Pragma("unroll") for (int _i = 0; _i < 2; ++_i) \
        __builtin_amdgcn_global_load_lds((const unsigned*)((const char*)(gbase) + (voff)[_i]), (PG8_LAS unsigned*)(lds + (bufoff) + ldsw + _i * 8192), 16, 0, 0); } while (0)
#define PG8_LDA(dst, b, h) do { _Pragma("unroll") for (int m = 0; m < 4; ++m) _Pragma("unroll") for (int k = 0; k < 2; ++k) dst[m][k] = *(const PG8_LAS bf16x8*)(lds + PG8_SA(b, h) + aoff + m * 2048 + k * 1024); } while (0)
#define PG8_LDB(dst, b, h) do { _Pragma("unroll") for (int n = 0; n < 2; ++n) _Pragma("unroll") for (int k = 0; k < 2; ++k) dst[n][k] = *(const PG8_LAS bf16x8*)(lds + PG8_SB(b, h) + boff + n * 2048 + k * 1024); } while (0)
#define PG8_MMA(ai, bj, At, Bt) do { __builtin_amdgcn_s_setprio(1); _Pragma("unroll") for (int m = 0; m < 4; ++m) _Pragma("unroll") for (int n = 0; n < 2; ++n) _Pragma("unroll") for (int k = 0; k < 2; ++k) \
        acc[ai][bj][m][n] = __builtin_amdgcn_mfma_f32_16x16x32_bf16(Bt[n][k], At[m][k], acc[ai][bj][m][n], 0, 0, 0); __builtin_amdgcn_s_setprio(0); } while (0)
#define PG8_WAIT_V(n) asm volatile("s_waitcnt vmcnt(" #n ")" ::: "memory")
#define PG8_WAIT_L(n) asm volatile("s_waitcnt lgkmcnt(" #n ")" ::: "memory")
#define PG8_BAR __builtin_amdgcn_s_barrier()
#define PG8_SCHED __builtin_amdgcn_sched_barrier(0)
    Unit cur, nxt; int ui = 0;
    if (!S.next(0, cur)) return;
    f32x4 acc[2][2][4][2];
#pragma unroll
    for (int a = 0; a < 2; ++a)
#pragma unroll
        for (int b = 0; b < 2; ++b)
#pragma unroll
            for (int m = 0; m < 4; ++m)
#pragma unroll
                for (int n = 0; n < 2; ++n) acc[a][b][m][n] = (f32x4){0.f, 0.f, 0.f, 0.f};
    bf16x8 At[4][2], B0[2][2], B1[2][2];
    const char* cA = PG8_TILEA(cur.pm); const char* cB = (const char*)g.Bt + (size_t)cur.pn * tstepB;
    S.a_ready(cur);
    if constexpr (SP2) {
        PG8_STAGE(PG8_SB(0, 0), cB, voffB); PG8_STAGE(PG8_SB(0, 1), cB + hstepB, voffB); PG8_STAGE(PG8_SA(0, 0), cA, voffA); PG8_STAGE(PG8_SA(0, 1), cA + hstepA, voffA);
        if (wr == 1) PG8_BAR;
        PG8_WAIT_V(2); PG8_BAR;
        PG8_STAGE(PG8_SB(1, 0), cB + kstep, voffB); PG8_STAGE(PG8_SA(1, 0), cA + kstep, voffA); PG8_STAGE(PG8_SB(1, 1), cB + hstepB + kstep, voffB);
        PG8_WAIT_V(6); PG8_BAR;
    } else {
        PG8_STAGE(PG8_SB(0, 0), cB, voffB); PG8_STAGE(PG8_SA(0, 0), cA, voffA); PG8_STAGE(PG8_SB(0, 1), cB + hstepB, voffB); PG8_STAGE(PG8_SA(0, 1), cA + hstepA, voffA);
        if (wr == 1) PG8_BAR;
        PG8_WAIT_V(4); PG8_BAR;
        PG8_STAGE(PG8_SB(1, 0), cB + kstep, voffB); PG8_STAGE(PG8_SA(1, 0), cA + kstep, voffA); PG8_STAGE(PG8_SB(1, 1), cB + hstepB + kstep, voffB);
        PG8_WAIT_V(6); PG8_BAR;
    }
    for (;;) {
        const bool has_next = S.next(ui + 1, nxt);
        const char* nA = has_next ? PG8_TILEA(nxt.pm) : cA; const char* nB = has_next ? (const char*)g.Bt + (size_t)nxt.pn * tstepB : cB;
        for (int t = 0; t < nt; t += 2) {
            const bool last = (t == nt - 2);
            const char* a1 = cA + (size_t)(t + 1) * kstep;
            const char* a2 = last ? nA : cA + (size_t)(t + 2) * kstep; const char* b2 = last ? nB : cB + (size_t)(t + 2) * kstep;
            const char* a3 = a2 + kstep; const char* b3 = b2 + kstep;
            if (last && has_next) S.a_ready(nxt);
            if constexpr (SP2) {
            PG8_LDB(B0, 0, 0); PG8_LDB(B1, 0, 1); PG8_SCHED; PG8_LDA(At, 0, 0); PG8_STAGE(PG8_SA(1, 1), a1 + hstepA, voffA);
            PG8_WAIT_V(8); PG8_WAIT_L(0); PG8_BAR; PG8_MMA(0, 0, At, B0); PG8_MMA(0, 1, At, B1); PG8_BAR; PG8_SCHED;
            PG8_LDA(At, 0, 1); PG8_STAGE(PG8_SB(0, 0), b2, voffB); PG8_STAGE(PG8_SB(0, 1), b2 + hstepB, voffB); PG8_STAGE(PG8_SA(0, 0), a2, voffA);
            PG8_WAIT_V(8); PG8_WAIT_L(0); PG8_BAR; PG8_MMA(1, 0, At, B0); PG8_MMA(1, 1, At, B1); PG8_BAR; PG8_SCHED;
            PG8_LDB(B0, 1, 0); PG8_LDB(B1, 1, 1); PG8_SCHED; PG8_LDA(At, 1, 0); PG8_STAGE(PG8_SA(0, 1), a2 + hstepA, voffA);
            PG8_WAIT_V(8); PG8_WAIT_L(0); PG8_BAR; PG8_MMA(0, 0, At, B0); PG8_MMA(0, 1, At, B1); PG8_BAR; PG8_SCHED;
            PG8_LDA(At, 1, 1); PG8_STAGE(PG8_SB(1, 0), b3, voffB); PG8_STAGE(PG8_SB(1, 1), b3 + hstepB, voffB); PG8_STAGE(PG8_SA(1, 0), a3, voffA);
            PG8_WAIT_V(8); PG8_WAIT_L(0); PG8_BAR; PG8_MMA(1, 0, At, B0); PG8_MMA(1, 1, At, B1); PG8_BAR; PG8_SCHED;
            } else {
            PG8_LDB(B0, 0, 0); PG8_SCHED; PG8_LDA(At, 0, 0); PG8_STAGE(PG8_SA(1, 1), a1 + hstepA, voffA);
            PG8_WAIT_L(8); PG8_BAR; PG8_WAIT_L(0); PG8_MMA(0, 0, At, B0); PG8_BAR; PG8_SCHED;
            PG8_LDB(B1, 0, 1); PG8_STAGE(PG8_SB(0, 0), b2, voffB);
            PG8_BAR; PG8_WAIT_L(0); PG8_MMA(0, 1, At, B1); PG8_BAR;
            PG8_LDA(At, 0, 1); PG8_STAGE(PG8_SA(0, 0), a2, voffA);
            PG8_BAR; PG8_WAIT_L(0); PG8_MMA(1, 0, At, B0); PG8_BAR; PG8_SCHED;
            PG8_STAGE(PG8_SB(0, 1), b2 + hstepB, voffB);
            PG8_WAIT_V(6); PG8_BAR; PG8_MMA(1, 1, At, B1); PG8_BAR;
            PG8_LDB(B0, 1, 0); PG8_SCHED; PG8_LDA(At, 1, 0); PG8_STAGE(PG8_SA(0, 1), a2 + hstepA, voffA);
            PG8_WAIT_L(8); PG8_BAR; PG8_WAIT_L(0); PG8_MMA(0, 0, At, B0); PG8_BAR; PG8_SCHED;
            PG8_LDB(B1, 1, 1); PG8_STAGE(PG8_SB(1, 0), b3, voffB);
            PG8_BAR; PG8_WAIT_L(0); PG8_MMA(0, 1, At, B1); PG8_BAR;
            PG8_LDA(At, 1, 1); PG8_STAGE(PG8_SA(1, 0), a3, voffA);
            PG8_BAR; PG8_WAIT_L(0); PG8_MMA(1, 0, At, B0); PG8_BAR; PG8_SCHED;
            PG8_STAGE(PG8_SB(1, 1), b3 + hstepB, voffB);
            PG8_WAIT_V(6); PG8_BAR; PG8_MMA(1, 1, At, B1); PG8_BAR;
            }
        }
        if constexpr (ALIGN_EPI) { if (wr == 0) PG8_BAR; }
        if constexpr (!Epi::AFTER_DRAIN) { const int le_ = lane_id(); E(acc, cur, wr, wc, le_ & 15, le_ >> 4); S.done(cur); }
        if (!has_next) break;
#pragma unroll
        for (int a = 0; a < 2; ++a)
#pragma unroll
            for (int b = 0; b < 2; ++b)
#pragma unroll
                for (int m = 0; m < 4; ++m)
#pragma unroll
                    for (int n = 0; n < 2; ++n) acc[a][b][m][n] = (f32x4){0.f, 0.f, 0.f, 0.f};
        cur = nxt; cA = nA; cB = nB; ++ui;
        if constexpr (ALIGN_EPI) { if (wr == 1) PG8_BAR; }
    }
    PG8_WAIT_V(0);
    if constexpr (!ALIGN_EPI) { if (wr == 0) PG8_BAR; }
    PG8_BAR;
    if constexpr (Epi::AFTER_DRAIN) { E.fused(acc, cur, wr, wc, fr, fq, lds, wid, lane); S.done(cur); }
#undef PG8_TILEA
#undef PG8_SA
#undef PG8_SB
#undef PG8_STAGE
#undef PG8_LDA
#undef PG8_LDB
#undef PG8_MMA
#undef PG8_WAIT_V
#undef PG8_WAIT_L
#undef PG8_BAR
#undef PG8_SCHED
}
}
constexpr int NWAVES = 8;
constexpr int MP = 16384, MS = 256, MT = MP + MS;
constexpr int DM = 1024, NU = 2048, FF = 2816;
constexpr int U_GQ = 0, U_GK = 256, U_GV = 512, U_GG = 1024, U_MQ = 1536, U_MKV = 1792, U_MKR = 1920, U_GA = 1952, IN_COLS = 1968;
constexpr float EPSN = 1e-6f;
constexpr float QSCALE = 0.10206207261596575f * 1.4426950408889634f;
constexpr size_t O_YP = 0, O_YS = 16777216, O_CKVP = 17039360, O_KRP = 19136512, O_GLAP = 19660800, O_CONVP = 19922944, O_CKVS = 19968000, O_KRS = 20000768, O_GLAS = 20008960, O_CONVS = 21057536, O_END = 21237760;
constexpr size_t MiB = 1u << 20;
constexpr size_t WS_CTL = 0, CTL_ZERO_BYTES = 1 * MiB;
constexpr size_t WS_WIN = 2 * MiB, WS_WQUP = 6 * MiB, WS_WKVUP = 6 * MiB + 512 * 1024, WS_WKVN = 6 * MiB + 768 * 1024, WS_WPP = 7 * MiB, WS_WKVP = 7 * MiB + 512 * 1024, WS_WO = 8 * MiB, WS_WPG = 10 * MiB, WS_WGU = 12 * MiB, WS_WD = 24 * MiB;
constexpr size_t WS_ROPE = 30 * MiB, WS_RS1 = 31 * MiB, WS_XB = 32 * MiB, WS_PB = 65 * MiB, WS_U = 74 * MiB, WS_PP = 139 * MiB, WS_LA = 172 * MiB, WS_QM = 189 * MiB, WS_KM = 214 * MiB, WS_VM = 239 * MiB;
constexpr size_t WS_AO = 256 * MiB, WS_H = 289 * MiB, WS_HB = 354 * MiB, WS_A = 387 * MiB, WS_C = 477 * MiB, WS_G = 567 * MiB, WS_H2B = 657 * MiB, WS_PART = 690 * MiB, WS_QABS = 699 * MiB, WS_QDEC = 700 * MiB, WS_KINV = 709 * MiB, WS_KENDT = 718 * MiB, WS_VT = 727 * MiB, WS_ELAST = 745 * MiB, WS_GGF = 746 * MiB, WS_PFSINK = 764 * MiB, WS_END = 765 * MiB;
constexpr int CW_BAR = 4096, CW_RSQ2 = 16384, CW_RSQ3 = 16384 + 16640, CW_DCNT = 50176, CW_Q = 2048, CW_RSQQ = 53248, CW_RSQKV = 53248 + 16640, CW_RSQKR = 53248 + 2 * 16640;
static_assert(CW_RSQ3 + 16640 <= CW_DCNT && CW_DCNT + 64 * 32 <= CW_RSQQ && (CW_RSQKR + 16640) * 4 <= (int)CTL_ZERO_BYTES, "ctl");
constexpr int RING_BYTES = 131072, LDSCTL_OFF = 161792, MISC_OFF = LDSCTL_OFF + 320, LDS_BYTES = 163840;

#define GAS __attribute__((address_space(1)))
#define LAS __attribute__((address_space(3)))
typedef unsigned short bf16;
typedef unsigned v4u __attribute__((ext_vector_type(4)));
typedef float f32x4 __attribute__((ext_vector_type(4)));
typedef short bf16x8 __attribute__((ext_vector_type(8)));
typedef GAS unsigned gu32;
typedef GAS unsigned long long gu64;
#define RLX_AGENT __ATOMIC_RELAXED, __HIP_MEMORY_SCOPE_AGENT
#define LDS_WAIT() asm volatile("s_waitcnt lgkmcnt(0)" ::: "memory")
#define VM_WAIT() asm volatile("s_waitcnt vmcnt(0)" ::: "memory")
__device__ __forceinline__ unsigned long long rt() { return __builtin_amdgcn_s_memrealtime(); }
__device__ __forceinline__ unsigned f2bf(float f) { unsigned u = __builtin_bit_cast(unsigned, f); return (u + 0x7fffu + ((u >> 16) & 1u)) >> 16; }
__device__ __forceinline__ unsigned pk2(float lo, float hi) { return f2bf(lo) | (f2bf(hi) << 16); }
#define XB_TMO      128
#define XB_XCNT(j)  (256  + 64 * (j))
#define XB_XSUB(j)  (1280 + 64 * (j))
#define XB_XGEN(j)  (2304 + 64 * (j))
#define XB_TOP      3328
#define XB_TOPGEN   3392
#define XCD_BAR_WORDS 3456
#define XB_SPIN_CAP (1u << 18)

__device__ __forceinline__ unsigned xb_ld(unsigned* p)              { return __hip_atomic_load(p, __ATOMIC_RELAXED, __HIP_MEMORY_SCOPE_AGENT); }
__device__ __forceinline__ unsigned xb_add(unsigned* p, unsigned v) { return __hip_atomic_fetch_add(p, v, __ATOMIC_RELAXED, __HIP_MEMORY_SCOPE_AGENT); }
__device__ __forceinline__ unsigned xb_xcc_id() { return (unsigned)__builtin_amdgcn_s_getreg((3 << 11) | 20) & 0xFu; }
#define XB_SPIN(cond, bar) do { unsigned _sp = 0; while (cond) { __builtin_amdgcn_s_sleep(1); \
    if ((++_sp & 255u) == 0u) { if (xb_ld(&(bar)[XB_TMO])) break; if (_sp > XB_SPIN_CAP) { atomicAdd(&(bar)[XB_TMO], 1u); break; } } } } while (0)

struct XcdBarrier {
    unsigned* bar; unsigned x;
    volatile LAS unsigned* st;
};

__device__ __forceinline__ XcdBarrier xcd_barrier_post(unsigned* bar, volatile LAS unsigned* st) {
    XcdBarrier b; b.bar = bar; b.x = xb_xcc_id(); b.st = st;
    if (threadIdx.x == 0) (void)xb_add(&bar[XB_XCNT(b.x)], 1u);
    return b;
}
__device__ __forceinline__ void xcd_barrier_complete(unsigned* bar, unsigned x, unsigned& nloc, unsigned& nx) {
    const unsigned G = gridDim.x * gridDim.y * gridDim.z;
    unsigned sum, cnt, mine, sp = 0u;
    for (;;) {
        sum = 0u; cnt = 0u; mine = 0u;
#pragma unroll
        for (unsigned j = 0; j < 16; ++j) { const unsigned c = xb_ld(&bar[XB_XCNT(j)]); sum += c; cnt += (c > 0u) ? 1u : 0u; mine = (j == x) ? c : mine; }
        if (sum == G) break;
        __builtin_amdgcn_s_sleep(1);
        if ((++sp & 255u) == 0u) { if (xb_ld(&bar[XB_TMO])) break; if (sp > XB_SPIN_CAP) { atomicAdd(&bar[XB_TMO], 1u); break; } }
    }
    nloc = mine > 0u ? mine : 1u; nx = cnt > 0u ? cnt : 1u;
}

__device__ __forceinline__ void xcd_barrier(const XcdBarrier& b, const int wave_s) {
    asm volatile("s_waitcnt vmcnt(0)" ::: "memory");
    __syncthreads();
    if (wave_s == 0 && lane_id() == 0) {
        unsigned* bar = b.bar;
        __builtin_amdgcn_s_waitcnt(0);
        unsigned nloc = b.st[0], nx = b.st[1];
        if (nloc == 0u) { xcd_barrier_complete(bar, b.x, nloc, nx); b.st[0] = nloc; b.st[1] = nx; }
        const unsigned old = xb_add(&bar[XB_XSUB(b.x)], 1u);
        const unsigned gen = old / nloc;
        if (old + 1u == (gen + 1u) * nloc) {
            __builtin_amdgcn_fence(__ATOMIC_RELEASE, "agent");
            asm volatile("s_waitcnt vmcnt(0)" ::: "memory");
            const unsigned og = xb_add(&bar[XB_TOP], 1u);
            const unsigned tg = og / nx;
            if (og + 1u == (tg + 1u) * nx) xb_add(&bar[XB_TOPGEN], 1u);
            else XB_SPIN(xb_ld(&bar[XB_TOPGEN]) == tg, bar);
            __builtin_amdgcn_fence(__ATOMIC_ACQUIRE, "agent");
            xb_add(&bar[XB_XGEN(b.x)], 1u);
            asm volatile("s_waitcnt vmcnt(0)" ::: "memory");
        } else {
            XB_SPIN(xb_ld(&bar[XB_XGEN(b.x)]) == gen, bar);
            __builtin_amdgcn_fence(__ATOMIC_ACQUIRE, "agent");
            asm volatile("s_waitcnt vmcnt(0)" ::: "memory");
        }
    }
    __syncthreads();
}
typedef unsigned u32x2 __attribute__((ext_vector_type(2)));
typedef float f32x2 __attribute__((ext_vector_type(2)));
__device__ __forceinline__ float blo(unsigned w) { return __builtin_bit_cast(float, w << 16); }
__device__ __forceinline__ float bhi(unsigned w) { return __builtin_bit_cast(float, w & 0xffff0000u); }
__device__ __forceinline__ float bf1(bf16 b) { return __builtin_bit_cast(float, (unsigned)b << 16); }
__device__ __forceinline__ float rbf(float f) { return __builtin_bit_cast(float, f2bf(f) << 16); }
__device__ __forceinline__ float wave_sum(float v) {
#pragma unroll
    for (int o = 1; o < 64; o <<= 1) v += __shfl_xor(v, o);
    return v;
}
__device__ __forceinline__ float wave_max(float v) {
#pragma unroll
    for (int o = 1; o < 64; o <<= 1) v = fmaxf(v, __shfl_xor(v, o));
    return v;
}
__device__ __forceinline__ float dot8(v4u w, f32x4 x0, f32x4 x1) {
    return (blo(w.x) * x0[0] + bhi(w.x) * x0[1]) + (blo(w.y) * x0[2] + bhi(w.y) * x0[3]) + (blo(w.z) * x1[0] + bhi(w.z) * x1[1]) + (blo(w.w) * x1[2] + bhi(w.w) * x1[3]);
}
__device__ __forceinline__ float silu_f(float x) { return x / (1.0f + __expf(-x)); }

struct Args { const void* in[32]; float* out; unsigned char* ws; int ph_lo, ph_hi; };

struct TItem { const float* W; const float* gk; bf16* WT; int K, N, mode, item; };
__device__ __forceinline__ TItem prep_item(const Args& a, int it) {
    unsigned char* ws = a.ws;
    constexpr int I_IN = 16 * 62, I_QUP = 4 * 24, I_KV = 2 * 32, I_O = 16 * 32, I_G = 16 * 88, I_D = 44 * 32, I_PG = 16 * 32;
    TItem t; int r = it;
    t.W = (const float*)a.in[10]; t.gk = (const float*)a.in[9]; t.WT = (bf16*)(ws + WS_WIN); t.K = 1024; t.N = IN_COLS; t.mode = 3; t.item = r;
    if (r >= I_IN) { r -= I_IN; t.W = (const float*)a.in[15]; t.gk = (const float*)a.in[14]; t.WT = (bf16*)(ws + WS_WQUP); t.K = 256; t.N = 768; t.mode = 4; t.item = r;
     if (r >= I_QUP) { r -= I_QUP; t.W = (const float*)a.in[20]; t.gk = nullptr; t.WT = (bf16*)(ws + WS_WKVUP); t.K = 128; t.N = 1024; t.mode = 0; t.item = r;
      if (r >= I_KV) { r -= I_KV; t.gk = (const float*)a.in[18]; t.WT = (bf16*)(ws + WS_WKVP); t.mode = 5; t.item = r;
       if (r >= I_KV) { r -= I_KV; t.W = (const float*)a.in[22]; t.gk = nullptr; t.WT = (bf16*)(ws + WS_WO); t.K = 1024; t.N = 1024; t.mode = 0; t.item = r;
        if (r >= I_O) { r -= I_O; t.W = (const float*)a.in[24]; t.gk = (const float*)a.in[23]; t.WT = (bf16*)(ws + WS_WGU); t.K = 1024; t.N = FF; t.mode = 1; t.item = r;
         if (r >= I_G) { r -= I_G; t.W = (const float*)a.in[25]; t.mode = 2; t.item = r;
          if (r >= I_G) { r -= I_G; t.W = (const float*)a.in[28]; t.gk = nullptr; t.WT = (bf16*)(ws + WS_WD); t.K = FF; t.N = 1024; t.mode = 0; t.item = r;
           if (r >= I_D) { r -= I_D; t.W = (const float*)a.in[30]; t.gk = (const float*)a.in[29]; t.WT = (bf16*)(ws + WS_WPG); t.K = 1024; t.N = 1024; t.item = r;
            if (r >= I_PG) { r -= I_PG; t.W = (const float*)a.in[31]; t.gk = nullptr; t.WT = (bf16*)(ws + WS_WPP); t.K = 256; t.N = 1024; t.item = r; } } } } } } } } }
    return t;
}
#define TI_LOAD(TV, T) do { const int nblk_ = ((T).N + 31) / 32, kb_ = (T).item / nblk_, nb_ = (T).item - kb_ * nblk_; const int nn_ = 32 * nb_ + (lane & 31); \
        _Pragma("unroll") for (int i = 0; i < 32; ++i) { const int kk = 2 * i + (lane >> 5); TV[i] = (nn_ < (T).N) ? (T).W[(size_t)(64 * kb_ + kk) * (T).N + nn_] : 0.f; } } while (0)
#define TI_FINISH(TV, T) do { const int nblk_ = ((T).N + 31) / 32, kb_ = (T).item / nblk_, nb_ = (T).item - kb_ * nblk_, k0 = 64 * kb_, n0 = 32 * nb_; \
        _Pragma("unroll") for (int i = 0; i < 32; ++i) { const int kk = 2 * i + (lane >> 5); float v = TV[i]; if ((T).gk) v *= (T).gk[k0 + kk]; scr[kk * 33 + (lane & 31)] = v; } \
        LDS_WAIT(); asm volatile("" ::: "memory"); \
        const int c = lane & 7; \
        _Pragma("unroll") for (int j = 0; j < 4; ++j) { const int nl = (lane >> 3) + 8 * j, n = n0 + nl; const LAS float* s = scr + (8 * c) * 33 + nl; \
            v4u o; o.x = pk2(s[0 * 33], s[1 * 33]); o.y = pk2(s[2 * 33], s[3 * 33]); o.z = pk2(s[4 * 33], s[5 * 33]); o.w = pk2(s[6 * 33], s[7 * 33]); \
            int row = n; const int mode = (T).mode; \
            if (mode == 1 || mode == 2) row = (n >> 7) * 256 + (n & 127) + (mode == 2 ? 128 : 0); \
            else if (mode == 3) { if (n >= 1936) row = 1920 + (n - 1936); else if (n >= 1808) row = 1792 + (n - 1808); else if (n >= 1552) row = 1536 + (n - 1552); else if (n >= 1536) row = 1952 + (n - 1536); } \
            else if (mode == 4) { const int h = n / 96, d = n - 96 * h; row = (d < 64) ? 256 * (h >> 2) + 128 * (d >> 5) + 32 * (h & 3) + (d & 31) : 512 + 128 * (h >> 2) + 32 * (h & 3) + (d - 64); } \
            else if (mode == 5) { const int h = n >> 7, x = n & 127; row = (x < 64) ? 256 * (h >> 2) + 128 * (x >> 5) + 32 * (h & 3) + (x & 31) : 512 + 256 * (h >> 2) + 128 * ((x - 64) >> 5) + 32 * (h & 3) + ((x - 64) & 31); } \
            if (n < (T).N) *(GAS v4u*)((T).WT + (size_t)row * (T).K + k0 + 8 * c) = o; } \
        LDS_WAIT(); asm volatile("" ::: "memory"); } while (0)
constexpr int PREP_LATE0 = 16 * 62 + 4 * 24 + 2 * (2 * 32), PREP_LATE1 = PREP_LATE0 + 16 * 32 + 2 * (16 * 88) + 44 * 32 + 16 * 32, PREP_LATE_TICKETS = (PREP_LATE1 - PREP_LATE0) / 16;
static_assert((PREP_LATE1 - PREP_LATE0) % 16 == 0, "late prep items per ticket");
__device__ __forceinline__ void prep_late(const Args& a, LAS unsigned char* lds, int ticket, int wave, int lane) {
    LAS float* scr = (LAS float*)(lds + wave * 16384);
    const int i0 = PREP_LATE0 + ticket * 16 + wave;
    float tvA[32], tvB[32]; TItem tA = prep_item(a, i0), tB = prep_item(a, i0 + 8);
    TI_LOAD(tvA, tA); TI_LOAD(tvB, tB); TI_FINISH(tvA, tA); TI_FINISH(tvB, tB);
}
constexpr int PREP_P_TICKETS = MP / 64;
__device__ __forceinline__ void prep_late_p(const Args& a, int ticket, int wave, int lane) {
    bf16* PB = (bf16*)(a.ws + WS_PB); const int m0 = ticket * 64 + wave * 8;
    f32x4 pv[8];
#pragma unroll
    for (int j = 0; j < 8; ++j) pv[j] = ((const GAS f32x4*)((const float*)a.in[7] + (size_t)(m0 + j) * 256))[lane];
#pragma unroll
    for (int j = 0; j < 8; ++j) ((GAS unsigned long long*)(PB + (size_t)(m0 + j) * 256))[lane] = (unsigned long long)pk2(pv[j].x, pv[j].y) | ((unsigned long long)pk2(pv[j].z, pv[j].w) << 32);
}
__device__ __forceinline__ void prep_phase(const Args& a, LAS unsigned char* lds, int gw, int NGW, int wave, int lane) {
    unsigned char* ws = a.ws;
    LAS float* scr = (LAS float*)(lds + wave * 16384);
    constexpr int NITEMS = PREP_LATE0 + 4 * 32;
#define EMAP(e) ((e) < PREP_LATE0 ? (e) : (e) + (PREP_LATE1 - PREP_LATE0))
    { float tvA[32], tvB[32]; int it = gw; TItem tA = prep_item(a, it < NITEMS ? EMAP(it) : 0), tB = tA;
      if (it < NITEMS) TI_LOAD(tvA, tA);
#pragma unroll 1
      while (it < NITEMS) {
          const int it1 = it + NGW; if (it1 < NITEMS) { tB = prep_item(a, EMAP(it1)); TI_LOAD(tvB, tB); }
          TI_FINISH(tvA, tA);
          if (it1 >= NITEMS) break;
          const int it2 = it1 + NGW; if (it2 < NITEMS) { tA = prep_item(a, EMAP(it2)); TI_LOAD(tvA, tA); }
          TI_FINISH(tvB, tB);
          it = it2; } }
#undef EMAP
    const int gt = gw * 64 + lane, NGT = NGW * 64;
    for (int i = gt; i < 128 * 1024 / 4; i += NGT) { const f32x4 v = ((const GAS f32x4*)a.in[20])[i]; ((GAS unsigned long long*)(ws + WS_WKVN))[i] = (unsigned long long)pk2(v.x, v.y) | ((unsigned long long)pk2(v.z, v.w) << 32); }
    for (int i = gt; i < 80 * 1024 / 8; i += NGT) ((GAS v4u*)(ws + WS_WIN + (size_t)IN_COLS * 1024 * 2))[i] = (v4u){0u, 0u, 0u, 0u};
    for (int i = gt; i < 2056 * 16; i += NGT) {
        const int pidx = i >> 4, d = i & 15; const int pos = pidx < 2048 ? pidx : 16384 + (pidx - 2048);
        double inv = 1.0; for (int k = 0; k < d; ++k) inv *= 0.56234132519034908;
        const float ang = (float)pos * (float)inv;
        const double turns = (double)ang * 0.15915494309189535; const double fr = turns - __builtin_floor(turns);
        f32x2 cs; cs.x = __builtin_amdgcn_cosf((float)fr); cs.y = __builtin_amdgcn_sinf((float)fr);
        ((GAS f32x2*)(ws + WS_ROPE))[i] = cs;
    }
    bf16* XB = (bf16*)(ws + WS_XB); float* RS1 = (float*)(ws + WS_RS1); bf16* PB = (bf16*)(ws + WS_PB);
#pragma unroll 4
    for (int m = gw; m < MT; m += NGW) {
        const float* xrow = (m < MP) ? (const float*)a.in[0] + (size_t)m * DM : (const float*)a.in[1] + (size_t)(m - MP) * DM;
        const GAS f32x4* xr = (const GAS f32x4*)xrow + lane;
        f32x4 v[4]; float s = 0.f;
#pragma unroll
        for (int j = 0; j < 4; ++j) { v[j] = xr[64 * j]; s += (v[j].x * v[j].x + v[j].y * v[j].y) + (v[j].z * v[j].z + v[j].w * v[j].w); }
        s = wave_sum(s);
        GAS unsigned long long* o8 = (GAS unsigned long long*)(XB + (size_t)m * DM) + lane;
#pragma unroll
        for (int j = 0; j < 4; ++j) o8[64 * j] = (unsigned long long)pk2(v[j].x, v[j].y) | ((unsigned long long)pk2(v[j].z, v[j].w) << 32);
        if (lane == 0) RS1[m] = 1.0f / sqrtf(s * (1.0f / DM) + EPSN);
        if (m >= MP) {
            const f32x4 pv = ((const GAS f32x4*)((const float*)a.in[8] + (size_t)(m - MP) * 256))[lane];
            ((GAS unsigned long long*)(PB + (size_t)m * 256))[lane] = (unsigned long long)pk2(pv.x, pv.y) | ((unsigned long long)pk2(pv.z, pv.w) << 32); }
    }
}

namespace pattn {
typedef short bf16x8 __attribute__((ext_vector_type(8)));
typedef short s16x4 __attribute__((ext_vector_type(4)));
typedef float f32x16 __attribute__((ext_vector_type(16)));
typedef unsigned u32x4 __attribute__((ext_vector_type(4)));
constexpr int NW = 8, QBLK = 32, KVBLK = 64, QB = NW * QBLK, DQK = 96, DV = 64;
constexpr int KP = 768, VP = 512, QP = 768, OP = 1024;
constexpr int SHM_V = KVBLK * 128 * 2, SHM_K = KVBLK * 256;
constexpr int LDS_BYTES = 2 * SHM_V + 2 * SHM_K + NW * 64 * 4;
constexpr float THR = 8.f;
#define KSWZ(row, colB) ((row) * 256 + ((colB) ^ (((row) & 7) << 4)))
#define SBAR() __builtin_amdgcn_sched_barrier(0)
__device__ __forceinline__ int v_st(int k, int c) { const int kk = (k & ~0xC) | ((k & 4) << 1) | ((k & 8) >> 1); return ((kk >> 3) * 4 + (c >> 5)) * 512 + ((kk & 7) * 32 + (c & 31)) * 2; }
__device__ __forceinline__ int v_rd_base(int lane) { return ((lane & 3) << 3) | (((lane >> 2) & 3) << 6) | (((lane >> 4) & 1) << 5) | (((lane >> 5) & 1) << 8); }
constexpr int v_rd_off(int d0, int ks, int half) { return d0 * 512 + ks * 4096 + half * 2048; }
__device__ __forceinline__ int crow(int r, int hi) { return (r & 3) + 8 * (r >> 2) + 4 * hi; }
__device__ __forceinline__ unsigned cvtpk(float lo, float hi) { unsigned r; asm volatile("v_cvt_pk_bf16_f32 %0, %1, %2" : "=v"(r) : "v"(lo), "v"(hi)); return r; }
__device__ __forceinline__ bf16x8 load8(const bf16* p) { return *reinterpret_cast<const bf16x8*>(p); }
__device__ __forceinline__ void mask_tile(f32x16& p0, f32x16& p1, int dq) {
    const float NEG = -__builtin_inff();
#pragma unroll
    for (int r = 0; r < 16; ++r) { const int c = (r & 3) + 8 * (r >> 2); if (dq - c < 0) p0[r] = NEG; if (dq - c - 32 < 0) p1[r] = NEG; }
}
__device__ __forceinline__ void partialSM(f32x16& p0, f32x16& p1, float& m_reg, float& mn, float& alpha) {
    float pmax = p0[0];
#pragma unroll
    for (int r = 1; r < 16; ++r) pmax = fmaxf(pmax, p0[r]);
#pragma unroll
    for (int r = 0; r < 16; ++r) pmax = fmaxf(pmax, p1[r]);
    { auto rr = __builtin_amdgcn_permlane32_swap(__float_as_uint(pmax), __float_as_uint(pmax), false, false); pmax = fmaxf(__uint_as_float(rr[0]), __uint_as_float(rr[1])); }
    if (__builtin_expect(__all((pmax - m_reg) <= THR), 1)) { mn = m_reg; alpha = 1.f; }
    else { mn = fmaxf(m_reg, pmax); alpha = __builtin_amdgcn_exp2f(m_reg - mn); m_reg = mn; }
#pragma unroll
    for (int r = 0; r < 16; ++r) p0[r] = p0[r] - mn;
#pragma unroll
    for (int r = 0; r < 16; ++r) p1[r] = p1[r] - mn;
#pragma unroll
    for (int r = 0; r < 16; ++r) p0[r] = __builtin_amdgcn_exp2f(p0[r]);
}
__device__ __forceinline__ void finishSM(f32x16& p0, f32x16& p1, float alpha, float& l_reg, bf16x8& pa0, bf16x8& pa1, bf16x8& pa2, bf16x8& pa3) {
#pragma unroll
    for (int r = 0; r < 16; ++r) p1[r] = __builtin_amdgcn_exp2f(p1[r]);
    float ps = 0;
#pragma unroll
    for (int r = 0; r < 16; ++r) ps += p0[r];
#pragma unroll
    for (int r = 0; r < 16; ++r) ps += p1[r];
    { auto rr = __builtin_amdgcn_permlane32_swap(__float_as_uint(ps), __float_as_uint(ps), false, false); ps = __uint_as_float(rr[0]) + __uint_as_float(rr[1]); }
    l_reg = l_reg * alpha + ps;
#define PK4(P, B_, OUT) do { unsigned a0 = cvtpk(P[B_+0], P[B_+1]), a1 = cvtpk(P[B_+2], P[B_+3]); unsigned b0 = cvtpk(P[B_+4], P[B_+5]), b1 = cvtpk(P[B_+6], P[B_+7]); \
        auto r0 = __builtin_amdgcn_permlane32_swap(a0, b0, false, false); auto r1 = __builtin_amdgcn_permlane32_swap(a1, b1, false, false); \
        u32x4 w = {r0[0], r1[0], r0[1], r1[1]}; OUT = *reinterpret_cast<bf16x8*>(&w); } while (0)
    PK4(p0, 0, pa0); PK4(p0, 8, pa1); PK4(p1, 0, pa2); PK4(p1, 8, pa3);
#undef PK4
}
template <int KB>
__device__ __forceinline__ void qkt(f32x16& p0, f32x16& p1, const char* K_lds, int r32, int hi, const bf16x8* qr) {
    p0 = f32x16{}; p1 = f32x16{};
    const char* kb[4];
#pragma unroll
    for (int dd = 0; dd < 4; ++dd) kb[dd] = K_lds + KB * SHM_K + KSWZ(r32, (dd * 16 + hi * 8) * 2);
#pragma unroll
    for (int d0 = 0; d0 < 6; ++d0) { const char* a = kb[d0 & 3] + (d0 >> 2) * 128;
        bf16x8 b0 = *reinterpret_cast<const bf16x8*>(a);
        bf16x8 b1 = *reinterpret_cast<const bf16x8*>(a + 32 * 256);
        p0 = __builtin_amdgcn_mfma_f32_32x32x16_bf16(b0, qr[d0], p0, 0, 0, 0);
        p1 = __builtin_amdgcn_mfma_f32_32x32x16_bf16(b1, qr[d0], p1, 0, 0, 0); }
}
template <int VB>
__device__ __forceinline__ void pv_tile(f32x16* o, int vb0, bf16x8 pa0, bf16x8 pa1, bf16x8 pa2, bf16x8 pa3) {
#define TRRD(dst, off) asm volatile("ds_read_b64_tr_b16 %0, %1 offset:%2" : "=&v"(dst) : "v"(vb0), "i"(off) : "memory")
#define PV_D0(d0) do { s16x4 l0, l1, l2, l3, h0, h1, h2, h3; constexpr int b_ = VB * SHM_V + v_rd_off(d0, 0, 0); \
        TRRD(l0, b_); TRRD(h0, b_ + 2048); TRRD(l1, b_ + 4096); TRRD(h1, b_ + 6144); TRRD(l2, b_ + 8192); TRRD(h2, b_ + 10240); TRRD(l3, b_ + 12288); TRRD(h3, b_ + 14336); \
        asm volatile("s_waitcnt lgkmcnt(0)" ::: "memory"); SBAR(); \
        o[d0] = __builtin_amdgcn_mfma_f32_32x32x16_bf16(pa0, (bf16x8){l0[0], l0[1], l0[2], l0[3], h0[0], h0[1], h0[2], h0[3]}, o[d0], 0, 0, 0); \
        o[d0] = __builtin_amdgcn_mfma_f32_32x32x16_bf16(pa1, (bf16x8){l1[0], l1[1], l1[2], l1[3], h1[0], h1[1], h1[2], h1[3]}, o[d0], 0, 0, 0); \
        o[d0] = __builtin_amdgcn_mfma_f32_32x32x16_bf16(pa2, (bf16x8){l2[0], l2[1], l2[2], l2[3], h2[0], h2[1], h2[2], h2[3]}, o[d0], 0, 0, 0); \
        o[d0] = __builtin_amdgcn_mfma_f32_32x32x16_bf16(pa3, (bf16x8){l3[0], l3[1], l3[2], l3[3], h3[0], h3[1], h3[2], h3[3]}, o[d0], 0, 0, 0); } while (0)
    PV_D0(0); PV_D0(1);
#undef PV_D0
#undef TRRD
}
struct BlockRef { const bf16* Q; const bf16* K; const bf16* V; bf16* O; int P0; };
struct Seam { bf16x8 qr[6]; bf16x8 st_v0, st_v1, st_k0, st_k1; };
#define VMW() asm volatile("s_waitcnt vmcnt(0)" ::: "memory")
#define VMWN(n) asm volatile("s_waitcnt vmcnt(%0)" :: "i"(n) : "memory")
#define SLOAD_H(Kp, Vp, k0) do { if (ch < 8) { S.st_v0 = load8((Vp) + (size_t)((k0) + sr) * VP + sc); S.st_v1 = load8((Vp) + (size_t)((k0) + 32 + sr) * VP + sc); } \
                                 if (ch < 12) { S.st_k0 = load8((Kp) + (size_t)((k0) + sr) * KP + sc); S.st_k1 = load8((Kp) + (size_t)((k0) + 32 + sr) * KP + sc); } } while (0)
#define SWRITE_HK(bf) do { if (ch < 12) { *(bf16x8*)(K_lds + (bf) * SHM_K + kws) = S.st_k0; *(bf16x8*)(K_lds + (bf) * SHM_K + kws + 32 * 256) = S.st_k1; } } while (0)
#define SWRITE_HV(bf) do { if (ch < 8) { *(bf16x8*)(V_lds + (bf) * SHM_V + vst0) = S.st_v0; *(bf16x8*)(V_lds + (bf) * SHM_V + vst1) = S.st_v1; } } while (0)
#define SWRITE_H(bf) do { SWRITE_HV(bf); SWRITE_HK(bf); } while (0)
__device__ __forceinline__ void prime(const BlockRef& cur, char* lds, Seam& S, const int wave_s) {
    int tid_o = wave_s * 64 + lane_id(); asm volatile("" : "+v"(tid_o));
    const int tid = tid_o, wid = __builtin_amdgcn_readfirstlane(tid >> 6), lane = tid & 63, r32 = lane & 31, hi = lane >> 5;
    const int sr = tid >> 4, ch = tid & 15, sc = ch * 8, kws = KSWZ(sr, sc * 2); char* K_lds = lds + 2 * SHM_V;
#pragma unroll
    for (int d0 = 0; d0 < 6; ++d0) S.qr[d0] = load8(cur.Q + (size_t)(wid * QBLK + r32) * QP + d0 * 16 + hi * 8);
    SLOAD_H(cur.K, cur.V, 0); VMW(); SWRITE_HK(0);
    __syncthreads();
}
__device__ __forceinline__ void block(const BlockRef& cur, const BlockRef& nxt, char* lds, Seam& S, const int wave_s) {
    int tid_o = wave_s * 64 + lane_id(); asm volatile("" : "+v"(tid_o));
    const int tid = tid_o, wid = __builtin_amdgcn_readfirstlane(tid >> 6), lane = tid & 63, r32 = lane & 31, hi = lane >> 5;
    const int NT = (cur.P0 + QB - 1) / KVBLK + 1;
    const int qlo = cur.P0 + wid * QBLK, qm = qlo + r32 - 4 * hi;
    char* V_lds = lds; char* K_lds = lds + 2 * SHM_V;
    float* wsf = (float*)(lds + 2 * SHM_V + 2 * SHM_K) + wid * 64; float* li_l = wsf, * al_l = wsf + 32;
    float m_reg = -1e30f, l_reg = 0; f32x16 o[2] = {};
    const int sr = tid >> 4, ch = tid & 15, sc = ch * 8, vst0 = v_st(sr, sc & 63), vst1 = v_st(32 + sr, sc & 63), kws = KSWZ(sr, sc * 2);
    const int vb0 = (int)(uintptr_t)V_lds + v_rd_base(lane);
    const bf16* Kh = cur.K; const bf16* Vh = cur.V;
#define RESC(a) do { if (__any((a) < 1.f)) { if (hi == 0) al_l[r32] = (a); asm volatile("s_waitcnt lgkmcnt(0)" ::: "memory"); \
                     _Pragma("unroll") for (int d_ = 0; d_ < 2; ++d_) _Pragma("unroll") for (int r = 0; r < 16; ++r) o[d_][r] *= al_l[crow(r, hi)]; } } while (0)
#define KBASE(t) ((t) * KVBLK)
#define MASKT(P0_, P1_, t) do { const int kb_ = KBASE(t); if (kb_ + KVBLK - 1 > qlo) mask_tile(P0_, P1_, qm - kb_); } while (0)
#define SEAM_K0() do { VMWN(6); SWRITE_HK(0); SBAR(); } while (0)
    f32x16 pA0, pA1, pB0, pB1; float mnA, mnB, alA, alB; bf16x8 pa0, pa1, pa2, pa3;
    SWRITE_HV(0); SBAR();
    if (NT > 1) SLOAD_H(Kh, Vh, KBASE(1));
    SBAR(); qkt<0>(pA0, pA1, K_lds, r32, hi, S.qr);
    MASKT(pA0, pA1, 0); partialSM(pA0, pA1, m_reg, mnA, alA);
    if (NT > 1) { VMW(); SWRITE_H(1); }
    __syncthreads();
#define HALF_STEP(PX0, PX1, mnX, alX, PY0, PY1, alY, t, KB, VB, SB) do { \
        SBAR(); qkt<KB>(PX0, PX1, K_lds, r32, hi, S.qr); \
        finishSM(PY0, PY1, alY, l_reg, pa0, pa1, pa2, pa3); SBAR(); \
        if ((t) + 1 < NT) { SLOAD_H(Kh, Vh, KBASE((t) + 1)); SBAR(); } \
        pv_tile<VB>(o, vb0, pa0, pa1, pa2, pa3); MASKT(PX0, PX1, (t)); partialSM(PX0, PX1, m_reg, mnX, alX); \
        __syncthreads(); \
        if ((t) + 1 < NT) { VMW(); SWRITE_H(SB); } \
        RESC(alX); __syncthreads(); } while (0)
    for (int t = 1; t + 1 < NT; t += 2) {
        HALF_STEP(pB0, pB1, mnB, alB, pA0, pA1, alA, t, 1, 0, 0);
        HALF_STEP(pA0, pA1, mnA, alA, pB0, pB1, alB, t + 1, 0, 1, 1);
    }
    const bool even = (NT & 1) == 0;
    if (even) { SBAR(); qkt<1>(pB0, pB1, K_lds, r32, hi, S.qr); SBAR(); }
    SLOAD_H(nxt.K, nxt.V, 0); SBAR();
#pragma unroll
    for (int d0 = 0; d0 < 6; ++d0) S.qr[d0] = load8(nxt.Q + (size_t)(wid * QBLK + r32) * QP + d0 * 16 + hi * 8);
    SBAR();
    finishSM(pA0, pA1, alA, l_reg, pa0, pa1, pa2, pa3); SBAR();
    pv_tile<0>(o, vb0, pa0, pa1, pa2, pa3);
    if (even) { MASKT(pB0, pB1, NT - 1); partialSM(pB0, pB1, m_reg, mnB, alB); __syncthreads(); RESC(alB);
        finishSM(pB0, pB1, alB, l_reg, pa0, pa1, pa2, pa3); SBAR(); pv_tile<1>(o, vb0, pa0, pa1, pa2, pa3); }
    SBAR(); SEAM_K0();
    if (hi == 0) li_l[r32] = l_reg; asm volatile("s_waitcnt lgkmcnt(0)" ::: "memory");
    float rli[16];
#pragma unroll
    for (int r = 0; r < 16; ++r) rli[r] = __builtin_amdgcn_rcpf(li_l[crow(r, hi)]);
    bf16* Ow = cur.O + (size_t)(wid * QBLK) * OP;
#pragma unroll
    for (int r = 0; r < 16; ++r) { const int orow = crow(r, hi);
#pragma unroll
        for (int d0 = 0; d0 < 2; ++d0) { const float v = o[d0][r] * rli[r]; const float vn = __shfl_xor(v, 1);
            if ((r32 & 1) == 0) *(unsigned*)(Ow + (size_t)orow * OP + d0 * 32 + r32) = cvtpk(v, vn); } }
    __syncthreads();
#undef RESC
#undef KBASE
#undef MASKT
#undef SEAM_K0
#undef HALF_STEP
}
#undef VMW
#undef VMWN
#undef SLOAD_H
#undef SWRITE_HK
#undef SWRITE_HV
#undef SWRITE_H
#undef KSWZ
#undef SBAR
__device__ __forceinline__ BlockRef mkref(const bf16* QM, const bf16* KM, const bf16* VM, bf16* AO, int item, int pass) {
    const int bh = item >> 2, y = item & 3, qb = pass ? 7 - y : y, b = bh >> 3, h = bh & 7; BlockRef r;
    r.Q = QM + (((size_t)b * 2048 + qb * QB) * 8 + h) * 96; r.K = KM + ((size_t)b * 2048 * 8 + h) * 96; r.V = VM + ((size_t)b * 2048 * 8 + h) * 64;
    r.O = AO + ((size_t)b * 2048 + qb * QB) * 1024 + 512 + h * 64; r.P0 = qb * QB; return r;
}
__device__ __forceinline__ void phase(char* lds, const bf16* QM, const bf16* KM, const bf16* VM, bf16* AO, int vcu, int G, const int wave_s) {
    Seam S;
    int item = vcu; if (item >= 256) return;
    BlockRef cur = mkref(QM, KM, VM, AO, item, 0); int pass = 0;
    prime(cur, lds, S, wave_s);
    for (;;) {
        int itn = item, pn = pass + 1; bool last = false;
        if (pass == 1) { pn = 0; itn = item + G; if (itn >= 256) { last = true; itn = item; pn = 1; } }
        const BlockRef nxt = mkref(QM, KM, VM, AO, itn, pn);
        block(cur, nxt, lds, S, wave_s);
        if (last) break;
        cur = nxt; item = itn; pass = pn;
    }
}
__device__ __forceinline__ void one(char* lds, const bf16* QM, const bf16* KM, const bf16* VM, bf16* AO, int idx, const int wave_s) {
    Seam S; const int qb = 7 - (idx >> 6), bh = idx & 63, b = bh >> 3, h = bh & 7; BlockRef r;
    r.Q = QM + (((size_t)b * 2048 + qb * QB) * 8 + h) * 96; r.K = KM + ((size_t)b * 2048 * 8 + h) * 96; r.V = VM + ((size_t)b * 2048 * 8 + h) * 64;
    r.O = AO + ((size_t)b * 2048 + qb * QB) * 1024 + 512 + h * 64; r.P0 = qb * QB;
    prime(r, lds, S, wave_s); block(r, r, lds, S, wave_s);
}
}
namespace dec {
typedef short bf16x8 __attribute__((ext_vector_type(8)));
typedef short s16x4 __attribute__((ext_vector_type(4)));
typedef float f32x16 __attribute__((ext_vector_type(16)));
typedef unsigned u32x4 __attribute__((ext_vector_type(4)));
typedef int i32x4 __attribute__((ext_vector_type(4)));
typedef int i32x16 __attribute__((ext_vector_type(16)));
typedef float f32x2 __attribute__((ext_vector_type(2)));
constexpr int L_SC = 0, L_CT = 65536, L_RT = 98304, L_QA = 106496, L_QR = 122880, L_RTAB = 126976, L_AL = 131072, L_ML = 133120, L_C8 = 137216, L_KI = 153600, L_END = 154112;
constexpr float THR = 8.f;
__device__ __forceinline__ unsigned off_b(unsigned row, unsigned ch) { return 256u * row + 16u * (ch ^ (((row & 3) << 2) | ((row >> 2) & 3))); }
__device__ __forceinline__ int crow(int r, int hi) { return (r & 3) + 8 * (r >> 2) + 4 * hi; }
__device__ __forceinline__ unsigned cvtpk(float lo, float hi) { unsigned r; asm volatile("v_cvt_pk_bf16_f32 %0, %1, %2" : "=v"(r) : "v"(lo), "v"(hi)); return r; }
__device__ __forceinline__ bf16x8 pack8(f32x4 a, f32x4 b) { u32x4 w = {cvtpk(a[0], a[1]), cvtpk(a[2], a[3]), cvtpk(b[0], b[1]), cvtpk(b[2], b[3])}; return *reinterpret_cast<bf16x8*>(&w); }
__device__ __forceinline__ unsigned off_c8(unsigned key, unsigned c16) { return 128u * key + ((c16 ^ ((key >> 1) & 7u)) << 4); }
__device__ __forceinline__ unsigned q4(float x0, float x1, float x2, float x3, float sc) {
    const unsigned f0 = __float_as_uint(__builtin_fmaf(x0, sc, 12582912.f)), f1 = __float_as_uint(__builtin_fmaf(x1, sc, 12582912.f)), f2 = __float_as_uint(__builtin_fmaf(x2, sc, 12582912.f)), f3 = __float_as_uint(__builtin_fmaf(x3, sc, 12582912.f));
    return __builtin_amdgcn_perm(f1, f0, 0x0c0c0400u) | __builtin_amdgcn_perm(f3, f2, 0x04000c0cu); }
__device__ __forceinline__ float rowmax16(float v) {
    asm("s_nop 1\n\tv_max_f32_dpp %0, %0, %0 row_ror:8 row_mask:0xf bank_mask:0xf\n\ts_nop 1\n\tv_max_f32_dpp %0, %0, %0 row_ror:4 row_mask:0xf bank_mask:0xf\n\t"
        "s_nop 1\n\tv_max_f32_dpp %0, %0, %0 row_ror:2 row_mask:0xf bank_mask:0xf\n\ts_nop 1\n\tv_max_f32_dpp %0, %0, %0 row_ror:1 row_mask:0xf bank_mask:0xf" : "+v"(v));
    return v; }
__device__ __forceinline__ float amax3(float a, float b, float c) { float r; asm("v_max3_f32 %0, |%1|, |%2|, |%3|" : "=v"(r) : "v"(a), "v"(b), "v"(c)); return r; }
__device__ __forceinline__ float amax8(f32x4 x0, f32x4 x1) { return amax3(x1[3], x1[3], amax3(x1[1], x1[2], amax3(x0[3], x1[0], amax3(x0[0], x0[1], x0[2])))); }
#define DBAR() asm volatile("s_waitcnt lgkmcnt(0)\n\ts_barrier" ::: "memory")
__device__ __forceinline__ void combine(const Args& a, char* lds, int bs, int wave, int lane) {
    unsigned char* ws = a.ws; const int h = wave, r31 = lane & 31, hi = lane >> 5, t = lane >> 3, x = lane & 7;
    const bf16* QM = (const bf16*)(ws + WS_QM); const bf16* KM = (const bf16*)(ws + WS_KM); const bf16* VM = (const bf16*)(ws + WS_VM); const bf16* WkvT = (const bf16*)(ws + WS_WKVUP); bf16* AO = (bf16*)(ws + WS_AO);
    const float* part = (const float*)(ws + WS_PART) + (size_t)bs * 8 * 64 * 132;
    float* wl = (float*)(lds + wave * 4096);
    float* pl = wl + 64; float* Ll = wl + 128; float* Dl = wl + 192;
    const size_t rowt = (size_t)MP + bs * 8 + t;
    const float mg = part[(x * 64 + h * 8 + t) * 132], lg = part[(x * 64 + h * 8 + t) * 132 + 1];
    float sn = 0.f;
    { const bf16* qrow = QM + (rowt * 8 + h) * 96; const bf16* krow = KM + (((size_t)MP + bs * 8 + x) * 8 + h) * 96;
#pragma unroll
      for (int c = 0; c < 12; ++c) { const v4u q = *(const v4u*)(qrow + c * 8), k = *(const v4u*)(krow + c * 8);
          sn += (blo(q.x) * blo(k.x) + bhi(q.x) * bhi(k.x)) + (blo(q.y) * blo(k.y) + bhi(q.y) * bhi(k.y)) + (blo(q.z) * blo(k.z) + bhi(q.z) * bhi(k.z)) + (blo(q.w) * blo(k.w) + bhi(q.w) * bhi(k.w)); } }
    if (x > t) sn = -1e30f;
    float mx = fmaxf(mg, sn); mx = fmaxf(mx, __shfl_xor(mx, 1)); mx = fmaxf(mx, __shfl_xor(mx, 2)); mx = fmaxf(mx, __shfl_xor(mx, 4));
    const float wg = __builtin_amdgcn_exp2f(mg - mx), pn = (x > t) ? 0.f : __builtin_amdgcn_exp2f(sn - mx);
    float L = lg * wg + pn; L += __shfl_xor(L, 1); L += __shfl_xor(L, 2); L += __shfl_xor(L, 4);
    wl[lane] = wg; pl[lane] = pn; if (x == 0) Ll[t] = L;
    asm volatile("s_waitcnt lgkmcnt(0)" ::: "memory");
    f32x16 D0 = {}, D1 = {};
    float wr8[8];
#pragma unroll
    for (int g = 0; g < 8; ++g) wr8[g] = (r31 < 8) ? wl[r31 * 8 + g] : 0.f;
#pragma unroll 2
    for (int ks = 0; ks < 8; ++ks) { f32x4 s0 = {0.f, 0.f, 0.f, 0.f}, s1 = {0.f, 0.f, 0.f, 0.f};
        if (r31 < 8) {
#pragma unroll
            for (int g = 0; g < 8; ++g) { const float* p = part + (g * 64 + h * 8 + r31) * 132 + 4 + 16 * ks + 8 * hi; s0 += wr8[g] * *(const f32x4*)p; s1 += wr8[g] * *(const f32x4*)(p + 4); } }
        const bf16x8 af = pack8(s0, s1);
        const bf16x8 b0 = *(const bf16x8*)(WkvT + (size_t)(128 * h + 64 + r31) * 128 + 16 * ks + 8 * hi), b1 = *(const bf16x8*)(WkvT + (size_t)(128 * h + 96 + r31) * 128 + 16 * ks + 8 * hi);
        D0 = __builtin_amdgcn_mfma_f32_32x32x16_bf16(af, b0, D0, 0, 0, 0); D1 = __builtin_amdgcn_mfma_f32_32x32x16_bf16(af, b1, D1, 0, 0, 0); }
#pragma unroll
    for (int r = 0; r < 4; ++r) { Dl[(r + 4 * hi) * 64 + r31] = D0[r]; Dl[(r + 4 * hi) * 64 + 32 + r31] = D1[r]; }
    asm volatile("s_waitcnt lgkmcnt(0)" ::: "memory");
    float vv[8];
#pragma unroll
    for (int tp = 0; tp < 8; ++tp) vv[tp] = bf1(VM[(((size_t)MP + bs * 8 + tp) * 8 + h) * 64 + lane]);
#pragma unroll
    for (int tt = 0; tt < 8; ++tt) { float o = Dl[tt * 64 + lane];
#pragma unroll
        for (int tp = 0; tp < 8; ++tp) o += pl[tt * 8 + tp] * vv[tp];
        AO[((size_t)MP + bs * 8 + tt) * 1024 + 512 + h * 64 + lane] = (bf16)f2bf(o / Ll[tt]); }
    asm volatile("s_waitcnt lgkmcnt(0)" ::: "memory");
}
__device__ __forceinline__ void item(const Args& a, char* lds, LAS unsigned char* ldsl, int bs, int grp, int half, int wave, int lane) {
    unsigned char* ws = a.ws; int tid_o = wave * 64 + lane_id(); asm volatile("" : "+v"(tid_o)); const int tid = tid_o; lane = tid & 63;
    const int h = wave, rb = wave >> 2, kb = wave & 3, r31 = lane & 31, hi = lane >> 5;
    const int NPG = half < 0 ? 16 : 8, pg0 = grp * 16 + (half > 0 ? 8 : 0);
    const float* cache_c = (const float*)a.in[2]; const float* cache_r = (const float*)a.in[3]; const int* ptab = (const int*)a.in[6];
    const bf16* WkvT = (const bf16*)(ws + WS_WKVUP); const bf16* QM = (const bf16*)(ws + WS_QM);
    const int myphys = (lane < NPG) ? ptab[bs * 128 + pg0 + lane] : 0;
    typedef __attribute__((address_space(3))) unsigned lds_u32;
#define PAGE_LOAD(pg_) do { const int phys_ = __builtin_amdgcn_readlane(myphys, (pg_)); const char* sc_ = (const char*)(cache_c + (size_t)phys_ * 16384); \
        _Pragma("unroll") for (int i = 0; i < 8; ++i) __builtin_amdgcn_global_load_lds((const unsigned*)(sc_ + (i * 8 + wave) * 1024 + lane * 16), (lds_u32*)(ldsl + L_SC + (i * 8 + wave) * 1024), 16, 0, 2); \
        } while (0)
#define R_LOAD(pg_) do { const int phys_ = __builtin_amdgcn_readlane(myphys, (pg_)); const f32x4* sr_ = (const f32x4*)(cache_r + (size_t)phys_ * 4096); rq0 = __builtin_nontemporal_load(sr_ + tid * 2); rq1 = __builtin_nontemporal_load(sr_ + tid * 2 + 1); } while (0)
#define PAGE_CONVERT() do { _Pragma("unroll") for (int i = 0; i < 4; ++i) { const int id = i * 512 + tid; const unsigned key_ = id >> 4, ch_ = id & 15; const f32x4 x0 = *(const f32x4*)(lds + L_SC + id * 32), x1 = *(const f32x4*)(lds + L_SC + id * 32 + 16); \
            *(bf16x8*)(lds + L_CT + off_b(key_, ch_)) = pack8(x0, x1); \
            const float mx_ = rowmax16(amax8(x0, x1)); \
            const float sc_ = mx_ > 0.f ? 127.f * __builtin_amdgcn_rcpf(mx_) : 0.f; \
            *(uint2*)(lds + L_C8 + off_c8(key_, ch_ >> 1) + 8 * (ch_ & 1)) = make_uint2(q4(x0[0], x0[1], x0[2], x0[3], sc_), q4(x1[0], x1[1], x1[2], x1[3], sc_)); \
            if (ch_ == 0) ((float*)(lds + L_KI))[key_] = mx_ * (1.f / 127.f); } \
        *(bf16x8*)(lds + L_RT + (tid >> 2) * 64 + (tid & 3) * 16) = pack8(rq0, rq1); } while (0)
    f32x4 rq0, rq1;
    i32x4 wk8[2][4]; float winv;
    { bf16x8 wk[2][8];
#pragma unroll
      for (int jb = 0; jb < 2; ++jb)
#pragma unroll
          for (int ks = 0; ks < 8; ++ks) wk[jb][ks] = *(const bf16x8*)(WkvT + (size_t)(128 * h + 32 * jb + r31) * 128 + 32 * (ks >> 1) + 16 * hi + 8 * (ks & 1));
      PAGE_LOAD(0); R_LOAD(0);
      float wm = 0.f;
#pragma unroll
      for (int jb = 0; jb < 2; ++jb)
#pragma unroll
          for (int ks = 0; ks < 8; ++ks)
#pragma unroll
              for (int e = 0; e < 8; ++e) wm = fmaxf(wm, __builtin_fabsf(bf1((bf16)wk[jb][ks][e])));
      wm = rowmax16(wm); wm = fmaxf(wm, __shfl_xor(wm, 16)); wm = fmaxf(wm, __shfl_xor(wm, 32));
      const float wsc = wm > 0.f ? 127.f * __builtin_amdgcn_rcpf(wm) : 0.f; winv = wm * (1.f / 127.f);
#pragma unroll
      for (int jb = 0; jb < 2; ++jb)
#pragma unroll
          for (int k8 = 0; k8 < 4; ++k8) { const bf16x8 lo_ = wk[jb][2 * k8], hi_ = wk[jb][2 * k8 + 1];
              wk8[jb][k8] = (i32x4){(int)q4(bf1((bf16)lo_[0]), bf1((bf16)lo_[1]), bf1((bf16)lo_[2]), bf1((bf16)lo_[3]), wsc), (int)q4(bf1((bf16)lo_[4]), bf1((bf16)lo_[5]), bf1((bf16)lo_[6]), bf1((bf16)lo_[7]), wsc),
                                    (int)q4(bf1((bf16)hi_[0]), bf1((bf16)hi_[1]), bf1((bf16)hi_[2]), bf1((bf16)hi_[3]), wsc), (int)q4(bf1((bf16)hi_[4]), bf1((bf16)hi_[5]), bf1((bf16)hi_[6]), bf1((bf16)hi_[7]), wsc)}; } }
    { const bf16* WkvN = (const bf16*)(ws + WS_WKVN); const float* g_kn = (const float*)a.in[21];
      bf16x8 qb[4];
#pragma unroll
      for (int ks = 0; ks < 4; ++ks) { const int j0 = 16 * ks + 8 * hi; u32x4 w = {0u, 0u, 0u, 0u};
          if (r31 < 8) { const bf16x8 qv = *(const bf16x8*)(QM + (((size_t)(MP + bs * 8 + r31)) * 8 + h) * 96 + j0); const f32x4 g0 = *(const f32x4*)(g_kn + j0), g1 = *(const f32x4*)(g_kn + j0 + 4);
              w.x = cvtpk(bf1((bf16)qv[0]) * g0[0], bf1((bf16)qv[1]) * g0[1]); w.y = cvtpk(bf1((bf16)qv[2]) * g0[2], bf1((bf16)qv[3]) * g0[3]);
              w.z = cvtpk(bf1((bf16)qv[4]) * g1[0], bf1((bf16)qv[5]) * g1[1]); w.w = cvtpk(bf1((bf16)qv[6]) * g1[2], bf1((bf16)qv[7]) * g1[3]); }
          qb[ks] = *reinterpret_cast<bf16x8*>(&w); }
#pragma unroll
      for (int cb = 0; cb < 4; ++cb) { f32x16 dq = {};
#pragma unroll
          for (int ks = 0; ks < 4; ++ks) { const bf16x8 wa_ = *(const bf16x8*)(WkvN + (size_t)(32 * cb + r31) * 1024 + 128 * h + 16 * ks + 8 * hi); dq = __builtin_amdgcn_mfma_f32_32x32x16_bf16(wa_, qb[ks], dq, 0, 0, 0); }
          if (r31 < 8) {
#pragma unroll
              for (int r = 0; r < 16; ++r) { const int c = 32 * cb + crow(r, hi); *(bf16*)(lds + L_QA + off_b(h * 8 + r31, c >> 3) + (c & 7) * 2) = (bf16)f2bf(dq[r]); } } } }
    if (tid < 256) { const int row = tid >> 2, ch = tid & 3, hh = row >> 3, t = row & 7;
        *(u32x4*)(lds + L_QR + row * 64 + ch * 16) = *(const u32x4*)(QM + (((size_t)(MP + bs * 8 + t)) * 8 + hh) * 96 + 64 + ch * 8); }
    asm volatile("s_waitcnt vmcnt(0)" ::: "memory"); DBAR(); PAGE_CONVERT();
    float* rtab = (float*)(lds + L_RTAB); float* al = (float*)(lds + L_AL) + wave * 64;
    float m_reg = -1e30f, l_reg = 0.f; f32x16 O[4] = {};
    const int hh = 4 * rb + (r31 >> 3);
    const unsigned q_ = (lane & 15) >> 2, p_ = lane & 3, blk_ = (lane >> 4) & 1;
    DBAR();
    for (int pg = 0; pg < NPG; ++pg) {
        const char* Cb = lds + L_CT; const char* Rb = lds + L_RT;
        if (pg + 1 < NPG) PAGE_LOAD(pg + 1);
        { const float* kiv = (const float*)(lds + L_KI);
          i32x4 cf[4];
#pragma unroll
          for (int ks = 0; ks < 4; ++ks) cf[ks] = *(const i32x4*)(lds + L_C8 + off_c8(r31, 2 * ks + hi));
          i32x16 X, Y; float sa0 = 0.f, sa1 = 0.f, kvs = 0.f;
#define FMAC1(S, A) asm("v_fmac_f32 %0, %1, %1" : "+v"(S) : "v"(A))
#define SSQ1(D, G) do { const float a0_ = (float)D[4 * G], a1_ = (float)D[4 * G + 1], a2_ = (float)D[4 * G + 2], a3_ = (float)D[4 * G + 3]; FMAC1(sa0, a0_); FMAC1(sa1, a1_); FMAC1(sa0, a2_); FMAC1(sa1, a3_); } while (0)
#define HCHUNK(KS, JB, DN, HASPREV, DP, RELOAD, NEXTOFF) do { \
            DN = __builtin_amdgcn_mfma_i32_32x32x32_i8(wk8[JB][KS], cf[KS], DN, 0, 0, 0); \
            if (RELOAD) cf[KS] = *(const i32x4*)(lds + L_C8 + (NEXTOFF)); \
            if (HASPREV) { SSQ1(DP, KS); } __builtin_amdgcn_sched_barrier(0); } while (0)
#define NFIN(KP) do { float ss = sa0 + sa1; \
            { auto rr = __builtin_amdgcn_permlane32_swap(__float_as_uint(ss), __float_as_uint(ss), false, false); ss = __uint_as_float(rr[0]) + __uint_as_float(rr[1]); } \
            const float dq_ = kvs * winv; rtab[h * 128 + 32 * (KP) + r31] = __builtin_amdgcn_rsqf(ss * (dq_ * dq_) * (1.0f / 64.0f) + EPSN); } while (0)
#define HBLK(K2, JB, DN, HASPREV, DP, NEWSQ, DOFIN, FINKP) do { DN = (i32x16){}; \
            if (NEWSQ) { sa0 = 0.f; sa1 = 0.f; } if (DOFIN) kvs = kiv[32 * (FINKP) + r31]; \
            HCHUNK(0, JB, DN, HASPREV, DP, (JB == 1 && K2 < 3), off_c8(32 * ((K2) + 1) + r31, 0 + hi)); \
            HCHUNK(1, JB, DN, HASPREV, DP, (JB == 1 && K2 < 3), off_c8(32 * ((K2) + 1) + r31, 2 + hi)); \
            HCHUNK(2, JB, DN, HASPREV, DP, (JB == 1 && K2 < 3), off_c8(32 * ((K2) + 1) + r31, 4 + hi)); \
            HCHUNK(3, JB, DN, HASPREV, DP, (JB == 1 && K2 < 3), off_c8(32 * ((K2) + 1) + r31, 6 + hi)); \
            if (DOFIN) { NFIN(FINKP); } } while (0)
          HBLK(0, 0, X, 0, Y, 0, 0, 0);
          HBLK(0, 1, Y, 1, X, 1, 0, 0);
          HBLK(1, 0, X, 1, Y, 0, 1, 0);
          HBLK(1, 1, Y, 1, X, 1, 0, 0);
          HBLK(2, 0, X, 1, Y, 0, 1, 1);
          HBLK(2, 1, Y, 1, X, 1, 0, 0);
          HBLK(3, 0, X, 1, Y, 0, 1, 2);
          HBLK(3, 1, Y, 1, X, 1, 0, 0);
          kvs = kiv[96 + r31];
          SSQ1(Y, 0); SSQ1(Y, 1); SSQ1(Y, 2); SSQ1(Y, 3);
          NFIN(3);
#undef HBLK
#undef NFIN
#undef HCHUNK
#undef SSQ1
#undef FMAC1
        }
        DBAR();
        if (pg + 1 < NPG) R_LOAD(pg + 1);
        f32x16 sn = {};
        { bf16x8 cfA = *(const bf16x8*)(Cb + off_b(32 * kb + r31, hi)), qfA = *(const bf16x8*)(lds + L_QA + off_b(32 * rb + r31, hi)), cfB, qfB;
#pragma unroll
          for (int ks = 0; ks < 8; ks += 2) {
              cfB = *(const bf16x8*)(Cb + off_b(32 * kb + r31, 2 * (ks + 1) + hi)); qfB = *(const bf16x8*)(lds + L_QA + off_b(32 * rb + r31, 2 * (ks + 1) + hi)); __builtin_amdgcn_sched_barrier(0);
              sn = __builtin_amdgcn_mfma_f32_32x32x16_bf16(cfA, qfA, sn, 0, 0, 0); __builtin_amdgcn_sched_barrier(0);
              if (ks + 2 < 8) { cfA = *(const bf16x8*)(Cb + off_b(32 * kb + r31, 2 * (ks + 2) + hi)); qfA = *(const bf16x8*)(lds + L_QA + off_b(32 * rb + r31, 2 * (ks + 2) + hi)); } __builtin_amdgcn_sched_barrier(0);
              sn = __builtin_amdgcn_mfma_f32_32x32x16_bf16(cfB, qfB, sn, 0, 0, 0); __builtin_amdgcn_sched_barrier(0); } }
#pragma unroll
        for (int q = 0; q < 4; ++q) { const f32x4 rv = *(const f32x4*)(rtab + hh * 128 + 32 * kb + 8 * q + 4 * hi);
#pragma unroll
            for (int e = 0; e < 4; ++e) sn[4 * q + e] = sn[4 * q + e] * rv[e]; }
#pragma unroll
        for (int ks = 0; ks < 2; ++ks) { const bf16x8 rf = *(const bf16x8*)(Rb + (32 * kb + r31) * 64 + (2 * ks + hi) * 16); const bf16x8 qf = *(const bf16x8*)(lds + L_QR + (32 * rb + r31) * 64 + (2 * ks + hi) * 16);
            sn = __builtin_amdgcn_mfma_f32_32x32x16_bf16(rf, qf, sn, 0, 0, 0); }
        float pmax = sn[0];
#pragma unroll
        for (int r = 1; r < 16; ++r) pmax = fmaxf(pmax, sn[r]);
        { auto rr = __builtin_amdgcn_permlane32_swap(__float_as_uint(pmax), __float_as_uint(pmax), false, false); pmax = fmaxf(__uint_as_float(rr[0]), __uint_as_float(rr[1])); }
        float mn, alpha;
        if (__all((pmax - m_reg) <= THR)) { mn = m_reg; alpha = 1.f; } else { mn = fmaxf(m_reg, pmax); alpha = __builtin_amdgcn_exp2f(m_reg - mn); m_reg = mn; }
        float ps = 0.f;
#pragma unroll
        for (int r = 0; r < 16; ++r) { sn[r] = __builtin_amdgcn_exp2f(sn[r] - mn); ps += sn[r]; }
        { auto rr = __builtin_amdgcn_permlane32_swap(__float_as_uint(ps), __float_as_uint(ps), false, false); ps = __uint_as_float(rr[0]) + __uint_as_float(rr[1]); }
        l_reg = l_reg * alpha + ps;
        bf16x8 pa0, pa1;
#define PK4(P, B_, OUT) do { unsigned a0 = cvtpk(P[B_+0], P[B_+1]), a1 = cvtpk(P[B_+2], P[B_+3]); unsigned b0 = cvtpk(P[B_+4], P[B_+5]), b1 = cvtpk(P[B_+6], P[B_+7]); \
        auto r0 = __builtin_amdgcn_permlane32_swap(a0, b0, false, false); auto r1 = __builtin_amdgcn_permlane32_swap(a1, b1, false, false); \
        u32x4 w = {r0[0], r1[0], r0[1], r1[1]}; OUT = *reinterpret_cast<bf16x8*>(&w); } while (0)
        PK4(sn, 0, pa0); PK4(sn, 8, pa1);
#undef PK4
        if (__any(alpha < 1.f)) { if (hi == 0) al[r31] = alpha; asm volatile("s_waitcnt lgkmcnt(0)" ::: "memory");
#pragma unroll
            for (int cb = 0; cb < 4; ++cb)
#pragma unroll
                for (int r = 0; r < 16; ++r) O[cb][r] *= al[crow(r, hi)]; }
        { const unsigned cbase = (unsigned)(uintptr_t)Cb;
#pragma unroll 1
          for (int s2 = 0; s2 < 2; ++s2) { s16x4 lo[4], hi4[4];
              unsigned a0[4], a1[4];
#pragma unroll
              for (int cb = 0; cb < 4; ++cb) { a0[cb] = cbase + off_b(32 * kb + 16 * s2 + 8 * hi + q_, 4 * cb + 2 * blk_ + (p_ >> 1)) + 8 * (p_ & 1);
                  a1[cb] = cbase + off_b(32 * kb + 16 * s2 + 8 * hi + 4 + q_, 4 * cb + 2 * blk_ + (p_ >> 1)) + 8 * (p_ & 1); }
              asm volatile("ds_read_b64_tr_b16 %0, %8\n\tds_read_b64_tr_b16 %1, %9\n\tds_read_b64_tr_b16 %2, %10\n\tds_read_b64_tr_b16 %3, %11\n\t"
                           "ds_read_b64_tr_b16 %4, %12\n\tds_read_b64_tr_b16 %5, %13\n\tds_read_b64_tr_b16 %6, %14\n\tds_read_b64_tr_b16 %7, %15\n\ts_waitcnt lgkmcnt(0)"
                           : "=&v"(lo[0]), "=&v"(hi4[0]), "=&v"(lo[1]), "=&v"(hi4[1]), "=&v"(lo[2]), "=&v"(hi4[2]), "=&v"(lo[3]), "=&v"(hi4[3])
                           : "v"(a0[0]), "v"(a1[0]), "v"(a0[1]), "v"(a1[1]), "v"(a0[2]), "v"(a1[2]), "v"(a0[3]), "v"(a1[3]) : "memory");
              __builtin_amdgcn_sched_barrier(0);
              const bf16x8 pa = s2 == 0 ? pa0 : pa1;
#pragma unroll
              for (int cb = 0; cb < 4; ++cb) { const bf16x8 bfr = (bf16x8){lo[cb][0], lo[cb][1], lo[cb][2], lo[cb][3], hi4[cb][0], hi4[cb][1], hi4[cb][2], hi4[cb][3]};
                  O[cb] = __builtin_amdgcn_mfma_f32_32x32x16_bf16(pa, bfr, O[cb], 0, 0, 0); } } }
        asm volatile("s_waitcnt vmcnt(0)" ::: "memory"); DBAR();
        if (pg + 1 < NPG) PAGE_CONVERT();
        DBAR();
    }
#undef PAGE_LOAD
#undef R_LOAD
#undef PAGE_CONVERT
    float* ML = (float*)(lds + L_ML);
    float* OB = (float*)lds;
    if (hi == 0) { ML[(wave * 32 + r31) * 2] = m_reg; ML[(wave * 32 + r31) * 2 + 1] = l_reg; }
    DBAR();
    float fsc[16];
#pragma unroll
    for (int r = 0; r < 16; ++r) { const int row = crow(r, hi); float M = ML[((rb * 4 + 0) * 32 + row) * 2];
#pragma unroll
        for (int k2 = 1; k2 < 4; ++k2) M = fmaxf(M, ML[((rb * 4 + k2) * 32 + row) * 2]);
        fsc[r] = __builtin_amdgcn_exp2f(ML[((rb * 4 + kb) * 32 + row) * 2] - M); }
    { float* OW = (float*)lds + wave * 4096;
#pragma unroll
      for (int cb = 0; cb < 4; ++cb)
#pragma unroll
          for (int r = 0; r < 16; ++r) OW[crow(r, hi) * 128 + cb * 32 + r31] = O[cb][r] * fsc[r]; }
    DBAR();
    float* const partG = (float*)(ws + WS_PART) + ((size_t)(bs * 8 + grp) * 64) * 132;
    float* const pairT = (float*)(ws + WS_G) + ((size_t)((bs & 3) * 8 + grp) * 2 * 64) * 132;
    { float* part = half < 0 ? partG : pairT + (size_t)half * 64 * 132; const float* OWs = (const float*)lds;
#pragma unroll 4
      for (int i = tid; i < 64 * 32; i += 512) { const int row = i >> 5, c4 = (i & 31) * 4, rbb = row >> 5, rr = row & 31; const float* p0 = OWs + (size_t)(rbb * 4) * 4096 + rr * 128 + c4;
          const f32x4 v = ((*(const f32x4*)p0 + *(const f32x4*)(p0 + 4096)) + *(const f32x4*)(p0 + 2 * 4096)) + *(const f32x4*)(p0 + 3 * 4096);
          *(f32x4*)(part + row * 132 + 4 + c4) = v; }
      if (tid < 64) { const int row = tid, rbb = row >> 5, rr = row & 31; float M = ML[((rbb * 4) * 32 + rr) * 2];
#pragma unroll
          for (int k2 = 1; k2 < 4; ++k2) M = fmaxf(M, ML[((rbb * 4 + k2) * 32 + rr) * 2]);
          float L = 0.f;
#pragma unroll
          for (int k2 = 0; k2 < 4; ++k2) L += ML[((rbb * 4 + k2) * 32 + rr) * 2 + 1] * __builtin_amdgcn_exp2f(ML[((rbb * 4 + k2) * 32 + rr) * 2] - M);
          part[row * 132] = M; part[row * 132 + 1] = L; } }
    asm volatile("s_waitcnt vmcnt(0)" ::: "memory");
    __syncthreads();
    unsigned* flagw = (unsigned*)(lds + L_ML);
    if (half >= 0) {
        if (tid == 0) { __builtin_amdgcn_fence(__ATOMIC_RELEASE, "agent"); asm volatile("s_waitcnt vmcnt(0)" ::: "memory");
            flagw[0] = __hip_atomic_fetch_add((unsigned*)(ws + WS_CTL) + CW_DCNT + 64 * bs + 16 + grp, 1u, __ATOMIC_RELAXED, __HIP_MEMORY_SCOPE_AGENT); }
        __syncthreads();
        const bool second = flagw[0] == 1u;
        __syncthreads();
        if (!second) return;
        if (tid == 0) { __builtin_amdgcn_fence(__ATOMIC_ACQUIRE, "agent"); asm volatile("s_waitcnt vmcnt(0)" ::: "memory"); }
        __syncthreads();
        const float* TA = pairT; const float* TB = pairT + 64 * 132;
#pragma unroll 4
        for (int i = tid; i < 64 * 32; i += 512) { const int row = i >> 5, c4 = (i & 31) * 4;
            const float MA = TA[row * 132], MB = TB[row * 132], M = fmaxf(MA, MB), sA = __builtin_amdgcn_exp2f(MA - M), sB = __builtin_amdgcn_exp2f(MB - M);
            const f32x4 va = *(const f32x4*)(TA + row * 132 + 4 + c4), vb = *(const f32x4*)(TB + row * 132 + 4 + c4); f32x4 v;
#pragma unroll
            for (int e = 0; e < 4; ++e) v[e] = __fadd_rn(__fmul_rn(va[e], sA), __fmul_rn(vb[e], sB));
            *(f32x4*)(partG + row * 132 + 4 + c4) = v;
            if (c4 == 0) { partG[row * 132] = M; partG[row * 132 + 1] = __fadd_rn(__fmul_rn(TA[row * 132 + 1], sA), __fmul_rn(TB[row * 132 + 1], sB)); } }
        asm volatile("s_waitcnt vmcnt(0)" ::: "memory");
        __syncthreads();
    }
    if (tid == 0) { __builtin_amdgcn_fence(__ATOMIC_RELEASE, "agent"); asm volatile("s_waitcnt vmcnt(0)" ::: "memory");
        flagw[0] = __hip_atomic_fetch_add((unsigned*)(ws + WS_CTL) + CW_DCNT + 64 * bs, 1u, __ATOMIC_RELAXED, __HIP_MEMORY_SCOPE_AGENT); }
    __syncthreads();
    const bool lastone = flagw[0] == 7u;
    __syncthreads();
    if (lastone) {
        if (tid == 0) { __builtin_amdgcn_fence(__ATOMIC_ACQUIRE, "agent"); asm volatile("s_waitcnt vmcnt(0)" ::: "memory"); }
        __syncthreads();
        combine(a, lds, bs, wave, lane);
        __syncthreads();
    }
}
#undef DBAR
}
__device__ __forceinline__ void post_tokens(const Args& a, int gw, int NGW, int lane_in) {
    unsigned char* ws = a.ws; int ln = lane_id(); asm volatile("" : "+v"(ln)); (void)lane_in; const int lane = ln;
    const bf16* U = (const bf16*)(ws + WS_U); const f32x2* ROPE = (const f32x2*)(ws + WS_ROPE); bf16* KM = (bf16*)(ws + WS_KM);
    const float* rsqkv = (const float*)(ws + WS_CTL) + CW_RSQKV; const float* rsqkr = (const float*)(ws + WS_CTL) + CW_RSQKR;
    const float* g_kva = (const float*)a.in[18]; const float* g_kr = (const float*)a.in[19];
    const f32x2 gk = *(const f32x2*)(g_kva + 2 * lane); const float gr = g_kr[lane & 31];
#pragma unroll 1
    for (int m0 = gw; m0 < MT; m0 += 4 * NGW) {
        unsigned raw[4]; float xr[4], sv[4], sr[4]; f32x2 cr[4];
#pragma unroll
        for (int i = 0; i < 4; ++i) { const int m = m0 + i * NGW; const bool ok = m < MT; const int mm = ok ? m : gw; const bf16* Urow = U + (size_t)mm * NU;
            raw[i] = *(const unsigned*)(Urow + U_MKV + 2 * lane); xr[i] = bf1(Urow[U_MKR + (lane & 31)]); sv[i] = rsqkv[mm]; sr[i] = rsqkr[mm];
            const int pidx = (mm < MP) ? (mm & 2047) : 2048 + ((mm - MP) & 7); cr[i] = ROPE[pidx * 16 + (lane & 15)]; }
#pragma unroll
        for (int i = 0; i < 4; ++i) { const int m = m0 + i * NGW; if (m < MT) {
            const float rs = __builtin_amdgcn_rsqf(sv[i] * (1.0f / 128.0f) + EPSN), rr = __builtin_amdgcn_rsqf(sr[i] * (1.0f / 32.0f) + EPSN);
            float* ck = (m < MP) ? a.out + O_CKVP + (size_t)m * 128 : a.out + O_CKVS + (size_t)(m - MP) * 128;
            *(f32x2*)(ck + 2 * lane) = (f32x2){blo(raw[i]) * rs * gk.x, bhi(raw[i]) * rs * gk.y};
            const float x = xr[i] * rr * gr, y = __shfl_xor(x, 16); const f32x2 c = cr[i];
            const float o = (lane & 16) ? (x * c.x + y * c.y) : (x * c.x - y * c.y);
            if (lane < 32) { float* kr = (m < MP) ? a.out + O_KRP + (size_t)m * 32 : a.out + O_KRS + (size_t)(m - MP) * 32; kr[lane] = o; }
            const int hh = lane >> 3, part = lane & 7;
            const float o0 = __shfl(o, 4 * part), o1 = __shfl(o, 4 * part + 1), o2 = __shfl(o, 4 * part + 2), o3 = __shfl(o, 4 * part + 3);
            u32x2 w; w.x = pk2(o0, o1); w.y = pk2(o2, o3); *(u32x2*)(KM + ((size_t)m * 8 + hh) * 96 + 64 + 4 * part) = w; } }
    }
}
namespace gla {
typedef short bf16x8 __attribute__((ext_vector_type(8)));
typedef float f32x16 __attribute__((ext_vector_type(16)));
typedef unsigned u32x4 __attribute__((ext_vector_type(4)));
__device__ __forceinline__ unsigned cvtpk(float lo, float hi) { unsigned r; asm volatile("v_cvt_pk_bf16_f32 %0, %1, %2" : "=v"(r) : "v"(lo), "v"(hi)); return r; }
__device__ __forceinline__ int crow(int r, int hi) { return (r & 3) + 8 * (r >> 2) + 4 * hi; }
__device__ __forceinline__ void prep_tile(const Args& a, char* lds, int tileidx, const int wave_s) {
    unsigned char* ws = a.ws; int tid_o = wave_s * 64 + lane_id(); asm volatile("" : "+v"(tid_o)); const int tid = tid_o, c = tid & 255, h = c >> 6, dk = c & 63;
    const int half = wave_s >> 2;
    const bf16* U = (const bf16*)(ws + WS_U); const float* w_a2 = (const float*)a.in[11]; const float* b_a = (const float*)a.in[12];
    bf16* QDEC = (bf16*)(ws + WS_QDEC); bf16* KINV = (bf16*)(ws + WS_KINV); bf16* KENDT = (bf16*)(ws + WS_KENDT); bf16* VT = (bf16*)(ws + WS_VT); float* ELAST = (float*)(ws + WS_ELAST);
    const int m0 = tileidx * 64 + half * 32; const bool is_p = m0 < MP;
    float* gaf = (float*)lds;
    __syncthreads();
    if (tid < 128) { const int t = tid >> 1, hh = tid & 1; const v4u g = *(const v4u*)(U + (size_t)(tileidx * 64 + t) * NU + U_GA + 8 * hh);
        *(f32x4*)(gaf + t * 16 + 8 * hh) = (f32x4){blo(g.x), bhi(g.x), blo(g.y), bhi(g.y)}; *(f32x4*)(gaf + t * 16 + 8 * hh + 4) = (f32x4){blo(g.z), bhi(g.z), blo(g.w), bhi(g.w)}; }
    float wa[16];
#pragma unroll
    for (int r = 0; r < 16; ++r) wa[r] = w_a2[r * 256 + c];
    const float ba = b_a[c];
    __syncthreads();
    float la[32];
#pragma unroll
    for (int t = 0; t < 32; ++t) { const float* gp = gaf + (half * 32 + t) * 16; const f32x4 g0 = *(const f32x4*)gp, g1 = *(const f32x4*)(gp + 4), g2 = *(const f32x4*)(gp + 8), g3 = *(const f32x4*)(gp + 12);
        const float z = ba + (g0[0] * wa[0] + g0[1] * wa[1] + g0[2] * wa[2] + g0[3] * wa[3]) + (g1[0] * wa[4] + g1[1] * wa[5] + g1[2] * wa[6] + g1[3] * wa[7])
                           + (g2[0] * wa[8] + g2[1] * wa[9] + g2[2] * wa[10] + g2[3] * wa[11]) + (g3[0] * wa[12] + g3[1] * wa[13] + g3[2] * wa[14] + g3[3] * wa[15]);
        la[t] = (fminf(z, 0.f) - __logf(1.0f + __expf(-fabsf(z)))) * (1.0f / 16.0f); }
#define PROC_SEG(T0, NG) do { const int ms = m0 + (T0); const int cid = is_p ? (ms >> 5) : 512 + ((ms - MP) >> 3); \
        float blast = 0.f; _Pragma("unroll") for (int t = 0; t < 8 * (NG); ++t) blast += la[(T0) + t]; \
        bf16* kt = KENDT + ((size_t)(cid * 4 + h) * 2 + (dk >> 5)) * 1024 + (dk & 31) * 8; \
        const size_t fbase = (((size_t)(cid * 4 + h) * 4 + (dk >> 4)) * 2 + ((dk >> 3) & 1)) * 256 + (dk & 7); \
        float b = 0.f; \
        _Pragma("unroll") for (int g = 0; g < (NG); ++g) { unsigned short qv[8], kv[8]; \
            _Pragma("unroll") for (int j = 0; j < 8; ++j) { const size_t m = (size_t)(ms + g * 8 + j); qv[j] = U[m * NU + U_GQ + c]; kv[j] = U[m * NU + U_GK + c]; } \
            unsigned pk[4]; \
            _Pragma("unroll") for (int j = 0; j < 8; j += 2) { float ke[2]; \
                _Pragma("unroll") for (int jj = 0; jj < 2; ++jj) { b += la[(T0) + g * 8 + j + jj]; const float eb = __expf(b), q = bf1(qv[j + jj]), k = bf1(kv[j + jj]); \
                    const size_t fo = fbase + (size_t)(g * 8 + j + jj) * 8; \
                    QDEC[fo] = (bf16)f2bf(q * 0.125f * eb); KINV[fo] = (bf16)f2bf(k * __builtin_amdgcn_rcpf(eb)); ke[jj] = k * __expf(blast - b); } \
                pk[j >> 1] = cvtpk(ke[0], ke[1]); } \
            *(v4u*)(kt + g * 256) = (v4u){pk[0], pk[1], pk[2], pk[3]}; } \
        if ((NG) == 1) { *(v4u*)(kt + 256) = (v4u){0u, 0u, 0u, 0u}; *(v4u*)(kt + 512) = (v4u){0u, 0u, 0u, 0u}; *(v4u*)(kt + 768) = (v4u){0u, 0u, 0u, 0u}; } \
        ELAST[(size_t)cid * 256 + c] = __expf(blast); } while (0)
    if (is_p) { PROC_SEG(0, 4); } else { PROC_SEG(0, 1); PROC_SEG(8, 1); PROC_SEG(16, 1); PROC_SEG(24, 1); }
#undef PROC_SEG
    bf16* GGF = (bf16*)(ws + WS_GGF);
    const int nseg = is_p ? 1 : 4, ng = is_p ? 4 : 1;
#pragma unroll 1
    for (int cc = 0; cc < 2; ++cc) { const int col = (tid & 255) + 256 * cc, hv = col >> 7, dv = col & 127, dvl = dv & 31;
        for (int seg = 0; seg < nseg; ++seg) { const int ms = m0 + seg * 8 * ng; const int cid = is_p ? (ms >> 5) : 512 + ((ms - MP) >> 3);
            bf16* vt = VT + (((size_t)(cid * 4 + hv) * 4 + (dv >> 5)) * 4) * 256 + dvl * 8;
            bf16* gf = GGF + (((((size_t)(cid * 4 + hv) * 4 + (dv >> 5)) * 4 + (dvl >> 3)) * 2 + ((dvl >> 2) & 1)) * 32) * 4 + (dvl & 3);
            for (int g = 0; g < ng; ++g) { unsigned short e[8], gg[8];
#pragma unroll
                for (int j = 0; j < 8; ++j) { e[j] = U[(size_t)(ms + g * 8 + j) * NU + U_GV + col]; gg[j] = U[(size_t)(ms + g * 8 + j) * NU + U_GG + col]; }
#pragma unroll
                for (int j = 0; j < 8; ++j) gf[(g * 8 + j) * 4] = gg[j];
                *(v4u*)(vt + g * 256) = (v4u){(unsigned)e[0] | ((unsigned)e[1] << 16), (unsigned)e[2] | ((unsigned)e[3] << 16), (unsigned)e[4] | ((unsigned)e[5] << 16), (unsigned)e[6] | ((unsigned)e[7] << 16)}; }
            if (!is_p) { *(v4u*)(vt + 256) = (v4u){0u, 0u, 0u, 0u}; *(v4u*)(vt + 512) = (v4u){0u, 0u, 0u, 0u}; *(v4u*)(vt + 768) = (v4u){0u, 0u, 0u, 0u}; } } }
    __syncthreads();
}
__device__ __forceinline__ void prep_tile_p(const Args& a, char* lds, LAS unsigned char* ldsl, int tileidx, const int wave_s) {
    typedef __attribute__((address_space(3))) unsigned lds_u32;
    constexpr int RS = 1040, RH = RS / 2, S1 = 4096, S2 = 4096 + 64 * RS;
    unsigned char* ws = a.ws; int tid_o = wave_s * 64 + lane_id(); asm volatile("" : "+v"(tid_o)); const int tid = tid_o, lane = tid & 63, c = tid & 255, h = c >> 6, dk = c & 63;
    const int half = wave_s >> 2, cid = tileidx * 2 + half;
    const bf16* U = (const bf16*)(ws + WS_U); const float* w_a2 = (const float*)a.in[11]; const float* b_a = (const float*)a.in[12];
    bf16* QDEC = (bf16*)(ws + WS_QDEC); bf16* KINV = (bf16*)(ws + WS_KINV); bf16* KENDT = (bf16*)(ws + WS_KENDT); bf16* VT = (bf16*)(ws + WS_VT); float* ELAST = (float*)(ws + WS_ELAST); bf16* GGF = (bf16*)(ws + WS_GGF);
    float* gaf = (float*)lds;
    __syncthreads();
    const char* rowb = (const char*)(U + (size_t)(tileidx * 64 + wave_s * 8) * NU) + lane * 16;
#pragma unroll
    for (int i = 0; i < 8; ++i) { __builtin_amdgcn_global_load_lds((const unsigned*)(rowb + (size_t)i * NU * 2), (lds_u32*)(ldsl + S1 + (wave_s * 8 + i) * RS), 16, 0, 0);
                                  __builtin_amdgcn_global_load_lds((const unsigned*)(rowb + (size_t)i * NU * 2 + 1024), (lds_u32*)(ldsl + S2 + (wave_s * 8 + i) * RS), 16, 0, 0); }
    if (tid < 128) { const int t = tid >> 1, hh = tid & 1; const v4u g = *(const v4u*)(U + (size_t)(tileidx * 64 + t) * NU + U_GA + 8 * hh);
        *(f32x4*)(gaf + t * 16 + 8 * hh) = (f32x4){blo(g.x), bhi(g.x), blo(g.y), bhi(g.y)}; *(f32x4*)(gaf + t * 16 + 8 * hh + 4) = (f32x4){blo(g.z), bhi(g.z), blo(g.w), bhi(g.w)}; }
    float wa[16];
#pragma unroll
    for (int r = 0; r < 16; ++r) wa[r] = w_a2[r * 256 + c];
    const float ba = b_a[c];
    __syncthreads();
    float la[32];
#pragma unroll
    for (int t = 0; t < 32; ++t) { const float* gp = gaf + (half * 32 + t) * 16; const f32x4 g0 = *(const f32x4*)gp, g1 = *(const f32x4*)(gp + 4), g2 = *(const f32x4*)(gp + 8), g3 = *(const f32x4*)(gp + 12);
        const float z = ba + (g0[0] * wa[0] + g0[1] * wa[1] + g0[2] * wa[2] + g0[3] * wa[3]) + (g1[0] * wa[4] + g1[1] * wa[5] + g1[2] * wa[6] + g1[3] * wa[7])
                           + (g2[0] * wa[8] + g2[1] * wa[9] + g2[2] * wa[10] + g2[3] * wa[11]) + (g3[0] * wa[12] + g3[1] * wa[13] + g3[2] * wa[14] + g3[3] * wa[15]);
        la[t] = (fminf(z, 0.f) - __logf(1.0f + __expf(-fabsf(z)))) * (1.0f / 16.0f); }
    asm volatile("s_waitcnt vmcnt(0)" ::: "memory");
    __syncthreads();
    { unsigned short* s1 = (unsigned short*)(lds + S1) + (half * 32) * RH + c;
      float blast = 0.f;
#pragma unroll
      for (int t = 0; t < 32; ++t) blast += la[t];
      bf16* kt = KENDT + ((size_t)(cid * 4 + h) * 2 + (dk >> 5)) * 1024 + (dk & 31) * 8;
      float b = 0.f;
#pragma unroll
      for (int g = 0; g < 4; ++g) { unsigned pk[4];
#pragma unroll
          for (int j = 0; j < 8; j += 2) { float ke[2];
#pragma unroll
              for (int jj = 0; jj < 2; ++jj) { const int t = g * 8 + j + jj; b += la[t]; const float eb = __expf(b), q = bf1(s1[t * RH]), k = bf1(s1[t * RH + 256]);
                  s1[t * RH] = (unsigned short)f2bf(q * 0.125f * eb); s1[t * RH + 256] = (unsigned short)f2bf(k * __builtin_amdgcn_rcpf(eb)); ke[jj] = k * __expf(blast - b); }
              pk[j >> 1] = cvtpk(ke[0], ke[1]); }
          *(v4u*)(kt + g * 256) = (v4u){pk[0], pk[1], pk[2], pk[3]}; }
      ELAST[(size_t)cid * 256 + c] = __expf(blast); }
    __syncthreads();
#pragma unroll
    for (int i = 0; i < 8; ++i) { const int u = i * 512 + tid, arr = u >> 11, r = u & 2047, hf = r >> 10, hh = (r >> 8) & 3, g8 = (r >> 5) & 7, t = r & 31;
        const v4u val = *(const v4u*)(lds + S1 + (hf * 32 + t) * RS + arr * 512 + (hh * 64 + g8 * 8) * 2);
        bf16* dst = (arr ? KINV : QDEC) + ((size_t)((tileidx * 2 + hf) * 4 + hh) * 8 + g8) * 256 + t * 8;
        *(v4u*)dst = val; }
    __syncthreads();
#pragma unroll
    for (int i = 0; i < 8; ++i) __builtin_amdgcn_global_load_lds((const unsigned*)(rowb + (size_t)i * NU * 2 + 2048), (lds_u32*)(ldsl + S1 + (wave_s * 8 + i) * RS), 16, 0, 0);
#pragma unroll
    for (int cc = 0; cc < 2; ++cc) { const int col = c + 256 * cc, hv = col >> 7, dv = col & 127, dvl = dv & 31;
        bf16* vt = VT + (((size_t)(cid * 4 + hv) * 4 + (dv >> 5)) * 4) * 256 + dvl * 8;
        const unsigned short* s2 = (const unsigned short*)(lds + S2) + (half * 32) * RH + col;
#pragma unroll
        for (int g = 0; g < 4; ++g) { unsigned e[8];
#pragma unroll
            for (int j = 0; j < 8; ++j) e[j] = s2[(g * 8 + j) * RH];
            *(v4u*)(vt + g * 256) = (v4u){e[0] | (e[1] << 16), e[2] | (e[3] << 16), e[4] | (e[5] << 16), e[6] | (e[7] << 16)}; } }
    asm volatile("s_waitcnt vmcnt(0)" ::: "memory");
    __syncthreads();
#pragma unroll
    for (int i = 0; i < 8; ++i) { const int u = i * 512 + tid, tp = u & 15, quad = (u >> 4) & 127, hf = u >> 11, hv = quad >> 5, dvb = (quad & 31) >> 3, q = (quad & 7) >> 1, hi = quad & 1;
        const u32x2 x0 = *(const u32x2*)(lds + S1 + (hf * 32 + 2 * tp) * RS + quad * 8), x1 = *(const u32x2*)(lds + S1 + (hf * 32 + 2 * tp + 1) * RS + quad * 8);
        bf16* dst = GGF + ((((((size_t)((tileidx * 2 + hf) * 4 + hv) * 4 + dvb) * 4 + q) * 2 + hi) * 32) + 2 * tp) * 4;
        *(v4u*)dst = (v4u){x0.x, x0.y, x1.x, x1.y}; }
    __syncthreads();
}
#define GBAR() asm volatile("s_waitcnt lgkmcnt(0)\n\ts_barrier" ::: "memory")
__device__ __forceinline__ void scan_unit(const Args& a, char* lds, int unit, int wave, int lane_in) {
    unsigned char* ws = a.ws; int ln = lane_id(); asm volatile("" : "+v"(ln)); (void)lane_in; const int lane = ln, r31 = lane & 31, hi = lane >> 5, sub = wave >> 2, dvb = wave & 3;
    const bool is_p = unit < 32; const int item = is_p ? unit : unit - 32; const int seq = item >> 2, h = item & 3;
    const int nch = is_p ? 64 : 1, tvalid = is_p ? 32 : 8;
    const size_t row0 = is_p ? (size_t)seq * 2048 : (size_t)MP + seq * 8; const int cid0 = is_p ? seq * 64 : 512 + seq;
    const bf16* U = (const bf16*)(ws + WS_U); const bf16* QDEC = (const bf16*)(ws + WS_QDEC); const bf16* KINV = (const bf16*)(ws + WS_KINV); const bf16* KENDT = (const bf16*)(ws + WS_KENDT); const bf16* VT = (const bf16*)(ws + WS_VT);
    const float* ELAST = (const float*)(ws + WS_ELAST); bf16* AO = (bf16*)(ws + WS_AO); const float* g_out = (const float*)a.in[13]; const bf16* GGF = (const bf16*)(ws + WS_GGF);
    if (sub) {
        const int hl = (wave & 3) * 64 + lane; const size_t ch0 = (size_t)cid0 * 4 + h;
        const bf16* p = KINV + ch0 * 2048; size_t stride = 0;
        if (hl < 32) { p = KINV + ch0 * 2048 + hl * 64; stride = 8192; } else if (hl < 64) { p = QDEC + ch0 * 2048 + (hl - 32) * 64; stride = 8192; }
        else if (hl < 96) { p = KENDT + ch0 * 2048 + (hl - 64) * 64; stride = 8192; } else if (hl < 160) { p = VT + ch0 * 4096 + (hl - 96) * 64; stride = 16384; }
        else if (hl < 224) { p = GGF + ch0 * 4096 + (hl - 160) * 64; stride = 16384; }
        unsigned accp = 0u, v0 = 0u, v1 = 0u, v2 = 0u, v3 = 0u;
        if (1 < nch) v1 = *(const unsigned*)(p + 1 * stride);
        if (2 < nch) v2 = *(const unsigned*)(p + 2 * stride);
        if (3 < nch) v3 = *(const unsigned*)(p + 3 * stride);
        GBAR();
#pragma unroll 1
        for (int n = 0; n < nch; n += 4) {
#define PF(V, k_) do { if (n + (k_) < nch) { accp += V; if (n + (k_) + 4 < nch) V = *(const unsigned*)(p + (size_t)(n + (k_) + 4) * stride); GBAR(); } } while (0)
            PF(v0, 0); PF(v1, 1); PF(v2, 2); PF(v3, 3);
#undef PF
        }
        if (accp == 0x9e3779b9u) ((unsigned*)(ws + WS_PFSINK))[wave * 64 + lane] = accp;
        GBAR(); return; }
    f32x16 S[2];
    if (is_p) { S[0] = f32x16{}; S[1] = f32x16{}; }
    else { const float* s0 = (const float*)a.in[4] + ((size_t)seq * 4 + h) * 8192;
#pragma unroll
        for (int blk = 0; blk < 2; ++blk)
#pragma unroll
            for (int r = 0; r < 16; ++r) S[blk][r] = s0[(32 * blk + crow(r, hi)) * 128 + 32 * dvb + r31]; }
#define PK4(P, B_, OUT) do { unsigned a0 = cvtpk(P[B_+0], P[B_+1]), a1 = cvtpk(P[B_+2], P[B_+3]); unsigned b0 = cvtpk(P[B_+4], P[B_+5]), b1 = cvtpk(P[B_+6], P[B_+7]); \
        auto r0 = __builtin_amdgcn_permlane32_swap(a0, b0, false, false); auto r1 = __builtin_amdgcn_permlane32_swap(a1, b1, false, false); \
        u32x4 w = {r0[0], r1[0], r0[1], r1[1]}; OUT = *reinterpret_cast<bf16x8*>(&w); } while (0)
    f32x4 gout[4];
#pragma unroll
    for (int q = 0; q < 4; ++q) gout[q] = *(const f32x4*)(g_out + 32 * dvb + 8 * q + 4 * hi);
    float* ELT = (float*)(lds + 65536) + sub * 4096;
    float* SS = (float*)lds;
    { const int l4 = (wave & 3) * 64 + lane;
      for (int i = l4; i < nch * 16; i += 256) { const int n = i >> 4, q4 = (i & 15) * 4; *(f32x4*)(ELT + n * 64 + q4) = *(const f32x4*)(ELAST + (size_t)(cid0 + n) * 256 + h * 64 + q4); } }
    GBAR();
    bf16x8 kiA[4], qdA[4], vtA[2], keA[2][2], kiB[4], qdB[4], vtB[2], keB[2][2]; u32x2 ggA[4], ggB[4];
#define LOADQ(KI, QD, VTX, KE, GG, n_) do { const size_t ch_ = (size_t)(cid0 + (n_)) * 4 + h; \
        _Pragma("unroll") for (int ks = 0; ks < 4; ++ks) { KI[ks] = *(const bf16x8*)(KINV + (((ch_ * 4 + ks) * 2 + hi) * 32 + r31) * 8); QD[ks] = *(const bf16x8*)(QDEC + (((ch_ * 4 + ks) * 2 + hi) * 32 + r31) * 8); } \
        _Pragma("unroll") for (int ks = 0; ks < 2; ++ks) VTX[ks] = *(const bf16x8*)(VT + ((((ch_ * 4 + dvb) * 2 + ks) * 2 + hi) * 32 + r31) * 8); \
        _Pragma("unroll") for (int blk = 0; blk < 2; ++blk) _Pragma("unroll") for (int ks = 0; ks < 2; ++ks) KE[blk][ks] = *(const bf16x8*)(KENDT + ((((ch_ * 2 + blk) * 2 + ks) * 2 + hi) * 32 + r31) * 8); \
        _Pragma("unroll") for (int q = 0; q < 4; ++q) GG[q] = *(const u32x2*)(GGF + ((((ch_ * 4 + dvb) * 4 + q) * 2 + hi) * 32 + r31) * 4); } while (0)
#define BODY(KI, QD, VTX, KE, GG, KIN, QDN, VTN, KEN, GGN, n_) do { const int n = (n_); const size_t rb = row0 + 32 * (size_t)n; \
        if (n + 1 < nch) LOADQ(KIN, QDN, VTN, KEN, GGN, n + 1); \
        f32x16 X = {}; \
        _Pragma("unroll") for (int ks = 0; ks < 4; ++ks) X = __builtin_amdgcn_mfma_f32_32x32x16_bf16(KI[ks], QD[ks], X, 0, 0, 0); \
        _Pragma("unroll") for (int r = 0; r < 16; ++r) if (crow(r, hi) > r31) X[r] = 0.f; \
        bf16x8 xb0, xb1; PK4(X, 0, xb0); PK4(X, 8, xb1); \
        f32x16 o = {}; \
        o = __builtin_amdgcn_mfma_f32_32x32x16_bf16(VTX[0], xb0, o, 0, 0, 0); o = __builtin_amdgcn_mfma_f32_32x32x16_bf16(VTX[1], xb1, o, 0, 0, 0); \
        _Pragma("unroll") for (int blk = 0; blk < 2; ++blk) { bf16x8 sb0, sb1; PK4(S[blk], 0, sb0); PK4(S[blk], 8, sb1); \
            o = __builtin_amdgcn_mfma_f32_32x32x16_bf16(sb0, QD[2 * blk], o, 0, 0, 0); o = __builtin_amdgcn_mfma_f32_32x32x16_bf16(sb1, QD[2 * blk + 1], o, 0, 0, 0); } \
        _Pragma("unroll") for (int blk = 0; blk < 2; ++blk) { \
            _Pragma("unroll") for (int q = 0; q < 4; ++q) { const f32x4 e4 = *(const f32x4*)(ELT + n * 64 + 32 * blk + 8 * q + 4 * hi); \
                S[blk][4 * q] *= e4[0]; S[blk][4 * q + 1] *= e4[1]; S[blk][4 * q + 2] *= e4[2]; S[blk][4 * q + 3] *= e4[3]; } \
            S[blk] = __builtin_amdgcn_mfma_f32_32x32x16_bf16(KE[blk][0], VTX[0], S[blk], 0, 0, 0); S[blk] = __builtin_amdgcn_mfma_f32_32x32x16_bf16(KE[blk][1], VTX[1], S[blk], 0, 0, 0); } \
        float ss = 0.f; \
        _Pragma("unroll") for (int r = 0; r < 16; ++r) ss += o[r] * o[r]; \
        { auto rr = __builtin_amdgcn_permlane32_swap(__float_as_uint(ss), __float_as_uint(ss), false, false); ss = __uint_as_float(rr[0]) + __uint_as_float(rr[1]); } \
        float* ssl = SS + ((n & 1) * 2 + sub) * 128; \
        if (hi == 0) ssl[dvb * 32 + r31] = ss; \
        GBAR(); \
        const float tot = (ssl[r31] + ssl[32 + r31]) + (ssl[64 + r31] + ssl[96 + r31]); const float rn = __builtin_amdgcn_rsqf(tot * (1.0f / 128.0f) + EPSN); \
        if (r31 < tvalid) { bf16* ao = AO + (rb + r31) * 1024 + h * 128 + 32 * dvb + 4 * hi; \
            _Pragma("unroll") for (int q = 0; q < 4; ++q) { u32x2 w; \
                w.x = cvtpk(o[4 * q] * rn * gout[q][0] * silu_f(blo(GG[q].x)), o[4 * q + 1] * rn * gout[q][1] * silu_f(bhi(GG[q].x))); \
                w.y = cvtpk(o[4 * q + 2] * rn * gout[q][2] * silu_f(blo(GG[q].y)), o[4 * q + 3] * rn * gout[q][3] * silu_f(bhi(GG[q].y))); \
                *(u32x2*)(ao + 8 * q) = w; } } \
    } while (0)
    LOADQ(kiA, qdA, vtA, keA, ggA, 0);
#pragma unroll 1
    for (int n2 = 0; n2 < nch; n2 += 2) {
        BODY(kiA, qdA, vtA, keA, ggA, kiB, qdB, vtB, keB, ggB, n2);
        if (n2 + 1 < nch) BODY(kiB, qdB, vtB, keB, ggB, kiA, qdA, vtA, keA, ggA, n2 + 1);
    }
#undef LOADQ
#undef BODY
#undef PK4
    float* so = is_p ? a.out + O_GLAP + ((size_t)seq * 4 + h) * 8192 : a.out + O_GLAS + ((size_t)seq * 4 + h) * 8192;
#pragma unroll
    for (int blk = 0; blk < 2; ++blk)
#pragma unroll
        for (int r = 0; r < 16; ++r) so[(32 * blk + crow(r, hi)) * 128 + 32 * dvb + r31] = S[blk][r];
    GBAR();
}
#undef GBAR
}
namespace skinny {
typedef short bf16x8 __attribute__((ext_vector_type(8)));
typedef float f32x16 __attribute__((ext_vector_type(16)));
__device__ __forceinline__ int crow(int r, int hi) { return (r & 3) + 8 * (r >> 2) + 4 * hi; }
template <int K, class F>
__device__ __forceinline__ void run(char* lds, const bf16* A, const bf16* Bt, int N, int vcu, int G, int wave, int lane_in, const F& f) {
    int tid_o = wave * 64 + lane_id(); asm volatile("" : "+v"(tid_o)); const int tid = tid_o, lane = tid & 63, r31 = lane & 31, hi = lane >> 5; (void)lane_in;
    constexpr int KS = K / 8 / 16;
    float* red = (float*)lds;
    const int ntiles = 8 * (N / 32);
    for (int tile = vcu; tile < ntiles; tile += G) { const int rt = tile & 7, ct = tile >> 3;
        const bf16* ap = A + (size_t)(MP + 32 * rt + r31) * K + wave * (K / 8) + 8 * hi; const bf16* bp = Bt + (size_t)(32 * ct + r31) * K + wave * (K / 8) + 8 * hi;
        const int prow = MP + 32 * rt + (tid >> 4), pcol = 32 * ct + (tid & 15) * 2;
        const typename F::Pre pre = f.pre(prow, pcol);
        f32x16 acc = {};
#pragma unroll
        for (int ks = 0; ks < KS; ++ks) { const bf16x8 av = *(const bf16x8*)(ap + 16 * ks), bv = *(const bf16x8*)(bp + 16 * ks); acc = __builtin_amdgcn_mfma_f32_32x32x16_bf16(av, bv, acc, 0, 0, 0); }
#pragma unroll
        for (int r = 0; r < 16; ++r) red[(wave * 32 + crow(r, hi)) * 32 + r31] = acc[r];
        __syncthreads();
        { const int row = tid >> 4, col = (tid & 15) * 2; float v0 = 0.f, v1 = 0.f;
#pragma unroll
          for (int w = 0; w < 8; ++w) { const f32x2 p = *(const f32x2*)(red + (w * 32 + row) * 32 + col); v0 += p.x; v1 += p.y; }
          f(MP + 32 * rt + row, 32 * ct + col, v0, v1, pre); }
        __syncthreads();
    }
}
struct FScaleBf16 { bf16* O; int ldc; const float* rs; typedef float Pre;
    __device__ __forceinline__ Pre pre(int row, int) const { return rs ? rs[row] : 1.f; }
    __device__ __forceinline__ void operator()(int row, int col, float v0, float v1, Pre s) const { *(unsigned*)(O + (size_t)row * ldc + col) = pk2(v0 * s, v1 * s); } };
struct FU { bf16* O; const float* rs; float* rsqb;
    typedef float Pre;
    __device__ __forceinline__ Pre pre(int row, int) const { return rs[row]; }
    __device__ __forceinline__ void operator()(int row, int col, float v0, float v1, Pre s) const { v0 *= s; v1 *= s; *(unsigned*)(O + (size_t)row * 2048 + col) = pk2(v0, v1);
        if (col >= 1536 && col < 1952) { float ss = v0 * v0 + v1 * v1; ss += __shfl_xor(ss, 1); ss += __shfl_xor(ss, 2); ss += __shfl_xor(ss, 4); ss += __shfl_xor(ss, 8);
            const int seg = (col >= 1792) + (col >= 1920);
            if ((lane_id() & 15) == 0) atomicAdd(rsqb + seg * 16640 + row, ss); } } };
template <bool BF> struct FResid { const void* base; bf16* hb; float* rsq;
    typedef f32x2 Pre;
    __device__ __forceinline__ Pre pre(int row, int col) const { const size_t off = (size_t)row * 1024 + col;
        if (BF) { const unsigned bw = *(const unsigned*)((const bf16*)base + off); return (f32x2){blo(bw), bhi(bw)}; } else return *(const f32x2*)((const float*)base + off); }
    __device__ __forceinline__ void operator()(int row, int col, float v0, float v1, Pre b) const { const size_t off = (size_t)row * 1024 + col; const float o0 = b.x + v0, o1 = b.y + v1;
        *(unsigned*)(hb + off) = pk2(o0, o1);
        float ss = o0 * o0 + o1 * o1; ss += __shfl_xor(ss, 1); ss += __shfl_xor(ss, 2); ss += __shfl_xor(ss, 4); ss += __shfl_xor(ss, 8);
        if ((lane_id() & 15) == 0) atomicAdd(rsq + row, ss); } };
struct FPle { const bf16* h2; const bf16* PP; const float* rsq; float* out;
    struct Pre { unsigned hw, pw; float rq; };
    __device__ __forceinline__ Pre pre(int row, int col) const { const size_t off = (size_t)row * 1024 + col; Pre p; p.hw = *(const unsigned*)(h2 + off); p.pw = *(const unsigned*)(PP + off); p.rq = rsq[row]; return p; }
    __device__ __forceinline__ void operator()(int row, int col, float v0, float v1, const Pre& p) const { const size_t off = (size_t)row * 1024 + col; const float rs = __builtin_amdgcn_rsqf(p.rq * (1.0f / 1024.0f) + 1e-6f);
        const unsigned hw = p.hw; const f32x2 hv = {blo(hw), bhi(hw)}; const unsigned pw = p.pw;
        *(f32x2*)(out + off) = (f32x2){hv.x + blo(pw) / (1.0f + __expf(-v0 * rs)), hv.y + bhi(pw) / (1.0f + __expf(-v1 * rs))}; } };
}
#ifndef MK_PER_PHASE
#define MK_PER_PHASE 0
#endif
constexpr int N_PHASES = 10;
__global__ void __launch_bounds__(NWAVES * 64, 2) hymba_fwd(Args args) {
    extern __shared__ __attribute__((aligned(16))) unsigned char lds_raw[];
    LAS unsigned char* lds = (LAS unsigned char*)lds_raw;
    volatile LAS unsigned* MISC = (volatile LAS unsigned*)(lds + MISC_OFF);
    const int tid = threadIdx.x, lane = tid & 63, wave = __builtin_amdgcn_readfirstlane(tid >> 6);
    const int G = gridDim.x; const int bx = blockIdx.x; const int vcu = (G % 8 == 0) ? (bx % 8) * (G / 8) + bx / 8 : bx;
    const int gw = vcu * NWAVES + wave, NGW = G * NWAVES;
    unsigned char* ws = args.ws;
    gu32* ctl = (gu32*)(ws + WS_CTL);
    for (int u = tid; u < (LDS_BYTES - LDSCTL_OFF) / 4; u += NWAVES * 64) ((LAS unsigned*)(lds + LDSCTL_OFF))[u] = 0u;
    __syncthreads();
    XcdBarrier bar; bar.bar = (unsigned*)(ctl + CW_BAR); bar.x = 0; bar.st = nullptr;
    if (!MK_PER_PHASE) bar = xcd_barrier_post((unsigned*)(ctl + CW_BAR), MISC + 8);
    const int lo = args.ph_lo, hi = args.ph_hi;
#define IN(k) (lo <= (k) && (k) < hi)
#define SEAM(k) do { if (IN(k) && IN((k) + 1)) xcd_barrier(bar, wave); } while (0)
    float* rsq2 = (float*)(ctl + CW_RSQ2); float* rsq3 = (float*)(ctl + CW_RSQ3); float* rsqq = (float*)(ctl + CW_RSQQ); float* rsqkv = (float*)(ctl + CW_RSQKV); float* rsqkr = (float*)(ctl + CW_RSQKR);

    if (IN(0)) { prep_phase(args, lds, gw, NGW, wave, lane_id()); }
    SEAM(0);
    if (IN(1)) {
        { pg8::Gemm g{(const bf16*)(ws + WS_XB), (const bf16*)(ws + WS_WIN), MP, NU, DM}; pg8::StaticOrder S; S.init(MP, NU, G, bx);
          pg8::EpiU E{(bf16*)(ws + WS_U), (const float*)(ws + WS_RS1), rsqq, rsqkv, rsqkr};
          pg8::gemm_phase<pg8::EpiU, pg8::StaticOrder, true, true>(lds, g, S, E, wave); }
        skinny::run<1024>((char*)lds_raw, (const bf16*)(ws + WS_XB), (const bf16*)(ws + WS_WIN), NU, vcu, G, wave, 0, skinny::FU{(bf16*)(ws + WS_U), (const float*)(ws + WS_RS1), rsqq});
        skinny::run<256>((char*)lds_raw, (const bf16*)(ws + WS_PB), (const bf16*)(ws + WS_WPP), DM, vcu, G, wave, 0, skinny::FScaleBf16{(bf16*)(ws + WS_PP), DM, nullptr});
    }
    SEAM(1);
    if (IN(2)) {
        if (bx < 110) { pg8::Gemm g{(const bf16*)(ws + WS_U) + U_MQ, (const bf16*)(ws + WS_WQUP), MT, 768, 256, NU}; pg8::StaticOrder S; S.init(MT, 768, 110, bx);
          pg8::EpiQ E{rsqq, (const float*)(ws + WS_ROPE), (const float*)args.in[16], (const float*)args.in[17], (bf16*)(ws + WS_QM)};
          pg8::gemm_phase<pg8::EpiQ, pg8::StaticOrder, true, true>(lds, g, S, E, wave); }
        else { pg8::Gemm g{(const bf16*)(ws + WS_U) + U_MKV, (const bf16*)(ws + WS_WKVP), MT, 1024, 128, NU}; pg8::StaticOrder S; S.init(MT, 1024, G - 110, bx - 110);
          pg8::EpiKV E{rsqkv, (const float*)args.in[21], (bf16*)(ws + WS_KM), (bf16*)(ws + WS_VM)};
          pg8::gemm_phase<pg8::EpiKV, pg8::StaticOrder, true, true>(lds, g, S, E, wave); }
        post_tokens(args, gw, NGW, 0);
        { volatile LAS unsigned* qs2 = MISC + 20;
          for (;;) {
              __syncthreads();
              if (wave == 0 && lane_id() == 0) qs2[0] = __hip_atomic_fetch_add((unsigned*)(ctl + CW_Q + 128), 1u, __ATOMIC_RELAXED, __HIP_MEMORY_SCOPE_AGENT);
              __syncthreads();
              const int tl = __builtin_amdgcn_readfirstlane((int)qs2[0]);
              if (tl >= MT / 64) break;
              if (tl < MP / 64) gla::prep_tile_p(args, (char*)lds_raw, lds, tl, wave); else gla::prep_tile(args, (char*)lds_raw, tl, wave);
          } }
    }
    SEAM(2);
    if (IN(3)) {
        volatile LAS unsigned* qs = MISC + 16;
        bool first = true;
        for (;;) {
            __syncthreads();
            if (!first && wave == 0 && lane_id() == 0) qs[0] = (unsigned)G + __hip_atomic_fetch_add((unsigned*)(ctl + CW_Q), 1u, __ATOMIC_RELAXED, __HIP_MEMORY_SCOPE_AGENT);
            __syncthreads();
            const int it = first ? bx : __builtin_amdgcn_readfirstlane((int)qs[0]);
            first = false;
            constexpr int TF0 = 768, TFW = TF0 + PREP_LATE_TICKETS, TF1 = TFW + PREP_P_TICKETS, TA2 = TF1 + 64, TEND = TA2 + 128;
            if (it >= TEND) break;
            if (it < 32) gla::scan_unit(args, (char*)lds_raw, it, wave, 0);
            else if (it < 432 && !(it >= 144 && it < 256)) { const bool whole = it < 368; const int d = it < 144 ? it - 32 : it - 144, j = it - 368;
                dec::item(args, (char*)lds_raw, lds, whole ? d >> 3 : 28 + (j >> 4), whole ? d & 7 : (j >> 1) & 7, whole ? -1 : (j & 1), wave, 0); }
            else if (it < TF0 || (it >= TF1 && it < TA2)) pattn::one((char*)lds_raw, (const bf16*)(ws + WS_QM), (const bf16*)(ws + WS_KM), (const bf16*)(ws + WS_VM), (bf16*)(ws + WS_AO), it < 256 ? it - 144 : (it < TF0 ? it - 320 : it - TF1 + 448), wave);
            else if (it < TFW) prep_late(args, lds, it - TF0, wave, lane_id());
            else if (it < TF1) prep_late_p(args, it - TFW, wave, lane_id());
            else gla::scan_unit(args, (char*)lds_raw, it - TA2 + 32, wave, 0);
        }
    }
    SEAM(3);
    if (IN(5)) {
        pg8::Gemm g{(const bf16*)(ws + WS_AO), (const bf16*)(ws + WS_WO), MP, DM, DM}; pg8::StaticOrder S; S.init(MP, DM, G, bx);
        pg8::EpiResid<false> E{args.in[0], (bf16*)(ws + WS_HB), rsq2};
        pg8::gemm_phase<pg8::EpiResid<false>, pg8::StaticOrder, true, true>(lds, g, S, E, wave);
        skinny::run<1024>((char*)lds_raw, (const bf16*)(ws + WS_AO), (const bf16*)(ws + WS_WO), DM, vcu, G, wave, 0, skinny::FResid<false>{(const float*)args.in[1] - (size_t)MP * DM, (bf16*)(ws + WS_HB), rsq2});
    }
    SEAM(5);
    if (IN(6)) {
        pg8::Gemm g{(const bf16*)(ws + WS_HB), (const bf16*)(ws + WS_WGU), MT, 2 * FF, DM, 0, 254, -2}; pg8::StaticOrder S; S.init_tiles(66, 22, G, bx);
        pg8::EpiConv E{rsq2, (PG8_LAS float*)(lds + 131072), (const float*)args.in[26], (const float*)args.in[27], (const float*)args.in[5], (bf16*)(ws + WS_G), args.out + O_CONVP, args.out + O_CONVS};
        pg8::gemm_phase<pg8::EpiConv, pg8::StaticOrder, true, true>(lds, g, S, E, wave);
        if (bx >= 1452 - 5 * G && G == 256) {
            pg8::Gemm g2{(const bf16*)(ws + WS_PB), (const bf16*)(ws + WS_WPP), MP, DM, 256}; pg8::StaticOrder S2; S2.init(MP, DM, G - (1452 - 5 * G), bx - (1452 - 5 * G));
            pg8::EpiScaleBf16 E2{(bf16*)(ws + WS_PP), DM, nullptr};
            pg8::gemm_phase<pg8::EpiScaleBf16, pg8::StaticOrder, true, true>(lds, g2, S2, E2, wave); }
        else if (G != 256) { pg8::Gemm g2{(const bf16*)(ws + WS_PB), (const bf16*)(ws + WS_WPP), MP, DM, 256}; pg8::StaticOrder S2; S2.init(MP, DM, G, bx);
            pg8::EpiScaleBf16 E2{(bf16*)(ws + WS_PP), DM, nullptr};
            pg8::gemm_phase<pg8::EpiScaleBf16, pg8::StaticOrder, true, true>(lds, g2, S2, E2, wave); }
    }
    SEAM(6);
    if (IN(8)) {
        pg8::Gemm g{(const bf16*)(ws + WS_G), (const bf16*)(ws + WS_WD), MP, DM, FF}; pg8::StaticOrder S; S.init(MP, DM, G, bx);
        pg8::EpiResid<true> E{(const void*)(ws + WS_HB), (bf16*)(ws + WS_H2B), rsq3};
        pg8::gemm_phase<pg8::EpiResid<true>, pg8::StaticOrder, true, true>(lds, g, S, E, wave);
        skinny::run<2816>((char*)lds_raw, (const bf16*)(ws + WS_G), (const bf16*)(ws + WS_WD), DM, vcu, G, wave, 0, skinny::FResid<true>{(const void*)(ws + WS_HB), (bf16*)(ws + WS_H2B), rsq3});
    }
    SEAM(8);
    if (IN(9)) {
        pg8::Gemm g{(const bf16*)(ws + WS_H2B), (const bf16*)(ws + WS_WPG), MP, DM, DM}; pg8::StaticOrder S; S.init(MP, DM, G, bx);
        pg8::EpiPle E{(const bf16*)(ws + WS_H2B), (const bf16*)(ws + WS_PP), rsq3, args.out + O_YP};
        pg8::gemm_phase<pg8::EpiPle, pg8::StaticOrder, true, true>(lds, g, S, E, wave);
        skinny::run<1024>((char*)lds_raw, (const bf16*)(ws + WS_H2B), (const bf16*)(ws + WS_WPG), DM, vcu, G, wave, 0, skinny::FPle{(const bf16*)(ws + WS_H2B), (const bf16*)(ws + WS_PP), rsq3, args.out + O_YP});
    }
#undef IN
#undef SEAM
}

extern "C" void kernel_launch(void* const* d_in, const int* in_sizes, int n_in, void* d_out, int out_size, void* d_ws, size_t ws_size, hipStream_t stream) {
    static int grid = 0;
    if (grid == 0) {
        if (n_in != 32 || out_size != (int)O_END || ws_size < WS_END) { fprintf(stderr, "kernel_launch: unexpected shapes: n_in %d out %d ws %zu; nothing launched\n", n_in, out_size, ws_size); grid = -1; return; }
        int dev = 0, cus = 0, per_cu = 0;
        if (hipGetDevice(&dev) != hipSuccess || hipDeviceGetAttribute(&cus, hipDeviceAttributeMultiprocessorCount, dev) != hipSuccess) { fprintf(stderr, "kernel_launch: device query failed\n"); grid = -1; return; }
        if (hipFuncSetAttribute((const void*)hymba_fwd, hipFuncAttributeMaxDynamicSharedMemorySize, LDS_BYTES) != hipSuccess) { fprintf(stderr, "kernel_launch: hipFuncSetAttribute failed\n"); grid = -1; return; }
        if (hipOccupancyMaxActiveBlocksPerMultiprocessor(&per_cu, (const void*)hymba_fwd, NWAVES * 64, LDS_BYTES) != hipSuccess || per_cu < 1)
            fprintf(stderr, "kernel_launch: note: occupancy query reports %d workgroups per CU\n", per_cu);
        (void)hipGetLastError();
        grid = cus;
        if (grid != 256) fprintf(stderr, "kernel_launch: note: %d CUs (built for 256)\n", grid);
    }
    if (grid < 0) return;
    (void)hipMemsetAsync((char*)d_ws + WS_CTL, 0, CTL_ZERO_BYTES, stream);
    Args a{};
    for (int i = 0; i < 32; ++i) a.in[i] = d_in[i];
    a.out = (float*)d_out; a.ws = (unsigned char*)d_ws;
#if MK_PER_PHASE
    for (int p = 0; p < N_PHASES; ++p) { a.ph_lo = p; a.ph_hi = p + 1; hipLaunchKernelGGL(hymba_fwd, dim3(grid), dim3(NWAVES * 64), LDS_BYTES, stream, a); }
#else
    a.ph_lo = 0; a.ph_hi = N_PHASES;
    hipLaunchKernelGGL(hymba_fwd, dim3(grid), dim3(NWAVES * 64), LDS_BYTES, stream, a);
#endif
    const hipError_t le = hipPeekAtLastError();
    if (le != hipSuccess) fprintf(stderr, "kernel_launch: launch failed: %s\n", hipGetErrorName(le));
}
```

```cpp
#include <hip/hip_runtime.h>
#include <cstdio>
#include <cstdint>
__device__ __forceinline__ int lane_id() { int l; asm volatile("v_mbcnt_lo_u32_b32 %0, -1, 0\n\tv_mbcnt_hi_u32_b32 %0, -1, %0" : "=v"(l)); return l; }
namespace pg8 {
#define PG8_LAS __attribute__((address_space(3)))
typedef unsigned short bf16_t;
typedef short bf16x8 __attribute__((ext_vector_type(8)));
typedef float f32x4 __attribute__((ext_vector_type(4)));
typedef unsigned u32x4 __attribute__((ext_vector_type(4)));
constexpr int BM = 256, BK = 64, HALF = 128, HTB = HALF * BK * 2  , STAGE_BYTES = 8 * HTB, NXCD = 8, WGM = 8;

__host__ __device__ __forceinline__ int lds_byte(int r, int c) { const int st = (r >> 4) * 2 + (c >> 5), rr = r & 15, cc = c & 31, ob = rr * 64 + cc * 2; return st * 1024 + (ob ^ (((ob >> 9) & 1) << 5)); }
__host__ __device__ __forceinline__ void stage_rc(int b, int& R, int& C) { const int st = b / 1024, sb = b % 1024, swz = sb ^ (((sb >> 9) & 1) << 5); R = (st >> 1) * 16 + swz / 64; C = (st & 1) * 32 + (swz % 64) / 2; }
__host__ __device__ __forceinline__ int perm32(int rho) { const int n = rho >> 4, i = rho & 15; return 8 * (i >> 2) + 4 * n + (i & 3); }

struct Unit { int pm, pn; };
struct Gemm { const bf16_t* A; const bf16_t* Bt; int M, N, K; int lda = 0, tile_rows = 0, row_off = 0; };

struct StaticOrder {
    int nM, nN, nwg, G, c;
    __host__ __device__ void init(int M, int N, int G_, int c_) { nM = M / BM; nN = N / BM; nwg = nM * nN; G = G_; c = c_; }
    __host__ __device__ void init_tiles(int nM_, int nN_, int G_, int c_) { nM = nM_; nN = nN_; nwg = nM * nN; G = G_; c = c_; }
    __host__ __device__ bool next(int i, Unit& u) const {
        const long L = (long)i * G + c; if (L >= nwg) return false;
        int wgid = (int)L; { const int q = nwg / NXCD, r = nwg % NXCD, xcd = wgid % NXCD, off = wgid / NXCD; wgid = (xcd < r ? xcd * (q + 1) : r * (q + 1) + (xcd - r) * q) + off; }
        const int nig = WGM * nN, gid = wgid / nig, fm = gid * WGM, gsz = (nM - fm) < WGM ? (nM - fm) : WGM;
        u.pm = fm + ((wgid % nig) % gsz); u.pn = (wgid % nig) / gsz; return true;
    }
    __device__ __forceinline__ void a_ready(const Unit&) const {}
    __device__ __forceinline__ void done(const Unit&) const {}
};

__device__ __forceinline__ unsigned cvt_pk_bf16(float lo, float hi) { unsigned r; asm volatile("v_cvt_pk_bf16_f32 %0, %1, %2" : "=v"(r) : "v"(lo), "v"(hi)); return r; }
typedef float f32x2 __attribute__((ext_vector_type(2)));
__device__ __forceinline__ unsigned short f2bf_rne(float f) { unsigned u = __builtin_bit_cast(unsigned, f); return (unsigned short)((u + 0x7fffu + ((u >> 16) & 1u)) >> 16); }
__device__ __forceinline__ float bf2f_(unsigned short b) { return __builtin_bit_cast(float, (unsigned)b << 16); }
struct EpiScaleBf16 {
    static constexpr bool PERM = true, AFTER_DRAIN = false;
    bf16_t* O; int ldc; const float* rs;
    __device__ __forceinline__ void operator()(const f32x4 (&acc)[2][2][4][2], const Unit& u, int wr, int wc, int fr, int fq) const {
        asm volatile("" : "+v"(fr), "+v"(fq));
        const int row0 = u.pm * BM + wr * 64 + fr, col0 = u.pn * BM + wc * 32 + 8 * fq;
#pragma unroll
        for (int ai = 0; ai < 2; ++ai)
#pragma unroll
            for (int m = 0; m < 4; ++m) { const int row = row0 + ai * HALF + m * 16; const float s = rs ? rs[row] : 1.f; bf16_t* rowp = O + (size_t)row * ldc + col0;
#pragma unroll
                for (int bj = 0; bj < 2; ++bj) { const f32x4 v0 = acc[ai][bj][m][0] * s, v1 = acc[ai][bj][m][1] * s;
                    u32x4 w; w.x = cvt_pk_bf16(v0[0], v0[1]); w.y = cvt_pk_bf16(v0[2], v0[3]); w.z = cvt_pk_bf16(v1[0], v1[1]); w.w = cvt_pk_bf16(v1[2], v1[3]);
                    *(u32x4*)(rowp + bj * HALF) = w; } }
    }
};
template <bool BF> struct EpiResid {
    static constexpr bool PERM = false, AFTER_DRAIN = false;
    const void* base; bf16_t* hb; float* rsq;
    __device__ __forceinline__ void operator()(const f32x4 (&acc)[2][2][4][2], const Unit& u, int wr, int wc, int fr, int fq) const {
        asm volatile("" : "+v"(fr), "+v"(fq));
        typedef unsigned u32x2v __attribute__((ext_vector_type(2)));
        const int col0 = u.pn * BM + wc * 32 + 4 * fq;
#pragma unroll
        for (int ai = 0; ai < 2; ++ai) { asm volatile("" ::: "memory");
#pragma unroll
            for (int m = 0; m < 4; ++m) { const int r = u.pm * BM + ai * HALF + wr * 64 + m * 16 + fr;
                float ss = 0.f;
#pragma unroll
                for (int bj = 0; bj < 2; ++bj)
#pragma unroll
                    for (int n = 0; n < 2; ++n) { const size_t off = (size_t)r * 1024 + col0 + bj * HALF + n * 16; f32x4 v;
                        if (BF) { const u32x2v bw = *(const u32x2v*)((const bf16_t*)base + off);
                            v = (f32x4){__builtin_bit_cast(float, bw.x << 16), __builtin_bit_cast(float, bw.x & 0xffff0000u), __builtin_bit_cast(float, bw.y << 16), __builtin_bit_cast(float, bw.y & 0xffff0000u)} + acc[ai][bj][m][n]; }
                        else v = *(const f32x4*)((const float*)base + off) + acc[ai][bj][m][n];
                        u32x2v w; w.x = cvt_pk_bf16(v[0], v[1]); w.y = cvt_pk_bf16(v[2], v[3]); *(u32x2v*)(hb + off) = w;
                        ss += (v[0] * v[0] + v[1] * v[1]) + (v[2] * v[2] + v[3] * v[3]); }
                ss += __shfl_xor(ss, 16); ss += __shfl_xor(ss, 32);
                if (fq == 0) atomicAdd(rsq + r, ss); } }
    }
};
struct EpiGateUp {
    static constexpr bool PERM = true, AFTER_DRAIN = false;
    const float* rsq; bf16_t* A; bf16_t* C; float* conv_p; float* conv_s;
    __device__ __forceinline__ void operator()(const f32x4 (&acc)[2][2][4][2], const Unit& u, int wr, int wc, int fr, int fq) const {
        asm volatile("" : "+v"(fr), "+v"(fq));
        const int f0 = u.pn * HALF + wc * 32 + 8 * fq;
#pragma unroll
        for (int ai = 0; ai < 2; ++ai)
#pragma unroll
            for (int m = 0; m < 4; ++m) { const int r = u.pm * BM + ai * HALF + wr * 64 + m * 16 + fr;
                const float rs = __builtin_amdgcn_rsqf(rsq[r] * (1.0f / 1024.0f) + 1e-6f);
                const f32x4 a0 = acc[ai][0][m][0] * rs, a1 = acc[ai][0][m][1] * rs, c0 = acc[ai][1][m][0] * rs, c1 = acc[ai][1][m][1] * rs;
                u32x4 w; w.x = cvt_pk_bf16(a0[0], a0[1]); w.y = cvt_pk_bf16(a0[2], a0[3]); w.z = cvt_pk_bf16(a1[0], a1[1]); w.w = cvt_pk_bf16(a1[2], a1[3]);
                *(u32x4*)(A + (size_t)r * 2816 + f0) = w;
                w.x = cvt_pk_bf16(c0[0], c0[1]); w.y = cvt_pk_bf16(c0[2], c0[3]); w.z = cvt_pk_bf16(c1[0], c1[1]); w.w = cvt_pk_bf16(c1[2], c1[3]);
                *(u32x4*)(C + (size_t)r * 2816 + f0) = w;
                float* dst = nullptr;
                if (r < 16384) { const int t = r & 2047; if (t >= 2046) dst = conv_p + ((size_t)(r >> 11) * 2 + (t - 2046)) * 2816 + f0; }
                else { const int rr = r - 16384, t = rr & 7; if (t >= 6) dst = conv_s + ((size_t)(rr >> 3) * 2 + (t - 6)) * 2816 + f0; }
                if (dst) { *(f32x4*)dst = a0; *(f32x4*)(dst + 4) = a1; } }
    }
};
struct EpiPle {
    static constexpr bool PERM = false, AFTER_DRAIN = false;
    const bf16_t* h2; const bf16_t* PP; const float* rsq; float* out;
    __device__ __forceinline__ void operator()(const f32x4 (&acc)[2][2][4][2], const Unit& u, int wr, int wc, int fr, int fq) const {
        asm volatile("" : "+v"(fr), "+v"(fq));
        typedef unsigned u32x2v __attribute__((ext_vector_type(2)));
        const int col0 = u.pn * BM + wc * 32 + 4 * fq;
#pragma unroll
        for (int ai = 0; ai < 2; ++ai) { asm volatile("" ::: "memory");
#pragma unroll
            for (int m = 0; m < 4; ++m) { const int r = u.pm * BM + ai * HALF + wr * 64 + m * 16 + fr;
                const float rs = __builtin_amdgcn_rsqf(rsq[r] * (1.0f / 1024.0f) + 1e-6f);
#pragma unroll
                for (int bj = 0; bj < 2; ++bj)
#pragma unroll
                    for (int n = 0; n < 2; ++n) { const size_t off = (size_t)r * 1024 + col0 + bj * HALF + n * 16; const u32x2v hw = *(const u32x2v*)(h2 + off); const f32x4 hv = {__builtin_bit_cast(float, hw.x << 16), __builtin_bit_cast(float, hw.x & 0xffff0000u), __builtin_bit_cast(float, hw.y << 16), __builtin_bit_cast(float, hw.y & 0xffff0000u)};
                        const u32x2v pw = *(const u32x2v*)(PP + off); const f32x4 z = acc[ai][bj][m][n] * rs; f32x4 o;
                        o[0] = hv[0] + __builtin_bit_cast(float, pw.x << 16) * __builtin_amdgcn_rcpf(1.0f + __builtin_amdgcn_exp2f(-1.4426950408889634f * z[0]));
                        o[1] = hv[1] + __builtin_bit_cast(float, pw.x & 0xffff0000u) * __builtin_amdgcn_rcpf(1.0f + __builtin_amdgcn_exp2f(-1.4426950408889634f * z[1]));
                        o[2] = hv[2] + __builtin_bit_cast(float, pw.y << 16) * __builtin_amdgcn_rcpf(1.0f + __builtin_amdgcn_exp2f(-1.4426950408889634f * z[2]));
                        o[3] = hv[3] + __builtin_bit_cast(float, pw.y & 0xffff0000u) * __builtin_amdgcn_rcpf(1.0f + __builtin_amdgcn_exp2f(-1.4426950408889634f * z[3]));
                        *(f32x4*)(out + off) = o; } } }
    }
};
struct EpiU {
    static constexpr bool PERM = true, AFTER_DRAIN = false;
    bf16_t* O; const float* rs; float* rsqq; float* rsqkv; float* rsqkr;
    __device__ __forceinline__ void operator()(const f32x4 (&acc)[2][2][4][2], const Unit& u, int wr, int wc, int fr, int fq) const {
        asm volatile("" : "+v"(fr), "+v"(fq));
        const int row0 = u.pm * BM + wr * 64 + fr, col0 = u.pn * BM + wc * 32 + 8 * fq;
#pragma unroll
        for (int ai = 0; ai < 2; ++ai)
#pragma unroll
            for (int m = 0; m < 4; ++m) { const int row = row0 + ai * HALF + m * 16; const float s = rs[row]; bf16_t* rowp = O + (size_t)row * 2048 + col0; float sq[2];
#pragma unroll
                for (int bj = 0; bj < 2; ++bj) { const f32x4 v0 = acc[ai][bj][m][0] * s, v1 = acc[ai][bj][m][1] * s;
                    u32x4 w; w.x = cvt_pk_bf16(v0[0], v0[1]); w.y = cvt_pk_bf16(v0[2], v0[3]); w.z = cvt_pk_bf16(v1[0], v1[1]); w.w = cvt_pk_bf16(v1[2], v1[3]);
                    *(u32x4*)(rowp + bj * HALF) = w;
                    sq[bj] = ((v0[0] * v0[0] + v0[1] * v0[1]) + (v0[2] * v0[2] + v0[3] * v0[3])) + ((v1[0] * v1[0] + v1[1] * v1[1]) + (v1[2] * v1[2] + v1[3] * v1[3])); }
                if (u.pn >= 6) { float a0 = (u.pn == 6) ? sq[0] + sq[1] : sq[0], a1 = sq[1];
                    a0 += __shfl_xor(a0, 16); a0 += __shfl_xor(a0, 32); a1 += __shfl_xor(a1, 16); a1 += __shfl_xor(a1, 32);
                    if (fq == 0) { if (u.pn == 6) atomicAdd(rsqq + row, a0); else { atomicAdd(rsqkv + row, a0); if (wc == 0) atomicAdd(rsqkr + row, a1); } } }
                asm volatile("" ::: "memory"); }
    }
};
struct EpiQ {
    static constexpr bool PERM = true, AFTER_DRAIN = false;
    const float* rsqq; const float* rope; const float* g_qn; const float* g_qr; bf16_t* QM;
    __device__ __forceinline__ void operator()(const f32x4 (&acc)[2][2][4][2], const Unit& u, int wr, int wc, int fr, int fq) const {
        asm volatile("" : "+v"(fr), "+v"(fq));
        constexpr float QS = 0.10206207261596575f * 1.4426950408889634f;
        float rsq8[8];
#pragma unroll
        for (int i = 0; i < 8; ++i) rsq8[i] = rsqq[u.pm * BM + (i >> 2) * HALF + wr * 64 + (i & 3) * 16 + fr];
#pragma unroll
        for (int ai = 0; ai < 2; ++ai)
#pragma unroll
            for (int m = 0; m < 4; ++m) { const int r = u.pm * BM + ai * HALF + wr * 64 + m * 16 + fr; const float rs = __builtin_amdgcn_rsqf(rsq8[ai * 4 + m] * (1.0f / 256.0f) + 1e-6f);
                if (u.pn < 2) { const int h = 4 * u.pn + wc; float ss = 0.f;
#pragma unroll
                    for (int bj = 0; bj < 2; ++bj)
#pragma unroll
                        for (int n = 0; n < 2; ++n) { const f32x4 v = acc[ai][bj][m][n] * rs; ss += (v[0] * v[0] + v[1] * v[1]) + (v[2] * v[2] + v[3] * v[3]); }
                    ss += __shfl_xor(ss, 16); ss += __shfl_xor(ss, 32);
                    const float rn = rs * QS * __builtin_amdgcn_rsqf(ss * (1.0f / 64.0f) + 1e-6f);
#pragma unroll
                    for (int bj = 0; bj < 2; ++bj) { const int d0 = 32 * bj + 8 * fq; const f32x4 g0 = *(const f32x4*)(g_qn + d0), g1 = *(const f32x4*)(g_qn + d0 + 4);
                        const f32x4 v0 = acc[ai][bj][m][0] * rn * g0, v1 = acc[ai][bj][m][1] * rn * g1;
                        u32x4 w; w.x = cvt_pk_bf16(v0[0], v0[1]); w.y = cvt_pk_bf16(v0[2], v0[3]); w.z = cvt_pk_bf16(v1[0], v1[1]); w.w = cvt_pk_bf16(v1[2], v1[3]);
                        *(u32x4*)(QM + ((size_t)r * 8 + h) * 96 + d0) = w; } }
                else { const int pidx = (r < 16384) ? (r & 2047) : 2048 + ((r - 16384) & 7);
                    const f32x4* rp = (const f32x4*)(rope + (pidx * 16 + 8 * (fq & 1)) * 2);
                    const f32x4 rc0 = rp[0], rc1 = rp[1], rc2 = rp[2], rc3 = rp[3];
#pragma unroll
                    for (int bj = 0; bj < 2; ++bj) { const int h = 4 * bj + wc, i0 = 8 * fq; float ss = 0.f;
#pragma unroll
                        for (int n = 0; n < 2; ++n) { const f32x4 v = acc[ai][bj][m][n] * rs; ss += (v[0] * v[0] + v[1] * v[1]) + (v[2] * v[2] + v[3] * v[3]); }
                        ss += __shfl_xor(ss, 16); ss += __shfl_xor(ss, 32);
                        const float rr = rs * QS * __builtin_amdgcn_rsqf(ss * (1.0f / 32.0f) + 1e-6f);
                        const f32x4 g0 = *(const f32x4*)(g_qr + i0), g1 = *(const f32x4*)(g_qr + i0 + 4);
                        unsigned wq[4];
#pragma unroll
                        for (int n = 0; n < 2; ++n) { const f32x4 gq = n ? g1 : g0; float o[4];
#pragma unroll
                            for (int j = 0; j < 4; ++j) { const float x = acc[ai][bj][m][n][j] * rr * gq[j]; const float y = __shfl_xor(x, 32);
                                const f32x4 rcv = (4 * n + j) < 2 ? rc0 : ((4 * n + j) < 4 ? rc1 : ((4 * n + j) < 6 ? rc2 : rc3)); const float cs_c = rcv[2 * (j & 1)], cs_s = rcv[2 * (j & 1) + 1];
                                o[j] = (fq < 2) ? (x * cs_c - y * cs_s) : (x * cs_c + y * cs_s); }
                            wq[2 * n] = cvt_pk_bf16(o[0], o[1]); wq[2 * n + 1] = cvt_pk_bf16(o[2], o[3]); }
                        u32x4 w; w.x = wq[0]; w.y = wq[1]; w.z = wq[2]; w.w = wq[3];
                        *(u32x4*)(QM + ((size_t)r * 8 + h) * 96 + 64 + i0) = w; } }
                asm volatile("" ::: "memory"); }
    }
};
struct EpiKV {
    static constexpr bool PERM = true, AFTER_DRAIN = false;
    const float* rsqkv; const float* g_kn; bf16_t* KM; bf16_t* VM;
    __device__ __forceinline__ void operator()(const f32x4 (&acc)[2][2][4][2], const Unit& u, int wr, int wc, int fr, int fq) const {
        asm volatile("" : "+v"(fr), "+v"(fq));
        float rsq8[8];
#pragma unroll
        for (int i = 0; i < 8; ++i) rsq8[i] = rsqkv[u.pm * BM + (i >> 2) * HALF + wr * 64 + (i & 3) * 16 + fr];
#pragma unroll
        for (int ai = 0; ai < 2; ++ai)
#pragma unroll
            for (int m = 0; m < 4; ++m) { const int r = u.pm * BM + ai * HALF + wr * 64 + m * 16 + fr; const float rs = __builtin_amdgcn_rsqf(rsq8[ai * 4 + m] * (1.0f / 128.0f) + 1e-6f);
                if (u.pn < 2) { const int h = 4 * u.pn + wc; float ss = 0.f;
#pragma unroll
                    for (int bj = 0; bj < 2; ++bj)
#pragma unroll
                        for (int n = 0; n < 2; ++n) { const f32x4 v = acc[ai][bj][m][n] * rs; ss += (v[0] * v[0] + v[1] * v[1]) + (v[2] * v[2] + v[3] * v[3]); }
                    ss += __shfl_xor(ss, 16); ss += __shfl_xor(ss, 32);
                    const float rk = rs * __builtin_amdgcn_rsqf(ss * (1.0f / 64.0f) + 1e-6f);
#pragma unroll
                    for (int bj = 0; bj < 2; ++bj) { const int d0 = 32 * bj + 8 * fq; const f32x4 g0 = *(const f32x4*)(g_kn + d0), g1 = *(const f32x4*)(g_kn + d0 + 4);
                        const f32x4 v0 = acc[ai][bj][m][0] * rk * g0, v1 = acc[ai][bj][m][1] * rk * g1;
                        u32x4 w; w.x = cvt_pk_bf16(v0[0], v0[1]); w.y = cvt_pk_bf16(v0[2], v0[3]); w.z = cvt_pk_bf16(v1[0], v1[1]); w.w = cvt_pk_bf16(v1[2], v1[3]);
                        *(u32x4*)(KM + ((size_t)r * 8 + h) * 96 + d0) = w; } }
                else { const int h = 4 * (u.pn - 2) + wc;
#pragma unroll
                    for (int bj = 0; bj < 2; ++bj) { const int d0 = 32 * bj + 8 * fq; const f32x4 v0 = acc[ai][bj][m][0] * rs, v1 = acc[ai][bj][m][1] * rs;
                        u32x4 w; w.x = cvt_pk_bf16(v0[0], v0[1]); w.y = cvt_pk_bf16(v0[2], v0[3]); w.z = cvt_pk_bf16(v1[0], v1[1]); w.w = cvt_pk_bf16(v1[2], v1[3]);
                        *(u32x4*)(VM + ((size_t)r * 8 + h) * 64 + d0) = w; } }
                asm volatile("" ::: "memory"); }
    }
};
__device__ __forceinline__ float dpp_f(float oldv, float src, const int ctrl_sel) {
    const int o = __builtin_bit_cast(int, oldv), s = __builtin_bit_cast(int, src); int r;
    if (ctrl_sel == 0) r = __builtin_amdgcn_update_dpp(o, s, 0x111, 0xf, 0xf, false); else if (ctrl_sel == 1) r = __builtin_amdgcn_update_dpp(o, s, 0x112, 0xf, 0xf, false);
    else if (ctrl_sel == 2) r = __builtin_amdgcn_update_dpp(o, s, 0x121, 0xf, 0xf, false); else r = __builtin_amdgcn_update_dpp(o, s, 0x122, 0xf, 0xf, false);
    return __builtin_bit_cast(float, r);
}
struct EpiConv {
    static constexpr bool PERM = true, AFTER_DRAIN = false;
    const float* rsq; PG8_LAS float* ex; const float* cw; const float* cb; const float* sc; bf16_t* G; float* conv_p; float* conv_s;
    __device__ __forceinline__ void operator()(const f32x4 (&acc)[2][2][4][2], const Unit& u, int wr, int wc, int fr, int fq) const {
        asm volatile("" : "+v"(fr), "+v"(fq));
        constexpr int MTr = 16640, MPr = 16384;
        const int f0 = u.pn * HALF + wc * 32 + 8 * fq; const int Rbase = u.pm * 254 - 2;
        float rq8[8];
#pragma unroll
        for (int i = 0; i < 8; ++i) { const int R = Rbase + (i >> 2) * HALF + wr * 64 + (i & 3) * 16 + fr; rq8[i] = rsq[R < 0 ? 0 : (R >= MTr ? MTr - 1 : R)]; }
#pragma unroll
        for (int ai = 0; ai < 2; ++ai) { const int R3 = Rbase + ai * HALF + wr * 64 + 48 + fr; const int Rc = R3 < 0 ? 0 : (R3 >= MTr ? MTr - 1 : R3);
            const float rs = __builtin_amdgcn_rsqf(rq8[ai * 4 + 3] * (1.0f / 1024.0f) + 1e-6f); (void)Rc;
            if (fr >= 14) { PG8_LAS float* p = ex + (((((2 * ai + wr) * 4 + wc) * 2 + (fr - 14)) * 4 + fq) * 8);
                *(PG8_LAS f32x4*)p = acc[ai][0][3][0] * rs; *(PG8_LAS f32x4*)(p + 4) = acc[ai][0][3][1] * rs; } }
        asm volatile("s_waitcnt lgkmcnt(0)\n\ts_barrier" ::: "memory");
        const f32x4 w0a = *(const f32x4*)(cw + f0), w0b = *(const f32x4*)(cw + f0 + 4), w1a = *(const f32x4*)(cw + 2816 + f0), w1b = *(const f32x4*)(cw + 2816 + f0 + 4);
        const f32x4 w2a = *(const f32x4*)(cw + 5632 + f0), w2b = *(const f32x4*)(cw + 5632 + f0 + 4), cba = *(const f32x4*)(cb + f0), cbb = *(const f32x4*)(cb + f0 + 4);
#pragma unroll
        for (int ai = 0; ai < 2; ++ai) {
            float pg[8];
            { const int s = 2 * ai + wr;
              if (s == 0) {
#pragma unroll
                  for (int e = 0; e < 8; ++e) pg[e] = 0.f;
              } else { const PG8_LAS float* p = ex + ((((((s - 1) * 4 + wc) * 2 + (fr & 1)) * 4 + fq) * 8)); const f32x4 a0 = *(const PG8_LAS f32x4*)p, a1 = *(const PG8_LAS f32x4*)(p + 4);
                  pg[0] = a0[0]; pg[1] = a0[1]; pg[2] = a0[2]; pg[3] = a0[3]; pg[4] = a1[0]; pg[5] = a1[1]; pg[6] = a1[2]; pg[7] = a1[3]; } }
#pragma unroll
            for (int m = 0; m < 4; ++m) { const int rl = ai * HALF + wr * 64 + m * 16 + fr; const int R = Rbase + rl; const int Rc = R < 0 ? 0 : (R >= MTr ? MTr - 1 : R);
                const float rs = __builtin_amdgcn_rsqf(rq8[ai * 4 + m] * (1.0f / 1024.0f) + 1e-6f); (void)Rc;
                float cur[8], go[8];
#pragma unroll
                for (int e = 0; e < 8; ++e) cur[e] = acc[ai][0][m][e >> 2][e & 3] * rs;
                const bool is_s = R >= MPr; const int t = is_s ? ((R - MPr) & 7) : (R & 2047);
                const float k1 = (t == 0) ? 0.f : 1.f, k2 = (t < 2) ? 0.f : 1.f;
                float c1[8], c2[8];
#pragma unroll
                for (int e = 0; e < 8; ++e) { c1[e] = dpp_f(dpp_f(0.f, pg[e], 2), cur[e], 0) * k1; c2[e] = dpp_f(dpp_f(0.f, pg[e], 3), cur[e], 1) * k2; }
                if (u.pm >= 64) { if (is_s && t < 2) { const int bs = (R - MPr) >> 3;
#pragma unroll
                        for (int e = 0; e < 8; ++e) { const float h1 = sc[((size_t)bs * 2 + 1) * 2816 + f0 + e], h0 = sc[((size_t)bs * 2) * 2816 + f0 + e]; if (t == 0) { c1[e] = h1; c2[e] = h0; } else c2[e] = h1; } } }
#pragma unroll
                for (int e = 0; e < 8; ++e) { const float w0 = e < 4 ? w0a[e & 3] : w0b[e & 3], w1 = e < 4 ? w1a[e & 3] : w1b[e & 3], w2 = e < 4 ? w2a[e & 3] : w2b[e & 3], bb = e < 4 ? cba[e & 3] : cbb[e & 3];
                    const float cv = bb + w0 * c2[e] + w1 * c1[e] + w2 * cur[e];
                    go[e] = cv * __builtin_amdgcn_rcpf(1.0f + __builtin_amdgcn_exp2f(-1.4426950408889634f * cv)) * (acc[ai][1][m][e >> 2][e & 3] * rs); }
                if (rl >= 2 && R < MTr) {
                    u32x4 w; w.x = cvt_pk_bf16(go[0], go[1]); w.y = cvt_pk_bf16(go[2], go[3]); w.z = cvt_pk_bf16(go[4], go[5]); w.w = cvt_pk_bf16(go[6], go[7]);
                    *(u32x4*)(G + (size_t)R * 2816 + f0) = w;
                    float* dst = nullptr;
                    if (!is_s) { if (t >= 2046) dst = conv_p + ((size_t)(R >> 11) * 2 + (t - 2046)) * 2816 + f0; }
                    else { if (t >= 6) dst = conv_s + ((size_t)((R - MPr) >> 3) * 2 + (t - 6)) * 2816 + f0; }
                    if (dst) { *(f32x4*)dst = (f32x4){cur[0], cur[1], cur[2], cur[3]}; *(f32x4*)(dst + 4) = (f32x4){cur[4], cur[5], cur[6], cur[7]}; } }
#pragma unroll
                for (int e = 0; e < 8; ++e) pg[e] = cur[e];
                asm volatile("" ::: "memory"); }
        }
    }
};
template <class Epi, class Sched, bool ALIGN_EPI = false, bool SP2 = false>
__device__ __forceinline__ void gemm_phase(PG8_LAS unsigned char* lds, const Gemm g, const Sched& S, const Epi& E, const int wid_s) {
    int tid_o = wid_s * 64 + lane_id(); asm volatile("" : "+v"(tid_o));
    const int tid = tid_o, wid = __builtin_amdgcn_readfirstlane(tid >> 6), lane = tid & 63, wr = wid >> 2, wc = wid & 3, fr = lane & 15, fq = lane >> 4;
    const int K = g.K, nt = K / BK;
    const int lda = g.lda ? g.lda : K;
    unsigned voffA[2], voffB[2];
#pragma unroll
    for (int i = 0; i < 2; ++i) { int R, C; stage_rc(tid * 16 + i * 8192, R, C); const int Rb = Epi::PERM ? ((R & ~31) + perm32(R & 31)) : R;
        voffA[i] = (unsigned)(R * lda + C) * 2u; voffB[i] = (unsigned)(Rb * K + C) * 2u; }
    const size_t kstep = (size_t)(BK * 2);
    const size_t hstepA = (size_t)HALF * lda * 2, hstepB = (size_t)HALF * K * 2;
    const size_t tstepB = 2 * hstepB;
    const long trows = g.tile_rows ? g.tile_rows : BM;
#define PG8_TILEA(pm_) ((const char*)g.A + ((long)(pm_) * trows + g.row_off) * (long)lda * 2)
    const unsigned ldsw = (unsigned)wid * 1024u;
    const int aoff = lds_byte(wr * 64 + fr, fq * 8), boff = lds_byte(wc * 32 + fr, fq * 8);
#define PG8_SA(b, h) (((b) * 2 + (h)) * HTB)
#define PG8_SB(b, h) ((4 + (b) * 2 + (h)) * HTB)
#define PG8_STAGE(bufoff, gbase, voff) do { _Pragma("unroll") for (int _i = 0; _i < 2; ++_i) \
        __builtin_amdgcn_global_load_lds((const unsigned*)((const char*)(gbase) + (voff)[_i]), (PG8_LAS unsigned*)(lds + (bufoff) + ldsw + _i * 8192), 16, 0, 0); } while (0)
#define PG8_LDA(dst, b, h) do { _Pragma("unroll") for (int m = 0; m < 4; ++m) _Pragma("unroll") for (int k = 0; k < 2; ++k) dst[m][k] = *(const PG8_LAS bf16x8*)(lds + PG8_SA(b, h) + aoff + m * 2048 + k * 1024); } while (0)
#define PG8_LDB(dst, b, h) do { _Pragma("unroll") for (int n = 0; n < 2; ++n) _Pragma("unroll") for (int k = 0; k < 2; ++k) dst[n][k] = *(const PG8_LAS bf16x8*)(lds + PG8_SB(b, h) + boff + n * 2048 + k * 1024); } while (0)
#define PG8_MMA(ai, bj, At, Bt) do { __builtin_amdgcn_s_setprio(1); _Pragma("unroll") for (int m = 0; m < 4; ++m) _Pragma("unroll") for (int n = 0; n < 2; ++n) _Pragma("unroll") for (int k = 0; k < 2; ++k) \
        acc[ai][bj][m][n] = __builtin_amdgcn_mfma_f32_16x16x32_bf16(Bt[n][k], At[m][k], acc[ai][bj][m][n], 0, 0, 0); __builtin_amdgcn_s_setprio(0); } while (0)
#define PG8_WAIT_V(n) asm volatile("s_waitcnt vmcnt(" #n ")" ::: "memory")
#define PG8_WAIT_L(n) asm volatile("s_waitcnt lgkmcnt(" #n ")" ::: "memory")
#define PG8_BAR __builtin_amdgcn_s_barrier()
#define PG8_SCHED __builtin_amdgcn_sched_barrier(0)
    Unit cur, nxt; int ui = 0;
    if (!S.next(0, cur)) return;
    f32x4 acc[2][2][4][2];
#pragma unroll
    for (int a = 0; a < 2; ++a)
#pragma unroll
        for (int b = 0; b < 2; ++b)
#pragma unroll
            for (int m = 0; m < 4; ++m)
#pragma unroll
                for (int n = 0; n < 2; ++n) acc[a][b][m][n] = (f32x4){0.f, 0.f, 0.f, 0.f};
    bf16x8 At[4][2], B0[2][2], B1[2][2];
    const char* cA = PG8_TILEA(cur.pm); const char* cB = (const char*)g.Bt + (size_t)cur.pn * tstepB;
    S.a_ready(cur);
    if constexpr (SP2) {
        PG8_STAGE(PG8_SB(0, 0), cB, voffB); PG8_STAGE(PG8_SB(0, 1), cB + hstepB, voffB); PG8_STAGE(PG8_SA(0, 0), cA, voffA); PG8_STAGE(PG8_SA(0, 1), cA + hstepA, voffA);
        if (wr == 1) PG8_BAR;
        PG8_WAIT_V(2); PG8_BAR;
        PG8_STAGE(PG8_SB(1, 0), cB + kstep, voffB); PG8_STAGE(PG8_SA(1, 0), cA + kstep, voffA); PG8_STAGE(PG8_SB(1, 1), cB + hstepB + kstep, voffB);
        PG8_WAIT_V(6); PG8_BAR;
    } else {
        PG8_STAGE(PG8_SB(0, 0), cB, voffB); PG8_STAGE(PG8_SA(0, 0), cA, voffA); PG8_STAGE(PG8_SB(0, 1), cB + hstepB, voffB); PG8_STAGE(PG8_SA(0, 1), cA + hstepA, voffA);
        if (wr == 1) PG8_BAR;
        PG8_WAIT_V(4); PG8_BAR;
        PG8_STAGE(PG8_SB(1, 0), cB + kstep, voffB); PG8_STAGE(PG8_SA(1, 0), cA + kstep, voffA); PG8_STAGE(PG8_SB(1, 1), cB + hstepB + kstep, voffB);
        PG8_WAIT_V(6); PG8_BAR;
    }
    for (;;) {
        const bool has_next = S.next(ui + 1, nxt);
        const char* nA = has_next ? PG8_TILEA(nxt.pm) : cA; const char* nB = has_next ? (const char*)g.Bt + (size_t)nxt.pn * tstepB : cB;
        for (int t = 0; t < nt; t += 2) {
            const bool last = (t == nt - 2);
            const char* a1 = cA + (size_t)(t + 1) * kstep;
            const char* a2 = last ? nA : cA + (size_t)(t + 2) * kstep; const char* b2 = last ? nB : cB + (size_t)(t + 2) * kstep;
            const char* a3 = a2 + kstep; const char* b3 = b2 + kstep;
            if (last && has_next) S.a_ready(nxt);
            if constexpr (SP2) {
            PG8_LDB(B0, 0, 0); PG8_LDB(B1, 0, 1); PG8_SCHED; PG8_LDA(At, 0, 0); PG8_STAGE(PG8_SA(1, 1), a1 + hstepA, voffA);
            PG8_WAIT_V(8); PG8_WAIT_L(0); PG8_BAR; PG8_MMA(0, 0, At, B0); PG8_MMA(0, 1, At, B1); PG8_BAR; PG8_SCHED;
            PG8_LDA(At, 0, 1); PG8_STAGE(PG8_SB(0, 0), b2, voffB); PG8_STAGE(PG8_SB(0, 1), b2 + hstepB, voffB); PG8_STAGE(PG8_SA(0, 0), a2, voffA);
            PG8_WAIT_V(8); PG8_WAIT_L(0); PG8_BAR; PG8_MMA(1, 0, At, B0); PG8_MMA(1, 1, At, B1); PG8_BAR; PG8_SCHED;
            PG8_LDB(B0, 1, 0); PG8_LDB(B1, 1, 1); PG8_SCHED; PG8_LDA(At, 1, 0); PG8_STAGE(PG8_SA(0, 1), a2 + hstepA, voffA);
            PG8_WAIT_V(8); PG8_WAIT_L(0); PG8_BAR; PG8_MMA(0, 0, At, B0); PG8_MMA(0, 1, At, B1); PG8_BAR; PG8_SCHED;
            PG8_LDA(At, 1, 1); PG8_STAGE(PG8_SB(1, 0), b3, voffB); PG8_STAGE(PG8_SB(1, 1), b3 + hstepB, voffB); PG8_STAGE(PG8_SA(1, 0), a3, voffA);
            PG8_WAIT_V(8); PG8_WAIT_L(0); PG8_BAR; PG8_MMA(1, 0, At, B0); PG8_MMA(1, 1, At, B1); PG8_BAR; PG8_SCHED;
            } else {
            PG8_LDB(B0, 0, 0); PG8_SCHED; PG8_LDA(At, 0, 0); PG8_STAGE(PG8_SA(1, 1), a1 + hstepA, voffA);
            PG8_WAIT_L(8); PG8_BAR; PG8_WAIT_L(0); PG8_MMA(0, 0, At, B0); PG8_BAR; PG8_SCHED;
            PG8_LDB(B1, 0, 1); PG8_STAGE(PG8_SB(0, 0), b2, voffB);
            PG8_BAR; PG8_WAIT_L(0); PG8_MMA(0, 1, At, B1); PG8_BAR;
            PG8_LDA(At, 0, 1); PG8_STAGE(PG8_SA(0, 0), a2, voffA);
            PG8_BAR; PG8_WAIT_L(0); PG8_MMA(1, 0, At, B0); PG8_BAR; PG8_SCHED;
            PG8_STAGE(PG8_SB(0, 1), b2 + hstepB, voffB);
            PG8_WAIT_V(6); PG8_BAR; PG8_MMA(1, 1, At, B1); PG8_BAR;
            PG8_LDB(B0, 1, 0); PG8_SCHED; PG8_LDA(At, 1, 0); PG8_STAGE(PG8_SA(0, 1), a2 + hstepA, voffA);
            PG8_WAIT_L(8); PG8_BAR; PG8_WAIT_L(0); PG8_MMA(0, 0, At, B0); PG8_BAR; PG8_SCHED;
            PG8_LDB(B1, 1, 1); PG8_STAGE(PG8_SB(1, 0), b3, voffB);
            PG8_BAR; PG8_WAIT_L(0); PG8_MMA(0, 1, At, B1); PG8_BAR;
            PG8_LDA(At, 1, 1); PG8_STAGE(PG8_SA(1, 0), a3, voffA);
            PG8_BAR; PG8_WAIT_L(0); PG8_MMA(1, 0, At, B0); PG8_BAR; PG8_SCHED;
            PG8_STAGE(PG8_SB(1, 1), b3 + hstepB, voffB);
            PG8_WAIT_V(6); PG8_BAR; PG8_MMA(1, 1, At, B1); PG8_BAR;
            }
        }
        if constexpr (ALIGN_EPI) { if (wr == 0) PG8_BAR; }
        if constexpr (!Epi::AFTER_DRAIN) { const int le_ = lane_id(); E(acc, cur, wr, wc, le_ & 15, le_ >> 4); S.done(cur); }
        if (!has_next) break;
#pragma unroll
        for (int a = 0; a < 2; ++a)
#pragma unroll
            for (int b = 0; b < 2; ++b)
#pragma unroll
                for (int m = 0; m < 4; ++m)
#pragma unroll
                    for (int n = 0; n < 2; ++n) acc[a][b][m][n] = (f32x4){0.f, 0.f, 0.f, 0.f};
        cur = nxt; cA = nA; cB = nB; ++ui;
        if constexpr (ALIGN_EPI) { if (wr == 1) PG8_BAR; }
    }
    PG8_WAIT_V(0);
    if constexpr (!ALIGN_EPI) { if (wr == 0) PG8_BAR; }
    PG8_BAR;
    if constexpr (Epi::AFTER_DRAIN) { E.fused(acc, cur, wr, wc, fr, fq, lds, wid, lane); S.done(cur); }
#undef PG8_TILEA
#undef PG8_SA
#undef PG8_SB
#undef PG8_STAGE
#undef PG8_LDA
#undef PG8_LDB
#undef PG8_MMA
#undef PG8_WAIT_V
#undef PG8_WAIT_L
#undef PG8_BAR
#undef PG8_SCHED
}
}
constexpr int NWAVES = 8;
constexpr int MP = 16384, MS = 256, MT = MP + MS;
constexpr int DM = 1024, NU = 2048, FF = 2816;
constexpr int U_GQ = 0, U_GK = 256, U_GV = 512, U_GG = 1024, U_MQ = 1536, U_MKV = 1792, U_MKR = 1920, U_GA = 1952, IN_COLS = 1968;
constexpr float EPSN = 1e-6f;
constexpr float QSCALE = 0.10206207261596575f * 1.4426950408889634f;
constexpr size_t O_YP = 0, O_YS = 16777216, O_CKVP = 17039360, O_KRP = 19136512, O_GLAP = 19660800, O_CONVP = 19922944, O_CKVS = 19968000, O_KRS = 20000768, O_GLAS = 20008960, O_CONVS = 21057536, O_END = 21237760;
constexpr size_t MiB = 1u << 20;
constexpr size_t WS_CTL = 0, CTL_ZERO_BYTES = 1 * MiB;
constexpr size_t WS_WIN = 2 * MiB, WS_WQUP = 6 * MiB, WS_WKVUP = 6 * MiB + 512 * 1024, WS_WKVN = 6 * MiB + 768 * 1024, WS_WPP = 7 * MiB, WS_WKVP = 7 * MiB + 512 * 1024, WS_WO = 8 * MiB, WS_WPG = 10 * MiB, WS_WGU = 12 * MiB, WS_WD = 24 * MiB;
constexpr size_t WS_ROPE = 30 * MiB, WS_RS1 = 31 * MiB, WS_XB = 32 * MiB, WS_PB = 65 * MiB, WS_U = 74 * MiB, WS_PP = 139 * MiB, WS_LA = 172 * MiB, WS_QM = 189 * MiB, WS_KM = 214 * MiB, WS_VM = 239 * MiB;
constexpr size_t WS_AO = 256 * MiB, WS_H = 289 * MiB, WS_HB = 354 * MiB, WS_A = 387 * MiB, WS_C = 477 * MiB, WS_G = 567 * MiB, WS_H2B = 657 * MiB, WS_PART = 690 * MiB, WS_QABS = 699 * MiB, WS_QDEC = 700 * MiB, WS_KINV = 709 * MiB, WS_KENDT = 718 * MiB, WS_VT = 727 * MiB, WS_ELAST = 745 * MiB, WS_GGF = 746 * MiB, WS_PFSINK = 764 * MiB, WS_END = 765 * MiB;
constexpr int CW_BAR = 4096, CW_RSQ2 = 16384, CW_RSQ3 = 16384 + 16640, CW_DCNT = 50176, CW_Q = 2048, CW_RSQQ = 53248, CW_RSQKV = 53248 + 16640, CW_RSQKR = 53248 + 2 * 16640;
static_assert(CW_RSQ3 + 16640 <= CW_DCNT && CW_DCNT + 64 * 32 <= CW_RSQQ && (CW_RSQKR + 16640) * 4 <= (int)CTL_ZERO_BYTES, "ctl");
constexpr int RING_BYTES = 131072, LDSCTL_OFF = 161792, MISC_OFF = LDSCTL_OFF + 320, LDS_BYTES = 163840;

#define GAS __attribute__((address_space(1)))
#define LAS __attribute__((address_space(3)))
typedef unsigned short bf16;
typedef unsigned v4u __attribute__((ext_vector_type(4)));
typedef float f32x4 __attribute__((ext_vector_type(4)));
typedef short bf16x8 __attribute__((ext_vector_type(8)));
typedef GAS unsigned gu32;
typedef GAS unsigned long long gu64;
#define RLX_AGENT __ATOMIC_RELAXED, __HIP_MEMORY_SCOPE_AGENT
#define LDS_WAIT() asm volatile("s_waitcnt lgkmcnt(0)" ::: "memory")
#define VM_WAIT() asm volatile("s_waitcnt vmcnt(0)" ::: "memory")
__device__ __forceinline__ unsigned long long rt() { return __builtin_amdgcn_s_memrealtime(); }
__device__ __forceinline__ unsigned f2bf(float f) { unsigned u = __builtin_bit_cast(unsigned, f); return (u + 0x7fffu + ((u >> 16) & 1u)) >> 16; }
__device__ __forceinline__ unsigned pk2(float lo, float hi) { return f2bf(lo) | (f2bf(hi) << 16); }
#define XB_TMO      128
#define XB_XCNT(j)  (256  + 64 * (j))
#define XB_XSUB(j)  (1280 + 64 * (j))
#define XB_XGEN(j)  (2304 + 64 * (j))
#define XB_TOP      3328
#define XB_TOPGEN   3392
#define XCD_BAR_WORDS 3456
#define XB_SPIN_CAP (1u << 18)

__device__ __forceinline__ unsigned xb_ld(unsigned* p)              { return __hip_atomic_load(p, __ATOMIC_RELAXED, __HIP_MEMORY_SCOPE_AGENT); }
__device__ __forceinline__ unsigned xb_add(unsigned* p, unsigned v) { return __hip_atomic_fetch_add(p, v, __ATOMIC_RELAXED, __HIP_MEMORY_SCOPE_AGENT); }
__device__ __forceinline__ unsigned xb_xcc_id() { return (unsigned)__builtin_amdgcn_s_getreg((3 << 11) | 20) & 0xFu; }
#define XB_SPIN(cond, bar) do { unsigned _sp = 0; while (cond) { __builtin_amdgcn_s_sleep(1); \
    if ((++_sp & 255u) == 0u) { if (xb_ld(&(bar)[XB_TMO])) break; if (_sp > XB_SPIN_CAP) { atomicAdd(&(bar)[XB_TMO], 1u); break; } } } } while (0)

struct XcdBarrier {
    unsigned* bar; unsigned x;
    volatile LAS unsigned* st;
};

__device__ __forceinline__ XcdBarrier xcd_barrier_post(unsigned* bar, volatile LAS unsigned* st) {
    XcdBarrier b; b.bar = bar; b.x = xb_xcc_id(); b.st = st;
    if (threadIdx.x == 0) (void)xb_add(&bar[XB_XCNT(b.x)], 1u);
    return b;
}
__device__ __forceinline__ void xcd_barrier_complete(unsigned* bar, unsigned x, unsigned& nloc, unsigned& nx) {
    const unsigned G = gridDim.x * gridDim.y * gridDim.z;
    unsigned sum, cnt, mine, sp = 0u;
    for (;;) {
        sum = 0u; cnt = 0u; mine = 0u;
#pragma unroll
        for (unsigned j = 0; j < 16; ++j) { const unsigned c = xb_ld(&bar[XB_XCNT(j)]); sum += c; cnt += (c > 0u) ? 1u : 0u; mine = (j == x) ? c : mine; }
        if (sum == G) break;
        __builtin_amdgcn_s_sleep(1);
        if ((++sp & 255u) == 0u) { if (xb_ld(&bar[XB_TMO])) break; if (sp > XB_SPIN_CAP) { atomicAdd(&bar[XB_TMO], 1u); break; } }
    }
    nloc = mine > 0u ? mine : 1u; nx = cnt > 0u ? cnt : 1u;
}

__device__ __forceinline__ void xcd_barrier(const XcdBarrier& b, const int wave_s) {
    asm volatile("s_waitcnt vmcnt(0)" ::: "memory");
    __syncthreads();
    if (wave_s == 0 && lane_id() == 0) {
        unsigned* bar = b.bar;
        __builtin_amdgcn_s_waitcnt(0);
        unsigned nloc = b.st[0], nx = b.st[1];
        if (nloc == 0u) { xcd_barrier_complete(bar, b.x, nloc, nx); b.st[0] = nloc; b.st[1] = nx; }
        const unsigned old = xb_add(&bar[XB_XSUB(b.x)], 1u);
        const unsigned gen = old / nloc;
        if (old + 1u == (gen + 1u) * nloc) {
            __builtin_amdgcn_fence(__ATOMIC_RELEASE, "agent");
            asm volatile("s_waitcnt vmcnt(0)" ::: "memory");
            const unsigned og = xb_add(&bar[XB_TOP], 1u);
            const unsigned tg = og / nx;
            if (og + 1u == (tg + 1u) * nx) xb_add(&bar[XB_TOPGEN], 1u);
            else XB_SPIN(xb_ld(&bar[XB_TOPGEN]) == tg, bar);
            __builtin_amdgcn_fence(__ATOMIC_ACQUIRE, "agent");
            xb_add(&bar[XB_XGEN(b.x)], 1u);
            asm volatile("s_waitcnt vmcnt(0)" ::: "memory");
        } else {
            XB_SPIN(xb_ld(&bar[XB_XGEN(b.x)]) == gen, bar);
            __builtin_amdgcn_fence(__ATOMIC_ACQUIRE, "agent");
            asm volatile("s_waitcnt vmcnt(0)" ::: "memory");
        }
    }
    __syncthreads();
}
typedef unsigned u32x2 __attribute__((ext_vector_type(2)));
typedef float f32x2 __attribute__((ext_vector_type(2)));
__device__ __forceinline__ float blo(unsigned w) { return __builtin_bit_cast(float, w << 16); }
__device__ __forceinline__ float bhi(unsigned w) { return __builtin_bit_cast(float, w & 0xffff0000u); }
__device__ __forceinline__ float bf1(bf16 b) { return __builtin_bit_cast(float, (unsigned)b << 16); }
__device__ __forceinline__ float rbf(float f) { return __builtin_bit_cast(float, f2bf(f) << 16); }
__device__ __forceinline__ float wave_sum(float v) {
#pragma unroll
    for (int o = 1; o < 64; o <<= 1) v += __shfl_xor(v, o);
    return v;
}
__device__ __forceinline__ float wave_max(float v) {
#pragma unroll
    for (int o = 1; o < 64; o <<= 1) v = fmaxf(v, __shfl_xor(v, o));
    return v;
}
__device__ __forceinline__ float dot8(v4u w, f32x4 x0, f32x4 x1) {
    return (blo(w.x) * x0[0] + bhi(w.x) * x0[1]) + (blo(w.y) * x0[2] + bhi(w.y) * x0[3]) + (blo(w.z) * x1[0] + bhi(w.z) * x1[1]) + (blo(w.w) * x1[2] + bhi(w.w) * x1[3]);
}
__device__ __forceinline__ float silu_f(float x) { return x / (1.0f + __expf(-x)); }

struct Args { const void* in[32]; float* out; unsigned char* ws; int ph_lo, ph_hi; };

struct TItem { const float* W; const float* gk; bf16* WT; int K, N, mode, item; };
__device__ __forceinline__ TItem prep_item(const Args& a, int it) {
    unsigned char* ws = a.ws;
    constexpr int I_IN = 16 * 62, I_QUP = 4 * 24, I_KV = 2 * 32, I_O = 16 * 32, I_G = 16 * 88, I_D = 44 * 32, I_PG = 16 * 32;
    TItem t; int r = it;
    t.W = (const float*)a.in[10]; t.gk = (const float*)a.in[9]; t.WT = (bf16*)(ws + WS_WIN); t.K = 1024; t.N = IN_COLS; t.mode = 3; t.item = r;
    if (r >= I_IN) { r -= I_IN; t.W = (const float*)a.in[15]; t.gk = (const float*)a.in[14]; t.WT = (bf16*)(ws + WS_WQUP); t.K = 256; t.N = 768; t.mode = 4; t.item = r;
     if (r >= I_QUP) { r -= I_QUP; t.W = (const float*)a.in[20]; t.gk = nullptr; t.WT = (bf16*)(ws + WS_WKVUP); t.K = 128; t.N = 1024; t.mode = 0; t.item = r;
      if (r >= I_KV) { r -= I_KV; t.gk = (const float*)a.in[18]; t.WT = (bf16*)(ws + WS_WKVP); t.mode = 5; t.item = r;
       if (r >= I_KV) { r -= I_KV; t.W = (const float*)a.in[22]; t.gk = nullptr; t.WT = (bf16*)(ws + WS_WO); t.K = 1024; t.N = 1024; t.mode = 0; t.item = r;
        if (r >= I_O) { r -= I_O; t.W = (const float*)a.in[24]; t.gk = (const float*)a.in[23]; t.WT = (bf16*)(ws + WS_WGU); t.K = 1024; t.N = FF; t.mode = 1; t.item = r;
         if (r >= I_G) { r -= I_G; t.W = (const float*)a.in[25]; t.mode = 2; t.item = r;
          if (r >= I_G) { r -= I_G; t.W = (const float*)a.in[28]; t.gk = nullptr; t.WT = (bf16*)(ws + WS_WD); t.K = FF; t.N = 1024; t.mode = 0; t.item = r;
           if (r >= I_D) { r -= I_D; t.W = (const float*)a.in[30]; t.gk = (const float*)a.in[29]; t.WT = (bf16*)(ws + WS_WPG); t.K = 1024; t.N = 1024; t.item = r;
            if (r >= I_PG) { r -= I_PG; t.W = (const float*)a.in[31]; t.gk = nullptr; t.WT = (bf16*)(ws + WS_WPP); t.K = 256; t.N = 1024; t.item = r; } } } } } } } } }
    return t;
}
#define TI_LOAD(TV, T) do { const int nblk_ = ((T).N + 31) / 32, kb_ = (T).item / nblk_, nb_ = (T).item - kb_ * nblk_; const int nn_ = 32 * nb_ + (lane & 31); \
        _Pragma("unroll") for (int i = 0; i < 32; ++i) { const int kk = 2 * i + (lane >> 5); TV[i] = (nn_ < (T).N) ? (T).W[(size_t)(64 * kb_ + kk) * (T).N + nn_] : 0.f; } } while (0)
#define TI_FINISH(TV, T) do { const int nblk_ = ((T).N + 31) / 32, kb_ = (T).item / nblk_, nb_ = (T).item - kb_ * nblk_, k0 = 64 * kb_, n0 = 32 * nb_; \
        _Pragma("unroll") for (int i = 0; i < 32; ++i) { const int kk = 2 * i + (lane >> 5); float v = TV[i]; if ((T).gk) v *= (T).gk[k0 + kk]; scr[kk * 33 + (lane & 31)] = v; } \
        LDS_WAIT(); asm volatile("" ::: "memory"); \
        const int c = lane & 7; \
        _Pragma("unroll") for (int j = 0; j < 4; ++j) { const int nl = (lane >> 3) + 8 * j, n = n0 + nl; const LAS float* s = scr + (8 * c) * 33 + nl; \
            v4u o; o.x = pk2(s[0 * 33], s[1 * 33]); o.y = pk2(s[2 * 33], s[3 * 33]); o.z = pk2(s[4 * 33], s[5 * 33]); o.w = pk2(s[6 * 33], s[7 * 33]); \
            int row = n; const int mode = (T).mode; \
            if (mode == 1 || mode == 2) row = (n >> 7) * 256 + (n & 127) + (mode == 2 ? 128 : 0); \
            else if (mode == 3) { if (n >= 1936) row = 1920 + (n - 1936); else if (n >= 1808) row = 1792 + (n - 1808); else if (n >= 1552) row = 1536 + (n - 1552); else if (n >= 1536) row = 1952 + (n - 1536); } \
            else if (mode == 4) { const int h = n / 96, d = n - 96 * h; row = (d < 64) ? 256 * (h >> 2) + 128 * (d >> 5) + 32 * (h & 3) + (d & 31) : 512 + 128 * (h >> 2) + 32 * (h & 3) + (d - 64); } \
            else if (mode == 5) { const int h = n >> 7, x = n & 127; row = (x < 64) ? 256 * (h >> 2) + 128 * (x >> 5) + 32 * (h & 3) + (x & 31) : 512 + 256 * (h >> 2) + 128 * ((x - 64) >> 5) + 32 * (h & 3) + ((x - 64) & 31); } \
            if (n < (T).N) *(GAS v4u*)((T).WT + (size_t)row * (T).K + k0 + 8 * c) = o; } \
        LDS_WAIT(); asm volatile("" ::: "memory"); } while (0)
constexpr int PREP_LATE0 = 16 * 62 + 4 * 24 + 2 * (2 * 32), PREP_LATE1 = PREP_LATE0 + 16 * 32 + 2 * (16 * 88) + 44 * 32 + 16 * 32, PREP_LATE_TICKETS = (PREP_LATE1 - PREP_LATE0) / 16;
static_assert((PREP_LATE1 - PREP_LATE0) % 16 == 0, "late prep items per ticket");
__device__ __forceinline__ void prep_late(const Args& a, LAS unsigned char* lds, int ticket, int wave, int lane) {
    LAS float* scr = (LAS float*)(lds + wave * 16384);
    const int i0 = PREP_LATE0 + ticket * 16 + wave;
    float tvA[32], tvB[32]; TItem tA = prep_item(a, i0), tB = prep_item(a, i0 + 8);
    TI_LOAD(tvA, tA); TI_LOAD(tvB, tB); TI_FINISH(tvA, tA); TI_FINISH(tvB, tB);
}
constexpr int PREP_P_TICKETS = MP / 64;
__device__ __forceinline__ void prep_late_p(const Args& a, int ticket, int wave, int lane) {
    bf16* PB = (bf16*)(a.ws + WS_PB); const int m0 = ticket * 64 + wave * 8;
    f32x4 pv[8];
#pragma unroll
    for (int j = 0; j < 8; ++j) pv[j] = ((const GAS f32x4*)((const float*)a.in[7] + (size_t)(m0 + j) * 256))[lane];
#pragma unroll
    for (int j = 0; j < 8; ++j) ((GAS unsigned long long*)(PB + (size_t)(m0 + j) * 256))[lane] = (unsigned long long)pk2(pv[j].x, pv[j].y) | ((unsigned long long)pk2(pv[j].z, pv[j].w) << 32);
}
__device__ __forceinline__ void prep_phase(const Args& a, LAS unsigned char* lds, int gw, int NGW, int wave, int lane) {
    unsigned char* ws = a.ws;
    LAS float* scr = (LAS float*)(lds + wave * 16384);
    constexpr int NITEMS = PREP_LATE0 + 4 * 32;
#define EMAP(e) ((e) < PREP_LATE0 ? (e) : (e) + (PREP_LATE1 - PREP_LATE0))
    { float tvA[32], tvB[32]; int it = gw; TItem tA = prep_item(a, it < NITEMS ? EMAP(it) : 0), tB = tA;
      if (it < NITEMS) TI_LOAD(tvA, tA);
#pragma unroll 1
      while (it < NITEMS) {
          const int it1 = it + NGW; if (it1 < NITEMS) { tB = prep_item(a, EMAP(it1)); TI_LOAD(tvB, tB); }
          TI_FINISH(tvA, tA);
          if (it1 >= NITEMS) break;
          const int it2 = it1 + NGW; if (it2 < NITEMS) { tA = prep_item(a, EMAP(it2)); TI_LOAD(tvA, tA); }
          TI_FINISH(tvB, tB);
          it = it2; } }
#undef EMAP
    const int gt = gw * 64 + lane, NGT = NGW * 64;
    for (int i = gt; i < 128 * 1024 / 4; i += NGT) { const f32x4 v = ((const GAS f32x4*)a.in[20])[i]; ((GAS unsigned long long*)(ws + WS_WKVN))[i] = (unsigned long long)pk2(v.x, v.y) | ((unsigned long long)pk2(v.z, v.w) << 32); }
    for (int i = gt; i < 80 * 1024 / 8; i += NGT) ((GAS v4u*)(ws + WS_WIN + (size_t)IN_COLS * 1024 * 2))[i] = (v4u){0u, 0u, 0u, 0u};
    for (int i = gt; i < 2056 * 16; i += NGT) {
        const int pidx = i >> 4, d = i & 15; const int pos = pidx < 2048 ? pidx : 16384 + (pidx - 2048);
        double inv = 1.0; for (int k = 0; k < d; ++k) inv *= 0.56234132519034908;
        const float ang = (float)pos * (float)inv;
        const double turns = (double)ang * 0.15915494309189535; const double fr = turns - __builtin_floor(turns);
        f32x2 cs; cs.x = __builtin_amdgcn_cosf((float)fr); cs.y = __builtin_amdgcn_sinf((float)fr);
        ((GAS f32x2*)(ws + WS_ROPE))[i] = cs;
    }
    bf16* XB = (bf16*)(ws + WS_XB); float* RS1 = (float*)(ws + WS_RS1); bf16* PB = (bf16*)(ws + WS_PB);
#pragma unroll 4
    for (int m = gw; m < MT; m += NGW) {
        const float* xrow = (m < MP) ? (const float*)a.in[0] + (size_t)m * DM : (const float*)a.in[1] + (size_t)(m - MP) * DM;
        const GAS f32x4* xr = (const GAS f32x4*)xrow + lane;
        f32x4 v[4]; float s = 0.f;
#pragma unroll
        for (int j = 0; j < 4; ++j) { v[j] = xr[64 * j]; s += (v[j].x * v[j].x + v[j].y * v[j].y) + (v[j].z * v[j].z + v[j].w * v[j].w); }
        s = wave_sum(s);
        GAS unsigned long long* o8 = (GAS unsigned long long*)(XB + (size_t)m * DM) + lane;
#pragma unroll
        for (int j = 0; j < 4; ++j) o8[64 * j] = (unsigned long long)pk2(v[j].x, v[j].y) | ((unsigned long long)pk2(v[j].z, v[j].w) << 32);
        if (lane == 0) RS1[m] = 1.0f / sqrtf(s * (1.0f / DM) + EPSN);
        if (m >= MP) {
            const f32x4 pv = ((const GAS f32x4*)((const float*)a.in[8] + (size_t)(m - MP) * 256))[lane];
            ((GAS unsigned long long*)(PB + (size_t)m * 256))[lane] = (unsigned long long)pk2(pv.x, pv.y) | ((unsigned long long)pk2(pv.z, pv.w) << 32); }
    }
}

namespace pattn {
typedef short bf16x8 __attribute__((ext_vector_type(8)));
typedef short s16x4 __attribute__((ext_vector_type(4)));
typedef float f32x16 __attribute__((ext_vector_type(16)));
typedef unsigned u32x4 __attribute__((ext_vector_type(4)));
constexpr int NW = 8, QBLK = 32, KVBLK = 64, QB = NW * QBLK, DQK = 96, DV = 64;
constexpr int KP = 768, VP = 512, QP = 768, OP = 1024;
constexpr int SHM_V = KVBLK * 128 * 2, SHM_K = KVBLK * 256;
constexpr int LDS_BYTES = 2 * SHM_V + 2 * SHM_K + NW * 64 * 4;
constexpr float THR = 8.f;
#define KSWZ(row, colB) ((row) * 256 + ((colB) ^ (((row) & 7) << 4)))
#define SBAR() __builtin_amdgcn_sched_barrier(0)
__device__ __forceinline__ int v_st(int k, int c) { const int kk = (k & ~0xC) | ((k & 4) << 1) | ((k & 8) >> 1); return ((kk >> 3) * 4 + (c >> 5)) * 512 + ((kk & 7) * 32 + (c & 31)) * 2; }
__device__ __forceinline__ int v_rd_base(int lane) { return ((lane & 3) << 3) | (((lane >> 2) & 3) << 6) | (((lane >> 4) & 1) << 5) | (((lane >> 5) & 1) << 8); }
constexpr int v_rd_off(int d0, int ks, int half) { return d0 * 512 + ks * 4096 + half * 2048; }
__device__ __forceinline__ int crow(int r, int hi) { return (r & 3) + 8 * (r >> 2) + 4 * hi; }
__device__ __forceinline__ unsigned cvtpk(float lo, float hi) { unsigned r; asm volatile("v_cvt_pk_bf16_f32 %0, %1, %2" : "=v"(r) : "v"(lo), "v"(hi)); return r; }
__device__ __forceinline__ bf16x8 load8(const bf16* p) { return *reinterpret_cast<const bf16x8*>(p); }
__device__ __forceinline__ void mask_tile(f32x16& p0, f32x16& p1, int dq) {
    const float NEG = -__builtin_inff();
#pragma unroll
    for (int r = 0; r < 16; ++r) { const int c = (r & 3) + 8 * (r >> 2); if (dq - c < 0) p0[r] = NEG; if (dq - c - 32 < 0) p1[r] = NEG; }
}
__device__ __forceinline__ void partialSM(f32x16& p0, f32x16& p1, float& m_reg, float& mn, float& alpha) {
    float pmax = p0[0];
#pragma unroll
    for (int r = 1; r < 16; ++r) pmax = fmaxf(pmax, p0[r]);
#pragma unroll
    for (int r = 0; r < 16; ++r) pmax = fmaxf(pmax, p1[r]);
    { auto rr = __builtin_amdgcn_permlane32_swap(__float_as_uint(pmax), __float_as_uint(pmax), false, false); pmax = fmaxf(__uint_as_float(rr[0]), __uint_as_float(rr[1])); }
    if (__builtin_expect(__all((pmax - m_reg) <= THR), 1)) { mn = m_reg; alpha = 1.f; }
    else { mn = fmaxf(m_reg, pmax); alpha = __builtin_amdgcn_exp2f(m_reg - mn); m_reg = mn; }
#pragma unroll
    for (int r = 0; r < 16; ++r) p0[r] = p0[r] - mn;
#pragma unroll
    for (int r = 0; r < 16; ++r) p1[r] = p1[r] - mn;
#pragma unroll
    for (int r = 0; r < 16; ++r) p0[r] = __builtin_amdgcn_exp2f(p0[r]);
}
__device__ __forceinline__ void finishSM(f32x16& p0, f32x16& p1, float alpha, float& l_reg, bf16x8& pa0, bf16x8& pa1, bf16x8& pa2, bf16x8& pa3) {
#pragma unroll
    for (int r = 0; r < 16; ++r) p1[r] = __builtin_amdgcn_exp2f(p1[r]);
    float ps = 0;
#pragma unroll
    for (int r = 0; r < 16; ++r) ps += p0[r];
#pragma unroll
    for (int r = 0; r < 16; ++r) ps += p1[r];
    { auto rr = __builtin_amdgcn_permlane32_swap(__float_as_uint(ps), __float_as_uint(ps), false, false); ps = __uint_as_float(rr[0]) + __uint_as_float(rr[1]); }
    l_reg = l_reg * alpha + ps;
#define PK4(P, B_, OUT) do { unsigned a0 = cvtpk(P[B_+0], P[B_+1]), a1 = cvtpk(P[B_+2], P[B_+3]); unsigned b0 = cvtpk(P[B_+4], P[B_+5]), b1 = cvtpk(P[B_+6], P[B_+7]); \
        auto r0 = __builtin_amdgcn_permlane32_swap(a0, b0, false, false); auto r1 = __builtin_amdgcn_permlane32_swap(a1, b1, false, false); \
        u32x4 w = {r0[0], r1[0], r0[1], r1[1]}; OUT = *reinterpret_cast<bf16x8*>(&w); } while (0)
    PK4(p0, 0, pa0); PK4(p0, 8, pa1); PK4(p1, 0, pa2); PK4(p1, 8, pa3);
#undef PK4
}
template <int KB>
__device__ __forceinline__ void qkt(f32x16& p0, f32x16& p1, const char* K_lds, int r32, int hi, const bf16x8* qr) {
    p0 = f32x16{}; p1 = f32x16{};
    const char* kb[4];
#pragma unroll
    for (int dd = 0; dd < 4; ++dd) kb[dd] = K_lds + KB * SHM_K + KSWZ(r32, (dd * 16 + hi * 8) * 2);
#pragma unroll
    for (int d0 = 0; d0 < 6; ++d0) { const char* a = kb[d0 & 3] + (d0 >> 2) * 128;
        bf16x8 b0 = *reinterpret_cast<const bf16x8*>(a);
        bf16x8 b1 = *reinterpret_cast<const bf16x8*>(a + 32 * 256);
        p0 = __builtin_amdgcn_mfma_f32_32x32x16_bf16(b0, qr[d0], p0, 0, 0, 0);
        p1 = __builtin_amdgcn_mfma_f32_32x32x16_bf16(b1, qr[d0], p1, 0, 0, 0); }
}
template <int VB>
__device__ __forceinline__ void pv_tile(f32x16* o, int vb0, bf16x8 pa0, bf16x8 pa1, bf16x8 pa2, bf16x8 pa3) {
#define TRRD(dst, off) asm volatile("ds_read_b64_tr_b16 %0, %1 offset:%2" : "=&v"(dst) : "v"(vb0), "i"(off) : "memory")
#define PV_D0(d0) do { s16x4 l0, l1, l2, l3, h0, h1, h2, h3; constexpr int b_ = VB * SHM_V + v_rd_off(d0, 0, 0); \
        TRRD(l0, b_); TRRD(h0, b_ + 2048); TRRD(l1, b_ + 4096); TRRD(h1, b_ + 6144); TRRD(l2, b_ + 8192); TRRD(h2, b_ + 10240); TRRD(l3, b_ + 12288); TRRD(h3, b_ + 14336); \
        asm volatile("s_waitcnt lgkmcnt(0)" ::: "memory"); SBAR(); \
        o[d0] = __builtin_amdgcn_mfma_f32_32x32x16_bf16(pa0, (bf16x8){l0[0], l0[1], l0[2], l0[3], h0[0], h0[1], h0[2], h0[3]}, o[d0], 0, 0, 0); \
        o[d0] = __builtin_amdgcn_mfma_f32_32x32x16_bf16(pa1, (bf16x8){l1[0], l1[1], l1[2], l1[3], h1[0], h1[1], h1[2], h1[3]}, o[d0], 0, 0, 0); \
        o[d0] = __builtin_amdgcn_mfma_f32_32x32x16_bf16(pa2, (bf16x8){l2[0], l2[1], l2[2], l2[3], h2[0], h2[1], h2[2], h2[3]}, o[d0], 0, 0, 0); \
        o[d0] = __builtin_amdgcn_mfma_f32_32x32x16_bf16(pa3, (bf16x8){l3[0], l3[1], l3[2], l3[3], h3[0], h3[1], h3[2], h3[3]}, o[d0], 0, 0, 0); } while (0)
    PV_D0(0); PV_D0(1);
#undef PV_D0
#undef TRRD
}
struct BlockRef { const bf16* Q; const bf16* K; const bf16* V; bf16* O; int P0; };
struct Seam { bf16x8 qr[6]; bf16x8 st_v0, st_v1, st_k0, st_k1; };
#define VMW() asm volatile("s_waitcnt vmcnt(0)" ::: "memory")
#define VMWN(n) asm volatile("s_waitcnt vmcnt(%0)" :: "i"(n) : "memory")
#define SLOAD_H(Kp, Vp, k0) do { if (ch < 8) { S.st_v0 = load8((Vp) + (size_t)((k0) + sr) * VP + sc); S.st_v1 = load8((Vp) + (size_t)((k0) + 32 + sr) * VP + sc); } \
                                 if (ch < 12) { S.st_k0 = load8((Kp) + (size_t)((k0) + sr) * KP + sc); S.st_k1 = load8((Kp) + (size_t)((k0) + 32 + sr) * KP + sc); } } while (0)
#define SWRITE_HK(bf) do { if (ch < 12) { *(bf16x8*)(K_lds + (bf) * SHM_K + kws) = S.st_k0; *(bf16x8*)(K_lds + (bf) * SHM_K + kws + 32 * 256) = S.st_k1; } } while (0)
#define SWRITE_HV(bf) do { if (ch < 8) { *(bf16x8*)(V_lds + (bf) * SHM_V + vst0) = S.st_v0; *(bf16x8*)(V_lds + (bf) * SHM_V + vst1) = S.st_v1; } } while (0)
#define SWRITE_H(bf) do { SWRITE_HV(bf); SWRITE_HK(bf); } while (0)
__device__ __forceinline__ void prime(const BlockRef& cur, char* lds, Seam& S, const int wave_s) {
    int tid_o = wave_s * 64 + lane_id(); asm volatile("" : "+v"(tid_o));
    const int tid = tid_o, wid = __builtin_amdgcn_readfirstlane(tid >> 6), lane = tid & 63, r32 = lane & 31, hi = lane >> 5;
    const int sr = tid >> 4, ch = tid & 15, sc = ch * 8, kws = KSWZ(sr, sc * 2); char* K_lds = lds + 2 * SHM_V;
#pragma unroll
    for (int d0 = 0; d0 < 6; ++d0) S.qr[d0] = load8(cur.Q + (size_t)(wid * QBLK + r32) * QP + d0 * 16 + hi * 8);
    SLOAD_H(cur.K, cur.V, 0); VMW(); SWRITE_HK(0);
    __syncthreads();
}
__device__ __forceinline__ void block(const BlockRef& cur, const BlockRef& nxt, char* lds, Seam& S, const int wave_s) {
    int tid_o = wave_s * 64 + lane_id(); asm volatile("" : "+v"(tid_o));
    const int tid = tid_o, wid = __builtin_amdgcn_readfirstlane(tid >> 6), lane = tid & 63, r32 = lane & 31, hi = lane >> 5;
    const int NT = (cur.P0 + QB - 1) / KVBLK + 1;
    const int qlo = cur.P0 + wid * QBLK, qm = qlo + r32 - 4 * hi;
    char* V_lds = lds; char* K_lds = lds + 2 * SHM_V;
    float* wsf = (float*)(lds + 2 * SHM_V + 2 * SHM_K) + wid * 64; float* li_l = wsf, * al_l = wsf + 32;
    float m_reg = -1e30f, l_reg = 0; f32x16 o[2] = {};
    const int sr = tid >> 4, ch = tid & 15, sc = ch * 8, vst0 = v_st(sr, sc & 63), vst1 = v_st(32 + sr, sc & 63), kws = KSWZ(sr, sc * 2);
    const int vb0 = (int)(uintptr_t)V_lds + v_rd_base(lane);
    const bf16* Kh = cur.K; const bf16* Vh = cur.V;
#define RESC(a) do { if (__any((a) < 1.f)) { if (hi == 0) al_l[r32] = (a); asm volatile("s_waitcnt lgkmcnt(0)" ::: "memory"); \
                     _Pragma("unroll") for (int d_ = 0; d_ < 2; ++d_) _Pragma("unroll") for (int r = 0; r < 16; ++r) o[d_][r] *= al_l[crow(r, hi)]; } } while (0)
#define KBASE(t) ((t) * KVBLK)
#define MASKT(P0_, P1_, t) do { const int kb_ = KBASE(t); if (kb_ + KVBLK - 1 > qlo) mask_tile(P0_, P1_, qm - kb_); } while (0)
#define SEAM_K0() do { VMWN(6); SWRITE_HK(0); SBAR(); } while (0)
    f32x16 pA0, pA1, pB0, pB1; float mnA, mnB, alA, alB; bf16x8 pa0, pa1, pa2, pa3;
    SWRITE_HV(0); SBAR();
    if (NT > 1) SLOAD_H(Kh, Vh, KBASE(1));
    SBAR(); qkt<0>(pA0, pA1, K_lds, r32, hi, S.qr);
    MASKT(pA0, pA1, 0); partialSM(pA0, pA1, m_reg, mnA, alA);
    if (NT > 1) { VMW(); SWRITE_H(1); }
    __syncthreads();
#define HALF_STEP(PX0, PX1, mnX, alX, PY0, PY1, alY, t, KB, VB, SB) do { \
        SBAR(); qkt<KB>(PX0, PX1, K_lds, r32, hi, S.qr); \
        finishSM(PY0, PY1, alY, l_reg, pa0, pa1, pa2, pa3); SBAR(); \
        if ((t) + 1 < NT) { SLOAD_H(Kh, Vh, KBASE((t) + 1)); SBAR(); } \
        pv_tile<VB>(o, vb0, pa0, pa1, pa2, pa3); MASKT(PX0, PX1, (t)); partialSM(PX0, PX1, m_reg, mnX, alX); \
        __syncthreads(); \
        if ((t) + 1 < NT) { VMW(); SWRITE_H(SB); } \
        RESC(alX); __syncthreads(); } while (0)
    for (int t = 1; t + 1 < NT; t += 2) {
        HALF_STEP(pB0, pB1, mnB, alB, pA0, pA1, alA, t, 1, 0, 0);
        HALF_STEP(pA0, pA1, mnA, alA, pB0, pB1, alB, t + 1, 0, 1, 1);
    }
    const bool even = (NT & 1) == 0;
    if (even) { SBAR(); qkt<1>(pB0, pB1, K_lds, r32, hi, S.qr); SBAR(); }
    SLOAD_H(nxt.K, nxt.V, 0); SBAR();
#pragma unroll
    for (int d0 = 0; d0 < 6; ++d0) S.qr[d0] = load8(nxt.Q + (size_t)(wid * QBLK + r32) * QP + d0 * 16 + hi * 8);
    SBAR();
    finishSM(pA0, pA1, alA, l_reg, pa0, pa1, pa2, pa3); SBAR();
    pv_tile<0>(o, vb0, pa0, pa1, pa2, pa3);
    if (even) { MASKT(pB0, pB1, NT - 1); partialSM(pB0, pB1, m_reg, mnB, alB); __syncthreads(); RESC(alB);
        finishSM(pB0, pB1, alB, l_reg, pa0, pa1, pa2, pa3); SBAR(); pv_tile<1>(o, vb0, pa0, pa1, pa2, pa3); }
    SBAR(); SEAM_K0();
    if (hi == 0) li_l[r32] = l_reg; asm volatile("s_waitcnt lgkmcnt(0)" ::: "memory");
    float rli[16];
#pragma unroll
    for (int r = 0; r < 16; ++r) rli[r] = __builtin_amdgcn_rcpf(li_l[crow(r, hi)]);
    bf16* Ow = cur.O + (size_t)(wid * QBLK) * OP;
#pragma unroll
    for (int r = 0; r < 16; ++r) { const int orow = crow(r, hi);
#pragma unroll
        for (int d0 = 0; d0 < 2; ++d0) { const float v = o[d0][r] * rli[r]; const float vn = __shfl_xor(v, 1);
            if ((r32 & 1) == 0) *(unsigned*)(Ow + (size_t)orow * OP + d0 * 32 + r32) = cvtpk(v, vn); } }
    __syncthreads();
#undef RESC
#undef KBASE
#undef MASKT
#undef SEAM_K0
#undef HALF_STEP
}
#undef VMW
#undef VMWN
#undef SLOAD_H
#undef SWRITE_HK
#undef SWRITE_HV
#undef SWRITE_H
#undef KSWZ
#undef SBAR
__device__ __forceinline__ BlockRef mkref(const bf16* QM, const bf16* KM, const bf16* VM, bf16* AO, int item, int pass) {
    const int bh = item >> 2, y = item & 3, qb = pass ? 7 - y : y, b = bh >> 3, h = bh & 7; BlockRef r;
    r.Q = QM + (((size_t)b * 2048 + qb * QB) * 8 + h) * 96; r.K = KM + ((size_t)b * 2048 * 8 + h) * 96; r.V = VM + ((size_t)b * 2048 * 8 + h) * 64;
    r.O = AO + ((size_t)b * 2048 + qb * QB) * 1024 + 512 + h * 64; r.P0 = qb * QB; return r;
}
__device__ __forceinline__ void phase(char* lds, const bf16* QM, const bf16* KM, const bf16* VM, bf16* AO, int vcu, int G, const int wave_s) {
    Seam S;
    int item = vcu; if (item >= 256) return;
    BlockRef cur = mkref(QM, KM, VM, AO, item, 0); int pass = 0;
    prime(cur, lds, S, wave_s);
    for (;;) {
        int itn = item, pn = pass + 1; bool last = false;
        if (pass == 1) { pn = 0; itn = item + G; if (itn >= 256) { last = true; itn = item; pn = 1; } }
        const BlockRef nxt = mkref(QM, KM, VM, AO, itn, pn);
        block(cur, nxt, lds, S, wave_s);
        if (last) break;
        cur = nxt; item = itn; pass = pn;
    }
}
__device__ __forceinline__ void one(char* lds, const bf16* QM, const bf16* KM, const bf16* VM, bf16* AO, int idx, const int wave_s) {
    Seam S; const int qb = 7 - (idx >> 6), bh = idx & 63, b = bh >> 3, h = bh & 7; BlockRef r;
    r.Q = QM + (((size_t)b * 2048 + qb * QB) * 8 + h) * 96; r.K = KM + ((size_t)b * 2048 * 8 + h) * 96; r.V = VM + ((size_t)b * 2048 * 8 + h) * 64;
    r.O = AO + ((size_t)b * 2048 + qb * QB) * 1024 + 512 + h * 64; r.P0 = qb * QB;
    prime(r, lds, S, wave_s); block(r, r, lds, S, wave_s);
}
}
namespace dec {
typedef short bf16x8 __attribute__((ext_vector_type(8)));
typedef short s16x4 __attribute__((ext_vector_type(4)));
typedef float f32x16 __attribute__((ext_vector_type(16)));
typedef unsigned u32x4 __attribute__((ext_vector_type(4)));
typedef int i32x4 __attribute__((ext_vector_type(4)));
typedef int i32x16 __attribute__((ext_vector_type(16)));
typedef float f32x2 __attribute__((ext_vector_type(2)));
constexpr int L_SC = 0, L_CT = 65536, L_RT = 98304, L_QA = 106496, L_QR = 122880, L_RTAB = 126976, L_AL = 131072, L_ML = 133120, L_C8 = 137216, L_KI = 153600, L_END = 154112;
constexpr float THR = 8.f;
__device__ __forceinline__ unsigned off_b(unsigned row, unsigned ch) { return 256u * row + 16u * (ch ^ (((row & 3) << 2) | ((row >> 2) & 3))); }
__device__ __forceinline__ int crow(int r, int hi) { return (r & 3) + 8 * (r >> 2) + 4 * hi; }
__device__ __forceinline__ unsigned cvtpk(float lo, float hi) { unsigned r; asm volatile("v_cvt_pk_bf16_f32 %0, %1, %2" : "=v"(r) : "v"(lo), "v"(hi)); return r; }
__device__ __forceinline__ bf16x8 pack8(f32x4 a, f32x4 b) { u32x4 w = {cvtpk(a[0], a[1]), cvtpk(a[2], a[3]), cvtpk(b[0], b[1]), cvtpk(b[2], b[3])}; return *reinterpret_cast<bf16x8*>(&w); }
__device__ __forceinline__ unsigned off_c8(unsigned key, unsigned c16) { return 128u * key + ((c16 ^ ((key >> 1) & 7u)) << 4); }
__device__ __forceinline__ unsigned q4(float x0, float x1, float x2, float x3, float sc) {
    const unsigned f0 = __float_as_uint(__builtin_fmaf(x0, sc, 12582912.f)), f1 = __float_as_uint(__builtin_fmaf(x1, sc, 12582912.f)), f2 = __float_as_uint(__builtin_fmaf(x2, sc, 12582912.f)), f3 = __float_as_uint(__builtin_fmaf(x3, sc, 12582912.f));
    return __builtin_amdgcn_perm(f1, f0, 0x0c0c0400u) | __builtin_amdgcn_perm(f3, f2, 0x04000c0cu); }
__device__ __forceinline__ float rowmax16(float v) {
    asm("s_nop 1\n\tv_max_f32_dpp %0, %0, %0 row_ror:8 row_mask:0xf bank_mask:0xf\n\ts_nop 1\n\tv_max_f32_dpp %0, %0, %0 row_ror:4 row_mask:0xf bank_mask:0xf\n\t"
        "s_nop 1\n\tv_max_f32_dpp %0, %0, %0 row_ror:2 row_mask:0xf bank_mask:0xf\n\ts_nop 1\n\tv_max_f32_dpp %0, %0, %0 row_ror:1 row_mask:0xf bank_mask:0xf" : "+v"(v));
    return v; }
__device__ __forceinline__ float amax3(float a, float b, float c) { float r; asm("v_max3_f32 %0, |%1|, |%2|, |%3|" : "=v"(r) : "v"(a), "v"(b), "v"(c)); return r; }
__device__ __forceinline__ float amax8(f32x4 x0, f32x4 x1) { return amax3(x1[3], x1[3], amax3(x1[1], x1[2], amax3(x0[3], x1[0], amax3(x0[0], x0[1], x0[2])))); }
#define DBAR() asm volatile("s_waitcnt lgkmcnt(0)\n\ts_barrier" ::: "memory")
__device__ __forceinline__ void combine(const Args& a, char* lds, int bs, int wave, int lane) {
    unsigned char* ws = a.ws; const int h = wave, r31 = lane & 31, hi = lane >> 5, t = lane >> 3, x = lane & 7;
    const bf16* QM = (const bf16*)(ws + WS_QM); const bf16* KM = (const bf16*)(ws + WS_KM); const bf16* VM = (const bf16*)(ws + WS_VM); const bf16* WkvT = (const bf16*)(ws + WS_WKVUP); bf16* AO = (bf16*)(ws + WS_AO);
    const float* part = (const float*)(ws + WS_PART) + (size_t)bs * 8 * 64 * 132;
    float* wl = (float*)(lds + wave * 4096);
    float* pl = wl + 64; float* Ll = wl + 128; float* Dl = wl + 192;
    const size_t rowt = (size_t)MP + bs * 8 + t;
    const float mg = part[(x * 64 + h * 8 + t) * 132], lg = part[(x * 64 + h * 8 + t) * 132 + 1];
    float sn = 0.f;
    { const bf16* qrow = QM + (rowt * 8 + h) * 96; const bf16* krow = KM + (((size_t)MP + bs * 8 + x) * 8 + h) * 96;
#pragma unroll
      for (int c = 0; c < 12; ++c) { const v4u q = *(const v4u*)(qrow + c * 8), k = *(const v4u*)(krow + c * 8);
          sn += (blo(q.x) * blo(k.x) + bhi(q.x) * bhi(k.x)) + (blo(q.y) * blo(k.y) + bhi(q.y) * bhi(k.y)) + (blo(q.z) * blo(k.z) + bhi(q.z) * bhi(k.z)) + (blo(q.w) * blo(k.w) + bhi(q.w) * bhi(k.w)); } }
    if (x > t) sn = -1e30f;
    float mx = fmaxf(mg, sn); mx = fmaxf(mx, __shfl_xor(mx, 1)); mx = fmaxf(mx, __shfl_xor(mx, 2)); mx = fmaxf(mx, __shfl_xor(mx, 4));
    const float wg = __builtin_amdgcn_exp2f(mg - mx), pn = (x > t) ? 0.f : __builtin_amdgcn_exp2f(sn - mx);
    float L = lg * wg + pn; L += __shfl_xor(L, 1); L += __shfl_xor(L, 2); L += __shfl_xor(L, 4);
    wl[lane] = wg; pl[lane] = pn; if (x == 0) Ll[t] = L;
    asm volatile("s_waitcnt lgkmcnt(0)" ::: "memory");
    f32x16 D0 = {}, D1 = {};
    float wr8[8];
#pragma unroll
    for (int g = 0; g < 8; ++g) wr8[g] = (r31 < 8) ? wl[r31 * 8 + g] : 0.f;
#pragma unroll 2
    for (int ks = 0; ks < 8; ++ks) { f32x4 s0 = {0.f, 0.f, 0.f, 0.f}, s1 = {0.f, 0.f, 0.f, 0.f};
        if (r31 < 8) {
#pragma unroll
            for (int g = 0; g < 8; ++g) { const float* p = part + (g * 64 + h * 8 + r31) * 132 + 4 + 16 * ks + 8 * hi; s0 += wr8[g] * *(const f32x4*)p; s1 += wr8[g] * *(const f32x4*)(p + 4); } }
        const bf16x8 af = pack8(s0, s1);
        const bf16x8 b0 = *(const bf16x8*)(WkvT + (size_t)(128 * h + 64 + r31) * 128 + 16 * ks + 8 * hi), b1 = *(const bf16x8*)(WkvT + (size_t)(128 * h + 96 + r31) * 128 + 16 * ks + 8 * hi);
        D0 = __builtin_amdgcn_mfma_f32_32x32x16_bf16(af, b0, D0, 0, 0, 0); D1 = __builtin_amdgcn_mfma_f32_32x32x16_bf16(af, b1, D1, 0, 0, 0); }
#pragma unroll
    for (int r = 0; r < 4; ++r) { Dl[(r + 4 * hi) * 64 + r31] = D0[r]; Dl[(r + 4 * hi) * 64 + 32 + r31] = D1[r]; }
    asm volatile("s_waitcnt lgkmcnt(0)" ::: "memory");
    float vv[8];
#pragma unroll
    for (int tp = 0; tp < 8; ++tp) vv[tp] = bf1(VM[(((size_t)MP + bs * 8 + tp) * 8 + h) * 64 + lane]);
#pragma unroll
    for (int tt = 0; tt < 8; ++tt) { float o = Dl[tt * 64 + lane];
#pragma unroll
        for (int tp = 0; tp < 8; ++tp) o += pl[tt * 8 + tp] * vv[tp];
        AO[((size_t)MP + bs * 8 + tt) * 1024 + 512 + h * 64 + lane] = (bf16)f2bf(o / Ll[tt]); }
    asm volatile("s_waitcnt lgkmcnt(0)" ::: "memory");
}
__device__ __forceinline__ void item(const Args& a, char* lds, LAS unsigned char* ldsl, int bs, int grp, int half, int wave, int lane) {
    unsigned char* ws = a.ws; int tid_o = wave * 64 + lane_id(); asm volatile("" : "+v"(tid_o)); const int tid = tid_o; lane = tid & 63;
    const int h = wave, rb = wave >> 2, kb = wave & 3, r31 = lane & 31, hi = lane >> 5;
    const int NPG = half < 0 ? 16 : 8, pg0 = grp * 16 + (half > 0 ? 8 : 0);
    const float* cache_c = (const float*)a.in[2]; const float* cache_r = (const float*)a.in[3]; const int* ptab = (const int*)a.in[6];
    const bf16* WkvT = (const bf16*)(ws + WS_WKVUP); const bf16* QM = (const bf16*)(ws + WS_QM);
    const int myphys = (lane < NPG) ? ptab[bs * 128 + pg0 + lane] : 0;
    typedef __attribute__((address_space(3))) unsigned lds_u32;
#define PAGE_LOAD(pg_) do { const int phys_ = __builtin_amdgcn_readlane(myphys, (pg_)); const char* sc_ = (const char*)(cache_c + (size_t)phys_ * 16384); \
        _Pragma("unroll") for (int i = 0; i < 8; ++i) __builtin_amdgcn_global_load_lds((const unsigned*)(sc_ + (i * 8 + wave) * 1024 + lane * 16), (lds_u32*)(ldsl + L_SC + (i * 8 + wave) * 1024), 16, 0, 2); \
        } while (0)
#define R_LOAD(pg_) do { const int phys_ = __builtin_amdgcn_readlane(myphys, (pg_)); const f32x4* sr_ = (const f32x4*)(cache_r + (size_t)phys_ * 4096); rq0 = __builtin_nontemporal_load(sr_ + tid * 2); rq1 = __builtin_nontemporal_load(sr_ + tid * 2 + 1); } while (0)
#define PAGE_CONVERT() do { _Pragma("unroll") for (int i = 0; i < 4; ++i) { const int id = i * 512 + tid; const unsigned key_ = id >> 4, ch_ = id & 15; const f32x4 x0 = *(const f32x4*)(lds + L_SC + id * 32), x1 = *(const f32x4*)(lds + L_SC + id * 32 + 16); \
            *(bf16x8*)(lds + L_CT + off_b(key_, ch_)) = pack8(x0, x1); \
            const float mx_ = rowmax16(amax8(x0, x1)); \
            const float sc_ = mx_ > 0.f ? 127.f * __builtin_amdgcn_rcpf(mx_) : 0.f; \
            *(uint2*)(lds + L_C8 + off_c8(key_, ch_ >> 1) + 8 * (ch_ & 1)) = make_uint2(q4(x0[0], x0[1], x0[2], x0[3], sc_), q4(x1[0], x1[1], x1[2], x1[3], sc_)); \
            if (ch_ == 0) ((float*)(lds + L_KI))[key_] = mx_ * (1.f / 127.f); } \
        *(bf16x8*)(lds + L_RT + (tid >> 2) * 64 + (tid & 3) * 16) = pack8(rq0, rq1); } while (0)
    f32x4 rq0, rq1;
    i32x4 wk8[2][4]; float winv;
    { bf16x8 wk[2][8];
#pragma unroll
      for (int jb = 0; jb < 2; ++jb)
#pragma unroll
          for (int ks = 0; ks < 8; ++ks) wk[jb][ks] = *(const bf16x8*)(WkvT + (size_t)(128 * h + 32 * jb + r31) * 128 + 32 * (ks >> 1) + 16 * hi + 8 * (ks & 1));
      PAGE_LOAD(0); R_LOAD(0);
      float wm = 0.f;
#pragma unroll
      for (int jb = 0; jb < 2; ++jb)
#pragma unroll
          for (int ks = 0; ks < 8; ++ks)
#pragma unroll
              for (int e = 0; e < 8; ++e) wm = fmaxf(wm, __builtin_fabsf(bf1((bf16)wk[jb][ks][e])));
      wm = rowmax16(wm); wm = fmaxf(wm, __shfl_xor(wm, 16)); wm = fmaxf(wm, __shfl_xor(wm, 32));
      const float wsc = wm > 0.f ? 127.f * __builtin_amdgcn_rcpf(wm) : 0.f; winv = wm * (1.f / 127.f);
#pragma unroll
      for (int jb = 0; jb < 2; ++jb)
#pragma unroll
          for (int k8 = 0; k8 < 4; ++k8) { const bf16x8 lo_ = wk[jb][2 * k8], hi_ = wk[jb][2 * k8 + 1];
              wk8[jb][k8] = (i32x4){(int)q4(bf1((bf16)lo_[0]), bf1((bf16)lo_[1]), bf1((bf16)lo_[2]), bf1((bf16)lo_[3]), wsc), (int)q4(bf1((bf16)lo_[4]), bf1((bf16)lo_[5]), bf1((bf16)lo_[6]), bf1((bf16)lo_[7]), wsc),
                                    (int)q4(bf1((bf16)hi_[0]), bf1((bf16)hi_[1]), bf1((bf16)hi_[2]), bf1((bf16)hi_[3]), wsc), (int)q4(bf1((bf16)hi_[4]), bf1((bf16)hi_[5]), bf1((bf16)hi_[6]), bf1((bf16)hi_[7]), wsc)}; } }
    { const bf16* WkvN = (const bf16*)(ws + WS_WKVN); const float* g_kn = (const float*)a.in[21];
      bf16x8 qb[4];
#pragma unroll
      for (int ks = 0; ks < 4; ++ks) { const int j0 = 16 * ks + 8 * hi; u32x4 w = {0u, 0u, 0u, 0u};
          if (r31 < 8) { const bf16x8 qv = *(const bf16x8*)(QM + (((size_t)(MP + bs * 8 + r31)) * 8 + h) * 96 + j0); const f32x4 g0 = *(const f32x4*)(g_kn + j0), g1 = *(const f32x4*)(g_kn + j0 + 4);
              w.x = cvtpk(bf1((bf16)qv[0]) * g0[0], bf1((bf16)qv[1]) * g0[1]); w.y = cvtpk(bf1((bf16)qv[2]) * g0[2], bf1((bf16)qv[3]) * g0[3]);
              w.z = cvtpk(bf1((bf16)qv[4]) * g1[0], bf1((bf16)qv[5]) * g1[1]); w.w = cvtpk(bf1((bf16)qv[6]) * g1[2], bf1((bf16)qv[7]) * g1[3]); }
          qb[ks] = *reinterpret_cast<bf16x8*>(&w); }
#pragma unroll
      for (int cb = 0; cb < 4; ++cb) { f32x16 dq = {};
#pragma unroll
          for (int ks = 0; ks < 4; ++ks) { const bf16x8 wa_ = *(const bf16x8*)(WkvN + (size_t)(32 * cb + r31) * 1024 + 128 * h + 16 * ks + 8 * hi); dq = __builtin_amdgcn_mfma_f32_32x32x16_bf16(wa_, qb[ks], dq, 0, 0, 0); }
          if (r31 < 8) {
#pragma unroll
              for (int r = 0; r < 16; ++r) { const int c = 32 * cb + crow(r, hi); *(bf16*)(lds + L_QA + off_b(h * 8 + r31, c >> 3) + (c & 7) * 2) = (bf16)f2bf(dq[r]); } } } }
    if (tid < 256) { const int row = tid >> 2, ch = tid & 3, hh = row >> 3, t = row & 7;
        *(u32x4*)(lds + L_QR + row * 64 + ch * 16) = *(const u32x4*)(QM + (((size_t)(MP + bs * 8 + t)) * 8 + hh) * 96 + 64 + ch * 8); }
    asm volatile("s_waitcnt vmcnt(0)" ::: "memory"); DBAR(); PAGE_CONVERT();
    float* rtab = (float*)(lds + L_RTAB); float* al = (float*)(lds + L_AL) + wave * 64;
    float m_reg = -1e30f, l_reg = 0.f; f32x16 O[4] = {};
    const int hh = 4 * rb + (r31 >> 3);
    const unsigned q_ = (lane & 15) >> 2, p_ = lane & 3, blk_ = (lane >> 4) & 1;
    DBAR();
    for (int pg = 0; pg < NPG; ++pg) {
        const char* Cb = lds + L_CT; const char* Rb = lds + L_RT;
        if (pg + 1 < NPG) PAGE_LOAD(pg + 1);
        { const float* kiv = (const float*)(lds + L_KI);
          i32x4 cf[4];
#pragma unroll
          for (int ks = 0; ks < 4; ++ks) cf[ks] = *(const i32x4*)(lds + L_C8 + off_c8(r31, 2 * ks + hi));
          i32x16 X, Y; float sa0 = 0.f, sa1 = 0.f, kvs = 0.f;
#define FMAC1(S, A) asm("v_fmac_f32 %0, %1, %1" : "+v"(S) : "v"(A))
#define SSQ1(D, G) do { const float a0_ = (float)D[4 * G], a1_ = (float)D[4 * G + 1], a2_ = (float)D[4 * G + 2], a3_ = (float)D[4 * G + 3]; FMAC1(sa0, a0_); FMAC1(sa1, a1_); FMAC1(sa0, a2_); FMAC1(sa1, a3_); } while (0)
#define HCHUNK(KS, JB, DN, HASPREV, DP, RELOAD, NEXTOFF) do { \
            DN = __builtin_amdgcn_mfma_i32_32x32x32_i8(wk8[JB][KS], cf[KS], DN, 0, 0, 0); \
            if (RELOAD) cf[KS] = *(const i32x4*)(lds + L_C8 + (NEXTOFF)); \
            if (HASPREV) { SSQ1(DP, KS); } __builtin_amdgcn_sched_barrier(0); } while (0)
#define NFIN(KP) do { float ss = sa0 + sa1; \
            { auto rr = __builtin_amdgcn_permlane32_swap(__float_as_uint(ss), __float_as_uint(ss), false, false); ss = __uint_as_float(rr[0]) + __uint_as_float(rr[1]); } \
            const float dq_ = kvs * winv; rtab[h * 128 + 32 * (KP) + r31] = __builtin_amdgcn_rsqf(ss * (dq_ * dq_) * (1.0f / 64.0f) + EPSN); } while (0)
#define HBLK(K2, JB, DN, HASPREV, DP, NEWSQ, DOFIN, FINKP) do { DN = (i32x16){}; \
            if (NEWSQ) { sa0 = 0.f; sa1 = 0.f; } if (DOFIN) kvs = kiv[32 * (FINKP) + r31]; \
            HCHUNK(0, JB, DN, HASPREV, DP, (JB == 1 && K2 < 3), off_c8(32 * ((K2) + 1) + r31, 0 + hi)); \
            HCHUNK(1, JB, DN, HASPREV, DP, (JB == 1 && K2 < 3), off_c8(32 * ((K2) + 1) + r31, 2 + hi)); \
            HCHUNK(2, JB, DN, HASPREV, DP, (JB == 1 && K2 < 3), off_c8(32 * ((K2) + 1) + r31, 4 + hi)); \
            HCHUNK(3, JB, DN, HASPREV, DP, (JB == 1 && K2 < 3), off_c8(32 * ((K2) + 1) + r31, 6 + hi)); \
            if (DOFIN) { NFIN(FINKP); } } while (0)
          HBLK(0, 0, X, 0, Y, 0, 0, 0);
          HBLK(0, 1, Y, 1, X, 1, 0, 0);
          HBLK(1, 0, X, 1, Y, 0, 1, 0);
          HBLK(1, 1, Y, 1, X, 1, 0, 0);
          HBLK(2, 0, X, 1, Y, 0, 1, 1);
          HBLK(2, 1, Y, 1, X, 1, 0, 0);
          HBLK(3, 0, X, 1, Y, 0, 1, 2);
          HBLK(3, 1, Y, 1, X, 1, 0, 0);
          kvs = kiv[96 + r31];
          SSQ1(Y, 0); SSQ1(Y, 1); SSQ1(Y, 2); SSQ1(Y, 3);
          NFIN(3);
#undef HBLK
#undef NFIN
#undef HCHUNK
#undef SSQ1
#undef FMAC1
        }
        DBAR();
        if (pg + 1 < NPG) R_LOAD(pg + 1);
        f32x16 sn = {};
        { bf16x8 cfA = *(const bf16x8*)(Cb + off_b(32 * kb + r31, hi)), qfA = *(const bf16x8*)(lds + L_QA + off_b(32 * rb + r31, hi)), cfB, qfB;
#pragma unroll
          for (int ks = 0; ks < 8; ks += 2) {
              cfB = *(const bf16x8*)(Cb + off_b(32 * kb + r31, 2 * (ks + 1) + hi)); qfB = *(const bf16x8*)(lds + L_QA + off_b(32 * rb + r31, 2 * (ks + 1) + hi)); __builtin_amdgcn_sched_barrier(0);
              sn = __builtin_amdgcn_mfma_f32_32x32x16_bf16(cfA, qfA, sn, 0, 0, 0); __builtin_amdgcn_sched_barrier(0);
              if (ks + 2 < 8) { cfA = *(const bf16x8*)(Cb + off_b(32 * kb + r31, 2 * (ks + 2) + hi)); qfA = *(const bf16x8*)(lds + L_QA + off_b(32 * rb + r31, 2 * (ks + 2) + hi)); } __builtin_amdgcn_sched_barrier(0);
              sn = __builtin_amdgcn_mfma_f32_32x32x16_bf16(cfB, qfB, sn, 0, 0, 0); __builtin_amdgcn_sched_barrier(0); } }
#pragma unroll
        for (int q = 0; q < 4; ++q) { const f32x4 rv = *(const f32x4*)(rtab + hh * 128 + 32 * kb + 8 * q + 4 * hi);
#pragma unroll
            for (int e = 0; e < 4; ++e) sn[4 * q + e] = sn[4 * q + e] * rv[e]; }
#pragma unroll
        for (int ks = 0; ks < 2; ++ks) { const bf16x8 rf = *(const bf16x8*)(Rb + (32 * kb + r31) * 64 + (2 * ks + hi) * 16); const bf16x8 qf = *(const bf16x8*)(lds + L_QR + (32 * rb + r31) * 64 + (2 * ks + hi) * 16);
            sn = __builtin_amdgcn_mfma_f32_32x32x16_bf16(rf, qf, sn, 0, 0, 0); }
        float pmax = sn[0];
#pragma unroll
        for (int r = 1; r < 16; ++r) pmax = fmaxf(pmax, sn[r]);
        { auto rr = __builtin_amdgcn_permlane32_swap(__float_as_uint(pmax), __float_as_uint(pmax), false, false); pmax = fmaxf(__uint_as_float(rr[0]), __uint_as_float(rr[1])); }
        float mn, alpha;
        if (__all((pmax - m_reg) <= THR)) { mn = m_reg; alpha = 1.f; } else { mn = fmaxf(m_reg, pmax); alpha = __builtin_amdgcn_exp2f(m_reg - mn); m_reg = mn; }
        float ps = 0.f;
#pragma unroll
        for (int r = 0; r < 16; ++r) { sn[r] = __builtin_amdgcn_exp2f(sn[r] - mn); ps += sn[r]; }
        { auto rr = __builtin_amdgcn_permlane32_swap(__float_as_uint(ps), __float_as_uint(ps), false, false); ps = __uint_as_float(rr[0]) + __uint_as_float(rr[1]); }
        l_reg = l_reg * alpha + ps;
        bf16x8 pa0, pa1;
#define PK4(P, B_, OUT) do { unsigned a0 = cvtpk(P[B_+0], P[B_+1]), a1 = cvtpk(P[B_+2], P[B_+3]); unsigned b0 = cvtpk(P[B_+4], P[B_+5]), b1 = cvtpk(P[B_+6], P[B_+7]); \
        auto r0 = __builtin_amdgcn_permlane32_swap(a0, b0, false, false); auto r1 = __builtin_amdgcn_permlane32_swap(a1, b1, false, false); \
        u32x4 w = {r0[0], r1[0], r0[1], r1[1]}; OUT = *reinterpret_cast<bf16x8*>(&w); } while (0)
        PK4(sn, 0, pa0); PK4(sn, 8, pa1);
#undef PK4
        if (__any(alpha < 1.f)) { if (hi == 0) al[r31] = alpha; asm volatile("s_waitcnt lgkmcnt(0)" ::: "memory");
#pragma unroll
            for (int cb = 0; cb < 4; ++cb)
#pragma unroll
                for (int r = 0; r < 16; ++r) O[cb][r] *= al[crow(r, hi)]; }
        { const unsigned cbase = (unsigned)(uintptr_t)Cb;
#pragma unroll 1
          for (int s2 = 0; s2 < 2; ++s2) { s16x4 lo[4], hi4[4];
              unsigned a0[4], a1[4];
#pragma unroll
              for (int cb = 0; cb < 4; ++cb) { a0[cb] = cbase + off_b(32 * kb + 16 * s2 + 8 * hi + q_, 4 * cb + 2 * blk_ + (p_ >> 1)) + 8 * (p_ & 1);
                  a1[cb] = cbase + off_b(32 * kb + 16 * s2 + 8 * hi + 4 + q_, 4 * cb + 2 * blk_ + (p_ >> 1)) + 8 * (p_ & 1); }
              asm volatile("ds_read_b64_tr_b16 %0, %8\n\tds_read_b64_tr_b16 %1, %9\n\tds_read_b64_tr_b16 %2, %10\n\tds_read_b64_tr_b16 %3, %11\n\t"
                           "ds_read_b64_tr_b16 %4, %12\n\tds_read_b64_tr_b16 %5, %13\n\tds_read_b64_tr_b16 %6, %14\n\tds_read_b64_tr_b16 %7, %15\n\ts_waitcnt lgkmcnt(0)"
                           : "=&v"(lo[0]), "=&v"(hi4[0]), "=&v"(lo[1]), "=&v"(hi4[1]), "=&v"(lo[2]), "=&v"(hi4[2]), "=&v"(lo[3]), "=&v"(hi4[3])
                           : "v"(a0[0]), "v"(a1[0]), "v"(a0[1]), "v"(a1[1]), "v"(a0[2]), "v"(a1[2]), "v"(a0[3]), "v"(a1[3]) : "memory");
              __builtin_amdgcn_sched_barrier(0);
              const bf16x8 pa = s2 == 0 ? pa0 : pa1;
#pragma unroll
              for (int cb = 0; cb < 4; ++cb) { const bf16x8 bfr = (bf16x8){lo[cb][0], lo[cb][1], lo[cb][2], lo[cb][3], hi4[cb][0], hi4[cb][1], hi4[cb][2], hi4[cb][3]};
                  O[cb] = __builtin_amdgcn_mfma_f32_32x32x16_bf16(pa, bfr, O[cb], 0, 0, 0); } } }
        asm volatile("s_waitcnt vmcnt(0)" ::: "memory"); DBAR();
        if (pg + 1 < NPG) PAGE_CONVERT();
        DBAR();
    }
#undef PAGE_LOAD
#undef R_LOAD
#undef PAGE_CONVERT
    float* ML = (float*)(lds + L_ML);
    float* OB = (float*)lds;
    if (hi == 0) { ML[(wave * 32 + r31) * 2] = m_reg; ML[(wave * 32 + r31) * 2 + 1] = l_reg; }
    DBAR();
    float fsc[16];
#pragma unroll
    for (int r = 0; r < 16; ++r) { const int row = crow(r, hi); float M = ML[((rb * 4 + 0) * 32 + row) * 2];
#pragma unroll
        for (int k2 = 1; k2 < 4; ++k2) M = fmaxf(M, ML[((rb * 4 + k2) * 32 + row) * 2]);
        fsc[r] = __builtin_amdgcn_exp2f(ML[((rb * 4 + kb) * 32 + row) * 2] - M); }
    { float* OW = (float*)lds + wave * 4096;
#pragma unroll
      for (int cb = 0; cb < 4; ++cb)
#pragma unroll
          for (int r = 0; r < 16; ++r) OW[crow(r, hi) * 128 + cb * 32 + r31] = O[cb][r] * fsc[r]; }
    DBAR();
    float* const partG = (float*)(ws + WS_PART) + ((size_t)(bs * 8 + grp) * 64) * 132;
    float* const pairT = (float*)(ws + WS_G) + ((size_t)((bs & 3) * 8 + grp) * 2 * 64) * 132;
    { float* part = half < 0 ? partG : pairT + (size_t)half * 64 * 132; const float* OWs = (const float*)lds;
#pragma unroll 4
      for (int i = tid; i < 64 * 32; i += 512) { const int row = i >> 5, c4 = (i & 31) * 4, rbb = row >> 5, rr = row & 31; const float* p0 = OWs + (size_t)(rbb * 4) * 4096 + rr * 128 + c4;
          const f32x4 v = ((*(const f32x4*)p0 + *(const f32x4*)(p0 + 4096)) + *(const f32x4*)(p0 + 2 * 4096)) + *(const f32x4*)(p0 + 3 * 4096);
          *(f32x4*)(part + row * 132 + 4 + c4) = v; }
      if (tid < 64) { const int row = tid, rbb = row >> 5, rr = row & 31; float M = ML[((rbb * 4) * 32 + rr) * 2];
#pragma unroll
          for (int k2 = 1; k2 < 4; ++k2) M = fmaxf(M, ML[((rbb * 4 + k2) * 32 + rr) * 2]);
          float L = 0.f;
#pragma unroll
          for (int k2 = 0; k2 < 4; ++k2) L += ML[((rbb * 4 + k2) * 32 + rr) * 2 + 1] * __builtin_amdgcn_exp2f(ML[((rbb * 4 + k2) * 32 + rr) * 2] - M);
          part[row * 132] = M; part[row * 132 + 1] = L; } }
    asm volatile("s_waitcnt vmcnt(0)" ::: "memory");
    __syncthreads();
    unsigned* flagw = (unsigned*)(lds + L_ML);
    if (half >= 0) {
        if (tid == 0) { __builtin_amdgcn_fence(__ATOMIC_RELEASE, "agent"); asm volatile("s_waitcnt vmcnt(0)" ::: "memory");
            flagw[0] = __hip_atomic_fetch_add((unsigned*)(ws + WS_CTL) + CW_DCNT + 64 * bs + 16 + grp, 1u, __ATOMIC_RELAXED, __HIP_MEMORY_SCOPE_AGENT); }
        __syncthreads();
        const bool second = flagw[0] == 1u;
        __syncthreads();
        if (!second) return;
        if (tid == 0) { __builtin_amdgcn_fence(__ATOMIC_ACQUIRE, "agent"); asm volatile("s_waitcnt vmcnt(0)" ::: "memory"); }
        __syncthreads();
        const float* TA = pairT; const float* TB = pairT + 64 * 132;
#pragma unroll 4
        for (int i = tid; i < 64 * 32; i += 512) { const int row = i >> 5, c4 = (i & 31) * 4;
            const float MA = TA[row * 132], MB = TB[row * 132], M = fmaxf(MA, MB), sA = __builtin_amdgcn_exp2f(MA - M), sB = __builtin_amdgcn_exp2f(MB - M);
            const f32x4 va = *(const f32x4*)(TA + row * 132 + 4 + c4), vb = *(const f32x4*)(TB + row * 132 + 4 + c4); f32x4 v;
#pragma unroll
            for (int e = 0; e < 4; ++e) v[e] = __fadd_rn(__fmul_rn(va[e], sA), __fmul_rn(vb[e], sB));
            *(f32x4*)(partG + row * 132 + 4 + c4) = v;
            if (c4 == 0) { partG[row * 132] = M; partG[row * 132 + 1] = __fadd_rn(__fmul_rn(TA[row * 132 + 1], sA), __fmul_rn(TB[row * 132 + 1], sB)); } }
        asm volatile("s_waitcnt vmcnt(0)" ::: "memory");
        __syncthreads();
    }
    if (tid == 0) { __builtin_amdgcn_fence(__ATOMIC_RELEASE, "agent"); asm volatile("s_waitcnt vmcnt(0)" ::: "memory");
        flagw[0] = __hip_atomic_fetch_add((unsigned*)(ws + WS_CTL) + CW_DCNT + 64 * bs, 1u, __ATOMIC_RELAXED, __HIP_MEMORY_SCOPE_AGENT); }
    __syncthreads();
    const bool lastone = flagw[0] == 7u;
    __syncthreads();
    if (lastone) {
        if (tid == 0) { __builtin_amdgcn_fence(__ATOMIC_ACQUIRE, "agent"); asm volatile("s_waitcnt vmcnt(0)" ::: "memory"); }
        __syncthreads();
        combine(a, lds, bs, wave, lane);
        __syncthreads();
    }
}
#undef DBAR
}
__device__ __forceinline__ void post_tokens(const Args& a, int gw, int NGW, int lane_in) {
    unsigned char* ws = a.ws; int ln = lane_id(); asm volatile("" : "+v"(ln)); (void)lane_in; const int lane = ln;
    const bf16* U = (const bf16*)(ws + WS_U); const f32x2* ROPE = (const f32x2*)(ws + WS_ROPE); bf16* KM = (bf16*)(ws + WS_KM);
    const float* rsqkv = (const float*)(ws + WS_CTL) + CW_RSQKV; const float* rsqkr = (const float*)(ws + WS_CTL) + CW_RSQKR;
    const float* g_kva = (const float*)a.in[18]; const float* g_kr = (const float*)a.in[19];
    const f32x2 gk = *(const f32x2*)(g_kva + 2 * lane); const float gr = g_kr[lane & 31];
#pragma unroll 1
    for (int m0 = gw; m0 < MT; m0 += 4 * NGW) {
        unsigned raw[4]; float xr[4], sv[4], sr[4]; f32x2 cr[4];
#pragma unroll
        for (int i = 0; i < 4; ++i) { const int m = m0 + i * NGW; const bool ok = m < MT; const int mm = ok ? m : gw; const bf16* Urow = U + (size_t)mm * NU;
            raw[i] = *(const unsigned*)(Urow + U_MKV + 2 * lane); xr[i] = bf1(Urow[U_MKR + (lane & 31)]); sv[i] = rsqkv[mm]; sr[i] = rsqkr[mm];
            const int pidx = (mm < MP) ? (mm & 2047) : 2048 + ((mm - MP) & 7); cr[i] = ROPE[pidx * 16 + (lane & 15)]; }
#pragma unroll
        for (int i = 0; i < 4; ++i) { const int m = m0 + i * NGW; if (m < MT) {
            const float rs = __builtin_amdgcn_rsqf(sv[i] * (1.0f / 128.0f) + EPSN), rr = __builtin_amdgcn_rsqf(sr[i] * (1.0f / 32.0f) + EPSN);
            float* ck = (m < MP) ? a.out + O_CKVP + (size_t)m * 128 : a.out + O_CKVS + (size_t)(m - MP) * 128;
            *(f32x2*)(ck + 2 * lane) = (f32x2){blo(raw[i]) * rs * gk.x, bhi(raw[i]) * rs * gk.y};
            const float x = xr[i] * rr * gr, y = __shfl_xor(x, 16); const f32x2 c = cr[i];
            const float o = (lane & 16) ? (x * c.x + y * c.y) : (x * c.x - y * c.y);
            if (lane < 32) { float* kr = (m < MP) ? a.out + O_KRP + (size_t)m * 32 : a.out + O_KRS + (size_t)(m - MP) * 32; kr[lane] = o; }
            const int hh = lane >> 3, part = lane & 7;
            const float o0 = __shfl(o, 4 * part), o1 = __shfl(o, 4 * part + 1), o2 = __shfl(o, 4 * part + 2), o3 = __shfl(o, 4 * part + 3);
            u32x2 w; w.x = pk2(o0, o1); w.y = pk2(o2, o3); *(u32x2*)(KM + ((size_t)m * 8 + hh) * 96 + 64 + 4 * part) = w; } }
    }
}
namespace gla {
typedef short bf16x8 __attribute__((ext_vector_type(8)));
typedef float f32x16 __attribute__((ext_vector_type(16)));
typedef unsigned u32x4 __attribute__((ext_vector_type(4)));
__device__ __forceinline__ unsigned cvtpk(float lo, float hi) { unsigned r; asm volatile("v_cvt_pk_bf16_f32 %0, %1, %2" : "=v"(r) : "v"(lo), "v"(hi)); return r; }
__device__ __forceinline__ int crow(int r, int hi) { return (r & 3) + 8 * (r >> 2) + 4 * hi; }
__device__ __forceinline__ void prep_tile(const Args& a, char* lds, int tileidx, const int wave_s) {
    unsigned char* ws = a.ws; int tid_o = wave_s * 64 + lane_id(); asm volatile("" : "+v"(tid_o)); const int tid = tid_o, c = tid & 255, h = c >> 6, dk = c & 63;
    const int half = wave_s >> 2;
    const bf16* U = (const bf16*)(ws + WS_U); const float* w_a2 = (const float*)a.in[11]; const float* b_a = (const float*)a.in[12];
    bf16* QDEC = (bf16*)(ws + WS_QDEC); bf16* KINV = (bf16*)(ws + WS_KINV); bf16* KENDT = (bf16*)(ws + WS_KENDT); bf16* VT = (bf16*)(ws + WS_VT); float* ELAST = (float*)(ws + WS_ELAST);
    const int m0 = tileidx * 64 + half * 32; const bool is_p = m0 < MP;
    float* gaf = (float*)lds;
    __syncthreads();
    if (tid < 128) { const int t = tid >> 1, hh = tid & 1; const v4u g = *(const v4u*)(U + (size_t)(tileidx * 64 + t) * NU + U_GA + 8 * hh);
        *(f32x4*)(gaf + t * 16 + 8 * hh) = (f32x4){blo(g.x), bhi(g.x), blo(g.y), bhi(g.y)}; *(f32x4*)(gaf + t * 16 + 8 * hh + 4) = (f32x4){blo(g.z), bhi(g.z), blo(g.w), bhi(g.w)}; }
    float wa[16];
#pragma unroll
    for (int r = 0; r < 16; ++r) wa[r] = w_a2[r * 256 + c];
    const float ba = b_a[c];
    __syncthreads();
    float la[32];
#pragma unroll
    for (int t = 0; t < 32; ++t) { const float* gp = gaf + (half * 32 + t) * 16; const f32x4 g0 = *(const f32x4*)gp, g1 = *(const f32x4*)(gp + 4), g2 = *(const f32x4*)(gp + 8), g3 = *(const f32x4*)(gp + 12);
        const float z = ba + (g0[0] * wa[0] + g0[1] * wa[1] + g0[2] * wa[2] + g0[3] * wa[3]) + (g1[0] * wa[4] + g1[1] * wa[5] + g1[2] * wa[6] + g1[3] * wa[7])
                           + (g2[0] * wa[8] + g2[1] * wa[9] + g2[2] * wa[10] + g2[3] * wa[11]) + (g3[0] * wa[12] + g3[1] * wa[13] + g3[2] * wa[14] + g3[3] * wa[15]);
        la[t] = (fminf(z, 0.f) - __logf(1.0f + __expf(-fabsf(z)))) * (1.0f / 16.0f); }
#define PROC_SEG(T0, NG) do { const int ms = m0 + (T0); const int cid = is_p ? (ms >> 5) : 512 + ((ms - MP) >> 3); \
        float blast = 0.f; _Pragma("unroll") for (int t = 0; t < 8 * (NG); ++t) blast += la[(T0) + t]; \
        bf16* kt = KENDT + ((size_t)(cid * 4 + h) * 2 + (dk >> 5)) * 1024 + (dk & 31) * 8; \
        const size_t fbase = (((size_t)(cid * 4 + h) * 4 + (dk >> 4)) * 2 + ((dk >> 3) & 1)) * 256 + (dk & 7); \
        float b = 0.f; \
        _Pragma("unroll") for (int g = 0; g < (NG); ++g) { unsigned short qv[8], kv[8]; \
            _Pragma("unroll") for (int j = 0; j < 8; ++j) { const size_t m = (size_t)(ms + g * 8 + j); qv[j] = U[m * NU + U_GQ + c]; kv[j] = U[m * NU + U_GK + c]; } \
            unsigned pk[4]; \
            _Pragma("unroll") for (int j = 0; j < 8; j += 2) { float ke[2]; \
                _Pragma("unroll") for (int jj = 0; jj < 2; ++jj) { b += la[(T0) + g * 8 + j + jj]; const float eb = __expf(b), q = bf1(qv[j + jj]), k = bf1(kv[j + jj]); \
                    const size_t fo = fbase + (size_t)(g * 8 + j + jj) * 8; \
                    QDEC[fo] = (bf16)f2bf(q * 0.125f * eb); KINV[fo] = (bf16)f2bf(k * __builtin_amdgcn_rcpf(eb)); ke[jj] = k * __expf(blast - b); } \
                pk[j >> 1] = cvtpk(ke[0], ke[1]); } \
            *(v4u*)(kt + g * 256) = (v4u){pk[0], pk[1], pk[2], pk[3]}; } \
        if ((NG) == 1) { *(v4u*)(kt + 256) = (v4u){0u, 0u, 0u, 0u}; *(v4u*)(kt + 512) = (v4u){0u, 0u, 0u, 0u}; *(v4u*)(kt + 768) = (v4u){0u, 0u, 0u, 0u}; } \
        ELAST[(size_t)cid * 256 + c] = __expf(blast); } while (0)
    if (is_p) { PROC_SEG(0, 4); } else { PROC_SEG(0, 1); PROC_SEG(8, 1); PROC_SEG(16, 1); PROC_SEG(24, 1); }
#undef PROC_SEG
    bf16* GGF = (bf16*)(ws + WS_GGF);
    const int nseg = is_p ? 1 : 4, ng = is_p ? 4 : 1;
#pragma unroll 1
    for (int cc = 0; cc < 2; ++cc) { const int col = (tid & 255) + 256 * cc, hv = col >> 7, dv = col & 127, dvl = dv & 31;
        for (int seg = 0; seg < nseg; ++seg) { const int ms = m0 + seg * 8 * ng; const int cid = is_p ? (ms >> 5) : 512 + ((ms - MP) >> 3);
            bf16* vt = VT + (((size_t)(cid * 4 + hv) * 4 + (dv >> 5)) * 4) * 256 + dvl * 8;
            bf16* gf = GGF + (((((size_t)(cid * 4 + hv) * 4 + (dv >> 5)) * 4 + (dvl >> 3)) * 2 + ((dvl >> 2) & 1)) * 32) * 4 + (dvl & 3);
            for (int g = 0; g < ng; ++g) { unsigned short e[8], gg[8];
#pragma unroll
                for (int j = 0; j < 8; ++j) { e[j] = U[(size_t)(ms + g * 8 + j) * NU + U_GV + col]; gg[j] = U[(size_t)(ms + g * 8 + j) * NU + U_GG + col]; }
#pragma unroll
                for (int j = 0; j < 8; ++j) gf[(g * 8 + j) * 4] = gg[j];
                *(v4u*)(vt + g * 256) = (v4u){(unsigned)e[0] | ((unsigned)e[1] << 16), (unsigned)e[2] | ((unsigned)e[3] << 16), (unsigned)e[4] | ((unsigned)e[5] << 16), (unsigned)e[6] | ((unsigned)e[7] << 16)}; }
            if (!is_p) { *(v4u*)(vt + 256) = (v4u){0u, 0u, 0u, 0u}; *(v4u*)(vt + 512) = (v4u){0u, 0u, 0u, 0u}; *(v4u*)(vt + 768) = (v4u){0u, 0u, 0u, 0u}; } } }
    __syncthreads();
}
__device__ __forceinline__ void prep_tile_p(const Args& a, char* lds, LAS unsigned char* ldsl, int tileidx, const int wave_s) {
    typedef __attribute__((address_space(3))) unsigned lds_u32;
    constexpr int RS = 1040, RH = RS / 2, S1 = 4096, S2 = 4096 + 64 * RS;
    unsigned char* ws = a.ws; int tid_o = wave_s * 64 + lane_id(); asm volatile("" : "+v"(tid_o)); const int tid = tid_o, lane = tid & 63, c = tid & 255, h = c >> 6, dk = c & 63;
    const int half = wave_s >> 2, cid = tileidx * 2 + half;
    const bf16* U = (const bf16*)(ws + WS_U); const float* w_a2 = (const float*)a.in[11]; const float* b_a = (const float*)a.in[12];
    bf16* QDEC = (bf16*)(ws + WS_QDEC); bf16* KINV = (bf16*)(ws + WS_KINV); bf16* KENDT = (bf16*)(ws + WS_KENDT); bf16* VT = (bf16*)(ws + WS_VT); float* ELAST = (float*)(ws + WS_ELAST); bf16* GGF = (bf16*)(ws + WS_GGF);
    float* gaf = (float*)lds;
    __syncthreads();
    const char* rowb = (const char*)(U + (size_t)(tileidx * 64 + wave_s * 8) * NU) + lane * 16;
#pragma unroll
    for (int i = 0; i < 8; ++i) { __builtin_amdgcn_global_load_lds((const unsigned*)(rowb + (size_t)i * NU * 2), (lds_u32*)(ldsl + S1 + (wave_s * 8 + i) * RS), 16, 0, 0);
                                  __builtin_amdgcn_global_load_lds((const unsigned*)(rowb + (size_t)i * NU * 2 + 1024), (lds_u32*)(ldsl + S2 + (wave_s * 8 + i) * RS), 16, 0, 0); }
    if (tid < 128) { const int t = tid >> 1, hh = tid & 1; const v4u g = *(const v4u*)(U + (size_t)(tileidx * 64 + t) * NU + U_GA + 8 * hh);
        *(f32x4*)(gaf + t * 16 + 8 * hh) = (f32x4){blo(g.x), bhi(g.x), blo(g.y), bhi(g.y)}; *(f32x4*)(gaf + t * 16 + 8 * hh + 4) = (f32x4){blo(g.z), bhi(g.z), blo(g.w), bhi(g.w)}; }
    float wa[16];
#pragma unroll
    for (int r = 0; r < 16; ++r) wa[r] = w_a2[r * 256 + c];
    const float ba = b_a[c];
    __syncthreads();
    float la[32];
#pragma unroll
    for (int t = 0; t < 32; ++t) { const float* gp = gaf + (half * 32 + t) * 16; const f32x4 g0 = *(const f32x4*)gp, g1 = *(const f32x4*)(gp + 4), g2 = *(const f32x4*)(gp + 8), g3 = *(const f32x4*)(gp + 12);
        const float z = ba + (g0[0] * wa[0] + g0[1] * wa[1] + g0[2] * wa[2] + g0[3] * wa[3]) + (g1[0] * wa[4] + g1[1] * wa[5] + g1[2] * wa[6] + g1[3] * wa[7])
                           + (g2[0] * wa[8] + g2[1] * wa[9] + g2[2] * wa[10] + g2[3] * wa[11]) + (g3[0] * wa[12] + g3[1] * wa[13] + g3[2] * wa[14] + g3[3] * wa[15]);
        la[t] = (fminf(z, 0.f) - __logf(1.0f + __expf(-fabsf(z)))) * (1.0f / 16.0f); }
    asm volatile("s_waitcnt vmcnt(0)" ::: "memory");
    __syncthreads();
    { unsigned short* s1 = (unsigned short*)(lds + S1) + (half * 32) * RH + c;
      float blast = 0.f;
#pragma unroll
      for (int t = 0; t < 32; ++t) blast += la[t];
      bf16* kt = KENDT + ((size_t)(cid * 4 + h) * 2 + (dk >> 5)) * 1024 + (dk & 31) * 8;
      float b = 0.f;
#pragma unroll
      for (int g = 0; g < 4; ++g) { unsigned pk[4];
#pragma unroll
          for (int j = 0; j < 8; j += 2) { float ke[2];
#pragma unroll
              for (int jj = 0; jj < 2; ++jj) { const int t = g * 8 + j + jj; b += la[t]; const float eb = __expf(b), q = bf1(s1[t * RH]), k = bf1(s1[t * RH + 256]);
                  s1[t * RH] = (unsigned short)f2bf(q * 0.125f * eb); s1[t * RH + 256] = (unsigned short)f2bf(k * __builtin_amdgcn_rcpf(eb)); ke[jj] = k * __expf(blast - b); }
              pk[j >> 1] = cvtpk(ke[0], ke[1]); }
          *(v4u*)(kt + g * 256) = (v4u){pk[0], pk[1], pk[2], pk[3]}; }
      ELAST[(size_t)cid * 256 + c] = __expf(blast); }
    __syncthreads();
#pragma unroll
    for (int i = 0; i < 8; ++i) { const int u = i * 512 + tid, arr = u >> 11, r = u & 2047, hf = r >> 10, hh = (r >> 8) & 3, g8 = (r >> 5) & 7, t = r & 31;
        const v4u val = *(const v4u*)(lds + S1 + (hf * 32 + t) * RS + arr * 512 + (hh * 64 + g8 * 8) * 2);
        bf16* dst = (arr ? KINV : QDEC) + ((size_t)((tileidx * 2 + hf) * 4 + hh) * 8 + g8) * 256 + t * 8;
        *(v4u*)dst = val; }
    __syncthreads();
#pragma unroll
    for (int i = 0; i < 8; ++i) __builtin_amdgcn_global_load_lds((const unsigned*)(rowb + (size_t)i * NU * 2 + 2048), (lds_u32*)(ldsl + S1 + (wave_s * 8 + i) * RS), 16, 0, 0);
#pragma unroll
    for (int cc = 0; cc < 2; ++cc) { const int col = c + 256 * cc, hv = col >> 7, dv = col & 127, dvl = dv & 31;
        bf16* vt = VT + (((size_t)(cid * 4 + hv) * 4 + (dv >> 5)) * 4) * 256 + dvl * 8;
        const unsigned short* s2 = (const unsigned short*)(lds + S2) + (half * 32) * RH + col;
#pragma unroll
        for (int g = 0; g < 4; ++g) { unsigned e[8];
#pragma unroll
            for (int j = 0; j < 8; ++j) e[j] = s2[(g * 8 + j) * RH];
            *(v4u*)(vt + g * 256) = (v4u){e[0] | (e[1] << 16), e[2] | (e[3] << 16), e[4] | (e[5] << 16), e[6] | (e[7] << 16)}; } }
    asm volatile("s_waitcnt vmcnt(0)" ::: "memory");
    __syncthreads();
#pragma unroll
    for (int i = 0; i < 8; ++i) { const int u = i * 512 + tid, tp = u & 15, quad = (u >> 4) & 127, hf = u >> 11, hv = quad >> 5, dvb = (quad & 31) >> 3, q = (quad & 7) >> 1, hi = quad & 1;
        const u32x2 x0 = *(const u32x2*)(lds + S1 + (hf * 32 + 2 * tp) * RS + quad * 8), x1 = *(const u32x2*)(lds + S1 + (hf * 32 + 2 * tp + 1) * RS + quad * 8);
        bf16* dst = GGF + ((((((size_t)((tileidx * 2 + hf) * 4 + hv) * 4 + dvb) * 4 + q) * 2 + hi) * 32) + 2 * tp) * 4;
        *(v4u*)dst = (v4u){x0.x, x0.y, x1.x, x1.y}; }
    __syncthreads();
}
#define GBAR() asm volatile("s_waitcnt lgkmcnt(0)\n\ts_barrier" ::: "memory")
__device__ __forceinline__ void scan_unit(const Args& a, char* lds, int unit, int wave, int lane_in) {
    unsigned char* ws = a.ws; int ln = lane_id(); asm volatile("" : "+v"(ln)); (void)lane_in; const int lane = ln, r31 = lane & 31, hi = lane >> 5, sub = wave >> 2, dvb = wave & 3;
    const bool is_p = unit < 32; const int item = is_p ? unit : unit - 32; const int seq = item >> 2, h = item & 3;
    const int nch = is_p ? 64 : 1, tvalid = is_p ? 32 : 8;
    const size_t row0 = is_p ? (size_t)seq * 2048 : (size_t)MP + seq * 8; const int cid0 = is_p ? seq * 64 : 512 + seq;
    const bf16* U = (const bf16*)(ws + WS_U); const bf16* QDEC = (const bf16*)(ws + WS_QDEC); const bf16* KINV = (const bf16*)(ws + WS_KINV); const bf16* KENDT = (const bf16*)(ws + WS_KENDT); const bf16* VT = (const bf16*)(ws + WS_VT);
    const float* ELAST = (const float*)(ws + WS_ELAST); bf16* AO = (bf16*)(ws + WS_AO); const float* g_out = (const float*)a.in[13]; const bf16* GGF = (const bf16*)(ws + WS_GGF);
    if (sub) {
        const int hl = (wave & 3) * 64 + lane; const size_t ch0 = (size_t)cid0 * 4 + h;
        const bf16* p = KINV + ch0 * 2048; size_t stride = 0;
        if (hl < 32) { p = KINV + ch0 * 2048 + hl * 64; stride = 8192; } else if (hl < 64) { p = QDEC + ch0 * 2048 + (hl - 32) * 64; stride = 8192; }
        else if (hl < 96) { p = KENDT + ch0 * 2048 + (hl - 64) * 64; stride = 8192; } else if (hl < 160) { p = VT + ch0 * 4096 + (hl - 96) * 64; stride = 16384; }
        else if (hl < 224) { p = GGF + ch0 * 4096 + (hl - 160) * 64; stride = 16384; }
        unsigned accp = 0u, v0 = 0u, v1 = 0u, v2 = 0u, v3 = 0u;
        if (1 < nch) v1 = *(const unsigned*)(p + 1 * stride);
        if (2 < nch) v2 = *(const unsigned*)(p + 2 * stride);
        if (3 < nch) v3 = *(const unsigned*)(p + 3 * stride);
        GBAR();
#pragma unroll 1
        for (int n = 0; n < nch; n += 4) {
#define PF(V, k_) do { if (n + (k_) < nch) { accp += V; if (n + (k_) + 4 < nch) V = *(const unsigned*)(p + (size_t)(n + (k_) + 4) * stride); GBAR(); } } while (0)
            PF(v0, 0); PF(v1, 1); PF(v2, 2); PF(v3, 3);
#undef PF
        }
        if (accp == 0x9e3779b9u) ((unsigned*)(ws + WS_PFSINK))[wave * 64 + lane] = accp;
        GBAR(); return; }
    f32x16 S[2];
    if (is_p) { S[0] = f32x16{}; S[1] = f32x16{}; }
    else { const float* s0 = (const float*)a.in[4] + ((size_t)seq * 4 + h) * 8192;
#pragma unroll
        for (int blk = 0; blk < 2; ++blk)
#pragma unroll
            for (int r = 0; r < 16; ++r) S[blk][r] = s0[(32 * blk + crow(r, hi)) * 128 + 32 * dvb + r31]; }
#define PK4(P, B_, OUT) do { unsigned a0 = cvtpk(P[B_+0], P[B_+1]), a1 = cvtpk(P[B_+2], P[B_+3]); unsigned b0 = cvtpk(P[B_+4], P[B_+5]), b1 = cvtpk(P[B_+6], P[B_+7]); \
        auto r0 = __builtin_amdgcn_permlane32_swap(a0, b0, false, false); auto r1 = __builtin_amdgcn_permlane32_swap(a1, b1, false, false); \
        u32x4 w = {r0[0], r1[0], r0[1], r1[1]}; OUT = *reinterpret_cast<bf16x8*>(&w); } while (0)
    f32x4 gout[4];
#pragma unroll
    for (int q = 0; q < 4; ++q) gout[q] = *(const f32x4*)(g_out + 32 * dvb + 8 * q + 4 * hi);
    float* ELT = (float*)(lds + 65536) + sub * 4096;
    float* SS = (float*)lds;
    { const int l4 = (wave & 3) * 64 + lane;
      for (int i = l4; i < nch * 16; i += 256) { const int n = i >> 4, q4 = (i & 15) * 4; *(f32x4*)(ELT + n * 64 + q4) = *(const f32x4*)(ELAST + (size_t)(cid0 + n) * 256 + h * 64 + q4); } }
    GBAR();
    bf16x8 kiA[4], qdA[4], vtA[2], keA[2][2], kiB[4], qdB[4], vtB[2], keB[2][2]; u32x2 ggA[4], ggB[4];
#define LOADQ(KI, QD, VTX, KE, GG, n_) do { const size_t ch_ = (size_t)(cid0 + (n_)) * 4 + h; \
        _Pragma("unroll") for (int ks = 0; ks < 4; ++ks) { KI[ks] = *(const bf16x8*)(KINV + (((ch_ * 4 + ks) * 2 + hi) * 32 + r31) * 8); QD[ks] = *(const bf16x8*)(QDEC + (((ch_ * 4 + ks) * 2 + hi) * 32 + r31) * 8); } \
        _Pragma("unroll") for (int ks = 0; ks < 2; ++ks) VTX[ks] = *(const bf16x8*)(VT + ((((ch_ * 4 + dvb) * 2 + ks) * 2 + hi) * 32 + r31) * 8); \
        _Pragma("unroll") for (int blk = 0; blk < 2; ++blk) _Pragma("unroll") for (int ks = 0; ks < 2; ++ks) KE[blk][ks] = *(const bf16x8*)(KENDT + ((((ch_ * 2 + blk) * 2 + ks) * 2 + hi) * 32 + r31) * 8); \
        _Pragma("unroll") for (int q = 0; q < 4; ++q) GG[q] = *(const u32x2*)(GGF + ((((ch_ * 4 + dvb) * 4 + q) * 2 + hi) * 32 + r31) * 4); } while (0)
#define BODY(KI, QD, VTX, KE, GG, KIN, QDN, VTN, KEN, GGN, n_) do { const int n = (n_); const size_t rb = row0 + 32 * (size_t)n; \
        if (n + 1 < nch) LOADQ(KIN, QDN, VTN, KEN, GGN, n + 1); \
        f32x16 X = {}; \
        _Pragma("unroll") for (int ks = 0; ks < 4; ++ks) X = __builtin_amdgcn_mfma_f32_32x32x16_bf16(KI[ks], QD[ks], X, 0, 0, 0); \
        _Pragma("unroll") for (int r = 0; r < 16; ++r) if (crow(r, hi) > r31) X[r] = 0.f; \
        bf16x8 xb0, xb1; PK4(X, 0, xb0); PK4(X, 8, xb1); \
        f32x16 o = {}; \
        o = __builtin_amdgcn_mfma_f32_32x32x16_bf16(VTX[0], xb0, o, 0, 0, 0); o = __builtin_amdgcn_mfma_f32_32x32x16_bf16(VTX[1], xb1, o, 0, 0, 0); \
        _Pragma("unroll") for (int blk = 0; blk < 2; ++blk) { bf16x8 sb0, sb1; PK4(S[blk], 0, sb0); PK4(S[blk], 8, sb1); \
            o = __builtin_amdgcn_mfma_f32_32x32x16_bf16(sb0, QD[2 * blk], o, 0, 0, 0); o = __builtin_amdgcn_mfma_f32_32x32x16_bf16(sb1, QD[2 * blk + 1], o, 0, 0, 0); } \
        _Pragma("unroll") for (int blk = 0; blk < 2; ++blk) { \
            _Pragma("unroll") for (int q = 0; q < 4; ++q) { const f32x4 e4 = *(const f32x4*)(ELT + n * 64 + 32 * blk + 8 * q + 4 * hi); \
                S[blk][4 * q] *= e4[0]; S[blk][4 * q + 1] *= e4[1]; S[blk][4 * q + 2] *= e4[2]; S[blk][4 * q + 3] *= e4[3]; } \
            S[blk] = __builtin_amdgcn_mfma_f32_32x32x16_bf16(KE[blk][0], VTX[0], S[blk], 0, 0, 0); S[blk] = __builtin_amdgcn_mfma_f32_32x32x16_bf16(KE[blk][1], VTX[1], S[blk], 0, 0, 0); } \
        float ss = 0.f; \
        _Pragma("unroll") for (int r = 0; r < 16; ++r) ss += o[r] * o[r]; \
        { auto rr = __builtin_amdgcn_permlane32_swap(__float_as_uint(ss), __float_as_uint(ss), false, false); ss = __uint_as_float(rr[0]) + __uint_as_float(rr[1]); } \
        float* ssl = SS + ((n & 1) * 2 + sub) * 128; \
        if (hi == 0) ssl[dvb * 32 + r31] = ss; \
        GBAR(); \
        const float tot = (ssl[r31] + ssl[32 + r31]) + (ssl[64 + r31] + ssl[96 + r31]); const float rn = __builtin_amdgcn_rsqf(tot * (1.0f / 128.0f) + EPSN); \
        if (r31 < tvalid) { bf16* ao = AO + (rb + r31) * 1024 + h * 128 + 32 * dvb + 4 * hi; \
            _Pragma("unroll") for (int q = 0; q < 4; ++q) { u32x2 w; \
                w.x = cvtpk(o[4 * q] * rn * gout[q][0] * silu_f(blo(GG[q].x)), o[4 * q + 1] * rn * gout[q][1] * silu_f(bhi(GG[q].x))); \
                w.y = cvtpk(o[4 * q + 2] * rn * gout[q][2] * silu_f(blo(GG[q].y)), o[4 * q + 3] * rn * gout[q][3] * silu_f(bhi(GG[q].y))); \
                *(u32x2*)(ao + 8 * q) = w; } } \
    } while (0)
    LOADQ(kiA, qdA, vtA, keA, ggA, 0);
#pragma unroll 1
    for (int n2 = 0; n2 < nch; n2 += 2) {
        BODY(kiA, qdA, vtA, keA, ggA, kiB, qdB, vtB, keB, ggB, n2);
        if (n2 + 1 < nch) BODY(kiB, qdB, vtB, keB, ggB, kiA, qdA, vtA, keA, ggA, n2 + 1);
    }
#undef LOADQ
#undef BODY
#undef PK4
    float* so = is_p ? a.out + O_GLAP + ((size_t)seq * 4 + h) * 8192 : a.out + O_GLAS + ((size_t)seq * 4 + h) * 8192;
#pragma unroll
    for (int blk = 0; blk < 2; ++blk)
#pragma unroll
        for (int r = 0; r < 16; ++r) so[(32 * blk + crow(r, hi)) * 128 + 32 * dvb + r31] = S[blk][r];
    GBAR();
}
#undef GBAR
}
namespace skinny {
typedef short bf16x8 __attribute__((ext_vector_type(8)));
typedef float f32x16 __attribute__((ext_vector_type(16)));
__device__ __forceinline__ int crow(int r, int hi) { return (r & 3) + 8 * (r >> 2) + 4 * hi; }
template <int K, class F>
__device__ __forceinline__ void run(char* lds, const bf16* A, const bf16* Bt, int N, int vcu, int G, int wave, int lane_in, const F& f) {
    int tid_o = wave * 64 + lane_id(); asm volatile("" : "+v"(tid_o)); const int tid = tid_o, lane = tid & 63, r31 = lane & 31, hi = lane >> 5; (void)lane_in;
    constexpr int KS = K / 8 / 16;
    float* red = (float*)lds;
    const int ntiles = 8 * (N / 32);
    for (int tile = vcu; tile < ntiles; tile += G) { const int rt = tile & 7, ct = tile >> 3;
        const bf16* ap = A + (size_t)(MP + 32 * rt + r31) * K + wave * (K / 8) + 8 * hi; const bf16* bp = Bt + (size_t)(32 * ct + r31) * K + wave * (K / 8) + 8 * hi;
        const int prow = MP + 32 * rt + (tid >> 4), pcol = 32 * ct + (tid & 15) * 2;
        const typename F::Pre pre = f.pre(prow, pcol);
        f32x16 acc = {};
#pragma unroll
        for (int ks = 0; ks < KS; ++ks) { const bf16x8 av = *(const bf16x8*)(ap + 16 * ks), bv = *(const bf16x8*)(bp + 16 * ks); acc = __builtin_amdgcn_mfma_f32_32x32x16_bf16(av, bv, acc, 0, 0, 0); }
#pragma unroll
        for (int r = 0; r < 16; ++r) red[(wave * 32 + crow(r, hi)) * 32 + r31] = acc[r];
        __syncthreads();
        { const int row = tid >> 4, col = (tid & 15) * 2; float v0 = 0.f, v1 = 0.f;
#pragma unroll
          for (int w = 0; w < 8; ++w) { const f32x2 p = *(const f32x2*)(red + (w * 32 + row) * 32 + col); v0 += p.x; v1 += p.y; }
          f(MP + 32 * rt + row, 32 * ct + col, v0, v1, pre); }
        __syncthreads();
    }
}
struct FScaleBf16 { bf16* O; int ldc; const float* rs; typedef float Pre;
    __device__ __forceinline__ Pre pre(int row, int) const { return rs ? rs[row] : 1.f; }
    __device__ __forceinline__ void operator()(int row, int col, float v0, float v1, Pre s) const { *(unsigned*)(O + (size_t)row * ldc + col) = pk2(v0 * s, v1 * s); } };
struct FU { bf16* O; const float* rs; float* rsqb;
    typedef float Pre;
    __device__ __forceinline__ Pre pre(int row, int) const { return rs[row]; }
    __device__ __forceinline__ void operator()(int row, int col, float v0, float v1, Pre s) const { v0 *= s; v1 *= s; *(unsigned*)(O + (size_t)row * 2048 + col) = pk2(v0, v1);
        if (col >= 1536 && col < 1952) { float ss = v0 * v0 + v1 * v1; ss += __shfl_xor(ss, 1); ss += __shfl_xor(ss, 2); ss += __shfl_xor(ss, 4); ss += __shfl_xor(ss, 8);
            const int seg = (col >= 1792) + (col >= 1920);
            if ((lane_id() & 15) == 0) atomicAdd(rsqb + seg * 16640 + row, ss); } } };
template <bool BF> struct FResid { const void* base; bf16* hb; float* rsq;
    typedef f32x2 Pre;
    __device__ __forceinline__ Pre pre(int row, int col) const { const size_t off = (size_t)row * 1024 + col;
        if (BF) { const unsigned bw = *(const unsigned*)((const bf16*)base + off); return (f32x2){blo(bw), bhi(bw)}; } else return *(const f32x2*)((const float*)base + off); }
    __device__ __forceinline__ void operator()(int row, int col, float v0, float v1, Pre b) const { const size_t off = (size_t)row * 1024 + col; const float o0 = b.x + v0, o1 = b.y + v1;
        *(unsigned*)(hb + off) = pk2(o0, o1);
        float ss = o0 * o0 + o1 * o1; ss += __shfl_xor(ss, 1); ss += __shfl_xor(ss, 2); ss += __shfl_xor(ss, 4); ss += __shfl_xor(ss, 8);
        if ((lane_id() & 15) == 0) atomicAdd(rsq + row, ss); } };
struct FPle { const bf16* h2; const bf16* PP; const float* rsq; float* out;
    struct Pre { unsigned hw, pw; float rq; };
    __device__ __forceinline__ Pre pre(int row, int col) const { const size_t off = (size_t)row * 1024 + col; Pre p; p.hw = *(const unsigned*)(h2 + off); p.pw = *(const unsigned*)(PP + off); p.rq = rsq[row]; return p; }
    __device__ __forceinline__ void operator()(int row, int col, float v0, float v1, const Pre& p) const { const size_t off = (size_t)row * 1024 + col; const float rs = __builtin_amdgcn_rsqf(p.rq * (1.0f / 1024.0f) + 1e-6f);
        const unsigned hw = p.hw; const f32x2 hv = {blo(hw), bhi(hw)}; const unsigned pw = p.pw;
        *(f32x2*)(out + off) = (f32x2){hv.x + blo(pw) / (1.0f + __expf(-v0 * rs)), hv.y + bhi(pw) / (1.0f + __expf(-v1 * rs))}; } };
}
#ifndef MK_PER_PHASE
#define MK_PER_PHASE 0
#endif
constexpr int N_PHASES = 10;
__global__ void __launch_bounds__(NWAVES * 64, 2) hymba_fwd(Args args) {
    extern __shared__ __attribute__((aligned(16))) unsigned char lds_raw[];
    LAS unsigned char* lds = (LAS unsigned char*)lds_raw;
    volatile LAS unsigned* MISC = (volatile LAS unsigned*)(lds + MISC_OFF);
    const int tid = threadIdx.x, lane = tid & 63, wave = __builtin_amdgcn_readfirstlane(tid >> 6);
    const int G = gridDim.x; const int bx = blockIdx.x; const int vcu = (G % 8 == 0) ? (bx % 8) * (G / 8) + bx / 8 : bx;
    const int gw = vcu * NWAVES + wave, NGW = G * NWAVES;
    unsigned char* ws = args.ws;
    gu32* ctl = (gu32*)(ws + WS_CTL);
    for (int u = tid; u < (LDS_BYTES - LDSCTL_OFF) / 4; u += NWAVES * 64) ((LAS unsigned*)(lds + LDSCTL_OFF))[u] = 0u;
    __syncthreads();
    XcdBarrier bar; bar.bar = (unsigned*)(ctl + CW_BAR); bar.x = 0; bar.st = nullptr;
    if (!MK_PER_PHASE) bar = xcd_barrier_post((unsigned*)(ctl + CW_BAR), MISC + 8);
    const int lo = args.ph_lo, hi = args.ph_hi;
#define IN(k) (lo <= (k) && (k) < hi)
#define SEAM(k) do { if (IN(k) && IN((k) + 1)) xcd_barrier(bar, wave); } while (0)
    float* rsq2 = (float*)(ctl + CW_RSQ2); float* rsq3 = (float*)(ctl + CW_RSQ3); float* rsqq = (float*)(ctl + CW_RSQQ); float* rsqkv = (float*)(ctl + CW_RSQKV); float* rsqkr = (float*)(ctl + CW_RSQKR);

    if (IN(0)) { prep_phase(args, lds, gw, NGW, wave, lane_id()); }
    SEAM(0);
    if (IN(1)) {
        { pg8::Gemm g{(const bf16*)(ws + WS_XB), (const bf16*)(ws + WS_WIN), MP, NU, DM}; pg8::StaticOrder S; S.init(MP, NU, G, bx);
          pg8::EpiU E{(bf16*)(ws + WS_U), (const float*)(ws + WS_RS1), rsqq, rsqkv, rsqkr};
          pg8::gemm_phase<pg8::EpiU, pg8::StaticOrder, true, true>(lds, g, S, E, wave); }
        skinny::run<1024>((char*)lds_raw, (const bf16*)(ws + WS_XB), (const bf16*)(ws + WS_WIN), NU, vcu, G, wave, 0, skinny::FU{(bf16*)(ws + WS_U), (const float*)(ws + WS_RS1), rsqq});
        skinny::run<256>((char*)lds_raw, (const bf16*)(ws + WS_PB), (const bf16*)(ws + WS_WPP), DM, vcu, G, wave, 0, skinny::FScaleBf16{(bf16*)(ws + WS_PP), DM, nullptr});
    }
    SEAM(1);
    if (IN(2)) {
        if (bx < 110) { pg8::Gemm g{(const bf16*)(ws + WS_U) + U_MQ, (const bf16*)(ws + WS_WQUP), MT, 768, 256, NU}; pg8::StaticOrder S; S.init(MT, 768, 110, bx);
          pg8::EpiQ E{rsqq, (const float*)(ws + WS_ROPE), (const float*)args.in[16], (const float*)args.in[17], (bf16*)(ws + WS_QM)};
          pg8::gemm_phase<pg8::EpiQ, pg8::StaticOrder, true, true>(lds, g, S, E, wave); }
        else { pg8::Gemm g{(const bf16*)(ws + WS_U) + U_MKV, (const bf16*)(ws + WS_WKVP), MT, 1024, 128, NU}; pg8::StaticOrder S; S.init(MT, 1024, G - 110, bx - 110);
          pg8::EpiKV E{rsqkv, (const float*)args.in[21], (bf16*)(ws + WS_KM), (bf16*)(ws + WS_VM)};
          pg8::gemm_phase<pg8::EpiKV, pg8::StaticOrder, true, true>(lds, g, S, E, wave); }
        post_tokens(args, gw, NGW, 0);
        { volatile LAS unsigned* qs2 = MISC + 20;
          for (;;) {
              __syncthreads();
              if (wave == 0 && lane_id() == 0) qs2[0] = __hip_atomic_fetch_add((unsigned*)(ctl + CW_Q + 128), 1u, __ATOMIC_RELAXED, __HIP_MEMORY_SCOPE_AGENT);
              __syncthreads();
              const int tl = __builtin_amdgcn_readfirstlane((int)qs2[0]);
              if (tl >= MT / 64) break;
              if (tl < MP / 64) gla::prep_tile_p(args, (char*)lds_raw, lds, tl, wave); else gla::prep_tile(args, (char*)lds_raw, tl, wave);
          } }
    }
    SEAM(2);
    if (IN(3)) {
        volatile LAS unsigned* qs = MISC + 16;
        bool first = true;
        for (;;) {
            __syncthreads();
            if (!first && wave == 0 && lane_id() == 0) qs[0] = (unsigned)G + __hip_atomic_fetch_add((unsigned*)(ctl + CW_Q), 1u, __ATOMIC_RELAXED, __HIP_MEMORY_SCOPE_AGENT);
            __syncthreads();
            const int it = first ? bx : __builtin_amdgcn_readfirstlane((int)qs[0]);
            first = false;
            constexpr int TF0 = 768, TFW = TF0 + PREP_LATE_TICKETS, TF1 = TFW + PREP_P_TICKETS, TA2 = TF1 + 64, TEND = TA2 + 128;
            if (it >= TEND) break;
            if (it < 32) gla::scan_unit(args, (char*)lds_raw, it, wave, 0);
            else if (it < 432 && !(it >= 144 && it < 256)) { const bool whole = it < 368; const int d = it < 144 ? it - 32 : it - 144, j = it - 368;
                dec::item(args, (char*)lds_raw, lds, whole ? d >> 3 : 28 + (j >> 4), whole ? d & 7 : (j >> 1) & 7, whole ? -1 : (j & 1), wave, 0); }
            else if (it < TF0 || (it >= TF1 && it < TA2)) pattn::one((char*)lds_raw, (const bf16*)(ws + WS_QM), (const bf16*)(ws + WS_KM), (const bf16*)(ws + WS_VM), (bf16*)(ws + WS_AO), it < 256 ? it - 144 : (it < TF0 ? it - 320 : it - TF1 + 448), wave);
            else if (it < TFW) prep_late(args, lds, it - TF0, wave, lane_id());
            else if (it < TF1) prep_late_p(args, it - TFW, wave, lane_id());
            else gla::scan_unit(args, (char*)lds_raw, it - TA2 + 32, wave, 0);
        }
    }
    SEAM(3);
    if (IN(5)) {
        pg8::Gemm g{(const bf16*)(ws + WS_AO), (const bf16*)(ws + WS_WO), MP, DM, DM}; pg8::StaticOrder S; S.init(MP, DM, G, bx);
        pg8::EpiResid<false> E{args.in[0], (bf16*)(ws + WS_HB), rsq2};
        pg8::gemm_phase<pg8::EpiResid<false>, pg8::StaticOrder, true, true>(lds, g, S, E, wave);
        skinny::run<1024>((char*)lds_raw, (const bf16*)(ws + WS_AO), (const bf16*)(ws + WS_WO), DM, vcu, G, wave, 0, skinny::FResid<false>{(const float*)args.in[1] - (size_t)MP * DM, (bf16*)(ws + WS_HB), rsq2});
    }
    SEAM(5);
    if (IN(6)) {
        pg8::Gemm g{(const bf16*)(ws + WS_HB), (const bf16*)(ws + WS_WGU), MT, 2 * FF, DM, 0, 254, -2}; pg8::StaticOrder S; S.init_tiles(66, 22, G, bx);
        pg8::EpiConv E{rsq2, (PG8_LAS float*)(lds + 131072), (const float*)args.in[26], (const float*)args.in[27], (const float*)args.in[5], (bf16*)(ws + WS_G), args.out + O_CONVP, args.out + O_CONVS};
        pg8::gemm_phase<pg8::EpiConv, pg8::StaticOrder, true, true>(lds, g, S, E, wave);
        if (bx >= 1452 - 5 * G && G == 256) {
            pg8::Gemm g2{(const bf16*)(ws + WS_PB), (const bf16*)(ws + WS_WPP), MP, DM, 256}; pg8::StaticOrder S2; S2.init(MP, DM, G - (1452 - 5 * G), bx - (1452 - 5 * G));
            pg8::EpiScaleBf16 E2{(bf16*)(ws + WS_PP), DM, nullptr};
            pg8::gemm_phase<pg8::EpiScaleBf16, pg8::StaticOrder, true, true>(lds, g2, S2, E2, wave); }
        else if (G != 256) { pg8::Gemm g2{(const bf16*)(ws + WS_PB), (const bf16*)(ws + WS_WPP), MP, DM, 256}; pg8::StaticOrder S2; S2.init(MP, DM, G, bx);
            pg8::EpiScaleBf16 E2{(bf16*)(ws + WS_PP), DM, nullptr};
            pg8::gemm_phase<pg8::EpiScaleBf16, pg8::StaticOrder, true, true>(lds, g2, S2, E2, wave); }
    }
    SEAM(6);
    if (IN(8)) {
        pg8::Gemm g{(const bf16*)(ws + WS_G), (const bf16*)(ws + WS_WD), MP, DM, FF}; pg8::StaticOrder S; S.init(MP, DM, G, bx);
        pg8::EpiResid<true> E{(const void*)(ws + WS_HB), (bf16*)(ws + WS_H2B), rsq3};
        pg8::gemm_phase<pg8::EpiResid<true>, pg8::StaticOrder, true, true>(lds, g, S, E, wave);
        skinny::run<2816>((char*)lds_raw, (const bf16*)(ws + WS_G), (const bf16*)(ws + WS_WD), DM, vcu, G, wave, 0, skinny::FResid<true>{(const void*)(ws + WS_HB), (bf16*)(ws + WS_H2B), rsq3});
    }
    SEAM(8);
    if (IN(9)) {
        pg8::Gemm g{(const bf16*)(ws + WS_H2B), (const bf16*)(ws + WS_WPG), MP, DM, DM}; pg8::StaticOrder S; S.init(MP, DM, G, bx);
        pg8::EpiPle E{(const bf16*)(ws + WS_H2B), (const bf16*)(ws + WS_PP), rsq3, args.out + O_YP};
        pg8::gemm_phase<pg8::EpiPle, pg8::StaticOrder, true, true>(lds, g, S, E, wave);
        skinny::run<1024>((char*)lds_raw, (const bf16*)(ws + WS_H2B), (const bf16*)(ws + WS_WPG), DM, vcu, G, wave, 0, skinny::FPle{(const bf16*)(ws + WS_H2B), (const bf16*)(ws + WS_PP), rsq3, args.out + O_YP});
    }
#undef IN
#undef SEAM
}

extern "C" void kernel_launch(void* const* d_in, const int* in_sizes, int n_in, void* d_out, int out_size, void* d_ws, size_t ws_size, hipStream_t stream) {
    static int grid = 0;
    if (grid == 0) {
        if (n_in != 32 || out_size != (int)O_END || ws_size < WS_END) { fprintf(stderr, "kernel_launch: unexpected shapes: n_in %d out %d ws %zu; nothing launched\n", n_in, out_size, ws_size); grid = -1; return; }
        int dev = 0, cus = 0, per_cu = 0;
        if (hipGetDevice(&dev) != hipSuccess || hipDeviceGetAttribute(&cus, hipDeviceAttributeMultiprocessorCount, dev) != hipSuccess) { fprintf(stderr, "kernel_launch: device query failed\n"); grid = -1; return; }
        if (hipFuncSetAttribute((const void*)hymba_fwd, hipFuncAttributeMaxDynamicSharedMemorySize, LDS_BYTES) != hipSuccess) { fprintf(stderr, "kernel_launch: hipFuncSetAttribute failed\n"); grid = -1; return; }
        if (hipOccupancyMaxActiveBlocksPerMultiprocessor(&per_cu, (const void*)hymba_fwd, NWAVES * 64, LDS_BYTES) != hipSuccess || per_cu < 1)
            fprintf(stderr, "kernel_launch: note: occupancy query reports %d workgroups per CU\n", per_cu);
        (void)hipGetLastError();
        grid = cus;
        if (grid != 256) fprintf(stderr, "kernel_launch: note: %d CUs (built for 256)\n", grid);
    }
    if (grid < 0) return;
    (void)hipMemsetAsync((char*)d_ws + WS_CTL, 0, CTL_ZERO_BYTES, stream);
    Args a{};
    for (int i = 0; i < 32; ++i) a.in[i] = d_in[i];
    a.out = (float*)d_out; a.ws = (unsigned char*)d_ws;
#if MK_PER_PHASE
    for (int p = 0; p < N_PHASES; ++p) { a.ph_lo = p; a.ph_hi = p + 1; hipLaunchKernelGGL(hymba_fwd, dim3(grid), dim3(NWAVES * 64), LDS_BYTES, stream, a); }
#else
    a.ph_lo = 0; a.ph_hi = N_PHASES;
    hipLaunchKernelGGL(hymba_fwd, dim3(grid), dim3(NWAVES * 64), LDS_BYTES, stream, a);
#endif
    const hipError_t le = hipPeekAtLastError();
    if (le != hipSuccess) fprintf(stderr, "kernel_launch: launch failed: %s\n", hipGetErrorName(le));
}
```

```cpp
#include <hip/hip_runtime.h>
#include <cstdio>
#include <cstdint>
__device__ __forceinline__ int lane_id() { int l; asm volatile("v_mbcnt_lo_u32_b32 %0, -1, 0\n\tv_mbcnt_hi_u32_b32 %0, -1, %0" : "=v"(l)); return l; }
namespace pg8 {
#define PG8_LAS __attribute__((address_space(3)))
typedef unsigned short bf16_t;
typedef short bf16x8 __attribute__((ext_vector_type(8)));
typedef float f32x4 __attribute__((ext_vector_type(4)));
typedef unsigned u32x4 __attribute__((ext_vector_type(4)));
constexpr int BM = 256, BK = 64, HALF = 128, HTB = HALF * BK * 2  , STAGE_BYTES = 8 * HTB, NXCD = 8, WGM = 8;

__host__ __device__ __forceinline__ int lds_byte(int r, int c) { const int st = (r >> 4) * 2 + (c >> 5), rr = r & 15, cc = c & 31, ob = rr * 64 + cc * 2; return st * 1024 + (ob ^ (((ob >> 9) & 1) << 5)); }
__host__ __device__ __forceinline__ void stage_rc(int b, int& R, int& C) { const int st = b / 1024, sb = b % 1024, swz = sb ^ (((sb >> 9) & 1) << 5); R = (st >> 1) * 16 + swz / 64; C = (st & 1) * 32 + (swz % 64) / 2; }
__host__ __device__ __forceinline__ int perm32(int rho) { const int n = rho >> 4, i = rho & 15; return 8 * (i >> 2) + 4 * n + (i & 3); }

struct Unit { int pm, pn; };
struct Gemm { const bf16_t* A; const bf16_t* Bt; int M, N, K; int lda = 0, tile_rows = 0, row_off = 0; };

struct StaticOrder {
    int nM, nN, nwg, G, c;
    __host__ __device__ void init(int M, int N, int G_, int c_) { nM = M / BM; nN = N / BM; nwg = nM * nN; G = G_; c = c_; }
    __host__ __device__ void init_tiles(int nM_, int nN_, int G_, int c_) { nM = nM_; nN = nN_; nwg = nM * nN; G = G_; c = c_; }
    __host__ __device__ bool next(int i, Unit& u) const {
        const long L = (long)i * G + c; if (L >= nwg) return false;
        int wgid = (int)L; { const int q = nwg / NXCD, r = nwg % NXCD, xcd = wgid % NXCD, off = wgid / NXCD; wgid = (xcd < r ? xcd * (q + 1) : r * (q + 1) + (xcd - r) * q) + off; }
        const int nig = WGM * nN, gid = wgid / nig, fm = gid * WGM, gsz = (nM - fm) < WGM ? (nM - fm) : WGM;
        u.pm = fm + ((wgid % nig) % gsz); u.pn = (wgid % nig) / gsz; return true;
    }
    __device__ __forceinline__ void a_ready(const Unit&) const {}
    __device__ __forceinline__ void done(const Unit&) const {}
};

__device__ __forceinline__ unsigned cvt_pk_bf16(float lo, float hi) { unsigned r; asm volatile("v_cvt_pk_bf16_f32 %0, %1, %2" : "=v"(r) : "v"(lo), "v"(hi)); return r; }
typedef float f32x2 __attribute__((ext_vector_type(2)));
__device__ __forceinline__ unsigned short f2bf_rne(float f) { unsigned u = __builtin_bit_cast(unsigned, f); return (unsigned short)((u + 0x7fffu + ((u >> 16) & 1u)) >> 16); }
__device__ __forceinline__ float bf2f_(unsigned short b) { return __builtin_bit_cast(float, (unsigned)b << 16); }
struct EpiScaleBf16 {
    static constexpr bool PERM = true, AFTER_DRAIN = false;
    bf16_t* O; int ldc; const float* rs;
    __device__ __forceinline__ void operator()(const f32x4 (&acc)[2][2][4][2], const Unit& u, int wr, int wc, int fr, int fq) const {
        asm volatile("" : "+v"(fr), "+v"(fq));
        const int row0 = u.pm * BM + wr * 64 + fr, col0 = u.pn * BM + wc * 32 + 8 * fq;
#pragma unroll
        for (int ai = 0; ai < 2; ++ai)
#pragma unroll
            for (int m = 0; m < 4; ++m) { const int row = row0 + ai * HALF + m * 16; const float s = rs ? rs[row] : 1.f; bf16_t* rowp = O + (size_t)row * ldc + col0;
#pragma unroll
                for (int bj = 0; bj < 2; ++bj) { const f32x4 v0 = acc[ai][bj][m][0] * s, v1 = acc[ai][bj][m][1] * s;
                    u32x4 w; w.x = cvt_pk_bf16(v0[0], v0[1]); w.y = cvt_pk_bf16(v0[2], v0[3]); w.z = cvt_pk_bf16(v1[0], v1[1]); w.w = cvt_pk_bf16(v1[2], v1[3]);
                    *(u32x4*)(rowp + bj * HALF) = w; } }
    }
};
template <bool BF> struct EpiResid {
    static constexpr bool PERM = false, AFTER_DRAIN = false;
    const void* base; bf16_t* hb; float* rsq;
    __device__ __forceinline__ void operator()(const f32x4 (&acc)[2][2][4][2], const Unit& u, int wr, int wc, int fr, int fq) const {
        asm volatile("" : "+v"(fr), "+v"(fq));
        typedef unsigned u32x2v __attribute__((ext_vector_type(2)));
        const int col0 = u.pn * BM + wc * 32 + 4 * fq;
#pragma unroll
        for (int ai = 0; ai < 2; ++ai) { asm volatile("" ::: "memory");
#pragma unroll
            for (int m = 0; m < 4; ++m) { const int r = u.pm * BM + ai * HALF + wr * 64 + m * 16 + fr;
                float ss = 0.f;
#pragma unroll
                for (int bj = 0; bj < 2; ++bj)
#pragma unroll
                    for (int n = 0; n < 2; ++n) { const size_t off = (size_t)r * 1024 + col0 + bj * HALF + n * 16; f32x4 v;
                        if (BF) { const u32x2v bw = *(const u32x2v*)((const bf16_t*)base + off);
                            v = (f32x4){__builtin_bit_cast(float, bw.x << 16), __builtin_bit_cast(float, bw.x & 0xffff0000u), __builtin_bit_cast(float, bw.y << 16), __builtin_bit_cast(float, bw.y & 0xffff0000u)} + acc[ai][bj][m][n]; }
                        else v = *(const f32x4*)((const float*)base + off) + acc[ai][bj][m][n];
                        u32x2v w; w.x = cvt_pk_bf16(v[0], v[1]); w.y = cvt_pk_bf16(v[2], v[3]); *(u32x2v*)(hb + off) = w;
                        ss += (v[0] * v[0] + v[1] * v[1]) + (v[2] * v[2] + v[3] * v[3]); }
                ss += __shfl_xor(ss, 16); ss += __shfl_xor(ss, 32);
                if (fq == 0) atomicAdd(rsq + r, ss); } }
    }
};
struct EpiGateUp {
    static constexpr bool PERM = true, AFTER_DRAIN = false;
    const float* rsq; bf16_t* A; bf16_t* C; float* conv_p; float* conv_s;
    __device__ __forceinline__ void operator()(const f32x4 (&acc)[2][2][4][2], const Unit& u, int wr, int wc, int fr, int fq) const {
        asm volatile("" : "+v"(fr), "+v"(fq));
        const int f0 = u.pn * HALF + wc * 32 + 8 * fq;
#pragma unroll
        for (int ai = 0; ai < 2; ++ai)
#pragma unroll
            for (int m = 0; m < 4; ++m) { const int r = u.pm * BM + ai * HALF + wr * 64 + m * 16 + fr;
                const float rs = __builtin_amdgcn_rsqf(rsq[r] * (1.0f / 1024.0f) + 1e-6f);
                const f32x4 a0 = acc[ai][0][m][0] * rs, a1 = acc[ai][0][m][1] * rs, c0 = acc[ai][1][m][0] * rs, c1 = acc[ai][1][m][1] * rs;
                u32x4 w; w.x = cvt_pk_bf16(a0[0], a0[1]); w.y = cvt_pk_bf16(a0[2], a0[3]); w.z = cvt_pk_bf16(a1[0], a1[1]); w.w = cvt_pk_bf16(a1[2], a1[3]);
                *(u32x4*)(A + (size_t)r * 2816 + f0) = w;
                w.x = cvt_pk_bf16(c0[0], c0[1]); w.y = cvt_pk_bf16(c0[2], c0[3]); w.z = cvt_pk_bf16(c1[0], c1[1]); w.w = cvt_pk_bf16(c1[2], c1[3]);
                *(u32x4*)(C + (size_t)r * 2816 + f0) = w;
                float* dst = nullptr;
                if (r < 16384) { const int t = r & 2047; if (t >= 2046) dst = conv_p + ((size_t)(r >> 11) * 2 + (t - 2046)) * 2816 + f0; }
                else { const int rr = r - 16384, t = rr & 7; if (t >= 6) dst = conv_s + ((size_t)(rr >> 3) * 2 + (t - 6)) * 2816 + f0; }
                if (dst) { *(f32x4*)dst = a0; *(f32x4*)(dst + 4) = a1; } }
    }
};
struct EpiPle {
    static constexpr bool PERM = false, AFTER_DRAIN = false;
    const bf16_t* h2; const bf16_t* PP; const float* rsq; float* out;
    __device__ __forceinline__ void operator()(const f32x4 (&acc)[2][2][4][2], const Unit& u, int wr, int wc, int fr, int fq) const {
        asm volatile("" : "+v"(fr), "+v"(fq));
        typedef unsigned u32x2v __attribute__((ext_vector_type(2)));
        const int col0 = u.pn * BM + wc * 32 + 4 * fq;
#pragma unroll
        for (int ai = 0; ai < 2; ++ai) { asm volatile("" ::: "memory");
#pragma unroll
            for (int m = 0; m < 4; ++m) { const int r = u.pm * BM + ai * HALF + wr * 64 + m * 16 + fr;
                const float rs = __builtin_amdgcn_rsqf(rsq[r] * (1.0f / 1024.0f) + 1e-6f);
#pragma unroll
                for (int bj = 0; bj < 2; ++bj)
#pragma unroll
                    for (int n = 0; n < 2; ++n) { const size_t off = (size_t)r * 1024 + col0 + bj * HALF + n * 16; const u32x2v hw = *(const u32x2v*)(h2 + off); const f32x4 hv = {__builtin_bit_cast(float, hw.x << 16), __builtin_bit_cast(float, hw.x & 0xffff0000u), __builtin_bit_cast(float, hw.y << 16), __builtin_bit_cast(float, hw.y & 0xffff0000u)};
                        const u32x2v pw = *(const u32x2v*)(PP + off); const f32x4 z = acc[ai][bj][m][n] * rs; f32x4 o;
                        o[0] = hv[0] + __builtin_bit_cast(float, pw.x << 16) * __builtin_amdgcn_rcpf(1.0f + __builtin_amdgcn_exp2f(-1.4426950408889634f * z[0]));
                        o[1] = hv[1] + __builtin_bit_cast(float, pw.x & 0xffff0000u) * __builtin_amdgcn_rcpf(1.0f + __builtin_amdgcn_exp2f(-1.4426950408889634f * z[1]));
                        o[2] = hv[2] + __builtin_bit_cast(float, pw.y << 16) * __builtin_amdgcn_rcpf(1.0f + __builtin_amdgcn_exp2f(-1.4426950408889634f * z[2]));
                        o[3] = hv[3] + __builtin_bit_cast(float, pw.y & 0xffff0000u) * __builtin_amdgcn_rcpf(1.0f + __builtin_amdgcn_exp2f(-1.4426950408889634f * z[3]));
                        *(f32x4*)(out + off) = o; } } }
    }
};
struct EpiU {
    static constexpr bool PERM = true, AFTER_DRAIN = false;
    bf16_t* O; const float* rs; float* rsqq; float* rsqkv; float* rsqkr;
    __device__ __forceinline__ void operator()(const f32x4 (&acc)[2][2][4][2], const Unit& u, int wr, int wc, int fr, int fq) const {
        asm volatile("" : "+v"(fr), "+v"(fq));
        const int row0 = u.pm * BM + wr * 64 + fr, col0 = u.pn * BM + wc * 32 + 8 * fq;
#pragma unroll
        for (int ai = 0; ai < 2; ++ai)
#pragma unroll
            for (int m = 0; m < 4; ++m) { const int row = row0 + ai * HALF + m * 16; const float s = rs[row]; bf16_t* rowp = O + (size_t)row * 2048 + col0; float sq[2];
#pragma unroll
                for (int bj = 0; bj < 2; ++bj) { const f32x4 v0 = acc[ai][bj][m][0] * s, v1 = acc[ai][bj][m][1] * s;
                    u32x4 w; w.x = cvt_pk_bf16(v0[0], v0[1]); w.y = cvt_pk_bf16(v0[2], v0[3]); w.z = cvt_pk_bf16(v1[0], v1[1]); w.w = cvt_pk_bf16(v1[2], v1[3]);
                    *(u32x4*)(rowp + bj * HALF) = w;
                    sq[bj] = ((v0[0] * v0[0] + v0[1] * v0[1]) + (v0[2] * v0[2] + v0[3] * v0[3])) + ((v1[0] * v1[0] + v1[1] * v1[1]) + (v1[2] * v1[2] + v1[3] * v1[3])); }
                if (u.pn >= 6) { float a0 = (u.pn == 6) ? sq[0] + sq[1] : sq[0], a1 = sq[1];
                    a0 += __shfl_xor(a0, 16); a0 += __shfl_xor(a0, 32); a1 += __shfl_xor(a1, 16); a1 += __shfl_xor(a1, 32);
                    if (fq == 0) { if (u.pn == 6) atomicAdd(rsqq + row, a0); else { atomicAdd(rsqkv + row, a0); if (wc == 0) atomicAdd(rsqkr + row, a1); } } }
                asm volatile("" ::: "memory"); }
    }
};
struct EpiQ {
    static constexpr bool PERM = true, AFTER_DRAIN = false;
    const float* rsqq; const float* rope; const float* g_qn; const float* g_qr; bf16_t* QM;
    __device__ __forceinline__ void operator()(const f32x4 (&acc)[2][2][4][2], const Unit& u, int wr, int wc, int fr, int fq) const {
        asm volatile("" : "+v"(fr), "+v"(fq));
        constexpr float QS = 0.10206207261596575f * 1.4426950408889634f;
        float rsq8[8];
#pragma unroll
        for (int i = 0; i < 8; ++i) rsq8[i] = rsqq[u.pm * BM + (i >> 2) * HALF + wr * 64 + (i & 3) * 16 + fr];
#pragma unroll
        for (int ai = 0; ai < 2; ++ai)
#pragma unroll
            for (int m = 0; m < 4; ++m) { const int r = u.pm * BM + ai * HALF + wr * 64 + m * 16 + fr; const float rs = __builtin_amdgcn_rsqf(rsq8[ai * 4 + m] * (1.0f / 256.0f) + 1e-6f);
                if (u.pn < 2) { const int h = 4 * u.pn + wc; float ss = 0.f;
#pragma unroll
                    for (int bj = 0; bj < 2; ++bj)
#pragma unroll
                        for (int n = 0; n < 2; ++n) { const f32x4 v = acc[ai][bj][m][n] * rs; ss += (v[0] * v[0] + v[1] * v[1]) + (v[2] * v[2] + v[3] * v[3]); }
                    ss += __shfl_xor(ss, 16); ss += __shfl_xor(ss, 32);
                    const float rn = rs * QS * __builtin_amdgcn_rsqf(ss * (1.0f / 64.0f) + 1e-6f);
#pragma unroll
                    for (int bj = 0; bj < 2; ++bj) { const int d0 = 32 * bj + 8 * fq; const f32x4 g0 = *(const f32x4*)(g_qn + d0), g1 = *(const f32x4*)(g_qn + d0 + 4);
                        const f32x4 v0 = acc[ai][bj][m][0] * rn * g0, v1 = acc[ai][bj][m][1] * rn * g1;
                        u32x4 w; w.x = cvt_pk_bf16(v0[0], v0[1]); w.y = cvt_pk_bf16(v0[2], v0[3]); w.z = cvt_pk_bf16(v1[0], v1[1]); w.w = cvt_pk_bf16(v1[2], v1[3]);
                        *(u32x4*)(QM + ((size_t)r * 8 + h) * 96 + d0) = w; } }
                else { const int pidx = (r < 16384) ? (r & 2047) : 2048 + ((r - 16384) & 7);
                    const f32x4* rp = (const f32x4*)(rope + (pidx * 16 + 8 * (fq & 1)) * 2);
                    const f32x4 rc0 = rp[0], rc1 = rp[1], rc2 = rp[2], rc3 = rp[3];
#pragma unroll
                    for (int bj = 0; bj < 2; ++bj) { const int h = 4 * bj + wc, i0 = 8 * fq; float ss = 0.f;
#pragma unroll
                        for (int n = 0; n < 2; ++n) { const f32x4 v = acc[ai][bj][m][n] * rs; ss += (v[0] * v[0] + v[1] * v[1]) + (v[2] * v[2] + v[3] * v[3]); }
                        ss += __shfl_xor(ss, 16); ss += __shfl_xor(ss, 32);
                        const float rr = rs * QS * __builtin_amdgcn_rsqf(ss * (1.0f / 32.0f) + 1e-6f);
                        const f32x4 g0 = *(const f32x4*)(g_qr + i0), g1 = *(const f32x4*)(g_qr + i0 + 4);
                        unsigned wq[4];
#pragma unroll
                        for (int n = 0; n < 2; ++n) { const f32x4 gq = n ? g1 : g0; float o[4];
#pragma unroll
                            for (int j = 0; j < 4; ++j) { const float x = acc[ai][bj][m][n][j] * rr * gq[j]; const float y = __shfl_xor(x, 32);
                                const f32x4 rcv = (4 * n + j) < 2 ? rc0 : ((4 * n + j) < 4 ? rc1 : ((4 * n + j) < 6 ? rc2 : rc3)); const float cs_c = rcv[2 * (j & 1)], cs_s = rcv[2 * (j & 1) + 1];
                                o[j] = (fq < 2) ? (x * cs_c - y * cs_s) : (x * cs_c + y * cs_s); }
                            wq[2 * n] = cvt_pk_bf16(o[0], o[1]); wq[2 * n + 1] = cvt_pk_bf16(o[2], o[3]); }
                        u32x4 w; w.x = wq[0]; w.y = wq[1]; w.z = wq[2]; w.w = wq[3];
                        *(u32x4*)(QM + ((size_t)r * 8 + h) * 96 + 64 + i0) = w; } }
                asm volatile("" ::: "memory"); }
    }
};
struct EpiKV {
    static constexpr bool PERM = true, AFTER_DRAIN = false;
    const float* rsqkv; const float* g_kn; bf16_t* KM; bf16_t* VM;
    __device__ __forceinline__ void operator()(const f32x4 (&acc)[2][2][4][2], const Unit& u, int wr, int wc, int fr, int fq) const {
        asm volatile("" : "+v"(fr), "+v"(fq));
        float rsq8[8];
#pragma unroll
        for (int i = 0; i < 8; ++i) rsq8[i] = rsqkv[u.pm * BM + (i >> 2) * HALF + wr * 64 + (i & 3) * 16 + fr];
#pragma unroll
        for (int ai = 0; ai < 2; ++ai)
#pragma unroll
            for (int m = 0; m < 4; ++m) { const int r = u.pm * BM + ai * HALF + wr * 64 + m * 16 + fr; const float rs = __builtin_amdgcn_rsqf(rsq8[ai * 4 + m] * (1.0f / 128.0f) + 1e-6f);
                if (u.pn < 2) { const int h = 4 * u.pn + wc; float ss = 0.f;
#pragma unroll
                    for (int bj = 0; bj < 2; ++bj)
#pragma unroll
                        for (int n = 0; n < 2; ++n) { const f32x4 v = acc[ai][bj][m][n] * rs; ss += (v[0] * v[0] + v[1] * v[1]) + (v[2] * v[2] + v[3] * v[3]); }
                    ss += __shfl_xor(ss, 16); ss += __shfl_xor(ss, 32);
                    const float rk = rs * __builtin_amdgcn_rsqf(ss * (1.0f / 64.0f) + 1e-6f);
#pragma unroll
                    for (int bj = 0; bj < 2; ++bj) { const int d0 = 32 * bj + 8 * fq; const f32x4 g0 = *(const f32x4*)(g_kn + d0), g1 = *(const f32x4*)(g_kn + d0 + 4);
                        const f32x4 v0 = acc[ai][bj][m][0] * rk * g0, v1 = acc[ai][bj][m][1] * rk * g1;
                        u32x4 w; w.x = cvt_pk_bf16(v0[0], v0[1]); w.y = cvt_pk_bf16(v0[2], v0[3]); w.z = cvt_pk_bf16(v1[0], v1[1]); w.w = cvt_pk_bf16(v1[2], v1[3]);
                        *(u32x4*)(KM + ((size_t)r * 8 + h) * 96 + d0) = w; } }
                else { const int h = 4 * (u.pn - 2) + wc;
#pragma unroll
                    for (int bj = 0; bj < 2; ++bj) { const int d0 = 32 * bj + 8 * fq; const f32x4 v0 = acc[ai][bj][m][0] * rs, v1 = acc[ai][bj][m][1] * rs;
                        u32x4 w; w.x = cvt_pk_bf16(v0[0], v0[1]); w.y = cvt_pk_bf16(v0[2], v0[3]); w.z = cvt_pk_bf16(v1[0], v1[1]); w.w = cvt_pk_bf16(v1[2], v1[3]);
                        *(u32x4*)(VM + ((size_t)r * 8 + h) * 64 + d0) = w; } }
                asm volatile("" ::: "memory"); }
    }
};
__device__ __forceinline__ float dpp_f(float oldv, float src, const int ctrl_sel) {
    const int o = __builtin_bit_cast(int, oldv), s = __builtin_bit_cast(int, src); int r;
    if (ctrl_sel == 0) r = __builtin_amdgcn_update_dpp(o, s, 0x111, 0xf, 0xf, false); else if (ctrl_sel == 1) r = __builtin_amdgcn_update_dpp(o, s, 0x112, 0xf, 0xf, false);
    else if (ctrl_sel == 2) r = __builtin_amdgcn_update_dpp(o, s, 0x121, 0xf, 0xf, false); else r = __builtin_amdgcn_update_dpp(o, s, 0x122, 0xf, 0xf, false);
    return __builtin_bit_cast(float, r);
}
struct EpiConv {
    static constexpr bool PERM = true, AFTER_DRAIN = false;
    const float* rsq; PG8_LAS float* ex; const float* cw; const float* cb; const float* sc; bf16_t* G; float* conv_p; float* conv_s;
    __device__ __forceinline__ void operator()(const f32x4 (&acc)[2][2][4][2], const Unit& u, int wr, int wc, int fr, int fq) const {
        asm volatile("" : "+v"(fr), "+v"(fq));
        constexpr int MTr = 16640, MPr = 16384;
        const int f0 = u.pn * HALF + wc * 32 + 8 * fq; const int Rbase = u.pm * 254 - 2;
        float rq8[8];
#pragma unroll
        for (int i = 0; i < 8; ++i) { const int R = Rbase + (i >> 2) * HALF + wr * 64 + (i & 3) * 16 + fr; rq8[i] = rsq[R < 0 ? 0 : (R >= MTr ? MTr - 1 : R)]; }
#pragma unroll
        for (int ai = 0; ai < 2; ++ai) { const int R3 = Rbase + ai * HALF + wr * 64 + 48 + fr; const int Rc = R3 < 0 ? 0 : (R3 >= MTr ? MTr - 1 : R3);
            const float rs = __builtin_amdgcn_rsqf(rq8[ai * 4 + 3] * (1.0f / 1024.0f) + 1e-6f); (void)Rc;
            if (fr >= 14) { PG8_LAS float* p = ex + (((((2 * ai + wr) * 4 + wc) * 2 + (fr - 14)) * 4 + fq) * 8);
                *(PG8_LAS f32x4*)p = acc[ai][0][3][0] * rs; *(PG8_LAS f32x4*)(p + 4) = acc[ai][0][3][1] * rs; } }
        asm volatile("s_waitcnt lgkmcnt(0)\n\ts_barrier" ::: "memory");
        const f32x4 w0a = *(const f32x4*)(cw + f0), w0b = *(const f32x4*)(cw + f0 + 4), w1a = *(const f32x4*)(cw + 2816 + f0), w1b = *(const f32x4*)(cw + 2816 + f0 + 4);
        const f32x4 w2a = *(const f32x4*)(cw + 5632 + f0), w2b = *(const f32x4*)(cw + 5632 + f0 + 4), cba = *(const f32x4*)(cb + f0), cbb = *(const f32x4*)(cb + f0 + 4);
#pragma unroll
        for (int ai = 0; ai < 2; ++ai) {
            float pg[8];
            { const int s = 2 * ai + wr;
              if (s == 0) {
#pragma unroll
                  for (int e = 0; e < 8; ++e) pg[e] = 0.f;
              } else { const PG8_LAS float* p = ex + ((((((s - 1) * 4 + wc) * 2 + (fr & 1)) * 4 + fq) * 8)); const f32x4 a0 = *(const PG8_LAS f32x4*)p, a1 = *(const PG8_LAS f32x4*)(p + 4);
                  pg[0] = a0[0]; pg[1] = a0[1]; pg[2] = a0[2]; pg[3] = a0[3]; pg[4] = a1[0]; pg[5] = a1[1]; pg[6] = a1[2]; pg[7] = a1[3]; } }
#pragma unroll
            for (int m = 0; m < 4; ++m) { const int rl = ai * HALF + wr * 64 + m * 16 + fr; const int R = Rbase + rl; const int Rc = R < 0 ? 0 : (R >= MTr ? MTr - 1 : R);
                const float rs = __builtin_amdgcn_rsqf(rq8[ai * 4 + m] * (1.0f / 1024.0f) + 1e-6f); (void)Rc;
                float cur[8], go[8];
#pragma unroll
                for (int e = 0; e < 8; ++e) cur[e] = acc[ai][0][m][e >> 2][e & 3] * rs;
                const bool is_s = R >= MPr; const int t = is_s ? ((R - MPr) & 7) : (R & 2047);
                const float k1 = (t == 0) ? 0.f : 1.f, k2 = (t < 2) ? 0.f : 1.f;
                float c1[8], c2[8];
#pragma unroll
                for (int e = 0; e < 8; ++e) { c1[e] = dpp_f(dpp_f(0.f, pg[e], 2), cur[e], 0) * k1; c2[e] = dpp_f(dpp_f(0.f, pg[e], 3), cur[e], 1) * k2; }
                if (u.pm >= 64) { if (is_s && t < 2) { const int bs = (R - MPr) >> 3;
#pragma unroll
                        for (int e = 0; e < 8; ++e) { const float h1 = sc[((size_t)bs * 2 + 1) * 2816 + f0 + e], h0 = sc[((size_t)bs * 2) * 2816 + f0 + e]; if (t == 0) { c1[e] = h1; c2[e] = h0; } else c2[e] = h1; } } }
#pragma unroll
                for (int e = 0; e < 8; ++e) { const float w0 = e < 4 ? w0a[e & 3] : w0b[e & 3], w1 = e < 4 ? w1a[e & 3] : w1b[e & 3], w2 = e < 4 ? w2a[e & 3] : w2b[e & 3], bb = e < 4 ? cba[e & 3] : cbb[e & 3];
                    const float cv = bb + w0 * c2[e] + w1 * c1[e] + w2 * cur[e];
                    go[e] = cv * __builtin_amdgcn_rcpf(1.0f + __builtin_amdgcn_exp2f(-1.4426950408889634f * cv)) * (acc[ai][1][m][e >> 2][e & 3] * rs); }
                if (rl >= 2 && R < MTr) {
                    u32x4 w; w.x = cvt_pk_bf16(go[0], go[1]); w.y = cvt_pk_bf16(go[2], go[3]); w.z = cvt_pk_bf16(go[4], go[5]); w.w = cvt_pk_bf16(go[6], go[7]);
                    *(u32x4*)(G + (size_t)R * 2816 + f0) = w;
                    float* dst = nullptr;
                    if (!is_s) { if (t >= 2046) dst = conv_p + ((size_t)(R >> 11) * 2 + (t - 2046)) * 2816 + f0; }
                    else { if (t >= 6) dst = conv_s + ((size_t)((R - MPr) >> 3) * 2 + (t - 6)) * 2816 + f0; }
                    if (dst) { *(f32x4*)dst = (f32x4){cur[0], cur[1], cur[2], cur[3]}; *(f32x4*)(dst + 4) = (f32x4){cur[4], cur[5], cur[6], cur[7]}; } }
#pragma unroll
                for (int e = 0; e < 8; ++e) pg[e] = cur[e];
                asm volatile("" ::: "memory"); }
        }
    }
};
template <class Epi, class Sched, bool ALIGN_EPI = false, bool SP2 = false>
__device__ __forceinline__ void gemm_phase(PG8_LAS unsigned char* lds, const Gemm g, const Sched& S, const Epi& E, const int wid_s) {
    int tid_o = wid_s * 64 + lane_id(); asm volatile("" : "+v"(tid_o));
    const int tid = tid_o, wid = __builtin_amdgcn_readfirstlane(tid >> 6), lane = tid & 63, wr = wid >> 2, wc = wid & 3, fr = lane & 15, fq = lane >> 4;
    const int K = g.K, nt = K / BK;
    const int lda = g.lda ? g.lda : K;
    unsigned voffA[2], voffB[2];
#pragma unroll
    for (int i = 0; i < 2; ++i) { int R, C; stage_rc(tid * 16 + i * 8192, R, C); const int Rb = Epi::PERM ? ((R & ~31) + perm32(R & 31)) : R;
        voffA[i] = (unsigned)(R * lda + C) * 2u; voffB[i] = (unsigned)(Rb * K + C) * 2u; }
    const size_t kstep = (size_t)(BK * 2);
    const size_t hstepA = (size_t)HALF * lda * 2, hstepB = (size_t)HALF * K * 2;
    const size_t tstepB = 2 * hstepB;
    const long trows = g.tile_rows ? g.tile_rows : BM;
#define PG8_TILEA(pm_) ((const char*)g.A + ((long)(pm_) * trows + g.row_off) * (long)lda * 2)
    const unsigned ldsw = (unsigned)wid * 1024u;
    const int aoff = lds_byte(wr * 64 + fr, fq * 8), boff = lds_byte(wc * 32 + fr, fq * 8);
#define PG8_SA(b, h) (((b) * 2 + (h)) * HTB)
#define PG8_SB(b, h) ((4 + (b) * 2 + (h)) * HTB)
#define PG8_STAGE(bufoff, gbase, voff) do { _Pragma("unroll") for (int _i = 0; _i < 2; ++_i) \
        __builtin_amdgcn_global_load_lds((const unsigned*)((const char*)(gbase) + (voff)[_i]), (PG8_LAS unsigned*)(lds + (bufoff) + ldsw + _i * 8192), 16, 0, 0); } while (0)
#define PG8_LDA(dst, b, h) do { _Pragma("unroll") for (int m = 0; m < 4; ++m) _Pragma("unroll") for (int k = 0; k < 2; ++k) dst[m][k] = *(const PG8_LAS bf16x8*)(lds + PG8_SA(b, h) + aoff + m * 2048 + k * 1024); } while (0)
#define PG8_LDB(dst, b, h) do { _Pragma("unroll") for (int n = 0; n < 2; ++n) _Pragma("unroll") for (int k = 0; k < 2; ++k) dst[n][k] = *(const PG8_LAS bf16x8*)(lds + PG8_SB(b, h) + boff + n * 2048 + k * 1024); } while (0)
#define PG8_MMA(ai, bj, At, Bt) do { __builtin_amdgcn_s_setprio(1); _Pragma("unroll") for (int m = 0; m < 4; ++m) _Pragma("unroll") for (int n = 0; n < 2; ++n) _Pragma("unroll") for (int k = 0; k < 2; ++k) \
        acc[ai][bj][m][n] = __builtin_amdgcn_mfma_f32_16x16x32_bf16(Bt[n][k], At[m][k], acc[ai][bj][m][n], 0, 0, 0); __builtin_amdgcn_s_setprio(0); } while (0)
#define PG8_WAIT_V(n) asm volatile("s_waitcnt vmcnt(" #n ")" ::: "memory")
#define PG8_WAIT_L(n) asm volatile("s_waitcnt lgkmcnt(" #n ")" ::: "memory")
#define PG8_BAR __builtin_amdgcn_s_barrier()
#define PG8_SCHED __builtin_amdgcn_sched_barrier(0)
    Unit cur, nxt; int ui = 0;
    if (!S.next(0, cur)) return;
    f32x4 acc[2][2][4][2];
#pragma unroll
    for (int a = 0; a < 2; ++a)
#pragma unroll
        for (int b = 0; b < 2; ++b)
#pragma unroll
            for (int m = 0; m < 4; ++m)
#pragma unroll
                for (int n = 0; n < 2; ++n) acc[a][b][m][n] = (f32x4){0.f, 0.f, 0.f, 0.f};
    bf16x8 At[4][2], B0[2][2], B1[2][2];
    const char* cA = PG8_TILEA(cur.pm); const char* cB = (const char*)g.Bt + (size_t)cur.pn * tstepB;
    S.a_ready(cur);
    if constexpr (SP2) {
        PG8_STAGE(PG8_SB(0, 0), cB, voffB); PG8_STAGE(PG8_SB(0, 1), cB + hstepB, voffB); PG8_STAGE(PG8_SA(0, 0), cA, voffA); PG8_STAGE(PG8_SA(0, 1), cA + hstepA, voffA);
        if (wr == 1) PG8_BAR;
        PG8_WAIT_V(2); PG8_BAR;
        PG8_STAGE(PG8_SB(1, 0), cB + kstep, voffB); PG8_STAGE(PG8_SA(1, 0), cA + kstep, voffA); PG8_STAGE(PG8_SB(1, 1), cB + hstepB + kstep, voffB);
        PG8_WAIT_V(6); PG8_BAR;
    } else {
        PG8_STAGE(PG8_SB(0, 0), cB, voffB); PG8_STAGE(PG8_SA(0, 0), cA, voffA); PG8_STAGE(PG8_SB(0, 1), cB + hstepB, voffB); PG8_STAGE(PG8_SA(0, 1), cA + hstepA, voffA);
        if (wr == 1) PG8_BAR;
        PG8_WAIT_V(4); PG8_BAR;
        PG8_STAGE(PG8_SB(1, 0), cB + kstep, voffB); PG8_STAGE(PG8_SA(1, 0), cA + kstep, voffA); PG8_STAGE(PG8_SB(1, 1), cB + hstepB + kstep, voffB);
        PG8_WAIT_V(6); PG8_BAR;
    }
    for (;;) {
        const bool has_next = S.next(ui + 1, nxt);
        const char* nA = has_next ? PG8_TILEA(nxt.pm) : cA; const char* nB = has_next ? (const char*)g.Bt + (size_t)nxt.pn * tstepB : cB;
        for (int t = 0; t < nt; t += 2) {
            const bool last = (t == nt - 2);
            const char* a1 = cA + (size_t)(t + 1) * kstep;
            const char* a2 = last ? nA : cA + (size_t)(t + 2) * kstep; const char* b2 = last ? nB : cB + (size_t)(t + 2) * kstep;
            const char* a3 = a2 + kstep; const char* b3 = b2 + kstep;
            if (last && has_next) S.a_ready(nxt);
            if constexpr (SP2) {
            PG8_LDB(B0, 0, 0); PG8_LDB(B1, 0, 1); PG8_SCHED; PG8_LDA(At, 0, 0); PG8_STAGE(PG8_SA(1, 1), a1 + hstepA, voffA);
            PG8_WAIT_V(8); PG8_WAIT_L(0); PG8_BAR; PG8_MMA(0, 0, At, B0); PG8_MMA(0, 1, At, B1); PG8_BAR; PG8_SCHED;
            PG8_LDA(At, 0, 1); PG8_STAGE(PG8_SB(0, 0), b2, voffB); PG8_STAGE(PG8_SB(0, 1), b2 + hstepB, voffB); PG8_STAGE(PG8_SA(0, 0), a2, voffA);
            PG8_WAIT_V(8); PG8_WAIT_L(0); PG8_BAR; PG8_MMA(1, 0, At, B0); PG8_MMA(1, 1, At, B1); PG8_BAR; PG8_SCHED;
            PG8_LDB(B0, 1, 0); PG8_LDB(B1, 1, 1); PG8_SCHED; PG8_LDA(At, 1, 0); PG8_STAGE(PG8_SA(0, 1), a2 + hstepA, voffA);
            PG8_WAIT_V(8); PG8_WAIT_L(0); PG8_BAR; PG8_MMA(0, 0, At, B0); PG8_MMA(0, 1, At, B1); PG8_BAR; PG8_SCHED;
            PG8_LDA(At, 1, 1); PG8_STAGE(PG8_SB(1, 0), b3, voffB); PG8_STAGE(PG8_SB(1, 1), b3 + hstepB, voffB); PG8_STAGE(PG8_SA(1, 0), a3, voffA);
            PG8_WAIT_V(8); PG8_WAIT_L(0); PG8_BAR; PG8_MMA(1, 0, At, B0); PG8_MMA(1, 1, At, B1); PG8_BAR; PG8_SCHED;
            } else {
            PG8_LDB(B0, 0, 0); PG8_SCHED; PG8_LDA(At, 0, 0); PG8_STAGE(PG8_SA(1, 1), a1 + hstepA, voffA);
            PG8_WAIT_L(8); PG8_BAR; PG8_WAIT_L(0); PG8_MMA(0, 0, At, B0); PG8_BAR; PG8_SCHED;
            PG8_LDB(B1, 0, 1); PG8_STAGE(PG8_SB(0, 0), b2, voffB);
            PG8_BAR; PG8_WAIT_L(0); PG8_MMA(0, 1, At, B1); PG8_BAR;
            PG8_LDA(At, 0, 1); PG8_STAGE(PG8_SA(0, 0), a2, voffA);
            PG8_BAR; PG8_WAIT_L(0); PG8_MMA(1, 0, At, B0); PG8_BAR; PG8_SCHED;
            PG8_STAGE(PG8_SB(0, 1), b2 + hstepB, voffB);
            PG8_WAIT_V(6); PG8_BAR; PG8_MMA(1, 1, At, B1); PG8_BAR;
            PG8_LDB(B0, 1, 0); PG8_SCHED; PG8_LDA(At, 1, 0); PG8_STAGE(PG8_SA(0, 1), a2 + hstepA, voffA);
            PG8_WAIT_L(8); PG8_BAR; PG8_WAIT_L(0); PG8_MMA(0, 0, At, B0); PG8_BAR; PG8_SCHED;
            PG8_LDB(B1, 1, 1); PG8_STAGE(PG8_SB(1, 0), b3, voffB);
            PG8_BAR; PG8_WAIT_L(0); PG8_MMA(0, 1, At, B1); PG8_BAR;
            PG8_LDA(At, 1, 1); PG8_STAGE(PG8_SA(1, 0), a3, voffA);
            PG8_BAR; PG8_WAIT_L(0); PG8_MMA(1, 0, At, B0); PG8_BAR; PG8_SCHED;
            PG8_STAGE(PG8_SB(1, 1), b3 + hstepB, voffB);
            PG8_WAIT_V(6); PG8_BAR; PG8_MMA(1, 1, At, B1); PG8_BAR;
            }
        }
        if constexpr (ALIGN_EPI) { if (wr == 0) PG8_BAR; }
        if constexpr (!Epi::AFTER_DRAIN) { const int le_ = lane_id(); E(acc, cur, wr, wc, le_ & 15, le_ >> 4); S.done(cur); }
        if (!has_next) break;
#pragma unroll
        for (int a = 0; a < 2; ++a)
#pragma unroll
            for (int b = 0; b < 2; ++b)
#pragma unroll
                for (int m = 0; m < 4; ++m)
#pragma unroll
                    for (int n = 0; n < 2; ++n) acc[a][b][m][n] = (f32x4){0.f, 0.f, 0.f, 0.f};
        cur = nxt; cA = nA; cB = nB; ++ui;
        if constexpr (ALIGN_EPI) { if (wr == 1) PG8_BAR; }
    }
    PG8_WAIT_V(0);
    if constexpr (!ALIGN_EPI) { if (wr == 0) PG8_BAR; }
    PG8_BAR;
    if constexpr (Epi::AFTER_DRAIN) { E.fused(acc, cur, wr, wc, fr, fq, lds, wid, lane); S.done(cur); }
#undef PG8_TILEA
#undef PG8_SA
#undef PG8_SB
#undef PG8_STAGE
#undef PG8_LDA
#undef PG8_LDB
#undef PG8_MMA
#undef PG8_WAIT_V
#undef PG8_WAIT_L
#undef PG8_BAR
#undef PG8_SCHED
}
}
constexpr int NWAVES = 8;
constexpr int MP = 16384, MS = 256, MT = MP + MS;
constexpr int DM = 1024, NU = 2048, FF = 2816;
constexpr int U_GQ = 0, U_GK = 256, U_GV = 512, U_GG = 1024, U_MQ = 1536, U_MKV = 1792, U_MKR = 1920, U_GA = 1952, IN_COLS = 1968;
constexpr float EPSN = 1e-6f;
constexpr float QSCALE = 0.10206207261596575f * 1.4426950408889634f;
constexpr size_t O_YP = 0, O_YS = 16777216, O_CKVP = 17039360, O_KRP = 19136512, O_GLAP = 19660800, O_CONVP = 19922944, O_CKVS = 19968000, O_KRS = 20000768, O_GLAS = 20008960, O_CONVS = 21057536, O_END = 21237760;
constexpr size_t MiB = 1u << 20;
constexpr size_t WS_CTL = 0, CTL_ZERO_BYTES = 1 * MiB;
constexpr size_t WS_WIN = 2 * MiB, WS_WQUP = 6 * MiB, WS_WKVUP = 6 * MiB + 512 * 1024, WS_WKVN = 6 * MiB + 768 * 1024, WS_WPP = 7 * MiB, WS_WKVP = 7 * MiB + 512 * 1024, WS_WO = 8 * MiB, WS_WPG = 10 * MiB, WS_WGU = 12 * MiB, WS_WD = 24 * MiB;
constexpr size_t WS_ROPE = 30 * MiB, WS_RS1 = 31 * MiB, WS_XB = 32 * MiB, WS_PB = 65 * MiB, WS_U = 74 * MiB, WS_PP = 139 * MiB, WS_LA = 172 * MiB, WS_QM = 189 * MiB, WS_KM = 214 * MiB, WS_VM = 239 * MiB;
constexpr size_t WS_AO = 256 * MiB, WS_H = 289 * MiB, WS_HB = 354 * MiB, WS_A = 387 * MiB, WS_C = 477 * MiB, WS_G = 567 * MiB, WS_H2B = 657 * MiB, WS_PART = 690 * MiB, WS_QABS = 699 * MiB, WS_QDEC = 700 * MiB, WS_KINV = 709 * MiB, WS_KENDT = 718 * MiB, WS_VT = 727 * MiB, WS_ELAST = 745 * MiB, WS_GGF = 746 * MiB, WS_PFSINK = 764 * MiB, WS_END = 765 * MiB;
constexpr int CW_BAR = 4096, CW_RSQ2 = 16384, CW_RSQ3 = 16384 + 16640, CW_DCNT = 50176, CW_Q = 2048, CW_RSQQ = 53248, CW_RSQKV = 53248 + 16640, CW_RSQKR = 53248 + 2 * 16640;
static_assert(CW_RSQ3 + 16640 <= CW_DCNT && CW_DCNT + 64 * 32 <= CW_RSQQ && (CW_RSQKR + 16640) * 4 <= (int)CTL_ZERO_BYTES, "ctl");
constexpr int RING_BYTES = 131072, LDSCTL_OFF = 161792, MISC_OFF = LDSCTL_OFF + 320, LDS_BYTES = 163840;

#define GAS __attribute__((address_space(1)))
#define LAS __attribute__((address_space(3)))
typedef unsigned short bf16;
typedef unsigned v4u __attribute__((ext_vector_type(4)));
typedef float f32x4 __attribute__((ext_vector_type(4)));
typedef short bf16x8 __attribute__((ext_vector_type(8)));
typedef GAS unsigned gu32;
typedef GAS unsigned long long gu64;
#define RLX_AGENT __ATOMIC_RELAXED, __HIP_MEMORY_SCOPE_AGENT
#define LDS_WAIT() asm volatile("s_waitcnt lgkmcnt(0)" ::: "memory")
#define VM_WAIT() asm volatile("s_waitcnt vmcnt(0)" ::: "memory")
__device__ __forceinline__ unsigned long long rt() { return __builtin_amdgcn_s_memrealtime(); }
__device__ __forceinline__ unsigned f2bf(float f) { unsigned u = __builtin_bit_cast(unsigned, f); return (u + 0x7fffu + ((u >> 16) & 1u)) >> 16; }
__device__ __forceinline__ unsigned pk2(float lo, float hi) { return f2bf(lo) | (f2bf(hi) << 16); }
#define XB_TMO      128
#define XB_XCNT(j)  (256  + 64 * (j))
#define XB_XSUB(j)  (1280 + 64 * (j))
#define XB_XGEN(j)  (2304 + 64 * (j))
#define XB_TOP      3328
#define XB_TOPGEN   3392
#define XCD_BAR_WORDS 3456
#define XB_SPIN_CAP (1u << 18)

__device__ __forceinline__ unsigned xb_ld(unsigned* p)              { return __hip_atomic_load(p, __ATOMIC_RELAXED, __HIP_MEMORY_SCOPE_AGENT); }
__device__ __forceinline__ unsigned xb_add(unsigned* p, unsigned v) { return __hip_atomic_fetch_add(p, v, __ATOMIC_RELAXED, __HIP_MEMORY_SCOPE_AGENT); }
__device__ __forceinline__ unsigned xb_xcc_id() { return (unsigned)__builtin_amdgcn_s_getreg((3 << 11) | 20) & 0xFu; }
#define XB_SPIN(cond, bar) do { unsigned _sp = 0; while (cond) { __builtin_amdgcn_s_sleep(1); \
    if ((++_sp & 255u) == 0u) { if (xb_ld(&(bar)[XB_TMO])) break; if (_sp > XB_SPIN_CAP) { atomicAdd(&(bar)[XB_TMO], 1u); break; } } } } while (0)

struct XcdBarrier {
    unsigned* bar; unsigned x;
    volatile LAS unsigned* st;
};

__device__ __forceinline__ XcdBarrier xcd_barrier_post(unsigned* bar, volatile LAS unsigned* st) {
    XcdBarrier b; b.bar = bar; b.x = xb_xcc_id(); b.st = st;
    if (threadIdx.x == 0) (void)xb_add(&bar[XB_XCNT(b.x)], 1u);
    return b;
}
__device__ __forceinline__ void xcd_barrier_complete(unsigned* bar, unsigned x, unsigned& nloc, unsigned& nx) {
    const unsigned G = gridDim.x * gridDim.y * gridDim.z;
    unsigned sum, cnt, mine, sp = 0u;
    for (;;) {
        sum = 0u; cnt = 0u; mine = 0u;
#pragma unroll
        for (unsigned j = 0; j < 16; ++j) { const unsigned c = xb_ld(&bar[XB_XCNT(j)]); sum += c; cnt += (c > 0u) ? 1u : 0u; mine = (j == x) ? c : mine; }
        if (sum == G) break;
        __builtin_amdgcn_s_sleep(1);
        if ((++sp & 255u) == 0u) { if (xb_ld(&bar[XB_TMO])) break; if (sp > XB_SPIN_CAP) { atomicAdd(&bar[XB_TMO], 1u); break; } }
    }
    nloc = mine > 0u ? mine : 1u; nx = cnt > 0u ? cnt : 1u;
}

__device__ __forceinline__ void xcd_barrier(const XcdBarrier& b, const int wave_s) {
    asm volatile("s_waitcnt vmcnt(0)" ::: "memory");
    __syncthreads();
    if (wave_s == 0 && lane_id() == 0) {
        unsigned* bar = b.bar;
        __builtin_amdgcn_s_waitcnt(0);
        unsigned nloc = b.st[0], nx = b.st[1];
        if (nloc == 0u) { xcd_barrier_complete(bar, b.x, nloc, nx); b.st[0] = nloc; b.st[1] = nx; }
        const unsigned old = xb_add(&bar[XB_XSUB(b.x)], 1u);
        const unsigned gen = old / nloc;
        if (old + 1u == (gen + 1u) * nloc) {
            __builtin_amdgcn_fence(__ATOMIC_RELEASE, "agent");
            asm volatile("s_waitcnt vmcnt(0)" ::: "memory");
            const unsigned og = xb_add(&bar[XB_TOP], 1u);
            const unsigned tg = og / nx;
            if (og + 1u == (tg + 1u) * nx) xb_add(&bar[XB_TOPGEN], 1u);
            else XB_SPIN(xb_ld(&bar[XB_TOPGEN]) == tg, bar);
            __builtin_amdgcn_fence(__ATOMIC_ACQUIRE, "agent");
            xb_add(&bar[XB_XGEN(b.x)], 1u);
            asm volatile("s_waitcnt vmcnt(0)" ::: "memory");
        } else {
            XB_SPIN(xb_ld(&bar[XB_XGEN(b.x)]) == gen, bar);
            __builtin_amdgcn_fence(__ATOMIC_ACQUIRE, "agent");
            asm volatile("s_waitcnt vmcnt(0)" ::: "memory");
        }
    }
    __syncthreads();
}
typedef unsigned u32x2 __attribute__((ext_vector_type(2)));
typedef float f32x2 __attribute__((ext_vector_type(2)));
__device__ __forceinline__ float blo(unsigned w) { return __builtin_bit_cast(float, w << 16); }
__device__ __forceinline__ float bhi(unsigned w) { return __builtin_bit_cast(float, w & 0xffff0000u); }
__device__ __forceinline__ float bf1(bf16 b) { return __builtin_bit_cast(float, (unsigned)b << 16); }
__device__ __forceinline__ float rbf(float f) { return __builtin_bit_cast(float, f2bf(f) << 16); }
__device__ __forceinline__ float wave_sum(float v) {
#pragma unroll
    for (int o = 1; o < 64; o <<= 1) v += __shfl_xor(v, o);
    return v;
}
__device__ __forceinline__ float wave_max(float v) {
#pragma unroll
    for (int o = 1; o < 64; o <<= 1) v = fmaxf(v, __shfl_xor(v, o));
    return v;
}
__device__ __forceinline__ float dot8(v4u w, f32x4 x0, f32x4 x1) {
    return (blo(w.x) * x0[0] + bhi(w.x) * x0[1]) + (blo(w.y) * x0[2] + bhi(w.y) * x0[3]) + (blo(w.z) * x1[0] + bhi(w.z) * x1[1]) + (blo(w.w) * x1[2] + bhi(w.w) * x1[3]);
}
__device__ __forceinline__ float silu_f(float x) { return x / (1.0f + __expf(-x)); }

struct Args { const void* in[32]; float* out; unsigned char* ws; int ph_lo, ph_hi; };

struct TItem { const float* W; const float* gk; bf16* WT; int K, N, mode, item; };
__device__ __forceinline__ TItem prep_item(const Args& a, int it) {
    unsigned char* ws = a.ws;
    constexpr int I_IN = 16 * 62, I_QUP = 4 * 24, I_KV = 2 * 32, I_O = 16 * 32, I_G = 16 * 88, I_D = 44 * 32, I_PG = 16 * 32;
    TItem t; int r = it;
    t.W = (const float*)a.in[10]; t.gk = (const float*)a.in[9]; t.WT = (bf16*)(ws + WS_WIN); t.K = 1024; t.N = IN_COLS; t.mode = 3; t.item = r;
    if (r >= I_IN) { r -= I_IN; t.W = (const float*)a.in[15]; t.gk = (const float*)a.in[14]; t.WT = (bf16*)(ws + WS_WQUP); t.K = 256; t.N = 768; t.mode = 4; t.item = r;
     if (r >= I_QUP) { r -= I_QUP; t.W = (const float*)a.in[20]; t.gk = nullptr; t.WT = (bf16*)(ws + WS_WKVUP); t.K = 128; t.N = 1024; t.mode = 0; t.item = r;
      if (r >= I_KV) { r -= I_KV; t.gk = (const float*)a.in[18]; t.WT = (bf16*)(ws + WS_WKVP); t.mode = 5; t.item = r;
       if (r >= I_KV) { r -= I_KV; t.W = (const float*)a.in[22]; t.gk = nullptr; t.WT = (bf16*)(ws + WS_WO); t.K = 1024; t.N = 1024; t.mode = 0; t.item = r;
        if (r >= I_O) { r -= I_O; t.W = (const float*)a.in[24]; t.gk = (const float*)a.in[23]; t.WT = (bf16*)(ws + WS_WGU); t.K = 1024; t.N = FF; t.mode = 1; t.item = r;
         if (r >= I_G) { r -= I_G; t.W = (const float*)a.in[25]; t.mode = 2; t.item = r;
          if (r >= I_G) { r -= I_G; t.W = (const float*)a.in[28]; t.gk = nullptr; t.WT = (bf16*)(ws + WS_WD); t.K = FF; t.N = 1024; t.mode = 0; t.item = r;
           if (r >= I_D) { r -= I_D; t.W = (const float*)a.in[30]; t.gk = (const float*)a.in[29]; t.WT = (bf16*)(ws + WS_WPG); t.K = 1024; t.N = 1024; t.item = r;
            if (r >= I_PG) { r -= I_PG; t.W = (const float*)a.in[31]; t.gk = nullptr; t.WT = (bf16*)(ws + WS_WPP); t.K = 256; t.N = 1024; t.item = r; } } } } } } } } }
    return t;
}
#define TI_LOAD(TV, T) do { const int nblk_ = ((T).N + 31) / 32, kb_ = (T).item / nblk_, nb_ = (T).item - kb_ * nblk_; const int nn_ = 32 * nb_ + (lane & 31); \
        _Pragma("unroll") for (int i = 0; i < 32; ++i) { const int kk = 2 * i + (lane >> 5); TV[i] = (nn_ < (T).N) ? (T).W[(size_t)(64 * kb_ + kk) * (T).N + nn_] : 0.f; } } while (0)
#define TI_FINISH(TV, T) do { const int nblk_ = ((T).N + 31) / 32, kb_ = (T).item / nblk_, nb_ = (T).item - kb_ * nblk_, k0 = 64 * kb_, n0 = 32 * nb_; \
        _Pragma("unroll") for (int i = 0; i < 32; ++i) { const int kk = 2 * i + (lane >> 5); float v = TV[i]; if ((T).gk) v *= (T).gk[k0 + kk]; scr[kk * 33 + (lane & 31)] = v; } \
        LDS_WAIT(); asm volatile("" ::: "memory"); \
        const int c = lane & 7; \
        _Pragma("unroll") for (int j = 0; j < 4; ++j) { const int nl = (lane >> 3) + 8 * j, n = n0 + nl; const LAS float* s = scr + (8 * c) * 33 + nl; \
            v4u o; o.x = pk2(s[0 * 33], s[1 * 33]); o.y = pk2(s[2 * 33], s[3 * 33]); o.z = pk2(s[4 * 33], s[5 * 33]); o.w = pk2(s[6 * 33], s[7 * 33]); \
            int row = n; const int mode = (T).mode; \
            if (mode == 1 || mode == 2) row = (n >> 7) * 256 + (n & 127) + (mode == 2 ? 128 : 0); \
            else if (mode == 3) { if (n >= 1936) row = 1920 + (n - 1936); else if (n >= 1808) row = 1792 + (n - 1808); else if (n >= 1552) row = 1536 + (n - 1552); else if (n >= 1536) row = 1952 + (n - 1536); } \
            else if (mode == 4) { const int h = n / 96, d = n - 96 * h; row = (d < 64) ? 256 * (h >> 2) + 128 * (d >> 5) + 32 * (h & 3) + (d & 31) : 512 + 128 * (h >> 2) + 32 * (h & 3) + (d - 64); } \
            else if (mode == 5) { const int h = n >> 7, x = n & 127; row = (x < 64) ? 256 * (h >> 2) + 128 * (x >> 5) + 32 * (h & 3) + (x & 31) : 512 + 256 * (h >> 2) + 128 * ((x - 64) >> 5) + 32 * (h & 3) + ((x - 64) & 31); } \
            if (n < (T).N) *(GAS v4u*)((T).WT + (size_t)row * (T).K + k0 + 8 * c) = o; } \
        LDS_WAIT(); asm volatile("" ::: "memory"); } while (0)
constexpr int PREP_LATE0 = 16 * 62 + 4 * 24 + 2 * (2 * 32), PREP_LATE1 = PREP_LATE0 + 16 * 32 + 2 * (16 * 88) + 44 * 32 + 16 * 32, PREP_LATE_TICKETS = (PREP_LATE1 - PREP_LATE0) / 16;
static_assert((PREP_LATE1 - PREP_LATE0) % 16 == 0, "late prep items per ticket");
__device__ __forceinline__ void prep_late(const Args& a, LAS unsigned char* lds, int ticket, int wave, int lane) {
    LAS float* scr = (LAS float*)(lds + wave * 16384);
    const int i0 = PREP_LATE0 + ticket * 16 + wave;
    float tvA[32], tvB[32]; TItem tA = prep_item(a, i0), tB = prep_item(a, i0 + 8);
    TI_LOAD(tvA, tA); TI_LOAD(tvB, tB); TI_FINISH(tvA, tA); TI_FINISH(tvB, tB);
}
constexpr int PREP_P_TICKETS = MP / 64;
__device__ __forceinline__ void prep_late_p(const Args& a, int ticket, int wave, int lane) {
    bf16* PB = (bf16*)(a.ws + WS_PB); const int m0 = ticket * 64 + wave * 8;
    f32x4 pv[8];
#pragma unroll
    for (int j = 0; j < 8; ++j) pv[j] = ((const GAS f32x4*)((const float*)a.in[7] + (size_t)(m0 + j) * 256))[lane];
#pragma unroll
    for (int j = 0; j < 8; ++j) ((GAS unsigned long long*)(PB + (size_t)(m0 + j) * 256))[lane] = (unsigned long long)pk2(pv[j].x, pv[j].y) | ((unsigned long long)pk2(pv[j].z, pv[j].w) << 32);
}
__device__ __forceinline__ void prep_phase(const Args& a, LAS unsigned char* lds, int gw, int NGW, int wave, int lane) {
    unsigned char* ws = a.ws;
    LAS float* scr = (LAS float*)(lds + wave * 16384);
    constexpr int NITEMS = PREP_LATE0 + 4 * 32;
#define EMAP(e) ((e) < PREP_LATE0 ? (e) : (e) + (PREP_LATE1 - PREP_LATE0))
    { float tvA[32], tvB[32]; int it = gw; TItem tA = prep_item(a, it < NITEMS ? EMAP(it) : 0), tB = tA;
      if (it < NITEMS) TI_LOAD(tvA, tA);
#pragma unroll 1
      while (it < NITEMS) {
          const int it1 = it + NGW; if (it1 < NITEMS) { tB = prep_item(a, EMAP(it1)); TI_LOAD(tvB, tB); }
          TI_FINISH(tvA, tA);
          if (it1 >= NITEMS) break;
          const int it2 = it1 + NGW; if (it2 < NITEMS) { tA = prep_item(a, EMAP(it2)); TI_LOAD(tvA, tA); }
          TI_FINISH(tvB, tB);
          it = it2; } }
#undef EMAP
    const int gt = gw * 64 + lane, NGT = NGW * 64;
    for (int i = gt; i < 128 * 1024 / 4; i += NGT) { const f32x4 v = ((const GAS f32x4*)a.in[20])[i]; ((GAS unsigned long long*)(ws + WS_WKVN))[i] = (unsigned long long)pk2(v.x, v.y) | ((unsigned long long)pk2(v.z, v.w) << 32); }
    for (int i = gt; i < 80 * 1024 / 8; i += NGT) ((GAS v4u*)(ws + WS_WIN + (size_t)IN_COLS * 1024 * 2))[i] = (v4u){0u, 0u, 0u, 0u};
    for (int i = gt; i < 2056 * 16; i += NGT) {
        const int pidx = i >> 4, d = i & 15; const int pos = pidx < 2048 ? pidx : 16384 + (pidx - 2048);
        double inv = 1.0; for (int k = 0; k < d; ++k) inv *= 0.56234132519034908;
        const float ang = (float)pos * (float)inv;
        const double turns = (double)ang * 0.15915494309189535; const double fr = turns - __builtin_floor(turns);
        f32x2 cs; cs.x = __builtin_amdgcn_cosf((float)fr); cs.y = __builtin_amdgcn_sinf((float)fr);
        ((GAS f32x2*)(ws + WS_ROPE))[i] = cs;
    }
    bf16* XB = (bf16*)(ws + WS_XB); float* RS1 = (float*)(ws + WS_RS1); bf16* PB = (bf16*)(ws + WS_PB);
#pragma unroll 4
    for (int m = gw; m < MT; m += NGW) {
        const float* xrow = (m < MP) ? (const float*)a.in[0] + (size_t)m * DM : (const float*)a.in[1] + (size_t)(m - MP) * DM;
        const GAS f32x4* xr = (const GAS f32x4*)xrow + lane;
        f32x4 v[4]; float s = 0.f;
#pragma unroll
        for (int j = 0; j < 4; ++j) { v[j] = xr[64 * j]; s += (v[j].x * v[j].x + v[j].y * v[j].y) + (v[j].z * v[j].z + v[j].w * v[j].w); }
        s = wave_sum(s);
        GAS unsigned long long* o8 = (GAS unsigned long long*)(XB + (size_t)m * DM) + lane;
#pragma unroll
        for (int j = 0; j < 4; ++j) o8[64 * j] = (unsigned long long)pk2(v[j].x, v[j].y) | ((unsigned long long)pk2(v[j].z, v[j].w) << 32);
        if (lane == 0) RS1[m] = 1.0f / sqrtf(s * (1.0f / DM) + EPSN);
        if (m >= MP) {
            const f32x4 pv = ((const GAS f32x4*)((const float*)a.in[8] + (size_t)(m - MP) * 256))[lane];
            ((GAS unsigned long long*)(PB + (size_t)m * 256))[lane] = (unsigned long long)pk2(pv.x, pv.y) | ((unsigned long long)pk2(pv.z, pv.w) << 32); }
    }
}

namespace pattn {
typedef short bf16x8 __attribute__((ext_vector_type(8)));
typedef short s16x4 __attribute__((ext_vector_type(4)));
typedef float f32x16 __attribute__((ext_vector_type(16)));
typedef unsigned u32x4 __attribute__((ext_vector_type(4)));
constexpr int NW = 8, QBLK = 32, KVBLK = 64, QB = NW * QBLK, DQK = 96, DV = 64;
constexpr int KP = 768, VP = 512, QP = 768, OP = 1024;
constexpr int SHM_V = KVBLK * 128 * 2, SHM_K = KVBLK * 256;
constexpr int LDS_BYTES = 2 * SHM_V + 2 * SHM_K + NW * 64 * 4;
constexpr float THR = 8.f;
#define KSWZ(row, colB) ((row) * 256 + ((colB) ^ (((row) & 7) << 4)))
#define SBAR() __builtin_amdgcn_sched_barrier(0)
__device__ __forceinline__ int v_st(int k, int c) { const int kk = (k & ~0xC) | ((k & 4) << 1) | ((k & 8) >> 1); return ((kk >> 3) * 4 + (c >> 5)) * 512 + ((kk & 7) * 32 + (c & 31)) * 2; }
__device__ __forceinline__ int v_rd_base(int lane) { return ((lane & 3) << 3) | (((lane >> 2) & 3) << 6) | (((lane >> 4) & 1) << 5) | (((lane >> 5) & 1) << 8); }
constexpr int v_rd_off(int d0, int ks, int half) { return d0 * 512 + ks * 4096 + half * 2048; }
__device__ __forceinline__ int crow(int r, int hi) { return (r & 3) + 8 * (r >> 2) + 4 * hi; }
__device__ __forceinline__ unsigned cvtpk(float lo, float hi) { unsigned r; asm volatile("v_cvt_pk_bf16_f32 %0, %1, %2" : "=v"(r) : "v"(lo), "v"(hi)); return r; }
__device__ __forceinline__ bf16x8 load8(const bf16* p) { return *reinterpret_cast<const bf16x8*>(p); }
__device__ __forceinline__ void mask_tile(f32x16& p0, f32x16& p1, int dq) {
    const float NEG = -__builtin_inff();
#pragma unroll
    for (int r = 0; r < 16; ++r) { const int c = (r & 3) + 8 * (r >> 2); if (dq - c < 0) p0[r] = NEG; if (dq - c - 32 < 0) p1[r] = NEG; }
}
__device__ __forceinline__ void partialSM(f32x16& p0, f32x16& p1, float& m_reg, float& mn, float& alpha) {
    float pmax = p0[0];
#pragma unroll
    for (int r = 1; r < 16; ++r) pmax = fmaxf(pmax, p0[r]);
#pragma unroll
    for (int r = 0; r < 16; ++r) pmax = fmaxf(pmax, p1[r]);
    { auto rr = __builtin_amdgcn_permlane32_swap(__float_as_uint(pmax), __float_as_uint(pmax), false, false); pmax = fmaxf(__uint_as_float(rr[0]), __uint_as_float(rr[1])); }
    if (__builtin_expect(__all((pmax - m_reg) <= THR), 1)) { mn = m_reg; alpha = 1.f; }
    else { mn = fmaxf(m_reg, pmax); alpha = __builtin_amdgcn_exp2f(m_reg - mn); m_reg = mn; }
#pragma unroll
    for (int r = 0; r < 16; ++r) p0[r] = p0[r] - mn;
#pragma unroll
    for (int r = 0; r < 16; ++r) p1[r] = p1[r] - mn;
#pragma unroll
    for (int r = 0; r < 16; ++r) p0[r] = __builtin_amdgcn_exp2f(p0[r]);
}
__device__ __forceinline__ void finishSM(f32x16& p0, f32x16& p1, float alpha, float& l_reg, bf16x8& pa0, bf16x8& pa1, bf16x8& pa2, bf16x8& pa3) {
#pragma unroll
    for (int r = 0; r < 16; ++r) p1[r] = __builtin_amdgcn_exp2f(p1[r]);
    float ps = 0;
#pragma unroll
    for (int r = 0; r < 16; ++r) ps += p0[r];
#pragma unroll
    for (int r = 0; r < 16; ++r) ps += p1[r];
    { auto rr = __builtin_amdgcn_permlane32_swap(__float_as_uint(ps), __float_as_uint(ps), false, false); ps = __uint_as_float(rr[0]) + __uint_as_float(rr[1]); }
    l_reg = l_reg * alpha + ps;
#define PK4(P, B_, OUT) do { unsigned a0 = cvtpk(P[B_+0], P[B_+1]), a1 = cvtpk(P[B_+2], P[B_+3]); unsigned b0 = cvtpk(P[B_+4], P[B_+5]), b1 = cvtpk(P[B_+6], P[B_+7]); \
        auto r0 = __builtin_amdgcn_permlane32_swap(a0, b0, false, false); auto r1 = __builtin_amdgcn_permlane32_swap(a1, b1, false, false); \
        u32x4 w = {r0[0], r1[0], r0[1], r1[1]}; OUT = *reinterpret_cast<bf16x8*>(&w); } while (0)
    PK4(p0, 0, pa0); PK4(p0, 8, pa1); PK4(p1, 0, pa2); PK4(p1, 8, pa3);
#undef PK4
}
template <int KB>
__device__ __forceinline__ void qkt(f32x16& p0, f32x16& p1, const char* K_lds, int r32, int hi, const bf16x8* qr) {
    p0 = f32x16{}; p1 = f32x16{};
    const char* kb[4];
#pragma unroll
    for (int dd = 0; dd < 4; ++dd) kb[dd] = K_lds + KB * SHM_K + KSWZ(r32, (dd * 16 + hi * 8) * 2);
#pragma unroll
    for (int d0 = 0; d0 < 6; ++d0) { const char* a = kb[d0 & 3] + (d0 >> 2) * 128;
        bf16x8 b0 = *reinterpret_cast<const bf16x8*>(a);
        bf16x8 b1 = *reinterpret_cast<const bf16x8*>(a + 32 * 256);
        p0 = __builtin_amdgcn_mfma_f32_32x32x16_bf16(b0, qr[d0], p0, 0, 0, 0);
        p1 = __builtin_amdgcn_mfma_f32_32x32x16_bf16(b1, qr[d0], p1, 0, 0, 0); }
}
template <int VB>
__device__ __forceinline__ void pv_tile(f32x16* o, int vb0, bf16x8 pa0, bf16x8 pa1, bf16x8 pa2, bf16x8 pa3) {
#define TRRD(dst, off) asm volatile("ds_read_b64_tr_b16 %0, %1 offset:%2" : "=&v"(dst) : "v"(vb0), "i"(off) : "memory")
#define PV_D0(d0) do { s16x4 l0, l1, l2, l3, h0, h1, h2, h3; constexpr int b_ = VB * SHM_V + v_rd_off(d0, 0, 0); \
        TRRD(l0, b_); TRRD(h0, b_ + 2048); TRRD(l1, b_ + 4096); TRRD(h1, b_ + 6144); TRRD(l2, b_ + 8192); TRRD(h2, b_ + 10240); TRRD(l3, b_ + 12288); TRRD(h3, b_ + 14336); \
        asm volatile("s_waitcnt lgkmcnt(0)" ::: "memory"); SBAR(); \
        o[d0] = __builtin_amdgcn_mfma_f32_32x32x16_bf16(pa0, (bf16x8){l0[0], l0[1], l0[2], l0[3], h0[0], h0[1], h0[2], h0[3]}, o[d0], 0, 0, 0); \
        o[d0] = __builtin_amdgcn_mfma_f32_32x32x16_bf16(pa1, (bf16x8){l1[0], l1[1], l1[2], l1[3], h1[0], h1[1], h1[2], h1[3]}, o[d0], 0, 0, 0); \
        o[d0] = __builtin_amdgcn_mfma_f32_32x32x16_bf16(pa2, (bf16x8){l2[0], l2[1], l2[2], l2[3], h2[0], h2[1], h2[2], h2[3]}, o[d0], 0, 0, 0); \
        o[d0] = __builtin_amdgcn_mfma_f32_32x32x16_bf16(pa3, (bf16x8){l3[0], l3[1], l3[2], l3[3], h3[0], h3[1], h3[2], h3[3]}, o[d0], 0, 0, 0); } while (0)
    PV_D0(0); PV_D0(1);
#undef PV_D0
#undef TRRD
}
struct BlockRef { const bf16* Q; const bf16* K; const bf16* V; bf16* O; int P0; };
struct Seam { bf16x8 qr[6]; bf16x8 st_v0, st_v1, st_k0, st_k1; };
#define VMW() asm volatile("s_waitcnt vmcnt(0)" ::: "memory")
#define VMWN(n) asm volatile("s_waitcnt vmcnt(%0)" :: "i"(n) : "memory")
#define SLOAD_H(Kp, Vp, k0) do { if (ch < 8) { S.st_v0 = load8((Vp) + (size_t)((k0) + sr) * VP + sc); S.st_v1 = load8((Vp) + (size_t)((k0) + 32 + sr) * VP + sc); } \
                                 if (ch < 12) { S.st_k0 = load8((Kp) + (size_t)((k0) + sr) * KP + sc); S.st_k1 = load8((Kp) + (size_t)((k0) + 32 + sr) * KP + sc); } } while (0)
#define SWRITE_HK(bf) do { if (ch < 12) { *(bf16x8*)(K_lds + (bf) * SHM_K + kws) = S.st_k0; *(bf16x8*)(K_lds + (bf) * SHM_K + kws + 32 * 256) = S.st_k1; } } while (0)
#define SWRITE_HV(bf) do { if (ch < 8) { *(bf16x8*)(V_lds + (bf) * SHM_V + vst0) = S.st_v0; *(bf16x8*)(V_lds + (bf) * SHM_V + vst1) = S.st_v1; } } while (0)
#define SWRITE_H(bf) do { SWRITE_HV(bf); SWRITE_HK(bf); } while (0)
__device__ __forceinline__ void prime(const BlockRef& cur, char* lds, Seam& S, const int wave_s) {
    int tid_o = wave_s * 64 + lane_id(); asm volatile("" : "+v"(tid_o));
    const int tid = tid_o, wid = __builtin_amdgcn_readfirstlane(tid >> 6), lane = tid & 63, r32 = lane & 31, hi = lane >> 5;
    const int sr = tid >> 4, ch = tid & 15, sc = ch * 8, kws = KSWZ(sr, sc * 2); char* K_lds = lds + 2 * SHM_V;
#pragma unroll
    for (int d0 = 0; d0 < 6; ++d0) S.qr[d0] = load8(cur.Q + (size_t)(wid * QBLK + r32) * QP + d0 * 16 + hi * 8);
    SLOAD_H(cur.K, cur.V, 0); VMW(); SWRITE_HK(0);
    __syncthreads();
}
__device__ __forceinline__ void block(const BlockRef& cur, const BlockRef& nxt, char* lds, Seam& S, const int wave_s) {
    int tid_o = wave_s * 64 + lane_id(); asm volatile("" : "+v"(tid_o));
    const int tid = tid_o, wid = __builtin_amdgcn_readfirstlane(tid >> 6), lane = tid & 63, r32 = lane & 31, hi = lane >> 5;
    const int NT = (cur.P0 + QB - 1) / KVBLK + 1;
    const int qlo = cur.P0 + wid * QBLK, qm = qlo + r32 - 4 * hi;
    char* V_lds = lds; char* K_lds = lds + 2 * SHM_V;
    float* wsf = (float*)(lds + 2 * SHM_V + 2 * SHM_K) + wid * 64; float* li_l = wsf, * al_l = wsf + 32;
    float m_reg = -1e30f, l_reg = 0; f32x16 o[2] = {};
    const int sr = tid >> 4, ch = tid & 15, sc = ch * 8, vst0 = v_st(sr, sc & 63), vst1 = v_st(32 + sr, sc & 63), kws = KSWZ(sr, sc * 2);
    const int vb0 = (int)(uintptr_t)V_lds + v_rd_base(lane);
    const bf16* Kh = cur.K; const bf16* Vh = cur.V;
#define RESC(a) do { if (__any((a) < 1.f)) { if (hi == 0) al_l[r32] = (a); asm volatile("s_waitcnt lgkmcnt(0)" ::: "memory"); \
                     _Pragma("unroll") for (int d_ = 0; d_ < 2; ++d_) _Pragma("unroll") for (int r = 0; r < 16; ++r) o[d_][r] *= al_l[crow(r, hi)]; } } while (0)
#define KBASE(t) ((t) * KVBLK)
#define MASKT(P0_, P1_, t) do { const int kb_ = KBASE(t); if (kb_ + KVBLK - 1 > qlo) mask_tile(P0_, P1_, qm - kb_); } while (0)
#define SEAM_K0() do { VMWN(6); SWRITE_HK(0); SBAR(); } while (0)
    f32x16 pA0, pA1, pB0, pB1; float mnA, mnB, alA, alB; bf16x8 pa0, pa1, pa2, pa3;
    SWRITE_HV(0); SBAR();
    if (NT > 1) SLOAD_H(Kh, Vh, KBASE(1));
    SBAR(); qkt<0>(pA0, pA1, K_lds, r32, hi, S.qr);
    MASKT(pA0, pA1, 0); partialSM(pA0, pA1, m_reg, mnA, alA);
    if (NT > 1) { VMW(); SWRITE_H(1); }
    __syncthreads();
#define HALF_STEP(PX0, PX1, mnX, alX, PY0, PY1, alY, t, KB, VB, SB) do { \
        SBAR(); qkt<KB>(PX0, PX1, K_lds, r32, hi, S.qr); \
        finishSM(PY0, PY1, alY, l_reg, pa0, pa1, pa2, pa3); SBAR(); \
        if ((t) + 1 < NT) { SLOAD_H(Kh, Vh, KBASE((t) + 1)); SBAR(); } \
        pv_tile<VB>(o, vb0, pa0, pa1, pa2, pa3); MASKT(PX0, PX1, (t)); partialSM(PX0, PX1, m_reg, mnX, alX); \
        __syncthreads(); \
        if ((t) + 1 < NT) { VMW(); SWRITE_H(SB); } \
        RESC(alX); __syncthreads(); } while (0)
    for (int t = 1; t + 1 < NT; t += 2) {
        HALF_STEP(pB0, pB1, mnB, alB, pA0, pA1, alA, t, 1, 0, 0);
        HALF_STEP(pA0, pA1, mnA, alA, pB0, pB1, alB, t + 1, 0, 1, 1);
    }
    const bool even = (NT & 1) == 0;
    if (even) { SBAR(); qkt<1>(pB0, pB1, K_lds, r32, hi, S.qr); SBAR(); }
    SLOAD_H(nxt.K, nxt.V, 0); SBAR();
#pragma unroll
    for (int d0 = 0; d0 < 6; ++d0) S.qr[d0] = load8(nxt.Q + (size_t)(wid * QBLK + r32) * QP + d0 * 16 + hi * 8);
    SBAR();
    finishSM(pA0, pA1, alA, l_reg, pa0, pa1, pa2, pa3); SBAR();
    pv_tile<0>(o, vb0, pa0, pa1, pa2, pa3);
    if (even) { MASKT(pB0, pB1, NT - 1); partialSM(pB0, pB1, m_reg, mnB, alB); __syncthreads(); RESC(alB);
        finishSM(pB0, pB1, alB, l_reg, pa0, pa1, pa2, pa3); SBAR(); pv_tile<1>(o, vb0, pa0, pa1, pa2, pa3); }
    SBAR(); SEAM_K0();
    if (hi == 0) li_l[r32] = l_reg; asm volatile("s_waitcnt lgkmcnt(0)" ::: "memory");
    float rli[16];
#pragma unroll
    for (int r = 0; r < 16; ++r) rli[r] = __builtin_amdgcn_rcpf(li_l[crow(r, hi)]);
    bf16* Ow = cur.O + (size_t)(wid * QBLK) * OP;
#pragma unroll
    for (int r = 0; r < 16; ++r) { const int orow = crow(r, hi);
#pragma unroll
        for (int d0 = 0; d0 < 2; ++d0) { const float v = o[d0][r] * rli[r]; const float vn = __shfl_xor(v, 1);
            if ((r32 & 1) == 0) *(unsigned*)(Ow + (size_t)orow * OP + d0 * 32 + r32) = cvtpk(v, vn); } }
    __syncthreads();
#undef RESC
#undef KBASE
#undef MASKT
#undef SEAM_K0
#undef HALF_STEP
}
#undef VMW
#undef VMWN
#undef SLOAD_H
#undef SWRITE_HK
#undef SWRITE_HV
#undef SWRITE_H
#undef KSWZ
#undef SBAR
__device__ __forceinline__ BlockRef mkref(const bf16* QM, const bf16* KM, const bf16* VM, bf16* AO, int item, int pass) {
    const int bh = item >> 2, y = item & 3, qb = pass ? 7 - y : y, b = bh >> 3, h = bh & 7; BlockRef r;
    r.Q = QM + (((size_t)b * 2048 + qb * QB) * 8 + h) * 96; r.K = KM + ((size_t)b * 2048 * 8 + h) * 96; r.V = VM + ((size_t)b * 2048 * 8 + h) * 64;
    r.O = AO + ((size_t)b * 2048 + qb * QB) * 1024 + 512 + h * 64; r.P0 = qb * QB; return r;
}
__device__ __forceinline__ void phase(char* lds, const bf16* QM, const bf16* KM, const bf16* VM, bf16* AO, int vcu, int G, const int wave_s) {
    Seam S;
    int item = vcu; if (item >= 256) return;
    BlockRef cur = mkref(QM, KM, VM, AO, item, 0); int pass = 0;
    prime(cur, lds, S, wave_s);
    for (;;) {
        int itn = item, pn = pass + 1; bool last = false;
        if (pass == 1) { pn = 0; itn = item + G; if (itn >= 256) { last = true; itn = item; pn = 1; } }
        const BlockRef nxt = mkref(QM, KM, VM, AO, itn, pn);
        block(cur, nxt, lds, S, wave_s);
        if (last) break;
        cur = nxt; item = itn; pass = pn;
    }
}
__device__ __forceinline__ void one(char* lds, const bf16* QM, const bf16* KM, const bf16* VM, bf16* AO, int idx, const int wave_s) {
    Seam S; const int qb = 7 - (idx >> 6), bh = idx & 63, b = bh >> 3, h = bh & 7; BlockRef r;
    r.Q = QM + (((size_t)b * 2048 + qb * QB) * 8 + h) * 96; r.K = KM + ((size_t)b * 2048 * 8 + h) * 96; r.V = VM + ((size_t)b * 2048 * 8 + h) * 64;
    r.O = AO + ((size_t)b * 2048 + qb * QB) * 1024 + 512 + h * 64; r.P0 = qb * QB;
    prime(r, lds, S, wave_s); block(r, r, lds, S, wave_s);
}
}
namespace dec {
typedef short bf16x8 __attribute__((ext_vector_type(8)));
typedef short s16x4 __attribute__((ext_vector_type(4)));
typedef float f32x16 __attribute__((ext_vector_type(16)));
typedef unsigned u32x4 __attribute__((ext_vector_type(4)));
typedef int i32x4 __attribute__((ext_vector_type(4)));
typedef int i32x16 __attribute__((ext_vector_type(16)));
typedef float f32x2 __attribute__((ext_vector_type(2)));
constexpr int L_SC = 0, L_CT = 65536, L_RT = 98304, L_QA = 106496, L_QR = 122880, L_RTAB = 126976, L_AL = 131072, L_ML = 133120, L_C8 = 137216, L_KI = 153600, L_END = 154112;
constexpr float THR = 8.f;
__device__ __forceinline__ unsigned off_b(unsigned row, unsigned ch) { return 256u * row + 16u * (ch ^ (((row & 3) << 2) | ((row >> 2) & 3))); }
__device__ __forceinline__ int crow(int r, int hi) { return (r & 3) + 8 * (r >> 2) + 4 * hi; }
__device__ __forceinline__ unsigned cvtpk(float lo, float hi) { unsigned r; asm volatile("v_cvt_pk_bf16_f32 %0, %1, %2" : "=v"(r) : "v"(lo), "v"(hi)); return r; }
__device__ __forceinline__ bf16x8 pack8(f32x4 a, f32x4 b) { u32x4 w = {cvtpk(a[0], a[1]), cvtpk(a[2], a[3]), cvtpk(b[0], b[1]), cvtpk(b[2], b[3])}; return *reinterpret_cast<bf16x8*>(&w); }
__device__ __forceinline__ unsigned off_c8(unsigned key, unsigned c16) { return 128u * key + ((c16 ^ ((key >> 1) & 7u)) << 4); }
__device__ __forceinline__ unsigned q4(float x0, float x1, float x2, float x3, float sc) {
    const unsigned f0 = __float_as_uint(__builtin_fmaf(x0, sc, 12582912.f)), f1 = __float_as_uint(__builtin_fmaf(x1, sc, 12582912.f)), f2 = __float_as_uint(__builtin_fmaf(x2, sc, 12582912.f)), f3 = __float_as_uint(__builtin_fmaf(x3, sc, 12582912.f));
    return __builtin_amdgcn_perm(f1, f0, 0x0c0c0400u) | __builtin_amdgcn_perm(f3, f2, 0x04000c0cu); }
__device__ __forceinline__ float rowmax16(float v) {
    asm("s_nop 1\n\tv_max_f32_dpp %0, %0, %0 row_ror:8 row_mask:0xf bank_mask:0xf\n\ts_nop 1\n\tv_max_f32_dpp %0, %0, %0 row_ror:4 row_mask:0xf bank_mask:0xf\n\t"
        "s_nop 1\n\tv_max_f32_dpp %0, %0, %0 row_ror:2 row_mask:0xf bank_mask:0xf\n\ts_nop 1\n\tv_max_f32_dpp %0, %0, %0 row_ror:1 row_mask:0xf bank_mask:0xf" : "+v"(v));
    return v; }
__device__ __forceinline__ float amax3(float a, float b, float c) { float r; asm("v_max3_f32 %0, |%1|, |%2|, |%3|" : "=v"(r) : "v"(a), "v"(b), "v"(c)); return r; }
__device__ __forceinline__ float amax8(f32x4 x0, f32x4 x1) { return amax3(x1[3], x1[3], amax3(x1[1], x1[2], amax3(x0[3], x1[0], amax3(x0[0], x0[1], x0[2])))); }
#define DBAR() asm volatile("s_waitcnt lgkmcnt(0)\n\ts_barrier" ::: "memory")
__device__ __forceinline__ void combine(const Args& a, char* lds, int bs, int wave, int lane) {
    unsigned char* ws = a.ws; const int h = wave, r31 = lane & 31, hi = lane >> 5, t = lane >> 3, x = lane & 7;
    const bf16* QM = (const bf16*)(ws + WS_QM); const bf16* KM = (const bf16*)(ws + WS_KM); const bf16* VM = (const bf16*)(ws + WS_VM); const bf16* WkvT = (const bf16*)(ws + WS_WKVUP); bf16* AO = (bf16*)(ws + WS_AO);
    const float* part = (const float*)(ws + WS_PART) + (size_t)bs * 8 * 64 * 132;
    float* wl = (float*)(lds + wave * 4096);
    float* pl = wl + 64; float* Ll = wl + 128; float* Dl = wl + 192;
    const size_t rowt = (size_t)MP + bs * 8 + t;
    const float mg = part[(x * 64 + h * 8 + t) * 132], lg = part[(x * 64 + h * 8 + t) * 132 + 1];
    float sn = 0.f;
    { const bf16* qrow = QM + (rowt * 8 + h) * 96; const bf16* krow = KM + (((size_t)MP + bs * 8 + x) * 8 + h) * 96;
#pragma unroll
      for (int c = 0; c < 12; ++c) { const v4u q = *(const v4u*)(qrow + c * 8), k = *(const v4u*)(krow + c * 8);
          sn += (blo(q.x) * blo(k.x) + bhi(q.x) * bhi(k.x)) + (blo(q.y) * blo(k.y) + bhi(q.y) * bhi(k.y)) + (blo(q.z) * blo(k.z) + bhi(q.z) * bhi(k.z)) + (blo(q.w) * blo(k.w) + bhi(q.w) * bhi(k.w)); } }
    if (x > t) sn = -1e30f;
    float mx = fmaxf(mg, sn); mx = fmaxf(mx, __shfl_xor(mx, 1)); mx = fmaxf(mx, __shfl_xor(mx, 2)); mx = fmaxf(mx, __shfl_xor(mx, 4));
    const float wg = __builtin_amdgcn_exp2f(mg - mx), pn = (x > t) ? 0.f : __builtin_amdgcn_exp2f(sn - mx);
    float L = lg * wg + pn; L += __shfl_xor(L, 1); L += __shfl_xor(L, 2); L += __shfl_xor(L, 4);
    wl[lane] = wg; pl[lane] = pn; if (x == 0) Ll[t] = L;
    asm volatile("s_waitcnt lgkmcnt(0)" ::: "memory");
    f32x16 D0 = {}, D1 = {};
    float wr8[8];
#pragma unroll
    for (int g = 0; g < 8; ++g) wr8[g] = (r31 < 8) ? wl[r31 * 8 + g] : 0.f;
#pragma unroll 2
    for (int ks = 0; ks < 8; ++ks) { f32x4 s0 = {0.f, 0.f, 0.f, 0.f}, s1 = {0.f, 0.f, 0.f, 0.f};
        if (r31 < 8) {
#pragma unroll
            for (int g = 0; g < 8; ++g) { const float* p = part + (g * 64 + h * 8 + r31) * 132 + 4 + 16 * ks + 8 * hi; s0 += wr8[g] * *(const f32x4*)p; s1 += wr8[g] * *(const f32x4*)(p + 4); } }
        const bf16x8 af = pack8(s0, s1);
        const bf16x8 b0 = *(const bf16x8*)(WkvT + (size_t)(128 * h + 64 + r31) * 128 + 16 * ks + 8 * hi), b1 = *(const bf16x8*)(WkvT + (size_t)(128 * h + 96 + r31) * 128 + 16 * ks + 8 * hi);
        D0 = __builtin_amdgcn_mfma_f32_32x32x16_bf16(af, b0, D0, 0, 0, 0); D1 = __builtin_amdgcn_mfma_f32_32x32x16_bf16(af, b1, D1, 0, 0, 0); }
#pragma unroll
    for (int r = 0; r < 4; ++r) { Dl[(r + 4 * hi) * 64 + r31] = D0[r]; Dl[(r + 4 * hi) * 64 + 32 + r31] = D1[r]; }
    asm volatile("s_waitcnt lgkmcnt(0)" ::: "memory");
    float vv[8];
#pragma unroll
    for (int tp = 0; tp < 8; ++tp) vv[tp] = bf1(VM[(((size_t)MP + bs * 8 + tp) * 8 + h) * 64 + lane]);
#pragma unroll
    for (int tt = 0; tt < 8; ++tt) { float o = Dl[tt * 64 + lane];
#pragma unroll
        for (int tp = 0; tp < 8; ++tp) o += pl[tt * 8 + tp] * vv[tp];
        AO[((size_t)MP + bs * 8 + tt) * 1024 + 512 + h * 64 + lane] = (bf16)f2bf(o / Ll[tt]); }
    asm volatile("s_waitcnt lgkmcnt(0)" ::: "memory");
}
__device__ __forceinline__ void item(const Args& a, char* lds, LAS unsigned char* ldsl, int bs, int grp, int half, int wave, int lane) {
    unsigned char* ws = a.ws; int tid_o = wave * 64 + lane_id(); asm volatile("" : "+v"(tid_o)); const int tid = tid_o; lane = tid & 63;
    const int h = wave, rb = wave >> 2, kb = wave & 3, r31 = lane & 31, hi = lane >> 5;
    const int NPG = half < 0 ? 16 : 8, pg0 = grp * 16 + (half > 0 ? 8 : 0);
    const float* cache_c = (const float*)a.in[2]; const float* cache_r = (const float*)a.in[3]; const int* ptab = (const int*)a.in[6];
    const bf16* WkvT = (const bf16*)(ws + WS_WKVUP); const bf16* QM = (const bf16*)(ws + WS_QM);
    const int myphys = (lane < NPG) ? ptab[bs * 128 + pg0 + lane] : 0;
    typedef __attribute__((address_space(3))) unsigned lds_u32;
#define PAGE_LOAD(pg_) do { const int phys_ = __builtin_amdgcn_readlane(myphys, (pg_)); const char* sc_ = (const char*)(cache_c + (size_t)phys_ * 16384); \
        _Pragma("unroll") for (int i = 0; i < 8; ++i) __builtin_amdgcn_global_load_lds((const unsigned*)(sc_ + (i * 8 + wave) * 1024 + lane * 16), (lds_u32*)(ldsl + L_SC + (i * 8 + wave) * 1024), 16, 0, 2); \
        } while (0)
#define R_LOAD(pg_) do { const int phys_ = __builtin_amdgcn_readlane(myphys, (pg_)); const f32x4* sr_ = (const f32x4*)(cache_r + (size_t)phys_ * 4096); rq0 = __builtin_nontemporal_load(sr_ + tid * 2); rq1 = __builtin_nontemporal_load(sr_ + tid * 2 + 1); } while (0)
#define PAGE_CONVERT() do { _Pragma("unroll") for (int i = 0; i < 4; ++i) { const int id = i * 512 + tid; const unsigned key_ = id >> 4, ch_ = id & 15; const f32x4 x0 = *(const f32x4*)(lds + L_SC + id * 32), x1 = *(const f32x4*)(lds + L_SC + id * 32 + 16); \
            *(bf16x8*)(lds + L_CT + off_b(key_, ch_)) = pack8(x0, x1); \
            const float mx_ = rowmax16(amax8(x0, x1)); \
            const float sc_ = mx_ > 0.f ? 127.f * __builtin_amdgcn_rcpf(mx_) : 0.f; \
            *(uint2*)(lds + L_C8 + off_c8(key_, ch_ >> 1) + 8 * (ch_ & 1)) = make_uint2(q4(x0[0], x0[1], x0[2], x0[3], sc_), q4(x1[0], x1[1], x1[2], x1[3], sc_)); \
            if (ch_ == 0) ((float*)(lds + L_KI))[key_] = mx_ * (1.f / 127.f); } \
        *(bf16x8*)(lds + L_RT + (tid >> 2) * 64 + (tid & 3) * 16) = pack8(rq0, rq1); } while (0)
    f32x4 rq0, rq1;
    i32x4 wk8[2][4]; float winv;
    { bf16x8 wk[2][8];
#pragma unroll
      for (int jb = 0; jb < 2; ++jb)
#pragma unroll
          for (int ks = 0; ks < 8; ++ks) wk[jb][ks] = *(const bf16x8*)(WkvT + (size_t)(128 * h + 32 * jb + r31) * 128 + 32 * (ks >> 1) + 16 * hi + 8 * (ks & 1));
      PAGE_LOAD(0); R_LOAD(0);
      float wm = 0.f;
#pragma unroll
      for (int jb = 0; jb < 2; ++jb)
#pragma unroll
          for (int ks = 0; ks < 8; ++ks)
#pragma unroll
              for (int e = 0; e < 8; ++e) wm = fmaxf(wm, __builtin_fabsf(bf1((bf16)wk[jb][ks][e])));
      wm = rowmax16(wm); wm = fmaxf(wm, __shfl_xor(wm, 16)); wm = fmaxf(wm, __shfl_xor(wm, 32));
      const float wsc = wm > 0.f ? 127.f * __builtin_amdgcn_rcpf(wm) : 0.f; winv = wm * (1.f / 127.f);
#pragma unroll
      for (int jb = 0; jb < 2; ++jb)
#pragma unroll
          for (int k8 = 0; k8 < 4; ++k8) { const bf16x8 lo_ = wk[jb][2 * k8], hi_ = wk[jb][2 * k8 + 1];
              wk8[jb][k8] = (i32x4){(int)q4(bf1((bf16)lo_[0]), bf1((bf16)lo_[1]), bf1((bf16)lo_[2]), bf1((bf16)lo_[3]), wsc), (int)q4(bf1((bf16)lo_[4]), bf1((bf16)lo_[5]), bf1((bf16)lo_[6]), bf1((bf16)lo_[7]), wsc),
                                    (int)q4(bf1((bf16)hi_[0]), bf1((bf16)hi_[1]), bf1((bf16)hi_[2]), bf1((bf16)hi_[3]), wsc), (int)q4(bf1((bf16)hi_[4]), bf1((bf16)hi_[5]), bf1((bf16)hi_[6]), bf1((bf16)hi_[7]), wsc)}; } }
    { const bf16* WkvN = (const bf16*)(ws + WS_WKVN); const float* g_kn = (const float*)a.in[21];
      bf16x8 qb[4];
#pragma unroll
      for (int ks = 0; ks < 4; ++ks) { const int j0 = 16 * ks + 8 * hi; u32x4 w = {0u, 0u, 0u, 0u};
          if (r31 < 8) { const bf16x8 qv = *(const bf16x8*)(QM + (((size_t)(MP + bs * 8 + r31)) * 8 + h) * 96 + j0); const f32x4 g0 = *(const f32x4*)(g_kn + j0), g1 = *(const f32x4*)(g_kn + j0 + 4);
              w.x = cvtpk(bf1((bf16)qv[0]) * g0[0], bf1((bf16)qv[1]) * g0[1]); w.y = cvtpk(bf1((bf16)qv[2]) * g0[2], bf1((bf16)qv[3]) * g0[3]);
              w.z = cvtpk(bf1((bf16)qv[4]) * g1[0], bf1((bf16)qv[5]) * g1[1]); w.w = cvtpk(bf1((bf16)qv[6]) * g1[2], bf1((bf16)qv[7]) * g1[3]); }
          qb[ks] = *reinterpret_cast<bf16x8*>(&w); }
#pragma unroll
      for (int cb = 0; cb < 4; ++cb) { f32x16 dq = {};
#pragma unroll
          for (int ks = 0; ks < 4; ++ks) { const bf16x8 wa_ = *(const bf16x8*)(WkvN + (size_t)(32 * cb + r31) * 1024 + 128 * h + 16 * ks + 8 * hi); dq = __builtin_amdgcn_mfma_f32_32x32x16_bf16(wa_, qb[ks], dq, 0, 0, 0); }
          if (r31 < 8) {
#pragma unroll
              for (int r = 0; r < 16; ++r) { const int c = 32 * cb + crow(r, hi); *(bf16*)(lds + L_QA + off_b(h * 8 + r31, c >> 3) + (c & 7) * 2) = (bf16)f2bf(dq[r]); } } } }
    if (tid < 256) { const int row = tid >> 2, ch = tid & 3, hh = row >> 3, t = row & 7;
        *(u32x4*)(lds + L_QR + row * 64 + ch * 16) = *(const u32x4*)(QM + (((size_t)(MP + bs * 8 + t)) * 8 + hh) * 96 + 64 + ch * 8); }
    asm volatile("s_waitcnt vmcnt(0)" ::: "memory"); DBAR(); PAGE_CONVERT();
    float* rtab = (float*)(lds + L_RTAB); float* al = (float*)(lds + L_AL) + wave * 64;
    float m_reg = -1e30f, l_reg = 0.f; f32x16 O[4] = {};
    const int hh = 4 * rb + (r31 >> 3);
    const unsigned q_ = (lane & 15) >> 2, p_ = lane & 3, blk_ = (lane >> 4) & 1;
    DBAR();
    for (int pg = 0; pg < NPG; ++pg) {
        const char* Cb = lds + L_CT; const char* Rb = lds + L_RT;
        if (pg + 1 < NPG) PAGE_LOAD(pg + 1);
        { const float* kiv = (const float*)(lds + L_KI);
          i32x4 cf[4];
#pragma unroll
          for (int ks = 0; ks < 4; ++ks) cf[ks] = *(const i32x4*)(lds + L_C8 + off_c8(r31, 2 * ks + hi));
          i32x16 X, Y; float sa0 = 0.f, sa1 = 0.f, kvs = 0.f;
#define FMAC1(S, A) asm("v_fmac_f32 %0, %1, %1" : "+v"(S) : "v"(A))
#define SSQ1(D, G) do { const float a0_ = (float)D[4 * G], a1_ = (float)D[4 * G + 1], a2_ = (float)D[4 * G + 2], a3_ = (float)D[4 * G + 3]; FMAC1(sa0, a0_); FMAC1(sa1, a1_); FMAC1(sa0, a2_); FMAC1(sa1, a3_); } while (0)
#define HCHUNK(KS, JB, DN, HASPREV, DP, RELOAD, NEXTOFF) do { \
            DN = __builtin_amdgcn_mfma_i32_32x32x32_i8(wk8[JB][KS], cf[KS], DN, 0, 0, 0); \
            if (RELOAD) cf[KS] = *(const i32x4*)(lds + L_C8 + (NEXTOFF)); \
            if (HASPREV) { SSQ1(DP, KS); } __builtin_amdgcn_sched_barrier(0); } while (0)
#define NFIN(KP) do { float ss = sa0 + sa1; \
            { auto rr = __builtin_amdgcn_permlane32_swap(__float_as_uint(ss), __float_as_uint(ss), false, false); ss = __uint_as_float(rr[0]) + __uint_as_float(rr[1]); } \
            const float dq_ = kvs * winv; rtab[h * 128 + 32 * (KP) + r31] = __builtin_amdgcn_rsqf(ss * (dq_ * dq_) * (1.0f / 64.0f) + EPSN); } while (0)
#define HBLK(K2, JB, DN, HASPREV, DP, NEWSQ, DOFIN, FINKP) do { DN = (i32x16){}; \
            if (NEWSQ) { sa0 = 0.f; sa1 = 0.f; } if (DOFIN) kvs = kiv[32 * (FINKP) + r31]; \
            HCHUNK(0, JB, DN, HASPREV, DP, (JB == 1 && K2 < 3), off_c8(32 * ((K2) + 1) + r31, 0 + hi)); \
            HCHUNK(1, JB, DN, HASPREV, DP, (JB == 1 && K2 < 3), off_c8(32 * ((K2) + 1) + r31, 2 + hi)); \
            HCHUNK(2, JB, DN, HASPREV, DP, (JB == 1 && K2 < 3), off_c8(32 * ((K2) + 1) + r31, 4 + hi)); \
            HCHUNK(3, JB, DN, HASPREV, DP, (JB == 1 && K2 < 3), off_c8(32 * ((K2) + 1) + r31, 6 + hi)); \
            if (DOFIN) { NFIN(FINKP); } } while (0)
          HBLK(0, 0, X, 0, Y, 0, 0, 0);
          HBLK(0, 1, Y, 1, X, 1, 0, 0);
          HBLK(1, 0, X, 1, Y, 0, 1, 0);
          HBLK(1, 1, Y, 1, X, 1, 0, 0);
          HBLK(2, 0, X, 1, Y, 0, 1, 1);
          HBLK(2, 1, Y, 1, X, 1, 0, 0);
          HBLK(3, 0, X, 1, Y, 0, 1, 2);
          HBLK(3, 1, Y, 1, X, 1, 0, 0);
          kvs = kiv[96 + r31];
          SSQ1(Y, 0); SSQ1(Y, 1); SSQ1(Y, 2); SSQ1(Y, 3);
          NFIN(3);
#undef HBLK
#undef NFIN
#undef HCHUNK
#undef SSQ1
#undef FMAC1
        }
        DBAR();
        if (pg + 1 < NPG) R_LOAD(pg + 1);
        f32x16 sn = {};
        { bf16x8 cfA = *(const bf16x8*)(Cb + off_b(32 * kb + r31, hi)), qfA = *(const bf16x8*)(lds + L_QA + off_b(32 * rb + r31, hi)), cfB, qfB;
#pragma unroll
          for (int ks = 0; ks < 8; ks += 2) {
              cfB = *(const bf16x8*)(Cb + off_b(32 * kb + r31, 2 * (ks + 1) + hi)); qfB = *(const bf16x8*)(lds + L_QA + off_b(32 * rb + r31, 2 * (ks + 1) + hi)); __builtin_amdgcn_sched_barrier(0);
              sn = __builtin_amdgcn_mfma_f32_32x32x16_bf16(cfA, qfA, sn, 0, 0, 0); __builtin_amdgcn_sched_barrier(0);
              if (ks + 2 < 8) { cfA = *(const bf16x8*)(Cb + off_b(32 * kb + r31, 2 * (ks + 2) + hi)); qfA = *(const bf16x8*)(lds + L_QA + off_b(32 * rb + r31, 2 * (ks + 2) + hi)); } __builtin_amdgcn_sched_barrier(0);
              sn = __builtin_amdgcn_mfma_f32_32x32x16_bf16(cfB, qfB, sn, 0, 0, 0); __builtin_amdgcn_sched_barrier(0); } }
#pragma unroll
        for (int q = 0; q < 4; ++q) { const f32x4 rv = *(const f32x4*)(rtab + hh * 128 + 32 * kb + 8 * q + 4 * hi);
#pragma unroll
            for (int e = 0; e < 4; ++e) sn[4 * q + e] = sn[4 * q + e] * rv[e]; }
#pragma unroll
        for (int ks = 0; ks < 2; ++ks) { const bf16x8 rf = *(const bf16x8*)(Rb + (32 * kb + r31) * 64 + (2 * ks + hi) * 16); const bf16x8 qf = *(const bf16x8*)(lds + L_QR + (32 * rb + r31) * 64 + (2 * ks + hi) * 16);
            sn = __builtin_amdgcn_mfma_f32_32x32x16_bf16(rf, qf, sn, 0, 0, 0); }
        float pmax = sn[0];
#pragma unroll
        for (int r = 1; r < 16; ++r) pmax = fmaxf(pmax, sn[r]);
        { auto rr = __builtin_amdgcn_permlane32_swap(__float_as_uint(pmax), __float_as_uint(pmax), false, false); pmax = fmaxf(__uint_as_float(rr[0]), __uint_as_float(rr[1])); }
        float mn, alpha;
        if (__all((pmax - m_reg) <= THR)) { mn = m_reg; alpha = 1.f; } else { mn = fmaxf(m_reg, pmax); alpha = __builtin_amdgcn_exp2f(m_reg - mn); m_reg = mn; }
        float ps = 0.f;
#pragma unroll
        for (int r = 0; r < 16; ++r) { sn[r] = __builtin_amdgcn_exp2f(sn[r] - mn); ps += sn[r]; }
        { auto rr = __builtin_amdgcn_permlane32_swap(__float_as_uint(ps), __float_as_uint(ps), false, false); ps = __uint_as_float(rr[0]) + __uint_as_float(rr[1]); }
        l_reg = l_reg * alpha + ps;
        bf16x8 pa0, pa1;
#define PK4(P, B_, OUT) do { unsigned a0 = cvtpk(P[B_+0], P[B_+1]), a1 = cvtpk(P[B_+2], P[B_+3]); unsigned b0 = cvtpk(P[B_+4], P[B_+5]), b1 = cvtpk(P[B_+6], P[B_+7]); \
        auto r0 = __builtin_amdgcn_permlane32_swap(a0, b0, false, false); auto r1 = __builtin_amdgcn_permlane32_swap(a1, b1, false, false); \
        u32x4 w = {r0[0], r1[0], r0[1], r1[1]}; OUT = *reinterpret_cast<bf16x8*>(&w); } while (0)
        PK4(sn, 0, pa0); PK4(sn, 8, pa1);
#undef PK4
        if (__any(alpha < 1.f)) { if (hi == 0) al[r31] = alpha; asm volatile("s_waitcnt lgkmcnt(0)" ::: "memory");
#pragma unroll
            for (int cb = 0; cb < 4; ++cb)
#pragma unroll
                for (int r = 0; r < 16; ++r) O[cb][r] *= al[crow(r, hi)]; }
        { const unsigned cbase = (unsigned)(uintptr_t)Cb;
#pragma unroll 1
          for (int s2 = 0; s2 < 2; ++s2) { s16x4 lo[4], hi4[4];
              unsigned a0[4], a1[4];
#pragma unroll
              for (int cb = 0; cb < 4; ++cb) { a0[cb] = cbase + off_b(32 * kb + 16 * s2 + 8 * hi + q_, 4 * cb + 2 * blk_ + (p_ >> 1)) + 8 * (p_ & 1);
                  a1[cb] = cbase + off_b(32 * kb + 16 * s2 + 8 * hi + 4 + q_, 4 * cb + 2 * blk_ + (p_ >> 1)) + 8 * (p_ & 1); }
              asm volatile("ds_read_b64_tr_b16 %0, %8\n\tds_read_b64_tr_b16 %1, %9\n\tds_read_b64_tr_b16 %2, %10\n\tds_read_b64_tr_b16 %3, %11\n\t"
                           "ds_read_b64_tr_b16 %4, %12\n\tds_read_b64_tr_b16 %5, %13\n\tds_read_b64_tr_b16 %6, %14\n\tds_read_b64_tr_b16 %7, %15\n\ts_waitcnt lgkmcnt(0)"
                           : "=&v"(lo[0]), "=&v"(hi4[0]), "=&v"(lo[1]), "=&v"(hi4[1]), "=&v"(lo[2]), "=&v"(hi4[2]), "=&v"(lo[3]), "=&v"(hi4[3])
                           : "v"(a0[0]), "v"(a1[0]), "v"(a0[1]), "v"(a1[1]), "v"(a0[2]), "v"(a1[2]), "v"(a0[3]), "v"(a1[3]) : "memory");
              __builtin_amdgcn_sched_barrier(0);
              const bf16x8 pa = s2 == 0 ? pa0 : pa1;
#pragma unroll
              for (int cb = 0; cb < 4; ++cb) { const bf16x8 bfr = (bf16x8){lo[cb][0], lo[cb][1], lo[cb][2], lo[cb][3], hi4[cb][0], hi4[cb][1], hi4[cb][2], hi4[cb][3]};
                  O[cb] = __builtin_amdgcn_mfma_f32_32x32x16_bf16(pa, bfr, O[cb], 0, 0, 0); } } }
        asm volatile("s_waitcnt vmcnt(0)" ::: "memory"); DBAR();
        if (pg + 1 < NPG) PAGE_CONVERT();
        DBAR();
    }
#undef PAGE_LOAD
#undef R_LOAD
#undef PAGE_CONVERT
    float* ML = (float*)(lds + L_ML);
    float* OB = (float*)lds;
    if (hi == 0) { ML[(wave * 32 + r31) * 2] = m_reg; ML[(wave * 32 + r31) * 2 + 1] = l_reg; }
    DBAR();
    float fsc[16];
#pragma unroll
    for (int r = 0; r < 16; ++r) { const int row = crow(r, hi); float M = ML[((rb * 4 + 0) * 32 + row) * 2];
#pragma unroll
        for (int k2 = 1; k2 < 4; ++k2) M = fmaxf(M, ML[((rb * 4 + k2) * 32 + row) * 2]);
        fsc[r] = __builtin_amdgcn_exp2f(ML[((rb * 4 + kb) * 32 + row) * 2] - M); }
    { float* OW = (float*)lds + wave * 4096;
#pragma unroll
      for (int cb = 0; cb < 4; ++cb)
#pragma unroll
          for (int r = 0; r < 16; ++r) OW[crow(r, hi) * 128 + cb * 32 + r31] = O[cb][r] * fsc[r]; }
    DBAR();
    float* const partG = (float*)(ws + WS_PART) + ((size_t)(bs * 8 + grp) * 64) * 132;
    float* const pairT = (float*)(ws + WS_G) + ((size_t)((bs & 3) * 8 + grp) * 2 * 64) * 132;
    { float* part = half < 0 ? partG : pairT + (size_t)half * 64 * 132; const float* OWs = (const float*)lds;
#pragma unroll 4
      for (int i = tid; i < 64 * 32; i += 512) { const int row = i >> 5, c4 = (i & 31) * 4, rbb = row >> 5, rr = row & 31; const float* p0 = OWs + (size_t)(rbb * 4) * 4096 + rr * 128 + c4;
          const f32x4 v = ((*(const f32x4*)p0 + *(const f32x4*)(p0 + 4096)) + *(const f32x4*)(p0 + 2 * 4096)) + *(const f32x4*)(p0 + 3 * 4096);
          *(f32x4*)(part + row * 132 + 4 + c4) = v; }
      if (tid < 64) { const int row = tid, rbb = row >> 5, rr = row & 31; float M = ML[((rbb * 4) * 32 + rr) * 2];
#pragma unroll
          for (int k2 = 1; k2 < 4; ++k2) M = fmaxf(M, ML[((rbb * 4 + k2) * 32 + rr) * 2]);
          float L = 0.f;
#pragma unroll
          for (int k2 = 0; k2 < 4; ++k2) L += ML[((rbb * 4 + k2) * 32 + rr) * 2 + 1] * __builtin_amdgcn_exp2f(ML[((rbb * 4 + k2) * 32 + rr) * 2] - M);
          part[row * 132] = M; part[row * 132 + 1] = L; } }
    asm volatile("s_waitcnt vmcnt(0)" ::: "memory");
    __syncthreads();
    unsigned* flagw = (unsigned*)(lds + L_ML);
    if (half >= 0) {
        if (tid == 0) { __builtin_amdgcn_fence(__ATOMIC_RELEASE, "agent"); asm volatile("s_waitcnt vmcnt(0)" ::: "memory");
            flagw[0] = __hip_atomic_fetch_add((unsigned*)(ws + WS_CTL) + CW_DCNT + 64 * bs + 16 + grp, 1u, __ATOMIC_RELAXED, __HIP_MEMORY_SCOPE_AGENT); }
        __syncthreads();
        const bool second = flagw[0] == 1u;
        __syncthreads();
        if (!second) return;
        if (tid == 0) { __builtin_amdgcn_fence(__ATOMIC_ACQUIRE, "agent"); asm volatile("s_waitcnt vmcnt(0)" ::: "memory"); }
        __syncthreads();
        const float* TA = pairT; const float* TB = pairT + 64 * 132;
#pragma unroll 4
        for (int i = tid; i < 64 * 32; i += 512) { const int row = i >> 5, c4 = (i & 31) * 4;
            const float MA = TA[row * 132], MB = TB[row * 132], M = fmaxf(MA, MB), sA = __builtin_amdgcn_exp2f(MA - M), sB = __builtin_amdgcn_exp2f(MB - M);
            const f32x4 va = *(const f32x4*)(TA + row * 132 + 4 + c4), vb = *(const f32x4*)(TB + row * 132 + 4 + c4); f32x4 v;
#pragma unroll
            for (int e = 0; e < 4; ++e) v[e] = __fadd_rn(__fmul_rn(va[e], sA), __fmul_rn(vb[e], sB));
            *(f32x4*)(partG + row * 132 + 4 + c4) = v;
            if (c4 == 0) { partG[row * 132] = M; partG[row * 132 + 1] = __fadd_rn(__fmul_rn(TA[row * 132 + 1], sA), __fmul_rn(TB[row * 132 + 1], sB)); } }
        asm volatile("s_waitcnt vmcnt(0)" ::: "memory");
        __syncthreads();
    }
    if (tid == 0) { __builtin_amdgcn_fence(__ATOMIC_RELEASE, "agent"); asm volatile("s_waitcnt vmcnt(0)" ::: "memory");
        flagw[0] = __hip_atomic_fetch_add((unsigned*)(ws + WS_CTL) + CW_DCNT + 64 * bs, 1u, __ATOMIC_RELAXED, __HIP_MEMORY_SCOPE_AGENT); }
    __syncthreads();
    const bool lastone = flagw[0] == 7u;
    __syncthreads();
    if (lastone) {
        if (tid == 0) { __builtin_amdgcn_fence(__ATOMIC_ACQUIRE, "agent"); asm volatile("s_waitcnt vmcnt(0)" ::: "memory"); }
        __syncthreads();
        combine(a, lds, bs, wave, lane);
        __syncthreads();
    }
}
#undef DBAR
}
__device__ __forceinline__ void post_tokens(const Args& a, int gw, int NGW, int lane_in) {
    unsigned char* ws = a.ws; int ln = lane_id(); asm volatile("" : "+v"(ln)); (void)lane_in; const int lane = ln;
    const bf16* U = (const bf16*)(ws + WS_U); const f32x2* ROPE = (const f32x2*)(ws + WS_ROPE); bf16* KM = (bf16*)(ws + WS_KM);
    const float* rsqkv = (const float*)(ws + WS_CTL) + CW_RSQKV; const float* rsqkr = (const float*)(ws + WS_CTL) + CW_RSQKR;
    const float* g_kva = (const float*)a.in[18]; const float* g_kr = (const float*)a.in[19];
    const f32x2 gk = *(const f32x2*)(g_kva + 2 * lane); const float gr = g_kr[lane & 31];
#pragma unroll 1
    for (int m0 = gw; m0 < MT; m0 += 4 * NGW) {
        unsigned raw[4]; float xr[4], sv[4], sr[4]; f32x2 cr[4];
#pragma unroll
        for (int i = 0; i < 4; ++i) { const int m = m0 + i * NGW; const bool ok = m < MT; const int mm = ok ? m : gw; const bf16* Urow = U + (size_t)mm * NU;
            raw[i] = *(const unsigned*)(Urow + U_MKV + 2 * lane); xr[i] = bf1(Urow[U_MKR + (lane & 31)]); sv[i] = rsqkv[mm]; sr[i] = rsqkr[mm];
            const int pidx = (mm < MP) ? (mm & 2047) : 2048 + ((mm - MP) & 7); cr[i] = ROPE[pidx * 16 + (lane & 15)]; }
#pragma unroll
        for (int i = 0; i < 4; ++i) { const int m = m0 + i * NGW; if (m < MT) {
            const float rs = __builtin_amdgcn_rsqf(sv[i] * (1.0f / 128.0f) + EPSN), rr = __builtin_amdgcn_rsqf(sr[i] * (1.0f / 32.0f) + EPSN);
            float* ck = (m < MP) ? a.out + O_CKVP + (size_t)m * 128 : a.out + O_CKVS + (size_t)(m - MP) * 128;
            *(f32x2*)(ck + 2 * lane) = (f32x2){blo(raw[i]) * rs * gk.x, bhi(raw[i]) * rs * gk.y};
            const float x = xr[i] * rr * gr, y = __shfl_xor(x, 16); const f32x2 c = cr[i];
            const float o = (lane & 16) ? (x * c.x + y * c.y) : (x * c.x - y * c.y);
            if (lane < 32) { float* kr = (m < MP) ? a.out + O_KRP + (size_t)m * 32 : a.out + O_KRS + (size_t)(m - MP) * 32; kr[lane] = o; }
            const int hh = lane >> 3, part = lane & 7;
            const float o0 = __shfl(o, 4 * part), o1 = __shfl(o, 4 * part + 1), o2 = __shfl(o, 4 * part + 2), o3 = __shfl(o, 4 * part + 3);
            u32x2 w; w.x = pk2(o0, o1); w.y = pk2(o2, o3); *(u32x2*)(KM + ((size_t)m * 8 + hh) * 96 + 64 + 4 * part) = w; } }
    }
}
namespace gla {
typedef short bf16x8 __attribute__((ext_vector_type(8)));
typedef float f32x16 __attribute__((ext_vector_type(16)));
typedef unsigned u32x4 __attribute__((ext_vector_type(4)));
__device__ __forceinline__ unsigned cvtpk(float lo, float hi) { unsigned r; asm volatile("v_cvt_pk_bf16_f32 %0, %1, %2" : "=v"(r) : "v"(lo), "v"(hi)); return r; }
__device__ __forceinline__ int crow(int r, int hi) { return (r & 3) + 8 * (r >> 2) + 4 * hi; }
__device__ __forceinline__ void prep_tile(const Args& a, char* lds, int tileidx, const int wave_s) {
    unsigned char* ws = a.ws; int tid_o = wave_s * 64 + lane_id(); asm volatile("" : "+v"(tid_o)); const int tid = tid_o, c = tid & 255, h = c >> 6, dk = c & 63;
    const int half = wave_s >> 2;
    const bf16* U = (const bf16*)(ws + WS_U); const float* w_a2 = (const float*)a.in[11]; const float* b_a = (const float*)a.in[12];
    bf16* QDEC = (bf16*)(ws + WS_QDEC); bf16* KINV = (bf16*)(ws + WS_KINV); bf16* KENDT = (bf16*)(ws + WS_KENDT); bf16* VT = (bf16*)(ws + WS_VT); float* ELAST = (float*)(ws + WS_ELAST);
    const int m0 = tileidx * 64 + half * 32; const bool is_p = m0 < MP;
    float* gaf = (float*)lds;
    __syncthreads();
    if (tid < 128) { const int t = tid >> 1, hh = tid & 1; const v4u g = *(const v4u*)(U + (size_t)(tileidx * 64 + t) * NU + U_GA + 8 * hh);
        *(f32x4*)(gaf + t * 16 + 8 * hh) = (f32x4){blo(g.x), bhi(g.x), blo(g.y), bhi(g.y)}; *(f32x4*)(gaf + t * 16 + 8 * hh + 4) = (f32x4){blo(g.z), bhi(g.z), blo(g.w), bhi(g.w)}; }
    float wa[16];
#pragma unroll
    for (int r = 0; r < 16; ++r) wa[r] = w_a2[r * 256 + c];
    const float ba = b_a[c];
    __syncthreads();
    float la[32];
#pragma unroll
    for (int t = 0; t < 32; ++t) { const float* gp = gaf + (half * 32 + t) * 16; const f32x4 g0 = *(const f32x4*)gp, g1 = *(const f32x4*)(gp + 4), g2 = *(const f32x4*)(gp + 8), g3 = *(const f32x4*)(gp + 12);
        const float z = ba + (g0[0] * wa[0] + g0[1] * wa[1] + g0[2] * wa[2] + g0[3] * wa[3]) + (g1[0] * wa[4] + g1[1] * wa[5] + g1[2] * wa[6] + g1[3] * wa[7])
                           + (g2[0] * wa[8] + g2[1] * wa[9] + g2[2] * wa[10] + g2[3] * wa[11]) + (g3[0] * wa[12] + g3[1] * wa[13] + g3[2] * wa[14] + g3[3] * wa[15]);
        la[t] = (fminf(z, 0.f) - __logf(1.0f + __expf(-fabsf(z)))) * (1.0f / 16.0f); }
#define PROC_SEG(T0, NG) do { const int ms = m0 + (T0); const int cid = is_p ? (ms >> 5) : 512 + ((ms - MP) >> 3); \
        float blast = 0.f; _Pragma("unroll") for (int t = 0; t < 8 * (NG); ++t) blast += la[(T0) + t]; \
        bf16* kt = KENDT + ((size_t)(cid * 4 + h) * 2 + (dk >> 5)) * 1024 + (dk & 31) * 8; \
        const size_t fbase = (((size_t)(cid * 4 + h) * 4 + (dk >> 4)) * 2 + ((dk >> 3) & 1)) * 256 + (dk & 7); \
        float b = 0.f; \
        _Pragma("unroll") for (int g = 0; g < (NG); ++g) { unsigned short qv[8], kv[8]; \
            _Pragma("unroll") for (int j = 0; j < 8; ++j) { const size_t m = (size_t)(ms + g * 8 + j); qv[j] = U[m * NU + U_GQ + c]; kv[j] = U[m * NU + U_GK + c]; } \
            unsigned pk[4]; \
            _Pragma("unroll") for (int j = 0; j < 8; j += 2) { float ke[2]; \
                _Pragma("unroll") for (int jj = 0; jj < 2; ++jj) { b += la[(T0) + g * 8 + j + jj]; const float eb = __expf(b), q = bf1(qv[j + jj]), k = bf1(kv[j + jj]); \
                    const size_t fo = fbase + (size_t)(g * 8 + j + jj) * 8; \
                    QDEC[fo] = (bf16)f2bf(q * 0.125f * eb); KINV[fo] = (bf16)f2bf(k * __builtin_amdgcn_rcpf(eb)); ke[jj] = k * __expf(blast - b); } \
                pk[j >> 1] = cvtpk(ke[0], ke[1]); } \
            *(v4u*)(kt + g * 256) = (v4u){pk[0], pk[1], pk[2], pk[3]}; } \
        if ((NG) == 1) { *(v4u*)(kt + 256) = (v4u){0u, 0u, 0u, 0u}; *(v4u*)(kt + 512) = (v4u){0u, 0u, 0u, 0u}; *(v4u*)(kt + 768) = (v4u){0u, 0u, 0u, 0u}; } \
        ELAST[(size_t)cid * 256 + c] = __expf(blast); } while (0)
    if (is_p) { PROC_SEG(0, 4); } else { PROC_SEG(0, 1); PROC_SEG(8, 1); PROC_SEG(16, 1); PROC_SEG(24, 1); }
#undef PROC_SEG
    bf16* GGF = (bf16*)(ws + WS_GGF);
    const int nseg = is_p ? 1 : 4, ng = is_p ? 4 : 1;
#pragma unroll 1
    for (int cc = 0; cc < 2; ++cc) { const int col = (tid & 255) + 256 * cc, hv = col >> 7, dv = col & 127, dvl = dv & 31;
        for (int seg = 0; seg < nseg; ++seg) { const int ms = m0 + seg * 8 * ng; const int cid = is_p ? (ms >> 5) : 512 + ((ms - MP) >> 3);
            bf16* vt = VT + (((size_t)(cid * 4 + hv) * 4 + (dv >> 5)) * 4) * 256 + dvl * 8;
            bf16* gf = GGF + (((((size_t)(cid * 4 + hv) * 4 + (dv >> 5)) * 4 + (dvl >> 3)) * 2 + ((dvl >> 2) & 1)) * 32) * 4 + (dvl & 3);
            for (int g = 0; g < ng; ++g) { unsigned short e[8], gg[8];
#pragma unroll
                for (int j = 0; j < 8; ++j) { e[j] = U[(size_t)(ms + g * 8 + j) * NU + U_GV + col]; gg[j] = U[(size_t)(ms + g * 8 + j) * NU + U_GG + col]; }
#pragma unroll
                for (int j = 0; j < 8; ++j) gf[(g * 8 + j) * 4] = gg[j];
                *(v4u*)(vt + g * 256) = (v4u){(unsigned)e[0] | ((unsigned)e[1] << 16), (unsigned)e[2] | ((unsigned)e[3] << 16), (unsigned)e[4] | ((unsigned)e[5] << 16), (unsigned)e[6] | ((unsigned)e[7] << 16)}; }
            if (!is_p) { *(v4u*)(vt + 256) = (v4u){0u, 0u, 0u, 0u}; *(v4u*)(vt + 512) = (v4u){0u, 0u, 0u, 0u}; *(v4u*)(vt + 768) = (v4u){0u, 0u, 0u, 0u}; } } }
    __syncthreads();
}
__device__ __forceinline__ void prep_tile_p(const Args& a, char* lds, LAS unsigned char* ldsl, int tileidx, const int wave_s) {
    typedef __attribute__((address_space(3))) unsigned lds_u32;
    constexpr int RS = 1040, RH = RS / 2, S1 = 4096, S2 = 4096 + 64 * RS;
    unsigned char* ws = a.ws; int tid_o = wave_s * 64 + lane_id(); asm volatile("" : "+v"(tid_o)); const int tid = tid_o, lane = tid & 63, c = tid & 255, h = c >> 6, dk = c & 63;
    const int half = wave_s >> 2, cid = tileidx * 2 + half;
    const bf16* U = (const bf16*)(ws + WS_U); const float* w_a2 = (const float*)a.in[11]; const float* b_a = (const float*)a.in[12];
    bf16* QDEC = (bf16*)(ws + WS_QDEC); bf16* KINV = (bf16*)(ws + WS_KINV); bf16* KENDT = (bf16*)(ws + WS_KENDT); bf16* VT = (bf16*)(ws + WS_VT); float* ELAST = (float*)(ws + WS_ELAST); bf16* GGF = (bf16*)(ws + WS_GGF);
    float* gaf = (float*)lds;
    __syncthreads();
    const char* rowb = (const char*)(U + (size_t)(tileidx * 64 + wave_s * 8) * NU) + lane * 16;
#pragma unroll
    for (int i = 0; i < 8; ++i) { __builtin_amdgcn_global_load_lds((const unsigned*)(rowb + (size_t)i * NU * 2), (lds_u32*)(ldsl + S1 + (wave_s * 8 + i) * RS), 16, 0, 0);
                                  __builtin_amdgcn_global_load_lds((const unsigned*)(rowb + (size_t)i * NU * 2 + 1024), (lds_u32*)(ldsl + S2 + (wave_s * 8 + i) * RS), 16, 0, 0); }
    if (tid < 128) { const int t = tid >> 1, hh = tid & 1; const v4u g = *(const v4u*)(U + (size_t)(tileidx * 64 + t) * NU + U_GA + 8 * hh);
        *(f32x4*)(gaf + t * 16 + 8 * hh) = (f32x4){blo(g.x), bhi(g.x), blo(g.y), bhi(g.y)}; *(f32x4*)(gaf + t * 16 + 8 * hh + 4) = (f32x4){blo(g.z), bhi(g.z), blo(g.w), bhi(g.w)}; }
    float wa[16];
#pragma unroll
    for (int r = 0; r < 16; ++r) wa[r] = w_a2[r * 256 + c];
    const float ba = b_a[c];
    __syncthreads();
    float la[32];
#pragma unroll
    for (int t = 0; t < 32; ++t) { const float* gp = gaf + (half * 32 + t) * 16; const f32x4 g0 = *(const f32x4*)gp, g1 = *(const f32x4*)(gp + 4), g2 = *(const f32x4*)(gp + 8), g3 = *(const f32x4*)(gp + 12);
        const float z = ba + (g0[0] * wa[0] + g0[1] * wa[1] + g0[2] * wa[2] + g0[3] * wa[3]) + (g1[0] * wa[4] + g1[1] * wa[5] + g1[2] * wa[6] + g1[3] * wa[7])
                           + (g2[0] * wa[8] + g2[1] * wa[9] + g2[2] * wa[10] + g2[3] * wa[11]) + (g3[0] * wa[12] + g3[1] * wa[13] + g3[2] * wa[14] + g3[3] * wa[15]);
        la[t] = (fminf(z, 0.f) - __logf(1.0f + __expf(-fabsf(z)))) * (1.0f / 16.0f); }
    asm volatile("s_waitcnt vmcnt(0)" ::: "memory");
    __syncthreads();
    { unsigned short* s1 = (unsigned short*)(lds + S1) + (half * 32) * RH + c;
      float blast = 0.f;
#pragma unroll
      for (int t = 0; t < 32; ++t) blast += la[t];
      bf16* kt = KENDT + ((size_t)(cid * 4 + h) * 2 + (dk >> 5)) * 1024 + (dk & 31) * 8;
      float b = 0.f;
#pragma unroll
      for (int g = 0; g < 4; ++g) { unsigned pk[4];
#pragma unroll
          for (int j = 0; j < 8; j += 2) { float ke[2];
#pragma unroll
              for (int jj = 0; jj < 2; ++jj) { const int t = g * 8 + j + jj; b += la[t]; const float eb = __expf(b), q = bf1(s1[t * RH]), k = bf1(s1[t * RH + 256]);
                  s1[t * RH] = (unsigned short)f2bf(q * 0.125f * eb); s1[t * RH + 256] = (unsigned short)f2bf(k * __builtin_amdgcn_rcpf(eb)); ke[jj] = k * __expf(blast - b); }
              pk[j >> 1] = cvtpk(ke[0], ke[1]); }
          *(v4u*)(kt + g * 256) = (v4u){pk[0], pk[1], pk[2], pk[3]}; }
      ELAST[(size_t)cid * 256 + c] = __expf(blast); }
    __syncthreads();
#pragma unroll
    for (int i = 0; i < 8; ++i) { const int u = i * 512 + tid, arr = u >> 11, r = u & 2047, hf = r >> 10, hh = (r >> 8) & 3, g8 = (r >> 5) & 7, t = r & 31;
        const v4u val = *(const v4u*)(lds + S1 + (hf * 32 + t) * RS + arr * 512 + (hh * 64 + g8 * 8) * 2);
        bf16* dst = (arr ? KINV : QDEC) + ((size_t)((tileidx * 2 + hf) * 4 + hh) * 8 + g8) * 256 + t * 8;
        *(v4u*)dst = val; }
    __syncthreads();
#pragma unroll
    for (int i = 0; i < 8; ++i) __builtin_amdgcn_global_load_lds((const unsigned*)(rowb + (size_t)i * NU * 2 + 2048), (lds_u32*)(ldsl + S1 + (wave_s * 8 + i) * RS), 16, 0, 0);
#pragma unroll
    for (int cc = 0; cc < 2; ++cc) { const int col = c + 256 * cc, hv = col >> 7, dv = col & 127, dvl = dv & 31;
        bf16* vt = VT + (((size_t)(cid * 4 + hv) * 4 + (dv >> 5)) * 4) * 256 + dvl * 8;
        const unsigned short* s2 = (const unsigned short*)(lds + S2) + (half * 32) * RH + col;
#pragma unroll
        for (int g = 0; g < 4; ++g) { unsigned e[8];
#pragma unroll
            for (int j = 0; j < 8; ++j) e[j] = s2[(g * 8 + j) * RH];
            *(v4u*)(vt + g * 256) = (v4u){e[0] | (e[1] << 16), e[2] | (e[3] << 16), e[4] | (e[5] << 16), e[6] | (e[7] << 16)}; } }
    asm volatile("s_waitcnt vmcnt(0)" ::: "memory");
    __syncthreads();
#pragma unroll
    for (int i = 0; i < 8; ++i) { const int u = i * 512 + tid, tp = u & 15, quad = (u >> 4) & 127, hf = u >> 11, hv = quad >> 5, dvb = (quad & 31) >> 3, q = (quad & 7) >> 1, hi = quad & 1;
        const u32x2 x0 = *(const u32x2*)(lds + S1 + (hf * 32 + 2 * tp) * RS + quad * 8), x1 = *(const u32x2*)(lds + S1 + (hf * 32 + 2 * tp + 1) * RS + quad * 8);
        bf16* dst = GGF + ((((((size_t)((tileidx * 2 + hf) * 4 + hv) * 4 + dvb) * 4 + q) * 2 + hi) * 32) + 2 * tp) * 4;
        *(v4u*)dst = (v4u){x0.x, x0.y, x1.x, x1.y}; }
    __syncthreads();
}
#define GBAR() asm volatile("s_waitcnt lgkmcnt(0)\n\ts_barrier" ::: "memory")
__device__ __forceinline__ void scan_unit(const Args& a, char* lds, int unit, int wave, int lane_in) {
    unsigned char* ws = a.ws; int ln = lane_id(); asm volatile("" : "+v"(ln)); (void)lane_in; const int lane = ln, r31 = lane & 31, hi = lane >> 5, sub = wave >> 2, dvb = wave & 3;
    const bool is_p = unit < 32; const int item = is_p ? unit : unit - 32; const int seq = item >> 2, h = item & 3;
    const int nch = is_p ? 64 : 1, tvalid = is_p ? 32 : 8;
    const size_t row0 = is_p ? (size_t)seq * 2048 : (size_t)MP + seq * 8; const int cid0 = is_p ? seq * 64 : 512 + seq;
    const bf16* U = (const bf16*)(ws + WS_U); const bf16* QDEC = (const bf16*)(ws + WS_QDEC); const bf16* KINV = (const bf16*)(ws + WS_KINV); const bf16* KENDT = (const bf16*)(ws + WS_KENDT); const bf16* VT = (const bf16*)(ws + WS_VT);
    const float* ELAST = (const float*)(ws + WS_ELAST); bf16* AO = (bf16*)(ws + WS_AO); const float* g_out = (const float*)a.in[13]; const bf16* GGF = (const bf16*)(ws + WS_GGF);
    if (sub) {
        const int hl = (wave & 3) * 64 + lane; const size_t ch0 = (size_t)cid0 * 4 + h;
        const bf16* p = KINV + ch0 * 2048; size_t stride = 0;
        if (hl < 32) { p = KINV + ch0 * 2048 + hl * 64; stride = 8192; } else if (hl < 64) { p = QDEC + ch0 * 2048 + (hl - 32) * 64; stride = 8192; }
        else if (hl < 96) { p = KENDT + ch0 * 2048 + (hl - 64) * 64; stride = 8192; } else if (hl < 160) { p = VT + ch0 * 4096 + (hl - 96) * 64; stride = 16384; }
        else if (hl < 224) { p = GGF + ch0 * 4096 + (hl - 160) * 64; stride = 16384; }
        unsigned accp = 0u, v0 = 0u, v1 = 0u, v2 = 0u, v3 = 0u;
        if (1 < nch) v1 = *(const unsigned*)(p + 1 * stride);
        if (2 < nch) v2 = *(const unsigned*)(p + 2 * stride);
        if (3 < nch) v3 = *(const unsigned*)(p + 3 * stride);
        GBAR();
#pragma unroll 1
        for (int n = 0; n < nch; n += 4) {
#define PF(V, k_) do { if (n + (k_) < nch) { accp += V; if (n + (k_) + 4 < nch) V = *(const unsigned*)(p + (size_t)(n + (k_) + 4) * stride); GBAR(); } } while (0)
            PF(v0, 0); PF(v1, 1); PF(v2, 2); PF(v3, 3);
#undef PF
        }
        if (accp == 0x9e3779b9u) ((unsigned*)(ws + WS_PFSINK))[wave * 64 + lane] = accp;
        GBAR(); return; }
    f32x16 S[2];
    if (is_p) { S[0] = f32x16{}; S[1] = f32x16{}; }
    else { const float* s0 = (const float*)a.in[4] + ((size_t)seq * 4 + h) * 8192;
#pragma unroll
        for (int blk = 0; blk < 2; ++blk)
#pragma unroll
            for (int r = 0; r < 16; ++r) S[blk][r] = s0[(32 * blk + crow(r, hi)) * 128 + 32 * dvb + r31]; }
#define PK4(P, B_, OUT) do { unsigned a0 = cvtpk(P[B_+0], P[B_+1]), a1 = cvtpk(P[B_+2], P[B_+3]); unsigned b0 = cvtpk(P[B_+4], P[B_+5]), b1 = cvtpk(P[B_+6], P[B_+7]); \
        auto r0 = __builtin_amdgcn_permlane32_swap(a0, b0, false, false); auto r1 = __builtin_amdgcn_permlane32_swap(a1, b1, false, false); \
        u32x4 w = {r0[0], r1[0], r0[1], r1[1]}; OUT = *reinterpret_cast<bf16x8*>(&w); } while (0)
    f32x4 gout[4];
#pragma unroll
    for (int q = 0; q < 4; ++q) gout[q] = *(const f32x4*)(g_out + 32 * dvb + 8 * q + 4 * hi);
    float* ELT = (float*)(lds + 65536) + sub * 4096;
    float* SS = (float*)lds;
    { const int l4 = (wave & 3) * 64 + lane;
      for (int i = l4; i < nch * 16; i += 256) { const int n = i >> 4, q4 = (i & 15) * 4; *(f32x4*)(ELT + n * 64 + q4) = *(const f32x4*)(ELAST + (size_t)(cid0 + n) * 256 + h * 64 + q4); } }
    GBAR();
    bf16x8 kiA[4], qdA[4], vtA[2], keA[2][2], kiB[4], qdB[4], vtB[2], keB[2][2]; u32x2 ggA[4], ggB[4];
#define LOADQ(KI, QD, VTX, KE, GG, n_) do { const size_t ch_ = (size_t)(cid0 + (n_)) * 4 + h; \
        _Pragma("unroll") for (int ks = 0; ks < 4; ++ks) { KI[ks] = *(const bf16x8*)(KINV + (((ch_ * 4 + ks) * 2 + hi) * 32 + r31) * 8); QD[ks] = *(const bf16x8*)(QDEC + (((ch_ * 4 + ks) * 2 + hi) * 32 + r31) * 8); } \
        _Pragma("unroll") for (int ks = 0; ks < 2; ++ks) VTX[ks] = *(const bf16x8*)(VT + ((((ch_ * 4 + dvb) * 2 + ks) * 2 + hi) * 32 + r31) * 8); \
        _Pragma("unroll") for (int blk = 0; blk < 2; ++blk) _Pragma("unroll") for (int ks = 0; ks < 2; ++ks) KE[blk][ks] = *(const bf16x8*)(KENDT + ((((ch_ * 2 + blk) * 2 + ks) * 2 + hi) * 32 + r31) * 8); \
        _Pragma("unroll") for (int q = 0; q < 4; ++q) GG[q] = *(const u32x2*)(GGF + ((((ch_ * 4 + dvb) * 4 + q) * 2 + hi) * 32 + r31) * 4); } while (0)
#define BODY(KI, QD, VTX, KE, GG, KIN, QDN, VTN, KEN, GGN, n_) do { const int n = (n_); const size_t rb = row0 + 32 * (size_t)n; \
        if (n + 1 < nch) LOADQ(KIN, QDN, VTN, KEN, GGN, n + 1); \
        f32x16 X = {}; \
        _Pragma("unroll") for (int ks = 0; ks < 4; ++ks) X = __builtin_amdgcn_mfma_f32_32x32x16_bf16(KI[ks], QD[ks], X, 0, 0, 0); \
        _Pragma("unroll") for (int r = 0; r < 16; ++r) if (crow(r, hi) > r31) X[r] = 0.f; \
        bf16x8 xb0, xb1; PK4(X, 0, xb0); PK4(X, 8, xb1); \
        f32x16 o = {}; \
        o = __builtin_amdgcn_mfma_f32_32x32x16_bf16(VTX[0], xb0, o, 0, 0, 0); o = __builtin_amdgcn_mfma_f32_32x32x16_bf16(VTX[1], xb1, o, 0, 0, 0); \
        _Pragma("unroll") for (int blk = 0; blk < 2; ++blk) { bf16x8 sb0, sb1; PK4(S[blk], 0, sb0); PK4(S[blk], 8, sb1); \
            o = __builtin_amdgcn_mfma_f32_32x32x16_bf16(sb0, QD[2 * blk], o, 0, 0, 0); o = __builtin_amdgcn_mfma_f32_32x32x16_bf16(sb1, QD[2 * blk + 1], o, 0, 0, 0); } \
        _Pragma("unroll") for (int blk = 0; blk < 2; ++blk) { \
            _Pragma("unroll") for (int q = 0; q < 4; ++q) { const f32x4 e4 = *(const f32x4*)(ELT + n * 64 + 32 * blk + 8 * q + 4 * hi); \
                S[blk][4 * q] *= e4[0]; S[blk][4 * q + 1] *= e4[1]; S[blk][4 * q + 2] *= e4[2]; S[blk][4 * q + 3] *= e4[3]; } \
            S[blk] = __builtin_amdgcn_mfma_f32_32x32x16_bf16(KE[blk][0], VTX[0], S[blk], 0, 0, 0); S[blk] = __builtin_amdgcn_mfma_f32_32x32x16_bf16(KE[blk][1], VTX[1], S[blk], 0, 0, 0); } \
        float ss = 0.f; \
        _Pragma("unroll") for (int r = 0; r < 16; ++r) ss += o[r] * o[r]; \
        { auto rr = __builtin_amdgcn_permlane32_swap(__float_as_uint(ss), __float_as_uint(ss), false, false); ss = __uint_as_float(rr[0]) + __uint_as_float(rr[1]); } \
        float* ssl = SS + ((n & 1) * 2 + sub) * 128; \
        if (hi == 0) ssl[dvb * 32 + r31] = ss; \
        GBAR(); \
        const float tot = (ssl[r31] + ssl[32 + r31]) + (ssl[64 + r31] + ssl[96 + r31]); const float rn = __builtin_amdgcn_rsqf(tot * (1.0f / 128.0f) + EPSN); \
        if (r31 < tvalid) { bf16* ao = AO + (rb + r31) * 1024 + h * 128 + 32 * dvb + 4 * hi; \
            _Pragma("unroll") for (int q = 0; q < 4; ++q) { u32x2 w; \
                w.x = cvtpk(o[4 * q] * rn * gout[q][0] * silu_f(blo(GG[q].x)), o[4 * q + 1] * rn * gout[q][1] * silu_f(bhi(GG[q].x))); \
                w.y = cvtpk(o[4 * q + 2] * rn * gout[q][2] * silu_f(blo(GG[q].y)), o[4 * q + 3] * rn * gout[q][3] * silu_f(bhi(GG[q].y))); \
                *(u32x2*)(ao + 8 * q) = w; } } \
    } while (0)
    LOADQ(kiA, qdA, vtA, keA, ggA, 0);
#pragma unroll 1
    for (int n2 = 0; n2 < nch; n2 += 2) {
        BODY(kiA, qdA, vtA, keA, ggA, kiB, qdB, vtB, keB, ggB, n2);
        if (n2 + 1 < nch) BODY(kiB, qdB, vtB, keB, ggB, kiA, qdA, vtA, keA, ggA, n2 + 1);
    }
#undef LOADQ
#undef BODY
#undef PK4
    float* so = is_p ? a.out + O_GLAP + ((size_t)seq * 4 + h) * 8192 : a.out + O_GLAS + ((size_t)seq * 4 + h) * 8192;
#pragma unroll
    for (int blk = 0; blk < 2; ++blk)
#pragma unroll
        for (int r = 0; r < 16; ++r) so[(32 * blk + crow(r, hi)) * 128 + 32 * dvb + r31] = S[blk][r];
    GBAR();
}
#undef GBAR
}
namespace skinny {
typedef short bf16x8 __attribute__((ext_vector_type(8)));
typedef float f32x16 __attribute__((ext_vector_type(16)));
__device__ __forceinline__ int crow(int r, int hi) { return (r & 3) + 8 * (r >> 2) + 4 * hi; }
template <int K, class F>
__device__ __forceinline__ void run(char* lds, const bf16* A, const bf16* Bt, int N, int vcu, int G, int wave, int lane_in, const F& f) {
    int tid_o = wave * 64 + lane_id(); asm volatile("" : "+v"(tid_o)); const int tid = tid_o, lane = tid & 63, r31 = lane & 31, hi = lane >> 5; (void)lane_in;
    constexpr int KS = K / 8 / 16;
    float* red = (float*)lds;
    const int ntiles = 8 * (N / 32);
    for (int tile = vcu; tile < ntiles; tile += G) { const int rt = tile & 7, ct = tile >> 3;
        const bf16* ap = A + (size_t)(MP + 32 * rt + r31) * K + wave * (K / 8) + 8 * hi; const bf16* bp = Bt + (size_t)(32 * ct + r31) * K + wave * (K / 8) + 8 * hi;
        const int prow = MP + 32 * rt + (tid >> 4), pcol = 32 * ct + (tid & 15) * 2;
        const typename F::Pre pre = f.pre(prow, pcol);
        f32x16 acc = {};
#pragma unroll
        for (int ks = 0; ks < KS; ++ks) { const bf16x8 av = *(const bf16x8*)(ap + 16 * ks), bv = *(const bf16x8*)(bp + 16 * ks); acc = __builtin_amdgcn_mfma_f32_32x32x16_bf16(av, bv, acc, 0, 0, 0); }
#pragma unroll
        for (int r = 0; r < 16; ++r) red[(wave * 32 + crow(r, hi)) * 32 + r31] = acc[r];
        __syncthreads();
        { const int row = tid >> 4, col = (tid & 15) * 2; float v0 = 0.f, v1 = 0.f;
#pragma unroll
          for (int w = 0; w < 8; ++w) { const f32x2 p = *(const f32x2*)(red + (w * 32 + row) * 32 + col); v0 += p.x; v1 += p.y; }
          f(MP + 32 * rt + row, 32 * ct + col, v0, v1, pre); }
        __syncthreads();
    }
}
struct FScaleBf16 { bf16* O; int ldc; const float* rs; typedef float Pre;
    __device__ __forceinline__ Pre pre(int row, int) const { return rs ? rs[row] : 1.f; }
    __device__ __forceinline__ void operator()(int row, int col, float v0, float v1, Pre s) const { *(unsigned*)(O + (size_t)row * ldc + col) = pk2(v0 * s, v1 * s); } };
struct FU { bf16* O; const float* rs; float* rsqb;
    typedef float Pre;
    __device__ __forceinline__ Pre pre(int row, int) const { return rs[row]; }
    __device__ __forceinline__ void operator()(int row, int col, float v0, float v1, Pre s) const { v0 *= s; v1 *= s; *(unsigned*)(O + (size_t)row * 2048 + col) = pk2(v0, v1);
        if (col >= 1536 && col < 1952) { float ss = v0 * v0 + v1 * v1; ss += __shfl_xor(ss, 1); ss += __shfl_xor(ss, 2); ss += __shfl_xor(ss, 4); ss += __shfl_xor(ss, 8);
            const int seg = (col >= 1792) + (col >= 1920);
            if ((lane_id() & 15) == 0) atomicAdd(rsqb + seg * 16640 + row, ss); } } };
template <bool BF> struct FResid { const void* base; bf16* hb; float* rsq;
    typedef f32x2 Pre;
    __device__ __forceinline__ Pre pre(int row, int col) const { const size_t off = (size_t)row * 1024 + col;
        if (BF) { const unsigned bw = *(const unsigned*)((const bf16*)base + off); return (f32x2){blo(bw), bhi(bw)}; } else return *(const f32x2*)((const float*)base + off); }
    __device__ __forceinline__ void operator()(int row, int col, float v0, float v1, Pre b) const { const size_t off = (size_t)row * 1024 + col; const float o0 = b.x + v0, o1 = b.y + v1;
        *(unsigned*)(hb + off) = pk2(o0, o1);
        float ss = o0 * o0 + o1 * o1; ss += __shfl_xor(ss, 1); ss += __shfl_xor(ss, 2); ss += __shfl_xor(ss, 4); ss += __shfl_xor(ss, 8);
        if ((lane_id() & 15) == 0) atomicAdd(rsq + row, ss); } };
struct FPle { const bf16* h2; const bf16* PP; const float* rsq; float* out;
    struct Pre { unsigned hw, pw; float rq; };
    __device__ __forceinline__ Pre pre(int row, int col) const { const size_t off = (size_t)row * 1024 + col; Pre p; p.hw = *(const unsigned*)(h2 + off); p.pw = *(const unsigned*)(PP + off); p.rq = rsq[row]; return p; }
    __device__ __forceinline__ void operator()(int row, int col, float v0, float v1, const Pre& p) const { const size_t off = (size_t)row * 1024 + col; const float rs = __builtin_amdgcn_rsqf(p.rq * (1.0f / 1024.0f) + 1e-6f);
        const unsigned hw = p.hw; const f32x2 hv = {blo(hw), bhi(hw)}; const unsigned pw = p.pw;
        *(f32x2*)(out + off) = (f32x2){hv.x + blo(pw) / (1.0f + __expf(-v0 * rs)), hv.y + bhi(pw) / (1.0f + __expf(-v1 * rs))}; } };
}
#ifndef MK_PER_PHASE
#define MK_PER_PHASE 0
#endif
constexpr int N_PHASES = 10;
__global__ void __launch_bounds__(NWAVES * 64, 2) hymba_fwd(Args args) {
    extern __shared__ __attribute__((aligned(16))) unsigned char lds_raw[];
    LAS unsigned char* lds = (LAS unsigned char*)lds_raw;
    volatile LAS unsigned* MISC = (volatile LAS unsigned*)(lds + MISC_OFF);
    const int tid = threadIdx.x, lane = tid & 63, wave = __builtin_amdgcn_readfirstlane(tid >> 6);
    const int G = gridDim.x; const int bx = blockIdx.x; const int vcu = (G % 8 == 0) ? (bx % 8) * (G / 8) + bx / 8 : bx;
    const int gw = vcu * NWAVES + wave, NGW = G * NWAVES;
    unsigned char* ws = args.ws;
    gu32* ctl = (gu32*)(ws + WS_CTL);
    for (int u = tid; u < (LDS_BYTES - LDSCTL_OFF) / 4; u += NWAVES * 64) ((LAS unsigned*)(lds + LDSCTL_OFF))[u] = 0u;
    __syncthreads();
    XcdBarrier bar; bar.bar = (unsigned*)(ctl + CW_BAR); bar.x = 0; bar.st = nullptr;
    if (!MK_PER_PHASE) bar = xcd_barrier_post((unsigned*)(ctl + CW_BAR), MISC + 8);
    const int lo = args.ph_lo, hi = args.ph_hi;
#define IN(k) (lo <= (k) && (k) < hi)
#define SEAM(k) do { if (IN(k) && IN((k) + 1)) xcd_barrier(bar, wave); } while (0)
    float* rsq2 = (float*)(ctl + CW_RSQ2); float* rsq3 = (float*)(ctl + CW_RSQ3); float* rsqq = (float*)(ctl + CW_RSQQ); float* rsqkv = (float*)(ctl + CW_RSQKV); float* rsqkr = (float*)(ctl + CW_RSQKR);

    if (IN(0)) { prep_phase(args, lds, gw, NGW, wave, lane_id()); }
    SEAM(0);
    if (IN(1)) {
        { pg8::Gemm g{(const bf16*)(ws + WS_XB), (const bf16*)(ws + WS_WIN), MP, NU, DM}; pg8::StaticOrder S; S.init(MP, NU, G, bx);
          pg8::EpiU E{(bf16*)(ws + WS_U), (const float*)(ws + WS_RS1), rsqq, rsqkv, rsqkr};
          pg8::gemm_phase<pg8::EpiU, pg8::StaticOrder, true, true>(lds, g, S, E, wave); }
        skinny::run<1024>((char*)lds_raw, (const bf16*)(ws + WS_XB), (const bf16*)(ws + WS_WIN), NU, vcu, G, wave, 0, skinny::FU{(bf16*)(ws + WS_U), (const float*)(ws + WS_RS1), rsqq});
        skinny::run<256>((char*)lds_raw, (const bf16*)(ws + WS_PB), (const bf16*)(ws + WS_WPP), DM, vcu, G, wave, 0, skinny::FScaleBf16{(bf16*)(ws + WS_PP), DM, nullptr});
    }
    SEAM(1);
    if (IN(2)) {
        if (bx < 126) { pg8::Gemm g{(const bf16*)(ws + WS_U) + U_MQ, (const bf16*)(ws + WS_WQUP), MT, 768, 256, NU}; pg8::StaticOrder S; S.init(MT, 768, 126, bx);
          pg8::EpiQ E{rsqq, (const float*)(ws + WS_ROPE), (const float*)args.in[16], (const float*)args.in[17], (bf16*)(ws + WS_QM)};
          pg8::gemm_phase<pg8::EpiQ, pg8::StaticOrder, true, true>(lds, g, S, E, wave); }
        else { pg8::Gemm g{(const bf16*)(ws + WS_U) + U_MKV, (const bf16*)(ws + WS_WKVP), MT, 1024, 128, NU}; pg8::StaticOrder S; S.init(MT, 1024, G - 126, bx - 126);
          pg8::EpiKV E{rsqkv, (const float*)args.in[21], (bf16*)(ws + WS_KM), (bf16*)(ws + WS_VM)};
          pg8::gemm_phase<pg8::EpiKV, pg8::StaticOrder, true, true>(lds, g, S, E, wave); }
        post_tokens(args, gw, NGW, 0);
        { volatile LAS unsigned* qs2 = MISC + 20;
          for (;;) {
              __syncthreads();
              if (wave == 0 && lane_id() == 0) qs2[0] = __hip_atomic_fetch_add((unsigned*)(ctl + CW_Q + 128), 1u, __ATOMIC_RELAXED, __HIP_MEMORY_SCOPE_AGENT);
              __syncthreads();
              const int tl = __builtin_amdgcn_readfirstlane((int)qs2[0]);
              if (tl >= MT / 64) break;
              if (tl < MP / 64) gla::prep_tile_p(args, (char*)lds_raw, lds, tl, wave); else gla::prep_tile(args, (char*)lds_raw, tl, wave);
          } }
    }
    SEAM(2);
    if (IN(3)) {
        volatile LAS unsigned* qs = MISC + 16;
        bool first = true;
        for (;;) {
            __syncthreads();
            if (!first && wave == 0 && lane_id() == 0) qs[0] = (unsigned)G + __hip_atomic_fetch_add((unsigned*)(ctl + CW_Q), 1u, __ATOMIC_RELAXED, __HIP_MEMORY_SCOPE_AGENT);
            __syncthreads();
            const int it = first ? bx : __builtin_amdgcn_readfirstlane((int)qs[0]);
            first = false;
            constexpr int TF0 = 768, TFW = TF0 + PREP_LATE_TICKETS, TF1 = TFW + PREP_P_TICKETS, TA2 = TF1 + 64, TEND = TA2 + 128;
            if (it >= TEND) break;
            if (it < 32) gla::scan_unit(args, (char*)lds_raw, it, wave, 0);
            else if (it < 432 && !(it >= 144 && it < 256)) { const bool whole = it < 368; const int d = it < 144 ? it - 32 : it - 144, j = it - 368;
                dec::item(args, (char*)lds_raw, lds, whole ? d >> 3 : 28 + (j >> 4), whole ? d & 7 : (j >> 1) & 7, whole ? -1 : (j & 1), wave, 0); }
            else if (it < TF0 || (it >= TF1 && it < TA2)) pattn::one((char*)lds_raw, (const bf16*)(ws + WS_QM), (const bf16*)(ws + WS_KM), (const bf16*)(ws + WS_VM), (bf16*)(ws + WS_AO), it < 256 ? it - 144 : (it < TF0 ? it - 320 : it - TF1 + 448), wave);
            else if (it < TFW) prep_late(args, lds, it - TF0, wave, lane_id());
            else if (it < TF1) prep_late_p(args, it - TFW, wave, lane_id());
            else gla::scan_unit(args, (char*)lds_raw, it - TA2 + 32, wave, 0);
        }
    }
    SEAM(3);
    if (IN(5)) {
        pg8::Gemm g{(const bf16*)(ws + WS_AO), (const bf16*)(ws + WS_WO), MP, DM, DM}; pg8::StaticOrder S; S.init(MP, DM, G, bx);
        pg8::EpiResid<false> E{args.in[0], (bf16*)(ws + WS_HB), rsq2};
        pg8::gemm_phase<pg8::EpiResid<false>, pg8::StaticOrder, true, true>(lds, g, S, E, wave);
        skinny::run<1024>((char*)lds_raw, (const bf16*)(ws + WS_AO), (const bf16*)(ws + WS_WO), DM, vcu, G, wave, 0, skinny::FResid<false>{(const float*)args.in[1] - (size_t)MP * DM, (bf16*)(ws + WS_HB), rsq2});
    }
    SEAM(5);
    if (IN(6)) {
        pg8::Gemm g{(const bf16*)(ws + WS_HB), (const bf16*)(ws + WS_WGU), MT, 2 * FF, DM, 0, 254, -2}; pg8::StaticOrder S; S.init_tiles(66, 22, G, bx);
        pg8::EpiConv E{rsq2, (PG8_LAS float*)(lds + 131072), (const float*)args.in[26], (const float*)args.in[27], (const float*)args.in[5], (bf16*)(ws + WS_G), args.out + O_CONVP, args.out + O_CONVS};
        pg8::gemm_phase<pg8::EpiConv, pg8::StaticOrder, true, true>(lds, g, S, E, wave);
        if (bx >= 1452 - 5 * G && G == 256) {
            pg8::Gemm g2{(const bf16*)(ws + WS_PB), (const bf16*)(ws + WS_WPP), MP, DM, 256}; pg8::StaticOrder S2; S2.init(MP, DM, G - (1452 - 5 * G), bx - (1452 - 5 * G));
            pg8::EpiScaleBf16 E2{(bf16*)(ws + WS_PP), DM, nullptr};
            pg8::gemm_phase<pg8::EpiScaleBf16, pg8::StaticOrder, true, true>(lds, g2, S2, E2, wave); }
        else if (G != 256) { pg8::Gemm g2{(const bf16*)(ws + WS_PB), (const bf16*)(ws + WS_WPP), MP, DM, 256}; pg8::StaticOrder S2; S2.init(MP, DM, G, bx);
            pg8::EpiScaleBf16 E2{(bf16*)(ws + WS_PP), DM, nullptr};
            pg8::gemm_phase<pg8::EpiScaleBf16, pg8::StaticOrder, true, true>(lds, g2, S2, E2, wave); }
    }
    SEAM(6);
    if (IN(8)) {
        pg8::Gemm g{(const bf16*)(ws + WS_G), (const bf16*)(ws + WS_WD), MP, DM, FF}; pg8::StaticOrder S; S.init(MP, DM, G, bx);
        pg8::EpiResid<true> E{(const void*)(ws + WS_HB), (bf16*)(ws + WS_H2B), rsq3};
        pg8::gemm_phase<pg8::EpiResid<true>, pg8::StaticOrder, true, true>(lds, g, S, E, wave);
        skinny::run<2816>((char*)lds_raw, (const bf16*)(ws + WS_G), (const bf16*)(ws + WS_WD), DM, vcu, G, wave, 0, skinny::FResid<true>{(const void*)(ws + WS_HB), (bf16*)(ws + WS_H2B), rsq3});
    }
    SEAM(8);
    if (IN(9)) {
        pg8::Gemm g{(const bf16*)(ws + WS_H2B), (const bf16*)(ws + WS_WPG), MP, DM, DM}; pg8::StaticOrder S; S.init(MP, DM, G, bx);
        pg8::EpiPle E{(const bf16*)(ws + WS_H2B), (const bf16*)(ws + WS_PP), rsq3, args.out + O_YP};
        pg8::gemm_phase<pg8::EpiPle, pg8::StaticOrder, true, true>(lds, g, S, E, wave);
        skinny::run<1024>((char*)lds_raw, (const bf16*)(ws + WS_H2B), (const bf16*)(ws + WS_WPG), DM, vcu, G, wave, 0, skinny::FPle{(const bf16*)(ws + WS_H2B), (const bf16*)(ws + WS_PP), rsq3, args.out + O_YP});
    }
#undef IN
#undef SEAM
}

extern "C" void kernel_launch(void* const* d_in, const int* in_sizes, int n_in, void* d_out, int out_size, void* d_ws, size_t ws_size, hipStream_t stream) {
    static int grid = 0;
    if (grid == 0) {
        if (n_in != 32 || out_size != (int)O_END || ws_size < WS_END) { fprintf(stderr, "kernel_launch: unexpected shapes: n_in %d out %d ws %zu; nothing launched\n", n_in, out_size, ws_size); grid = -1; return; }
        int dev = 0, cus = 0, per_cu = 0;
        if (hipGetDevice(&dev) != hipSuccess || hipDeviceGetAttribute(&cus, hipDeviceAttributeMultiprocessorCount, dev) != hipSuccess) { fprintf(stderr, "kernel_launch: device query failed\n"); grid = -1; return; }
        if (hipFuncSetAttribute((const void*)hymba_fwd, hipFuncAttributeMaxDynamicSharedMemorySize, LDS_BYTES) != hipSuccess) { fprintf(stderr, "kernel_launch: hipFuncSetAttribute failed\n"); grid = -1; return; }
        if (hipOccupancyMaxActiveBlocksPerMultiprocessor(&per_cu, (const void*)hymba_fwd, NWAVES * 64, LDS_BYTES) != hipSuccess || per_cu < 1)
            fprintf(stderr, "kernel_launch: note: occupancy query reports %d workgroups per CU\n", per_cu);
        (void)hipGetLastError();
        grid = cus;
        if (grid != 256) fprintf(stderr, "kernel_launch: note: %d CUs (built for 256)\n", grid);
    }
    if (grid < 0) return;
    (void)hipMemsetAsync((char*)d_ws + WS_CTL, 0, CTL_ZERO_BYTES, stream);
    Args a{};
    for (int i = 0; i < 32; ++i) a.in[i] = d_in[i];
    a.out = (float*)d_out; a.ws = (unsigned char*)d_ws;
#if MK_PER_PHASE
    for (int p = 0; p < N_PHASES; ++p) { a.ph_lo = p; a.ph_hi = p + 1; hipLaunchKernelGGL(hymba_fwd, dim3(grid), dim3(NWAVES * 64), LDS_BYTES, stream, a); }
#else
    a.ph_lo = 0; a.ph_hi = N_PHASES;
    hipLaunchKernelGGL(hymba_fwd, dim3(grid), dim3(NWAVES * 64), LDS_BYTES, stream, a);
#endif
    const hipError_t le = hipPeekAtLastError();
    if (le != hipSuccess) fprintf(stderr, "kernel_launch: launch failed: %s\n", hipGetErrorName(le));
}
```

```cpp
#include <hip/hip_runtime.h>
#include <cstdio>
#include <cstdint>
__device__ __forceinline__ int lane_id() { int l; asm volatile("v_mbcnt_lo_u32_b32 %0, -1, 0\n\tv_mbcnt_hi_u32_b32 %0, -1, %0" : "=v"(l)); return l; }
namespace pg8 {
#define PG8_LAS __attribute__((address_space(3)))
typedef unsigned short bf16_t;
typedef short bf16x8 __attribute__((ext_vector_type(8)));
typedef float f32x4 __attribute__((ext_vector_type(4)));
typedef unsigned u32x4 __attribute__((ext_vector_type(4)));
constexpr int BM = 256, BK = 64, HALF = 128, HTB = HALF * BK * 2  , STAGE_BYTES = 8 * HTB, NXCD = 8, WGM = 8;

__host__ __device__ __forceinline__ int lds_byte(int r, int c) { const int st = (r >> 4) * 2 + (c >> 5), rr = r & 15, cc = c & 31, ob = rr * 64 + cc * 2; return st * 1024 + (ob ^ (((ob >> 9) & 1) << 5)); }
__host__ __device__ __forceinline__ void stage_rc(int b, int& R, int& C) { const int st = b / 1024, sb = b % 1024, swz = sb ^ (((sb >> 9) & 1) << 5); R = (st >> 1) * 16 + swz / 64; C = (st & 1) * 32 + (swz % 64) / 2; }
__host__ __device__ __forceinline__ int perm32(int rho) { const int n = rho >> 4, i = rho & 15; return 8 * (i >> 2) + 4 * n + (i & 3); }

struct Unit { int pm, pn; };
struct Gemm { const bf16_t* A; const bf16_t* Bt; int M, N, K; int lda = 0, tile_rows = 0, row_off = 0; };

struct StaticOrder {
    int nM, nN, nwg, G, c;
    __host__ __device__ void init(int M, int N, int G_, int c_) { nM = M / BM; nN = N / BM; nwg = nM * nN; G = G_; c = c_; }
    __host__ __device__ void init_tiles(int nM_, int nN_, int G_, int c_) { nM = nM_; nN = nN_; nwg = nM * nN; G = G_; c = c_; }
    __host__ __device__ bool next(int i, Unit& u) const {
        const long L = (long)i * G + c; if (L >= nwg) return false;
        int wgid = (int)L; { const int q = nwg / NXCD, r = nwg % NXCD, xcd = wgid % NXCD, off = wgid / NXCD; wgid = (xcd < r ? xcd * (q + 1) : r * (q + 1) + (xcd - r) * q) + off; }
        const int nig = WGM * nN, gid = wgid / nig, fm = gid * WGM, gsz = (nM - fm) < WGM ? (nM - fm) : WGM;
        u.pm = fm + ((wgid % nig) % gsz); u.pn = (wgid % nig) / gsz; return true;
    }
    __device__ __forceinline__ void a_ready(const Unit&) const {}
    __device__ __forceinline__ void done(const Unit&) const {}
};

__device__ __forceinline__ unsigned cvt_pk_bf16(float lo, float hi) { unsigned r; asm volatile("v_cvt_pk_bf16_f32 %0, %1, %2" : "=v"(r) : "v"(lo), "v"(hi)); return r; }
typedef float f32x2 __attribute__((ext_vector_type(2)));
__device__ __forceinline__ unsigned short f2bf_rne(float f) { unsigned u = __builtin_bit_cast(unsigned, f); return (unsigned short)((u + 0x7fffu + ((u >> 16) & 1u)) >> 16); }
__device__ __forceinline__ float bf2f_(unsigned short b) { return __builtin_bit_cast(float, (unsigned)b << 16); }
struct EpiScaleBf16 {
    static constexpr bool PERM = true, AFTER_DRAIN = false;
    bf16_t* O; int ldc; const float* rs;
    __device__ __forceinline__ void operator()(const f32x4 (&acc)[2][2][4][2], const Unit& u, int wr, int wc, int fr, int fq) const {
        asm volatile("" : "+v"(fr), "+v"(fq));
        const int row0 = u.pm * BM + wr * 64 + fr, col0 = u.pn * BM + wc * 32 + 8 * fq;
#pragma unroll
        for (int ai = 0; ai < 2; ++ai)
#pragma unroll
            for (int m = 0; m < 4; ++m) { const int row = row0 + ai * HALF + m * 16; const float s = rs ? rs[row] : 1.f; bf16_t* rowp = O + (size_t)row * ldc + col0;
#pragma unroll
                for (int bj = 0; bj < 2; ++bj) { const f32x4 v0 = acc[ai][bj][m][0] * s, v1 = acc[ai][bj][m][1] * s;
                    u32x4 w; w.x = cvt_pk_bf16(v0[0], v0[1]); w.y = cvt_pk_bf16(v0[2], v0[3]); w.z = cvt_pk_bf16(v1[0], v1[1]); w.w = cvt_pk_bf16(v1[2], v1[3]);
                    *(u32x4*)(rowp + bj * HALF) = w; } }
    }
};
template <bool BF> struct EpiResid {
    static constexpr bool PERM = false, AFTER_DRAIN = false;
    const void* base; bf16_t* hb; float* rsq;
    __device__ __forceinline__ void operator()(const f32x4 (&acc)[2][2][4][2], const Unit& u, int wr, int wc, int fr, int fq) const {
        asm volatile("" : "+v"(fr), "+v"(fq));
        typedef unsigned u32x2v __attribute__((ext_vector_type(2)));
        const int col0 = u.pn * BM + wc * 32 + 4 * fq;
#pragma unroll
        for (int ai = 0; ai < 2; ++ai) { asm volatile("" ::: "memory");
#pragma unroll
            for (int m = 0; m < 4; ++m) { const int r = u.pm * BM + ai * HALF + wr * 64 + m * 16 + fr;
                float ss = 0.f;
#pragma unroll
                for (int bj = 0; bj < 2; ++bj)
#pragma unroll
                    for (int n = 0; n < 2; ++n) { const size_t off = (size_t)r * 1024 + col0 + bj * HALF + n * 16; f32x4 v;
                        if (BF) { const u32x2v bw = *(const u32x2v*)((const bf16_t*)base + off);
                            v = (f32x4){__builtin_bit_cast(float, bw.x << 16), __builtin_bit_cast(float, bw.x & 0xffff0000u), __builtin_bit_cast(float, bw.y << 16), __builtin_bit_cast(float, bw.y & 0xffff0000u)} + acc[ai][bj][m][n]; }
                        else v = *(const f32x4*)((const float*)base + off) + acc[ai][bj][m][n];
                        u32x2v w; w.x = cvt_pk_bf16(v[0], v[1]); w.y = cvt_pk_bf16(v[2], v[3]); *(u32x2v*)(hb + off) = w;
                        ss += (v[0] * v[0] + v[1] * v[1]) + (v[2] * v[2] + v[3] * v[3]); }
                ss += __shfl_xor(ss, 16); ss += __shfl_xor(ss, 32);
                if (fq == 0) atomicAdd(rsq + r, ss); } }
    }
};
struct EpiGateUp {
    static constexpr bool PERM = true, AFTER_DRAIN = false;
    const float* rsq; bf16_t* A; bf16_t* C; float* conv_p; float* conv_s;
    __device__ __forceinline__ void operator()(const f32x4 (&acc)[2][2][4][2], const Unit& u, int wr, int wc, int fr, int fq) const {
        asm volatile("" : "+v"(fr), "+v"(fq));
        const int f0 = u.pn * HALF + wc * 32 + 8 * fq;
#pragma unroll
        for (int ai = 0; ai < 2; ++ai)
#pragma unroll
            for (int m = 0; m < 4; ++m) { const int r = u.pm * BM + ai * HALF + wr * 64 + m * 16 + fr;
                const float rs = __builtin_amdgcn_rsqf(rsq[r] * (1.0f / 1024.0f) + 1e-6f);
                const f32x4 a0 = acc[ai][0][m][0] * rs, a1 = acc[ai][0][m][1] * rs, c0 = acc[ai][1][m][0] * rs, c1 = acc[ai][1][m][1] * rs;
                u32x4 w; w.x = cvt_pk_bf16(a0[0], a0[1]); w.y = cvt_pk_bf16(a0[2], a0[3]); w.z = cvt_pk_bf16(a1[0], a1[1]); w.w = cvt_pk_bf16(a1[2], a1[3]);
                *(u32x4*)(A + (size_t)r * 2816 + f0) = w;
                w.x = cvt_pk_bf16(c0[0], c0[1]); w.y = cvt_pk_bf16(c0[2], c0[3]); w.z = cvt_pk_bf16(c1[0], c1[1]); w.w = cvt_pk_bf16(c1[2], c1[3]);
                *(u32x4*)(C + (size_t)r * 2816 + f0) = w;
                float* dst = nullptr;
                if (r < 16384) { const int t = r & 2047; if (t >= 2046) dst = conv_p + ((size_t)(r >> 11) * 2 + (t - 2046)) * 2816 + f0; }
                else { const int rr = r - 16384, t = rr & 7; if (t >= 6) dst = conv_s + ((size_t)(rr >> 3) * 2 + (t - 6)) * 2816 + f0; }
                if (dst) { *(f32x4*)dst = a0; *(f32x4*)(dst + 4) = a1; } }
    }
};
struct EpiPle {
    static constexpr bool PERM = false, AFTER_DRAIN = false;
    const bf16_t* h2; const bf16_t* PP; const float* rsq; float* out;
    __device__ __forceinline__ void operator()(const f32x4 (&acc)[2][2][4][2], const Unit& u, int wr, int wc, int fr, int fq) const {
        asm volatile("" : "+v"(fr), "+v"(fq));
        typedef unsigned u32x2v __attribute__((ext_vector_type(2)));
        const int col0 = u.pn * BM + wc * 32 + 4 * fq;
#pragma unroll
        for (int ai = 0; ai < 2; ++ai) { asm volatile("" ::: "memory");
#pragma unroll
            for (int m = 0; m < 4; ++m) { const int r = u.pm * BM + ai * HALF + wr * 64 + m * 16 + fr;
                const float rs = __builtin_amdgcn_rsqf(rsq[r] * (1.0f / 1024.0f) + 1e-6f);
#pragma unroll
                for (int bj = 0; bj < 2; ++bj)
#pragma unroll
                    for (int n = 0; n < 2; ++n) { const size_t off = (size_t)r * 1024 + col0 + bj * HALF + n * 16; const u32x2v hw = *(const u32x2v*)(h2 + off); const f32x4 hv = {__builtin_bit_cast(float, hw.x << 16), __builtin_bit_cast(float, hw.x & 0xffff0000u), __builtin_bit_cast(float, hw.y << 16), __builtin_bit_cast(float, hw.y & 0xffff0000u)};
                        const u32x2v pw = *(const u32x2v*)(PP + off); const f32x4 z = acc[ai][bj][m][n] * rs; f32x4 o;
                        o[0] = hv[0] + __builtin_bit_cast(float, pw.x << 16) * __builtin_amdgcn_rcpf(1.0f + __builtin_amdgcn_exp2f(-1.4426950408889634f * z[0]));
                        o[1] = hv[1] + __builtin_bit_cast(float, pw.x & 0xffff0000u) * __builtin_amdgcn_rcpf(1.0f + __builtin_amdgcn_exp2f(-1.4426950408889634f * z[1]));
                        o[2] = hv[2] + __builtin_bit_cast(float, pw.y << 16) * __builtin_amdgcn_rcpf(1.0f + __builtin_amdgcn_exp2f(-1.4426950408889634f * z[2]));
                        o[3] = hv[3] + __builtin_bit_cast(float, pw.y & 0xffff0000u) * __builtin_amdgcn_rcpf(1.0f + __builtin_amdgcn_exp2f(-1.4426950408889634f * z[3]));
                        *(f32x4*)(out + off) = o; } } }
    }
};
struct EpiU {
    static constexpr bool PERM = true, AFTER_DRAIN = false;
    bf16_t* O; const float* rs; float* rsqq; float* rsqkv; float* rsqkr;
    __device__ __forceinline__ void operator()(const f32x4 (&acc)[2][2][4][2], const Unit& u, int wr, int wc, int fr, int fq) const {
        asm volatile("" : "+v"(fr), "+v"(fq));
        const int row0 = u.pm * BM + wr * 64 + fr, col0 = u.pn * BM + wc * 32 + 8 * fq;
#pragma unroll
        for (int ai = 0; ai < 2; ++ai)
#pragma unroll
            for (int m = 0; m < 4; ++m) { const int row = row0 + ai * HALF + m * 16; const float s = rs[row]; bf16_t* rowp = O + (size_t)row * 2048 + col0; float sq[2];
#pragma unroll
                for (int bj = 0; bj < 2; ++bj) { const f32x4 v0 = acc[ai][bj][m][0] * s, v1 = acc[ai][bj][m][1] * s;
                    u32x4 w; w.x = cvt_pk_bf16(v0[0], v0[1]); w.y = cvt_pk_bf16(v0[2], v0[3]); w.z = cvt_pk_bf16(v1[0], v1[1]); w.w = cvt_pk_bf16(v1[2], v1[3]);
                    *(u32x4*)(rowp + bj * HALF) = w;
                    sq[bj] = ((v0[0] * v0[0] + v0[1] * v0[1]) + (v0[2] * v0[2] + v0[3] * v0[3])) + ((v1[0] * v1[0] + v1[1] * v1[1]) + (v1[2] * v1[2] + v1[3] * v1[3])); }
                if (u.pn >= 6) { float a0 = (u.pn == 6) ? sq[0] + sq[1] : sq[0], a1 = sq[1];
                    a0 += __shfl_xor(a0, 16); a0 += __shfl_xor(a0, 32); a1 += __shfl_xor(a1, 16); a1 += __shfl_xor(a1, 32);
                    if (fq == 0) { if (u.pn == 6) atomicAdd(rsqq + row, a0); else { atomicAdd(rsqkv + row, a0); if (wc == 0) atomicAdd(rsqkr + row, a1); } } }
                asm volatile("" ::: "memory"); }
    }
};
struct EpiQ {
    static constexpr bool PERM = true, AFTER_DRAIN = false;
    const float* rsqq; const float* rope; const float* g_qn; const float* g_qr; bf16_t* QM;
    __device__ __forceinline__ void operator()(const f32x4 (&acc)[2][2][4][2], const Unit& u, int wr, int wc, int fr, int fq) const {
        asm volatile("" : "+v"(fr), "+v"(fq));
        constexpr float QS = 0.10206207261596575f * 1.4426950408889634f;
        float rsq8[8];
#pragma unroll
        for (int i = 0; i < 8; ++i) rsq8[i] = rsqq[u.pm * BM + (i >> 2) * HALF + wr * 64 + (i & 3) * 16 + fr];
#pragma unroll
        for (int ai = 0; ai < 2; ++ai)
#pragma unroll
            for (int m = 0; m < 4; ++m) { const int r = u.pm * BM + ai * HALF + wr * 64 + m * 16 + fr; const float rs = __builtin_amdgcn_rsqf(rsq8[ai * 4 + m] * (1.0f / 256.0f) + 1e-6f);
                if (u.pn < 2) { const int h = 4 * u.pn + wc; float ss = 0.f;
#pragma unroll
                    for (int bj = 0; bj < 2; ++bj)
#pragma unroll
                        for (int n = 0; n < 2; ++n) { const f32x4 v = acc[ai][bj][m][n] * rs; ss += (v[0] * v[0] + v[1] * v[1]) + (v[2] * v[2] + v[3] * v[3]); }
                    ss += __shfl_xor(ss, 16); ss += __shfl_xor(ss, 32);
                    const float rn = rs * QS * __builtin_amdgcn_rsqf(ss * (1.0f / 64.0f) + 1e-6f);
#pragma unroll
                    for (int bj = 0; bj < 2; ++bj) { const int d0 = 32 * bj + 8 * fq; const f32x4 g0 = *(const f32x4*)(g_qn + d0), g1 = *(const f32x4*)(g_qn + d0 + 4);
                        const f32x4 v0 = acc[ai][bj][m][0] * rn * g0, v1 = acc[ai][bj][m][1] * rn * g1;
                        u32x4 w; w.x = cvt_pk_bf16(v0[0], v0[1]); w.y = cvt_pk_bf16(v0[2], v0[3]); w.z = cvt_pk_bf16(v1[0], v1[1]); w.w = cvt_pk_bf16(v1[2], v1[3]);
                        *(u32x4*)(QM + ((size_t)r * 8 + h) * 96 + d0) = w; } }
                else { const int pidx = (r < 16384) ? (r & 2047) : 2048 + ((r - 16384) & 7);
#pragma unroll
                    for (int bj = 0; bj < 2; ++bj) { const int h = 4 * bj + wc, i0 = 8 * fq; float ss = 0.f;
#pragma unroll
                        for (int n = 0; n < 2; ++n) { const f32x4 v = acc[ai][bj][m][n] * rs; ss += (v[0] * v[0] + v[1] * v[1]) + (v[2] * v[2] + v[3] * v[3]); }
                        ss += __shfl_xor(ss, 16); ss += __shfl_xor(ss, 32);
                        const float rr = rs * QS * __builtin_amdgcn_rsqf(ss * (1.0f / 32.0f) + 1e-6f);
                        const f32x4 g0 = *(const f32x4*)(g_qr + i0), g1 = *(const f32x4*)(g_qr + i0 + 4);
                        unsigned wq[4];
#pragma unroll
                        for (int n = 0; n < 2; ++n) { const f32x4 gq = n ? g1 : g0; float o[4];
#pragma unroll
                            for (int j = 0; j < 4; ++j) { const float x = acc[ai][bj][m][n][j] * rr * gq[j]; const float y = __shfl_xor(x, 32);
                                const float cs_c = rope[(pidx * 16 + 8 * (fq & 1) + 4 * n + j) * 2], cs_s = rope[(pidx * 16 + 8 * (fq & 1) + 4 * n + j) * 2 + 1];
                                o[j] = (fq < 2) ? (x * cs_c - y * cs_s) : (x * cs_c + y * cs_s); }
                            wq[2 * n] = cvt_pk_bf16(o[0], o[1]); wq[2 * n + 1] = cvt_pk_bf16(o[2], o[3]); }
                        u32x4 w; w.x = wq[0]; w.y = wq[1]; w.z = wq[2]; w.w = wq[3];
                        *(u32x4*)(QM + ((size_t)r * 8 + h) * 96 + 64 + i0) = w; } }
                asm volatile("" ::: "memory"); }
    }
};
struct EpiKV {
    static constexpr bool PERM = true, AFTER_DRAIN = false;
    const float* rsqkv; const float* g_kn; bf16_t* KM; bf16_t* VM;
    __device__ __forceinline__ void operator()(const f32x4 (&acc)[2][2][4][2], const Unit& u, int wr, int wc, int fr, int fq) const {
        asm volatile("" : "+v"(fr), "+v"(fq));
        float rsq8[8];
#pragma unroll
        for (int i = 0; i < 8; ++i) rsq8[i] = rsqkv[u.pm * BM + (i >> 2) * HALF + wr * 64 + (i & 3) * 16 + fr];
#pragma unroll
        for (int ai = 0; ai < 2; ++ai)
#pragma unroll
            for (int m = 0; m < 4; ++m) { const int r = u.pm * BM + ai * HALF + wr * 64 + m * 16 + fr; const float rs = __builtin_amdgcn_rsqf(rsq8[ai * 4 + m] * (1.0f / 128.0f) + 1e-6f);
                if (u.pn < 2) { const int h = 4 * u.pn + wc; float ss = 0.f;
#pragma unroll
                    for (int bj = 0; bj < 2; ++bj)
#pragma unroll
                        for (int n = 0; n < 2; ++n) { const f32x4 v = acc[ai][bj][m][n] * rs; ss += (v[0] * v[0] + v[1] * v[1]) + (v[2] * v[2] + v[3] * v[3]); }
                    ss += __shfl_xor(ss, 16); ss += __shfl_xor(ss, 32);
                    const float rk = rs * __builtin_amdgcn_rsqf(ss * (1.0f / 64.0f) + 1e-6f);
#pragma unroll
                    for (int bj = 0; bj < 2; ++bj) { const int d0 = 32 * bj + 8 * fq; const f32x4 g0 = *(const f32x4*)(g_kn + d0), g1 = *(const f32x4*)(g_kn + d0 + 4);
                        const f32x4 v0 = acc[ai][bj][m][0] * rk * g0, v1 = acc[ai][bj][m][1] * rk * g1;
                        u32x4 w; w.x = cvt_pk_bf16(v0[0], v0[1]); w.y = cvt_pk_bf16(v0[2], v0[3]); w.z = cvt_pk_bf16(v1[0], v1[1]); w.w = cvt_pk_bf16(v1[2], v1[3]);
                        *(u32x4*)(KM + ((size_t)r * 8 + h) * 96 + d0) = w; } }
                else { const int h = 4 * (u.pn - 2) + wc;
#pragma unroll
                    for (int bj = 0; bj < 2; ++bj) { const int d0 = 32 * bj + 8 * fq; const f32x4 v0 = acc[ai][bj][m][0] * rs, v1 = acc[ai][bj][m][1] * rs;
                        u32x4 w; w.x = cvt_pk_bf16(v0[0], v0[1]); w.y = cvt_pk_bf16(v0[2], v0[3]); w.z = cvt_pk_bf16(v1[0], v1[1]); w.w = cvt_pk_bf16(v1[2], v1[3]);
                        *(u32x4*)(VM + ((size_t)r * 8 + h) * 64 + d0) = w; } }
                asm volatile("" ::: "memory"); }
    }
};
__device__ __forceinline__ float dpp_f(float oldv, float src, const int ctrl_sel) {
    const int o = __builtin_bit_cast(int, oldv), s = __builtin_bit_cast(int, src); int r;
    if (ctrl_sel == 0) r = __builtin_amdgcn_update_dpp(o, s, 0x111, 0xf, 0xf, false); else if (ctrl_sel == 1) r = __builtin_amdgcn_update_dpp(o, s, 0x112, 0xf, 0xf, false);
    else if (ctrl_sel == 2) r = __builtin_amdgcn_update_dpp(o, s, 0x121, 0xf, 0xf, false); else r = __builtin_amdgcn_update_dpp(o, s, 0x122, 0xf, 0xf, false);
    return __builtin_bit_cast(float, r);
}
struct EpiConv {
    static constexpr bool PERM = true, AFTER_DRAIN = false;
    const float* rsq; PG8_LAS float* ex; const float* cw; const float* cb; const float* sc; bf16_t* G; float* conv_p; float* conv_s;
    __device__ __forceinline__ void operator()(const f32x4 (&acc)[2][2][4][2], const Unit& u, int wr, int wc, int fr, int fq) const {
        asm volatile("" : "+v"(fr), "+v"(fq));
        constexpr int MTr = 16640, MPr = 16384;
        const int f0 = u.pn * HALF + wc * 32 + 8 * fq; const int Rbase = u.pm * 254 - 2;
#pragma unroll
        for (int ai = 0; ai < 2; ++ai) { const int R3 = Rbase + ai * HALF + wr * 64 + 48 + fr; const int Rc = R3 < 0 ? 0 : (R3 >= MTr ? MTr - 1 : R3);
            const float rs = __builtin_amdgcn_rsqf(rsq[Rc] * (1.0f / 1024.0f) + 1e-6f);
            if (fr >= 14) { PG8_LAS float* p = ex + (((((2 * ai + wr) * 4 + wc) * 2 + (fr - 14)) * 4 + fq) * 8);
                *(PG8_LAS f32x4*)p = acc[ai][0][3][0] * rs; *(PG8_LAS f32x4*)(p + 4) = acc[ai][0][3][1] * rs; } }
        asm volatile("s_waitcnt lgkmcnt(0)\n\ts_barrier" ::: "memory");
        const f32x4 w0a = *(const f32x4*)(cw + f0), w0b = *(const f32x4*)(cw + f0 + 4), w1a = *(const f32x4*)(cw + 2816 + f0), w1b = *(const f32x4*)(cw + 2816 + f0 + 4);
        const f32x4 w2a = *(const f32x4*)(cw + 5632 + f0), w2b = *(const f32x4*)(cw + 5632 + f0 + 4), cba = *(const f32x4*)(cb + f0), cbb = *(const f32x4*)(cb + f0 + 4);
#pragma unroll
        for (int ai = 0; ai < 2; ++ai) {
            float pg[8];
            { const int s = 2 * ai + wr;
              if (s == 0) {
#pragma unroll
                  for (int e = 0; e < 8; ++e) pg[e] = 0.f;
              } else { const PG8_LAS float* p = ex + ((((((s - 1) * 4 + wc) * 2 + (fr & 1)) * 4 + fq) * 8)); const f32x4 a0 = *(const PG8_LAS f32x4*)p, a1 = *(const PG8_LAS f32x4*)(p + 4);
                  pg[0] = a0[0]; pg[1] = a0[1]; pg[2] = a0[2]; pg[3] = a0[3]; pg[4] = a1[0]; pg[5] = a1[1]; pg[6] = a1[2]; pg[7] = a1[3]; } }
#pragma unroll
            for (int m = 0; m < 4; ++m) { const int rl = ai * HALF + wr * 64 + m * 16 + fr; const int R = Rbase + rl; const int Rc = R < 0 ? 0 : (R >= MTr ? MTr - 1 : R);
                const float rs = __builtin_amdgcn_rsqf(rsq[Rc] * (1.0f / 1024.0f) + 1e-6f);
                float cur[8], go[8];
#pragma unroll
                for (int e = 0; e < 8; ++e) cur[e] = acc[ai][0][m][e >> 2][e & 3] * rs;
                const bool is_s = R >= MPr; const int t = is_s ? ((R - MPr) & 7) : (R & 2047);
                const float k1 = (t == 0) ? 0.f : 1.f, k2 = (t < 2) ? 0.f : 1.f;
                float c1[8], c2[8];
#pragma unroll
                for (int e = 0; e < 8; ++e) { c1[e] = dpp_f(dpp_f(0.f, pg[e], 2), cur[e], 0) * k1; c2[e] = dpp_f(dpp_f(0.f, pg[e], 3), cur[e], 1) * k2; }
                if (u.pm >= 64) { if (is_s && t < 2) { const int bs = (R - MPr) >> 3;
#pragma unroll
                        for (int e = 0; e < 8; ++e) { const float h1 = sc[((size_t)bs * 2 + 1) * 2816 + f0 + e], h0 = sc[((size_t)bs * 2) * 2816 + f0 + e]; if (t == 0) { c1[e] = h1; c2[e] = h0; } else c2[e] = h1; } } }
#pragma unroll
                for (int e = 0; e < 8; ++e) { const float w0 = e < 4 ? w0a[e & 3] : w0b[e & 3], w1 = e < 4 ? w1a[e & 3] : w1b[e & 3], w2 = e < 4 ? w2a[e & 3] : w2b[e & 3], bb = e < 4 ? cba[e & 3] : cbb[e & 3];
                    const float cv = bb + w0 * c2[e] + w1 * c1[e] + w2 * cur[e];
                    go[e] = cv * __builtin_amdgcn_rcpf(1.0f + __builtin_amdgcn_exp2f(-1.4426950408889634f * cv)) * (acc[ai][1][m][e >> 2][e & 3] * rs); }
                if (rl >= 2 && R < MTr) {
                    u32x4 w; w.x = cvt_pk_bf16(go[0], go[1]); w.y = cvt_pk_bf16(go[2], go[3]); w.z = cvt_pk_bf16(go[4], go[5]); w.w = cvt_pk_bf16(go[6], go[7]);
                    *(u32x4*)(G + (size_t)R * 2816 + f0) = w;
                    float* dst = nullptr;
                    if (!is_s) { if (t >= 2046) dst = conv_p + ((size_t)(R >> 11) * 2 + (t - 2046)) * 2816 + f0; }
                    else { if (t >= 6) dst = conv_s + ((size_t)((R - MPr) >> 3) * 2 + (t - 6)) * 2816 + f0; }
                    if (dst) { *(f32x4*)dst = (f32x4){cur[0], cur[1], cur[2], cur[3]}; *(f32x4*)(dst + 4) = (f32x4){cur[4], cur[5], cur[6], cur[7]}; } }
#pragma unroll
                for (int e = 0; e < 8; ++e) pg[e] = cur[e];
                asm volatile("" ::: "memory"); }
        }
    }
};
template <class Epi, class Sched, bool ALIGN_EPI = false, bool SP2 = false>
__device__ __forceinline__ void gemm_phase(PG8_LAS unsigned char* lds, const Gemm g, const Sched& S, const Epi& E, const int wid_s) {
    int tid_o = wid_s * 64 + lane_id(); asm volatile("" : "+v"(tid_o));
    const int tid = tid_o, wid = __builtin_amdgcn_readfirstlane(tid >> 6), lane = tid & 63, wr = wid >> 2, wc = wid & 3, fr = lane & 15, fq = lane >> 4;
    const int K = g.K, nt = K / BK;
    const int lda = g.lda ? g.lda : K;
    unsigned voffA[2], voffB[2];
#pragma unroll
    for (int i = 0; i < 2; ++i) { int R, C; stage_rc(tid * 16 + i * 8192, R, C); const int Rb = Epi::PERM ? ((R & ~31) + perm32(R & 31)) : R;
        voffA[i] = (unsigned)(R * lda + C) * 2u; voffB[i] = (unsigned)(Rb * K + C) * 2u; }
    const size_t kstep = (size_t)(BK * 2);
    const size_t hstepA = (size_t)HALF * lda * 2, hstepB = (size_t)HALF * K * 2;
    const size_t tstepB = 2 * hstepB;
    const long trows = g.tile_rows ? g.tile_rows : BM;
#define PG8_TILEA(pm_) ((const char*)g.A + ((long)(pm_) * trows + g.row_off) * (long)lda * 2)
    const unsigned ldsw = (unsigned)wid * 1024u;
    const int aoff = lds_byte(wr * 64 + fr, fq * 8), boff = lds_byte(wc * 32 + fr, fq * 8);
#define PG8_SA(b, h) (((b) * 2 + (h)) * HTB)
#define PG8_SB(b, h) ((4 + (b) * 2 + (h)) * HTB)
#define PG8_STAGE(bufoff, gbase, voff) do { _Pragma("unroll") for (int _i = 0; _i < 2; ++_i) \
        __builtin_amdgcn_global_load_lds((const unsigned*)((const char*)(gbase) + (voff)[_i]), (PG8_LAS unsigned*)(lds + (bufoff) + ldsw + _i * 8192), 16, 0, 0); } while (0)
#define PG8_LDA(dst, b, h) do { _Pragma("unroll") for (int m = 0; m < 4; ++m) _Pragma("unroll") for (int k = 0; k < 2; ++k) dst[m][k] = *(const PG8_LAS bf16x8*)(lds + PG8_SA(b, h) + aoff + m * 2048 + k * 1024); } while (0)
#define PG8_LDB(dst, b, h) do { _Pragma("unroll") for (int n = 0; n < 2; ++n) _Pragma("unroll") for (int k = 0; k < 2; ++k) dst[n][k] = *(const PG8_LAS bf16x8*)(lds + PG8_SB(b, h) + boff + n * 2048 + k * 1024); } while (0)
#define PG8_MMA(ai, bj, At, Bt) do { __builtin_amdgcn_s_setprio(1); _Pragma("unroll") for (int m = 0; m < 4; ++m) _Pragma("unroll") for (int n = 0; n < 2; ++n) _Pragma("unroll") for (int k = 0; k < 2; ++k) \
        acc[ai][bj][m][n] = __builtin_amdgcn_mfma_f32_16x16x32_bf16(Bt[n][k], At[m][k], acc[ai][bj][m][n], 0, 0, 0); __builtin_amdgcn_s_setprio(0); } while (0)
#define PG8_WAIT_V(n) asm volatile("s_waitcnt vmcnt(" #n ")" ::: "memory")
#define PG8_WAIT_L(n) asm volatile("s_waitcnt lgkmcnt(" #n ")" ::: "memory")
#define PG8_BAR __builtin_amdgcn_s_barrier()
#define PG8_SCHED __builtin_amdgcn_sched_barrier(0)
    Unit cur, nxt; int ui = 0;
    if (!S.next(0, cur)) return;
    f32x4 acc[2][2][4][2];
#pragma unroll
    for (int a = 0; a < 2; ++a)
#pragma unroll
        for (int b = 0; b < 2; ++b)
#pragma unroll
            for (int m = 0; m < 4; ++m)
#pragma unroll
                for (int n = 0; n < 2; ++n) acc[a][b][m][n] = (f32x4){0.f, 0.f, 0.f, 0.f};
    bf16x8 At[4][2], B0[2][2], B1[2][2];
    const char* cA = PG8_TILEA(cur.pm); const char* cB = (const char*)g.Bt + (size_t)cur.pn * tstepB;
    S.a_ready(cur);
    if constexpr (SP2) {
        PG8_STAGE(PG8_SB(0, 0), cB, voffB); PG8_STAGE(PG8_SB(0, 1), cB + hstepB, voffB); PG8_STAGE(PG8_SA(0, 0), cA, voffA); PG8_STAGE(PG8_SA(0, 1), cA + hstepA, voffA);
        if (wr == 1) PG8_BAR;
        PG8_WAIT_V(2); PG8_BAR;
        PG8_STAGE(PG8_SB(1, 0), cB + kstep, voffB); PG8_STAGE(PG8_SA(1, 0), cA + kstep, voffA); PG8_STAGE(PG8_SB(1, 1), cB + hstepB + kstep, voffB);
        PG8_WAIT_V(6); PG8_BAR;
    } else {
        PG8_STAGE(PG8_SB(0, 0), cB, voffB); PG8_STAGE(PG8_SA(0, 0), cA, voffA); PG8_STAGE(PG8_SB(0, 1), cB + hstepB, voffB); PG8_STAGE(PG8_SA(0, 1), cA + hstepA, voffA);
        if (wr == 1) PG8_BAR;
        PG8_WAIT_V(4); PG8_BAR;
        PG8_STAGE(PG8_SB(1, 0), cB + kstep, voffB); PG8_STAGE(PG8_SA(1, 0), cA + kstep, voffA); PG8_STAGE(PG8_SB(1, 1), cB + hstepB + kstep, voffB);
        PG8_WAIT_V(6); PG8_BAR;
    }
    for (;;) {
        const bool has_next = S.next(ui + 1, nxt);
        const char* nA = has_next ? PG8_TILEA(nxt.pm) : cA; const char* nB = has_next ? (const char*)g.Bt + (size_t)nxt.pn * tstepB : cB;
        for (int t = 0; t < nt; t += 2) {
            const bool last = (t == nt - 2);
            const char* a1 = cA + (size_t)(t + 1) * kstep;
            const char* a2 = last ? nA : cA + (size_t)(t + 2) * kstep; const char* b2 = last ? nB : cB + (size_t)(t + 2) * kstep;
            const char* a3 = a2 + kstep; const char* b3 = b2 + kstep;
            if (last && has_next) S.a_ready(nxt);
            if constexpr (SP2) {
            PG8_LDB(B0, 0, 0); PG8_LDB(B1, 0, 1); PG8_SCHED; PG8_LDA(At, 0, 0); PG8_STAGE(PG8_SA(1, 1), a1 + hstepA, voffA);
            PG8_WAIT_V(8); PG8_WAIT_L(0); PG8_BAR; PG8_MMA(0, 0, At, B0); PG8_MMA(0, 1, At, B1); PG8_BAR; PG8_SCHED;
            PG8_LDA(At, 0, 1); PG8_STAGE(PG8_SB(0, 0), b2, voffB); PG8_STAGE(PG8_SB(0, 1), b2 + hstepB, voffB); PG8_STAGE(PG8_SA(0, 0), a2, voffA);
            PG8_WAIT_V(8); PG8_WAIT_L(0); PG8_BAR; PG8_MMA(1, 0, At, B0); PG8_MMA(1, 1, At, B1); PG8_BAR; PG8_SCHED;
            PG8_LDB(B0, 1, 0); PG8_LDB(B1, 1, 1); PG8_SCHED; PG8_LDA(At, 1, 0); PG8_STAGE(PG8_SA(0, 1), a2 + hstepA, voffA);
            PG8_WAIT_V(8); PG8_WAIT_L(0); PG8_BAR; PG8_MMA(0, 0, At, B0); PG8_MMA(0, 1, At, B1); PG8_BAR; PG8_SCHED;
            PG8_LDA(At, 1, 1); PG8_STAGE(PG8_SB(1, 0), b3, voffB); PG8_STAGE(PG8_SB(1, 1), b3 + hstepB, voffB); PG8_STAGE(PG8_SA(1, 0), a3, voffA);
            PG8_WAIT_V(8); PG8_WAIT_L(0); PG8_BAR; PG8_MMA(1, 0, At, B0); PG8_MMA(1, 1, At, B1); PG8_BAR; PG8_SCHED;
            } else {
            PG8_LDB(B0, 0, 0); PG8_SCHED; PG8_LDA(At, 0, 0); PG8_STAGE(PG8_SA(1, 1), a1 + hstepA, voffA);
            PG8_WAIT_L(8); PG8_BAR; PG8_WAIT_L(0); PG8_MMA(0, 0, At, B0); PG8_BAR; PG8_SCHED;
            PG8_LDB(B1, 0, 1); PG8_STAGE(PG8_SB(0, 0), b2, voffB);
            PG8_BAR; PG8_WAIT_L(0); PG8_MMA(0, 1, At, B1); PG8_BAR;
            PG8_LDA(At, 0, 1); PG8_STAGE(PG8_SA(0, 0), a2, voffA);
            PG8_BAR; PG8_WAIT_L(0); PG8_MMA(1, 0, At, B0); PG8_BAR; PG8_SCHED;
            PG8_STAGE(PG8_SB(0, 1), b2 + hstepB, voffB);
            PG8_WAIT_V(6); PG8_BAR; PG8_MMA(1, 1, At, B1); PG8_BAR;
            PG8_LDB(B0, 1, 0); PG8_SCHED; PG8_LDA(At, 1, 0); PG8_STAGE(PG8_SA(0, 1), a2 + hstepA, voffA);
            PG8_WAIT_L(8); PG8_BAR; PG8_WAIT_L(0); PG8_MMA(0, 0, At, B0); PG8_BAR; PG8_SCHED;
            PG8_LDB(B1, 1, 1); PG8_STAGE(PG8_SB(1, 0), b3, voffB);
            PG8_BAR; PG8_WAIT_L(0); PG8_MMA(0, 1, At, B1); PG8_BAR;
            PG8_LDA(At, 1, 1); PG8_STAGE(PG8_SA(1, 0), a3, voffA);
            PG8_BAR; PG8_WAIT_L(0); PG8_MMA(1, 0, At, B0); PG8_BAR; PG8_SCHED;
            PG8_STAGE(PG8_SB(1, 1), b3 + hstepB, voffB);
            PG8_WAIT_V(6); PG8_BAR; PG8_MMA(1, 1, At, B1); PG8_BAR;
            }
        }
        if constexpr (ALIGN_EPI) { if (wr == 0) PG8_BAR; }
        if constexpr (!Epi::AFTER_DRAIN) { const int le_ = lane_id(); E(acc, cur, wr, wc, le_ & 15, le_ >> 4); S.done(cur); }
        if (!has_next) break;
#pragma unroll
        for (int a = 0; a < 2; ++a)
#pragma unroll
            for (int b = 0; b < 2; ++b)
#pragma unroll
                for (int m = 0; m < 4; ++m)
#pragma unroll
                    for (int n = 0; n < 2; ++n) acc[a][b][m][n] = (f32x4){0.f, 0.f, 0.f, 0.f};
        cur = nxt; cA = nA; cB = nB; ++ui;
        if constexpr (ALIGN_EPI) { if (wr == 1) PG8_BAR; }
    }
    PG8_WAIT_V(0);
    if constexpr (!ALIGN_EPI) { if (wr == 0) PG8_BAR; }
    PG8_BAR;
    if constexpr (Epi::AFTER_DRAIN) { E.fused(acc, cur, wr, wc, fr, fq, lds, wid, lane); S.done(cur); }
#undef PG8_TILEA
#undef PG8_SA
#undef PG8_SB
#undef PG8_STAGE
#undef PG8_LDA
#undef PG8_LDB
#undef PG8_MMA
#undef PG8_WAIT_V
#undef PG8_WAIT_L
#undef PG8_BAR
#undef PG8_SCHED
}
}
constexpr int NWAVES = 8;
constexpr int MP = 16384, MS = 256, MT = MP + MS;
constexpr int DM = 1024, NU = 2048, FF = 2816;
constexpr int U_GQ = 0, U_GK = 256, U_GV = 512, U_GG = 1024, U_MQ = 1536, U_MKV = 1792, U_MKR = 1920, U_GA = 1952, IN_COLS = 1968;
constexpr float EPSN = 1e-6f;
constexpr float QSCALE = 0.10206207261596575f * 1.4426950408889634f;
constexpr size_t O_YP = 0, O_YS = 16777216, O_CKVP = 17039360, O_KRP = 19136512, O_GLAP = 19660800, O_CONVP = 19922944, O_CKVS = 19968000, O_KRS = 20000768, O_GLAS = 20008960, O_CONVS = 21057536, O_END = 21237760;
constexpr size_t MiB = 1u << 20;
constexpr size_t WS_CTL = 0, CTL_ZERO_BYTES = 1 * MiB;
constexpr size_t WS_WIN = 2 * MiB, WS_WQUP = 6 * MiB, WS_WKVUP = 6 * MiB + 512 * 1024, WS_WKVN = 6 * MiB + 768 * 1024, WS_WPP = 7 * MiB, WS_WKVP = 7 * MiB + 512 * 1024, WS_WO = 8 * MiB, WS_WPG = 10 * MiB, WS_WGU = 12 * MiB, WS_WD = 24 * MiB;
constexpr size_t WS_ROPE = 30 * MiB, WS_RS1 = 31 * MiB, WS_XB = 32 * MiB, WS_PB = 65 * MiB, WS_U = 74 * MiB, WS_PP = 139 * MiB, WS_LA = 172 * MiB, WS_QM = 189 * MiB, WS_KM = 214 * MiB, WS_VM = 239 * MiB;
constexpr size_t WS_AO = 256 * MiB, WS_H = 289 * MiB, WS_HB = 354 * MiB, WS_A = 387 * MiB, WS_C = 477 * MiB, WS_G = 567 * MiB, WS_H2B = 657 * MiB, WS_PART = 690 * MiB, WS_QABS = 699 * MiB, WS_QDEC = 700 * MiB, WS_KINV = 709 * MiB, WS_KENDT = 718 * MiB, WS_VT = 727 * MiB, WS_ELAST = 745 * MiB, WS_GGF = 746 * MiB, WS_PFSINK = 764 * MiB, WS_END = 765 * MiB;
constexpr int CW_BAR = 4096, CW_RSQ2 = 16384, CW_RSQ3 = 16384 + 16640, CW_DCNT = 50176, CW_Q = 2048, CW_RSQQ = 53248, CW_RSQKV = 53248 + 16640, CW_RSQKR = 53248 + 2 * 16640;
static_assert(CW_RSQ3 + 16640 <= CW_DCNT && CW_DCNT + 64 * 32 <= CW_RSQQ && (CW_RSQKR + 16640) * 4 <= (int)CTL_ZERO_BYTES, "ctl");
constexpr int RING_BYTES = 131072, LDSCTL_OFF = 161792, MISC_OFF = LDSCTL_OFF + 320, LDS_BYTES = 163840;

#define GAS __attribute__((address_space(1)))
#define LAS __attribute__((address_space(3)))
typedef unsigned short bf16;
typedef unsigned v4u __attribute__((ext_vector_type(4)));
typedef float f32x4 __attribute__((ext_vector_type(4)));
typedef short bf16x8 __attribute__((ext_vector_type(8)));
typedef GAS unsigned gu32;
typedef GAS unsigned long long gu64;
#define RLX_AGENT __ATOMIC_RELAXED, __HIP_MEMORY_SCOPE_AGENT
#define LDS_WAIT() asm volatile("s_waitcnt lgkmcnt(0)" ::: "memory")
#define VM_WAIT() asm volatile("s_waitcnt vmcnt(0)" ::: "memory")
__device__ __forceinline__ unsigned long long rt() { return __builtin_amdgcn_s_memrealtime(); }
__device__ __forceinline__ unsigned f2bf(float f) { unsigned u = __builtin_bit_cast(unsigned, f); return (u + 0x7fffu + ((u >> 16) & 1u)) >> 16; }
__device__ __forceinline__ unsigned pk2(float lo, float hi) { return f2bf(lo) | (f2bf(hi) << 16); }
#define XB_TMO      128
#define XB_XCNT(j)  (256  + 64 * (j))
#define XB_XSUB(j)  (1280 + 64 * (j))
#define XB_XGEN(j)  (2304 + 64 * (j))
#define XB_TOP      3328
#define XB_TOPGEN   3392
#define XCD_BAR_WORDS 3456
#define XB_SPIN_CAP (1u << 18)

__device__ __forceinline__ unsigned xb_ld(unsigned* p)              { return __hip_atomic_load(p, __ATOMIC_RELAXED, __HIP_MEMORY_SCOPE_AGENT); }
__device__ __forceinline__ unsigned xb_add(unsigned* p, unsigned v) { return __hip_atomic_fetch_add(p, v, __ATOMIC_RELAXED, __HIP_MEMORY_SCOPE_AGENT); }
__device__ __forceinline__ unsigned xb_xcc_id() { return (unsigned)__builtin_amdgcn_s_getreg((3 << 11) | 20) & 0xFu; }
#define XB_SPIN(cond, bar) do { unsigned _sp = 0; while (cond) { __builtin_amdgcn_s_sleep(1); \
    if ((++_sp & 255u) == 0u) { if (xb_ld(&(bar)[XB_TMO])) break; if (_sp > XB_SPIN_CAP) { atomicAdd(&(bar)[XB_TMO], 1u); break; } } } } while (0)

struct XcdBarrier {
    unsigned* bar; unsigned x;
    volatile LAS unsigned* st;
};

__device__ __forceinline__ XcdBarrier xcd_barrier_post(unsigned* bar, volatile LAS unsigned* st) {
    XcdBarrier b; b.bar = bar; b.x = xb_xcc_id(); b.st = st;
    if (threadIdx.x == 0) (void)xb_add(&bar[XB_XCNT(b.x)], 1u);
    return b;
}
__device__ __forceinline__ void xcd_barrier_complete(unsigned* bar, unsigned x, unsigned& nloc, unsigned& nx) {
    const unsigned G = gridDim.x * gridDim.y * gridDim.z;
    unsigned sum, cnt, mine, sp = 0u;
    for (;;) {
        sum = 0u; cnt = 0u; mine = 0u;
#pragma unroll
        for (unsigned j = 0; j < 16; ++j) { const unsigned c = xb_ld(&bar[XB_XCNT(j)]); sum += c; cnt += (c > 0u) ? 1u : 0u; mine = (j == x) ? c : mine; }
        if (sum == G) break;
        __builtin_amdgcn_s_sleep(1);
        if ((++sp & 255u) == 0u) { if (xb_ld(&bar[XB_TMO])) break; if (sp > XB_SPIN_CAP) { atomicAdd(&bar[XB_TMO], 1u); break; } }
    }
    nloc = mine > 0u ? mine : 1u; nx = cnt > 0u ? cnt : 1u;
}

__device__ __forceinline__ void xcd_barrier(const XcdBarrier& b, const int wave_s) {
    asm volatile("s_waitcnt vmcnt(0)" ::: "memory");
    __syncthreads();
    if (wave_s == 0 && lane_id() == 0) {
        unsigned* bar = b.bar;
        __builtin_amdgcn_s_waitcnt(0);
        unsigned nloc = b.st[0], nx = b.st[1];
        if (nloc == 0u) { xcd_barrier_complete(bar, b.x, nloc, nx); b.st[0] = nloc; b.st[1] = nx; }
        const unsigned old = xb_add(&bar[XB_XSUB(b.x)], 1u);
        const unsigned gen = old / nloc;
        if (old + 1u == (gen + 1u) * nloc) {
            __builtin_amdgcn_fence(__ATOMIC_RELEASE, "agent");
            asm volatile("s_waitcnt vmcnt(0)" ::: "memory");
            const unsigned og = xb_add(&bar[XB_TOP], 1u);
            const unsigned tg = og / nx;
            if (og + 1u == (tg + 1u) * nx) xb_add(&bar[XB_TOPGEN], 1u);
            else XB_SPIN(xb_ld(&bar[XB_TOPGEN]) == tg, bar);
            __builtin_amdgcn_fence(__ATOMIC_ACQUIRE, "agent");
            xb_add(&bar[XB_XGEN(b.x)], 1u);
            asm volatile("s_waitcnt vmcnt(0)" ::: "memory");
        } else {
            XB_SPIN(xb_ld(&bar[XB_XGEN(b.x)]) == gen, bar);
            __builtin_amdgcn_fence(__ATOMIC_ACQUIRE, "agent");
            asm volatile("s_waitcnt vmcnt(0)" ::: "memory");
        }
    }
    __syncthreads();
}
typedef unsigned u32x2 __attribute__((ext_vector_type(2)));
typedef float f32x2 __attribute__((ext_vector_type(2)));
__device__ __forceinline__ float blo(unsigned w) { return __builtin_bit_cast(float, w << 16); }
__device__ __forceinline__ float bhi(unsigned w) { return __builtin_bit_cast(float, w & 0xffff0000u); }
__device__ __forceinline__ float bf1(bf16 b) { return __builtin_bit_cast(float, (unsigned)b << 16); }
__device__ __forceinline__ float rbf(float f) { return __builtin_bit_cast(float, f2bf(f) << 16); }
__device__ __forceinline__ float wave_sum(float v) {
#pragma unroll
    for (int o = 1; o < 64; o <<= 1) v += __shfl_xor(v, o);
    return v;
}
__device__ __forceinline__ float wave_max(float v) {
#pragma unroll
    for (int o = 1; o < 64; o <<= 1) v = fmaxf(v, __shfl_xor(v, o));
    return v;
}
__device__ __forceinline__ float dot8(v4u w, f32x4 x0, f32x4 x1) {
    return (blo(w.x) * x0[0] + bhi(w.x) * x0[1]) + (blo(w.y) * x0[2] + bhi(w.y) * x0[3]) + (blo(w.z) * x1[0] + bhi(w.z) * x1[1]) + (blo(w.w) * x1[2] + bhi(w.w) * x1[3]);
}
__device__ __forceinline__ float silu_f(float x) { return x / (1.0f + __expf(-x)); }

struct Args { const void* in[32]; float* out; unsigned char* ws; int ph_lo, ph_hi; };

struct TItem { const float* W; const float* gk; bf16* WT; int K, N, mode, item; };
__device__ __forceinline__ TItem prep_item(const Args& a, int it) {
    unsigned char* ws = a.ws;
    constexpr int I_IN = 16 * 62, I_QUP = 4 * 24, I_KV = 2 * 32, I_O = 16 * 32, I_G = 16 * 88, I_D = 44 * 32, I_PG = 16 * 32;
    TItem t; int r = it;
    t.W = (const float*)a.in[10]; t.gk = (const float*)a.in[9]; t.WT = (bf16*)(ws + WS_WIN); t.K = 1024; t.N = IN_COLS; t.mode = 3; t.item = r;
    if (r >= I_IN) { r -= I_IN; t.W = (const float*)a.in[15]; t.gk = (const float*)a.in[14]; t.WT = (bf16*)(ws + WS_WQUP); t.K = 256; t.N = 768; t.mode = 4; t.item = r;
     if (r >= I_QUP) { r -= I_QUP; t.W = (const float*)a.in[20]; t.gk = nullptr; t.WT = (bf16*)(ws + WS_WKVUP); t.K = 128; t.N = 1024; t.mode = 0; t.item = r;
      if (r >= I_KV) { r -= I_KV; t.gk = (const float*)a.in[18]; t.WT = (bf16*)(ws + WS_WKVP); t.mode = 5; t.item = r;
       if (r >= I_KV) { r -= I_KV; t.W = (const float*)a.in[22]; t.gk = nullptr; t.WT = (bf16*)(ws + WS_WO); t.K = 1024; t.N = 1024; t.mode = 0; t.item = r;
        if (r >= I_O) { r -= I_O; t.W = (const float*)a.in[24]; t.gk = (const float*)a.in[23]; t.WT = (bf16*)(ws + WS_WGU); t.K = 1024; t.N = FF; t.mode = 1; t.item = r;
         if (r >= I_G) { r -= I_G; t.W = (const float*)a.in[25]; t.mode = 2; t.item = r;
          if (r >= I_G) { r -= I_G; t.W = (const float*)a.in[28]; t.gk = nullptr; t.WT = (bf16*)(ws + WS_WD); t.K = FF; t.N = 1024; t.mode = 0; t.item = r;
           if (r >= I_D) { r -= I_D; t.W = (const float*)a.in[30]; t.gk = (const float*)a.in[29]; t.WT = (bf16*)(ws + WS_WPG); t.K = 1024; t.N = 1024; t.item = r;
            if (r >= I_PG) { r -= I_PG; t.W = (const float*)a.in[31]; t.gk = nullptr; t.WT = (bf16*)(ws + WS_WPP); t.K = 256; t.N = 1024; t.item = r; } } } } } } } } }
    return t;
}
#define TI_LOAD(TV, T) do { const int nblk_ = ((T).N + 31) / 32, kb_ = (T).item / nblk_, nb_ = (T).item - kb_ * nblk_; const int nn_ = 32 * nb_ + (lane & 31); \
        _Pragma("unroll") for (int i = 0; i < 32; ++i) { const int kk = 2 * i + (lane >> 5); TV[i] = (nn_ < (T).N) ? (T).W[(size_t)(64 * kb_ + kk) * (T).N + nn_] : 0.f; } } while (0)
#define TI_FINISH(TV, T) do { const int nblk_ = ((T).N + 31) / 32, kb_ = (T).item / nblk_, nb_ = (T).item - kb_ * nblk_, k0 = 64 * kb_, n0 = 32 * nb_; \
        _Pragma("unroll") for (int i = 0; i < 32; ++i) { const int kk = 2 * i + (lane >> 5); float v = TV[i]; if ((T).gk) v *= (T).gk[k0 + kk]; scr[kk * 33 + (lane & 31)] = v; } \
        LDS_WAIT(); asm volatile("" ::: "memory"); \
        const int c = lane & 7; \
        _Pragma("unroll") for (int j = 0; j < 4; ++j) { const int nl = (lane >> 3) + 8 * j, n = n0 + nl; const LAS float* s = scr + (8 * c) * 33 + nl; \
            v4u o; o.x = pk2(s[0 * 33], s[1 * 33]); o.y = pk2(s[2 * 33], s[3 * 33]); o.z = pk2(s[4 * 33], s[5 * 33]); o.w = pk2(s[6 * 33], s[7 * 33]); \
            int row = n; const int mode = (T).mode; \
            if (mode == 1 || mode == 2) row = (n >> 7) * 256 + (n & 127) + (mode == 2 ? 128 : 0); \
            else if (mode == 3) { if (n >= 1936) row = 1920 + (n - 1936); else if (n >= 1808) row = 1792 + (n - 1808); else if (n >= 1552) row = 1536 + (n - 1552); else if (n >= 1536) row = 1952 + (n - 1536); } \
            else if (mode == 4) { const int h = n / 96, d = n - 96 * h; row = (d < 64) ? 256 * (h >> 2) + 128 * (d >> 5) + 32 * (h & 3) + (d & 31) : 512 + 128 * (h >> 2) + 32 * (h & 3) + (d - 64); } \
            else if (mode == 5) { const int h = n >> 7, x = n & 127; row = (x < 64) ? 256 * (h >> 2) + 128 * (x >> 5) + 32 * (h & 3) + (x & 31) : 512 + 256 * (h >> 2) + 128 * ((x - 64) >> 5) + 32 * (h & 3) + ((x - 64) & 31); } \
            if (n < (T).N) *(GAS v4u*)((T).WT + (size_t)row * (T).K + k0 + 8 * c) = o; } \
        LDS_WAIT(); asm volatile("" ::: "memory"); } while (0)
constexpr int PREP_LATE0 = 16 * 62 + 4 * 24 + 2 * (2 * 32), PREP_LATE1 = PREP_LATE0 + 16 * 32 + 2 * (16 * 88) + 44 * 32 + 16 * 32, PREP_LATE_TICKETS = (PREP_LATE1 - PREP_LATE0) / 16;
static_assert((PREP_LATE1 - PREP_LATE0) % 16 == 0, "late prep items per ticket");
__device__ __forceinline__ void prep_late(const Args& a, LAS unsigned char* lds, int ticket, int wave, int lane) {
    LAS float* scr = (LAS float*)(lds + wave * 16384);
    const int i0 = PREP_LATE0 + ticket * 16 + wave;
    float tvA[32], tvB[32]; TItem tA = prep_item(a, i0), tB = prep_item(a, i0 + 8);
    TI_LOAD(tvA, tA); TI_LOAD(tvB, tB); TI_FINISH(tvA, tA); TI_FINISH(tvB, tB);
}
constexpr int PREP_P_TICKETS = MP / 64;
__device__ __forceinline__ void prep_late_p(const Args& a, int ticket, int wave, int lane) {
    bf16* PB = (bf16*)(a.ws + WS_PB); const int m0 = ticket * 64 + wave * 8;
    f32x4 pv[8];
#pragma unroll
    for (int j = 0; j < 8; ++j) pv[j] = ((const GAS f32x4*)((const float*)a.in[7] + (size_t)(m0 + j) * 256))[lane];
#pragma unroll
    for (int j = 0; j < 8; ++j) ((GAS unsigned long long*)(PB + (size_t)(m0 + j) * 256))[lane] = (unsigned long long)pk2(pv[j].x, pv[j].y) | ((unsigned long long)pk2(pv[j].z, pv[j].w) << 32);
}
__device__ __forceinline__ void prep_phase(const Args& a, LAS unsigned char* lds, int gw, int NGW, int wave, int lane) {
    unsigned char* ws = a.ws;
    LAS float* scr = (LAS float*)(lds + wave * 16384);
    constexpr int NITEMS = PREP_LATE0 + 4 * 32;
#define EMAP(e) ((e) < PREP_LATE0 ? (e) : (e) + (PREP_LATE1 - PREP_LATE0))
    { float tvA[32], tvB[32]; int it = gw; TItem tA = prep_item(a, it < NITEMS ? EMAP(it) : 0), tB = tA;
      if (it < NITEMS) TI_LOAD(tvA, tA);
#pragma unroll 1
      while (it < NITEMS) {
          const int it1 = it + NGW; if (it1 < NITEMS) { tB = prep_item(a, EMAP(it1)); TI_LOAD(tvB, tB); }
          TI_FINISH(tvA, tA);
          if (it1 >= NITEMS) break;
          const int it2 = it1 + NGW; if (it2 < NITEMS) { tA = prep_item(a, EMAP(it2)); TI_LOAD(tvA, tA); }
          TI_FINISH(tvB, tB);
          it = it2; } }
#undef EMAP
    const int gt = gw * 64 + lane, NGT = NGW * 64;
    for (int i = gt; i < 128 * 1024 / 4; i += NGT) { const f32x4 v = ((const GAS f32x4*)a.in[20])[i]; ((GAS unsigned long long*)(ws + WS_WKVN))[i] = (unsigned long long)pk2(v.x, v.y) | ((unsigned long long)pk2(v.z, v.w) << 32); }
    for (int i = gt; i < 80 * 1024 / 8; i += NGT) ((GAS v4u*)(ws + WS_WIN + (size_t)IN_COLS * 1024 * 2))[i] = (v4u){0u, 0u, 0u, 0u};
    for (int i = gt; i < 2056 * 16; i += NGT) {
        const int pidx = i >> 4, d = i & 15; const int pos = pidx < 2048 ? pidx : 16384 + (pidx - 2048);
        double inv = 1.0; for (int k = 0; k < d; ++k) inv *= 0.56234132519034908;
        const float ang = (float)pos * (float)inv;
        const double turns = (double)ang * 0.15915494309189535; const double fr = turns - __builtin_floor(turns);
        f32x2 cs; cs.x = __builtin_amdgcn_cosf((float)fr); cs.y = __builtin_amdgcn_sinf((float)fr);
        ((GAS f32x2*)(ws + WS_ROPE))[i] = cs;
    }
    bf16* XB = (bf16*)(ws + WS_XB); float* RS1 = (float*)(ws + WS_RS1); bf16* PB = (bf16*)(ws + WS_PB);
#pragma unroll 4
    for (int m = gw; m < MT; m += NGW) {
        const float* xrow = (m < MP) ? (const float*)a.in[0] + (size_t)m * DM : (const float*)a.in[1] + (size_t)(m - MP) * DM;
        const GAS f32x4* xr = (const GAS f32x4*)xrow + lane;
        f32x4 v[4]; float s = 0.f;
#pragma unroll
        for (int j = 0; j < 4; ++j) { v[j] = xr[64 * j]; s += (v[j].x * v[j].x + v[j].y * v[j].y) + (v[j].z * v[j].z + v[j].w * v[j].w); }
        s = wave_sum(s);
        GAS unsigned long long* o8 = (GAS unsigned long long*)(XB + (size_t)m * DM) + lane;
#pragma unroll
        for (int j = 0; j < 4; ++j) o8[64 * j] = (unsigned long long)pk2(v[j].x, v[j].y) | ((unsigned long long)pk2(v[j].z, v[j].w) << 32);
        if (lane == 0) RS1[m] = 1.0f / sqrtf(s * (1.0f / DM) + EPSN);
        if (m >= MP) {
            const f32x4 pv = ((const GAS f32x4*)((const float*)a.in[8] + (size_t)(m - MP) * 256))[lane];
            ((GAS unsigned long long*)(PB + (size_t)m * 256))[lane] = (unsigned long long)pk2(pv.x, pv.y) | ((unsigned long long)pk2(pv.z, pv.w) << 32); }
    }
}

namespace pattn {
typedef short bf16x8 __attribute__((ext_vector_type(8)));
typedef short s16x4 __attribute__((ext_vector_type(4)));
typedef float f32x16 __attribute__((ext_vector_type(16)));
typedef unsigned u32x4 __attribute__((ext_vector_type(4)));
constexpr int NW = 8, QBLK = 32, KVBLK = 64, QB = NW * QBLK, DQK = 96, DV = 64;
constexpr int KP = 768, VP = 512, QP = 768, OP = 1024;
constexpr int SHM_V = KVBLK * 128 * 2, SHM_K = KVBLK * 256;
constexpr int LDS_BYTES = 2 * SHM_V + 2 * SHM_K + NW * 64 * 4;
constexpr float THR = 8.f;
#define KSWZ(row, colB) ((row) * 256 + ((colB) ^ (((row) & 7) << 4)))
#define SBAR() __builtin_amdgcn_sched_barrier(0)
__device__ __forceinline__ int v_st(int k, int c) { const int kk = (k & ~0xC) | ((k & 4) << 1) | ((k & 8) >> 1); return ((kk >> 3) * 4 + (c >> 5)) * 512 + ((kk & 7) * 32 + (c & 31)) * 2; }
__device__ __forceinline__ int v_rd_base(int lane) { return ((lane & 3) << 3) | (((lane >> 2) & 3) << 6) | (((lane >> 4) & 1) << 5) | (((lane >> 5) & 1) << 8); }
constexpr int v_rd_off(int d0, int ks, int half) { return d0 * 512 + ks * 4096 + half * 2048; }
__device__ __forceinline__ int crow(int r, int hi) { return (r & 3) + 8 * (r >> 2) + 4 * hi; }
__device__ __forceinline__ unsigned cvtpk(float lo, float hi) { unsigned r; asm volatile("v_cvt_pk_bf16_f32 %0, %1, %2" : "=v"(r) : "v"(lo), "v"(hi)); return r; }
__device__ __forceinline__ bf16x8 load8(const bf16* p) { return *reinterpret_cast<const bf16x8*>(p); }
__device__ __forceinline__ void mask_tile(f32x16& p0, f32x16& p1, int dq) {
    const float NEG = -__builtin_inff();
#pragma unroll
    for (int r = 0; r < 16; ++r) { const int c = (r & 3) + 8 * (r >> 2); if (dq - c < 0) p0[r] = NEG; if (dq - c - 32 < 0) p1[r] = NEG; }
}
__device__ __forceinline__ void partialSM(f32x16& p0, f32x16& p1, float& m_reg, float& mn, float& alpha) {
    float pmax = p0[0];
#pragma unroll
    for (int r = 1; r < 16; ++r) pmax = fmaxf(pmax, p0[r]);
#pragma unroll
    for (int r = 0; r < 16; ++r) pmax = fmaxf(pmax, p1[r]);
    { auto rr = __builtin_amdgcn_permlane32_swap(__float_as_uint(pmax), __float_as_uint(pmax), false, false); pmax = fmaxf(__uint_as_float(rr[0]), __uint_as_float(rr[1])); }
    if (__builtin_expect(__all((pmax - m_reg) <= THR), 1)) { mn = m_reg; alpha = 1.f; }
    else { mn = fmaxf(m_reg, pmax); alpha = __builtin_amdgcn_exp2f(m_reg - mn); m_reg = mn; }
#pragma unroll
    for (int r = 0; r < 16; ++r) p0[r] = p0[r] - mn;
#pragma unroll
    for (int r = 0; r < 16; ++r) p1[r] = p1[r] - mn;
#pragma unroll
    for (int r = 0; r < 16; ++r) p0[r] = __builtin_amdgcn_exp2f(p0[r]);
}
__device__ __forceinline__ void finishSM(f32x16& p0, f32x16& p1, float alpha, float& l_reg, bf16x8& pa0, bf16x8& pa1, bf16x8& pa2, bf16x8& pa3) {
#pragma unroll
    for (int r = 0; r < 16; ++r) p1[r] = __builtin_amdgcn_exp2f(p1[r]);
    float ps = 0;
#pragma unroll
    for (int r = 0; r < 16; ++r) ps += p0[r];
#pragma unroll
    for (int r = 0; r < 16; ++r) ps += p1[r];
    { auto rr = __builtin_amdgcn_permlane32_swap(__float_as_uint(ps), __float_as_uint(ps), false, false); ps = __uint_as_float(rr[0]) + __uint_as_float(rr[1]); }
    l_reg = l_reg * alpha + ps;
#define PK4(P, B_, OUT) do { unsigned a0 = cvtpk(P[B_+0], P[B_+1]), a1 = cvtpk(P[B_+2], P[B_+3]); unsigned b0 = cvtpk(P[B_+4], P[B_+5]), b1 = cvtpk(P[B_+6], P[B_+7]); \
        auto r0 = __builtin_amdgcn_permlane32_swap(a0, b0, false, false); auto r1 = __builtin_amdgcn_permlane32_swap(a1, b1, false, false); \
        u32x4 w = {r0[0], r1[0], r0[1], r1[1]}; OUT = *reinterpret_cast<bf16x8*>(&w); } while (0)
    PK4(p0, 0, pa0); PK4(p0, 8, pa1); PK4(p1, 0, pa2); PK4(p1, 8, pa3);
#undef PK4
}
template <int KB>
__device__ __forceinline__ void qkt(f32x16& p0, f32x16& p1, const char* K_lds, int r32, int hi, const bf16x8* qr) {
    p0 = f32x16{}; p1 = f32x16{};
    const char* kb[4];
#pragma unroll
    for (int dd = 0; dd < 4; ++dd) kb[dd] = K_lds + KB * SHM_K + KSWZ(r32, (dd * 16 + hi * 8) * 2);
#pragma unroll
    for (int d0 = 0; d0 < 6; ++d0) { const char* a = kb[d0 & 3] + (d0 >> 2) * 128;
        bf16x8 b0 = *reinterpret_cast<const bf16x8*>(a);
        bf16x8 b1 = *reinterpret_cast<const bf16x8*>(a + 32 * 256);
        p0 = __builtin_amdgcn_mfma_f32_32x32x16_bf16(b0, qr[d0], p0, 0, 0, 0);
        p1 = __builtin_amdgcn_mfma_f32_32x32x16_bf16(b1, qr[d0], p1, 0, 0, 0); }
}
template <int VB>
__device__ __forceinline__ void pv_tile(f32x16* o, int vb0, bf16x8 pa0, bf16x8 pa1, bf16x8 pa2, bf16x8 pa3) {
#define TRRD(dst, off) asm volatile("ds_read_b64_tr_b16 %0, %1 offset:%2" : "=&v"(dst) : "v"(vb0), "i"(off) : "memory")
#define PV_D0(d0) do { s16x4 l0, l1, l2, l3, h0, h1, h2, h3; constexpr int b_ = VB * SHM_V + v_rd_off(d0, 0, 0); \
        TRRD(l0, b_); TRRD(h0, b_ + 2048); TRRD(l1, b_ + 4096); TRRD(h1, b_ + 6144); TRRD(l2, b_ + 8192); TRRD(h2, b_ + 10240); TRRD(l3, b_ + 12288); TRRD(h3, b_ + 14336); \
        asm volatile("s_waitcnt lgkmcnt(0)" ::: "memory"); SBAR(); \
        o[d0] = __builtin_amdgcn_mfma_f32_32x32x16_bf16(pa0, (bf16x8){l0[0], l0[1], l0[2], l0[3], h0[0], h0[1], h0[2], h0[3]}, o[d0], 0, 0, 0); \
        o[d0] = __builtin_amdgcn_mfma_f32_32x32x16_bf16(pa1, (bf16x8){l1[0], l1[1], l1[2], l1[3], h1[0], h1[1], h1[2], h1[3]}, o[d0], 0, 0, 0); \
        o[d0] = __builtin_amdgcn_mfma_f32_32x32x16_bf16(pa2, (bf16x8){l2[0], l2[1], l2[2], l2[3], h2[0], h2[1], h2[2], h2[3]}, o[d0], 0, 0, 0); \
        o[d0] = __builtin_amdgcn_mfma_f32_32x32x16_bf16(pa3, (bf16x8){l3[0], l3[1], l3[2], l3[3], h3[0], h3[1], h3[2], h3[3]}, o[d0], 0, 0, 0); } while (0)
    PV_D0(0); PV_D0(1);
#undef PV_D0
#undef TRRD
}
struct BlockRef { const bf16* Q; const bf16* K; const bf16* V; bf16* O; int P0; };
struct Seam { bf16x8 qr[6]; bf16x8 st_v0, st_v1, st_k0, st_k1; };
#define VMW() asm volatile("s_waitcnt vmcnt(0)" ::: "memory")
#define VMWN(n) asm volatile("s_waitcnt vmcnt(%0)" :: "i"(n) : "memory")
#define SLOAD_H(Kp, Vp, k0) do { if (ch < 8) { S.st_v0 = load8((Vp) + (size_t)((k0) + sr) * VP + sc); S.st_v1 = load8((Vp) + (size_t)((k0) + 32 + sr) * VP + sc); } \
                                 if (ch < 12) { S.st_k0 = load8((Kp) + (size_t)((k0) + sr) * KP + sc); S.st_k1 = load8((Kp) + (size_t)((k0) + 32 + sr) * KP + sc); } } while (0)
#define SWRITE_HK(bf) do { if (ch < 12) { *(bf16x8*)(K_lds + (bf) * SHM_K + kws) = S.st_k0; *(bf16x8*)(K_lds + (bf) * SHM_K + kws + 32 * 256) = S.st_k1; } } while (0)
#define SWRITE_HV(bf) do { if (ch < 8) { *(bf16x8*)(V_lds + (bf) * SHM_V + vst0) = S.st_v0; *(bf16x8*)(V_lds + (bf) * SHM_V + vst1) = S.st_v1; } } while (0)
#define SWRITE_H(bf) do { SWRITE_HV(bf); SWRITE_HK(bf); } while (0)
__device__ __forceinline__ void prime(const BlockRef& cur, char* lds, Seam& S, const int wave_s) {
    int tid_o = wave_s * 64 + lane_id(); asm volatile("" : "+v"(tid_o));
    const int tid = tid_o, wid = __builtin_amdgcn_readfirstlane(tid >> 6), lane = tid & 63, r32 = lane & 31, hi = lane >> 5;
    const int sr = tid >> 4, ch = tid & 15, sc = ch * 8, kws = KSWZ(sr, sc * 2); char* K_lds = lds + 2 * SHM_V;
#pragma unroll
    for (int d0 = 0; d0 < 6; ++d0) S.qr[d0] = load8(cur.Q + (size_t)(wid * QBLK + r32) * QP + d0 * 16 + hi * 8);
    SLOAD_H(cur.K, cur.V, 0); VMW(); SWRITE_HK(0);
    __syncthreads();
}
__device__ __forceinline__ void block(const BlockRef& cur, const BlockRef& nxt, char* lds, Seam& S, const int wave_s) {
    int tid_o = wave_s * 64 + lane_id(); asm volatile("" : "+v"(tid_o));
    const int tid = tid_o, wid = __builtin_amdgcn_readfirstlane(tid >> 6), lane = tid & 63, r32 = lane & 31, hi = lane >> 5;
    const int NT = (cur.P0 + QB - 1) / KVBLK + 1;
    const int qlo = cur.P0 + wid * QBLK, qm = qlo + r32 - 4 * hi;
    char* V_lds = lds; char* K_lds = lds + 2 * SHM_V;
    float* wsf = (float*)(lds + 2 * SHM_V + 2 * SHM_K) + wid * 64; float* li_l = wsf, * al_l = wsf + 32;
    float m_reg = -1e30f, l_reg = 0; f32x16 o[2] = {};
    const int sr = tid >> 4, ch = tid & 15, sc = ch * 8, vst0 = v_st(sr, sc & 63), vst1 = v_st(32 + sr, sc & 63), kws = KSWZ(sr, sc * 2);
    const int vb0 = (int)(uintptr_t)V_lds + v_rd_base(lane);
    const bf16* Kh = cur.K; const bf16* Vh = cur.V;
#define RESC(a) do { if (__any((a) < 1.f)) { if (hi == 0) al_l[r32] = (a); asm volatile("s_waitcnt lgkmcnt(0)" ::: "memory"); \
                     _Pragma("unroll") for (int d_ = 0; d_ < 2; ++d_) _Pragma("unroll") for (int r = 0; r < 16; ++r) o[d_][r] *= al_l[crow(r, hi)]; } } while (0)
#define KBASE(t) ((t) * KVBLK)
#define MASKT(P0_, P1_, t) do { const int kb_ = KBASE(t); if (kb_ + KVBLK - 1 > qlo) mask_tile(P0_, P1_, qm - kb_); } while (0)
#define SEAM_K0() do { VMWN(6); SWRITE_HK(0); SBAR(); } while (0)
    f32x16 pA0, pA1, pB0, pB1; float mnA, mnB, alA, alB; bf16x8 pa0, pa1, pa2, pa3;
    SWRITE_HV(0); SBAR();
    if (NT > 1) SLOAD_H(Kh, Vh, KBASE(1));
    SBAR(); qkt<0>(pA0, pA1, K_lds, r32, hi, S.qr);
    MASKT(pA0, pA1, 0); partialSM(pA0, pA1, m_reg, mnA, alA);
    if (NT > 1) { VMW(); SWRITE_H(1); }
    __syncthreads();
#define HALF_STEP(PX0, PX1, mnX, alX, PY0, PY1, alY, t, KB, VB, SB) do { \
        SBAR(); qkt<KB>(PX0, PX1, K_lds, r32, hi, S.qr); \
        finishSM(PY0, PY1, alY, l_reg, pa0, pa1, pa2, pa3); SBAR(); \
        if ((t) + 1 < NT) { SLOAD_H(Kh, Vh, KBASE((t) + 1)); SBAR(); } \
        pv_tile<VB>(o, vb0, pa0, pa1, pa2, pa3); MASKT(PX0, PX1, (t)); partialSM(PX0, PX1, m_reg, mnX, alX); \
        __syncthreads(); \
        if ((t) + 1 < NT) { VMW(); SWRITE_H(SB); } \
        RESC(alX); __syncthreads(); } while (0)
    for (int t = 1; t + 1 < NT; t += 2) {
        HALF_STEP(pB0, pB1, mnB, alB, pA0, pA1, alA, t, 1, 0, 0);
        HALF_STEP(pA0, pA1, mnA, alA, pB0, pB1, alB, t + 1, 0, 1, 1);
    }
    const bool even = (NT & 1) == 0;
    if (even) { SBAR(); qkt<1>(pB0, pB1, K_lds, r32, hi, S.qr); SBAR(); }
    SLOAD_H(nxt.K, nxt.V, 0); SBAR();
#pragma unroll
    for (int d0 = 0; d0 < 6; ++d0) S.qr[d0] = load8(nxt.Q + (size_t)(wid * QBLK + r32) * QP + d0 * 16 + hi * 8);
    SBAR();
    finishSM(pA0, pA1, alA, l_reg, pa0, pa1, pa2, pa3); SBAR();
    pv_tile<0>(o, vb0, pa0, pa1, pa2, pa3);
    if (even) { MASKT(pB0, pB1, NT - 1); partialSM(pB0, pB1, m_reg, mnB, alB); __syncthreads(); RESC(alB);
        finishSM(pB0, pB1, alB, l_reg, pa0, pa1, pa2, pa3); SBAR(); pv_tile<1>(o, vb0, pa0, pa1, pa2, pa3); }
    SBAR(); SEAM_K0();
    if (hi == 0) li_l[r32] = l_reg; asm volatile("s_waitcnt lgkmcnt(0)" ::: "memory");
    float rli[16];
#pragma unroll
    for (int r = 0; r < 16; ++r) rli[r] = __builtin_amdgcn_rcpf(li_l[crow(r, hi)]);
    bf16* Ow = cur.O + (size_t)(wid * QBLK) * OP;
    { unsigned short* so = (unsigned short*)(lds + 73728 + wid * 4096);
#pragma unroll
      for (int r = 0; r < 16; ++r) { const int orow = crow(r, hi);
#pragma unroll
          for (int d0 = 0; d0 < 2; ++d0) so[orow * 64 + d0 * 32 + r32] = (unsigned short)f2bf(o[d0][r] * rli[r]); }
      asm volatile("s_waitcnt lgkmcnt(0)" ::: "memory");
#pragma unroll
      for (int i = 0; i < 4; ++i) { const int chunk = i * 64 + lane, row = chunk >> 3, c8 = chunk & 7;
          const u32x4 v = *(const u32x4*)(so + row * 64 + c8 * 8);
          *(u32x4*)(Ow + (size_t)row * OP + c8 * 8) = v; } }
    __syncthreads();
#undef RESC
#undef KBASE
#undef MASKT
#undef SEAM_K0
#undef HALF_STEP
}
#undef VMW
#undef VMWN
#undef SLOAD_H
#undef SWRITE_HK
#undef SWRITE_HV
#undef SWRITE_H
#undef KSWZ
#undef SBAR
__device__ __forceinline__ BlockRef mkref(const bf16* QM, const bf16* KM, const bf16* VM, bf16* AO, int item, int pass) {
    const int bh = item >> 2, y = item & 3, qb = pass ? 7 - y : y, b = bh >> 3, h = bh & 7; BlockRef r;
    r.Q = QM + (((size_t)b * 2048 + qb * QB) * 8 + h) * 96; r.K = KM + ((size_t)b * 2048 * 8 + h) * 96; r.V = VM + ((size_t)b * 2048 * 8 + h) * 64;
    r.O = AO + ((size_t)b * 2048 + qb * QB) * 1024 + 512 + h * 64; r.P0 = qb * QB; return r;
}
__device__ __forceinline__ void phase(char* lds, const bf16* QM, const bf16* KM, const bf16* VM, bf16* AO, int vcu, int G, const int wave_s) {
    Seam S;
    int item = vcu; if (item >= 256) return;
    BlockRef cur = mkref(QM, KM, VM, AO, item, 0); int pass = 0;
    prime(cur, lds, S, wave_s);
    for (;;) {
        int itn = item, pn = pass + 1; bool last = false;
        if (pass == 1) { pn = 0; itn = item + G; if (itn >= 256) { last = true; itn = item; pn = 1; } }
        const BlockRef nxt = mkref(QM, KM, VM, AO, itn, pn);
        block(cur, nxt, lds, S, wave_s);
        if (last) break;
        cur = nxt; item = itn; pass = pn;
    }
}
__device__ __forceinline__ void one(char* lds, const bf16* QM, const bf16* KM, const bf16* VM, bf16* AO, int idx, const int wave_s) {
    Seam S; const int qb = 7 - (idx >> 6), bh = idx & 63, b = bh >> 3, h = bh & 7; BlockRef r;
    r.Q = QM + (((size_t)b * 2048 + qb * QB) * 8 + h) * 96; r.K = KM + ((size_t)b * 2048 * 8 + h) * 96; r.V = VM + ((size_t)b * 2048 * 8 + h) * 64;
    r.O = AO + ((size_t)b * 2048 + qb * QB) * 1024 + 512 + h * 64; r.P0 = qb * QB;
    prime(r, lds, S, wave_s); block(r, r, lds, S, wave_s);
}
}
namespace dec {
typedef short bf16x8 __attribute__((ext_vector_type(8)));
typedef short s16x4 __attribute__((ext_vector_type(4)));
typedef float f32x16 __attribute__((ext_vector_type(16)));
typedef unsigned u32x4 __attribute__((ext_vector_type(4)));
typedef int i32x4 __attribute__((ext_vector_type(4)));
typedef int i32x16 __attribute__((ext_vector_type(16)));
typedef float f32x2 __attribute__((ext_vector_type(2)));
constexpr int L_SC = 0, L_CT = 65536, L_RT = 98304, L_QA = 106496, L_QR = 122880, L_RTAB = 126976, L_AL = 131072, L_ML = 133120, L_C8 = 137216, L_KI = 153600, L_END = 154112;
constexpr float THR = 8.f;
__device__ __forceinline__ unsigned off_b(unsigned row, unsigned ch) { return 256u * row + 16u * (ch ^ (((row & 3) << 2) | ((row >> 2) & 3))); }
__device__ __forceinline__ int crow(int r, int hi) { return (r & 3) + 8 * (r >> 2) + 4 * hi; }
__device__ __forceinline__ unsigned cvtpk(float lo, float hi) { unsigned r; asm volatile("v_cvt_pk_bf16_f32 %0, %1, %2" : "=v"(r) : "v"(lo), "v"(hi)); return r; }
__device__ __forceinline__ bf16x8 pack8(f32x4 a, f32x4 b) { u32x4 w = {cvtpk(a[0], a[1]), cvtpk(a[2], a[3]), cvtpk(b[0], b[1]), cvtpk(b[2], b[3])}; return *reinterpret_cast<bf16x8*>(&w); }
__device__ __forceinline__ unsigned off_c8(unsigned key, unsigned c16) { return 128u * key + ((c16 ^ ((key >> 1) & 7u)) << 4); }
__device__ __forceinline__ unsigned q4(float x0, float x1, float x2, float x3, float sc) {
    const unsigned f0 = __float_as_uint(__builtin_fmaf(x0, sc, 12582912.f)), f1 = __float_as_uint(__builtin_fmaf(x1, sc, 12582912.f)), f2 = __float_as_uint(__builtin_fmaf(x2, sc, 12582912.f)), f3 = __float_as_uint(__builtin_fmaf(x3, sc, 12582912.f));
    return __builtin_amdgcn_perm(f1, f0, 0x0c0c0400u) | __builtin_amdgcn_perm(f3, f2, 0x04000c0cu); }
__device__ __forceinline__ float rowmax16(float v) {
    asm("s_nop 1\n\tv_max_f32_dpp %0, %0, %0 row_ror:8 row_mask:0xf bank_mask:0xf\n\ts_nop 1\n\tv_max_f32_dpp %0, %0, %0 row_ror:4 row_mask:0xf bank_mask:0xf\n\t"
        "s_nop 1\n\tv_max_f32_dpp %0, %0, %0 row_ror:2 row_mask:0xf bank_mask:0xf\n\ts_nop 1\n\tv_max_f32_dpp %0, %0, %0 row_ror:1 row_mask:0xf bank_mask:0xf" : "+v"(v));
    return v; }
__device__ __forceinline__ float amax3(float a, float b, float c) { float r; asm("v_max3_f32 %0, |%1|, |%2|, |%3|" : "=v"(r) : "v"(a), "v"(b), "v"(c)); return r; }
__device__ __forceinline__ float amax8(f32x4 x0, f32x4 x1) { return amax3(x1[3], x1[3], amax3(x1[1], x1[2], amax3(x0[3], x1[0], amax3(x0[0], x0[1], x0[2])))); }
#define DBAR() asm volatile("s_waitcnt lgkmcnt(0)\n\ts_barrier" ::: "memory")
__device__ __forceinline__ void combine(const Args& a, char* lds, int bs, int wave, int lane) {
    unsigned char* ws = a.ws; const int h = wave, r31 = lane & 31, hi = lane >> 5, t = lane >> 3, x = lane & 7;
    const bf16* QM = (const bf16*)(ws + WS_QM); const bf16* KM = (const bf16*)(ws + WS_KM); const bf16* VM = (const bf16*)(ws + WS_VM); const bf16* WkvT = (const bf16*)(ws + WS_WKVUP); bf16* AO = (bf16*)(ws + WS_AO);
    const float* part = (const float*)(ws + WS_PART) + (size_t)bs * 8 * 64 * 132;
    float* wl = (float*)(lds + wave * 4096);
    float* pl = wl + 64; float* Ll = wl + 128; float* Dl = wl + 192;
    const size_t rowt = (size_t)MP + bs * 8 + t;
    const float mg = part[(x * 64 + h * 8 + t) * 132], lg = part[(x * 64 + h * 8 + t) * 132 + 1];
    float sn = 0.f;
    { const bf16* qrow = QM + (rowt * 8 + h) * 96; const bf16* krow = KM + (((size_t)MP + bs * 8 + x) * 8 + h) * 96;
#pragma unroll
      for (int c = 0; c < 12; ++c) { const v4u q = *(const v4u*)(qrow + c * 8), k = *(const v4u*)(krow + c * 8);
          sn += (blo(q.x) * blo(k.x) + bhi(q.x) * bhi(k.x)) + (blo(q.y) * blo(k.y) + bhi(q.y) * bhi(k.y)) + (blo(q.z) * blo(k.z) + bhi(q.z) * bhi(k.z)) + (blo(q.w) * blo(k.w) + bhi(q.w) * bhi(k.w)); } }
    if (x > t) sn = -1e30f;
    float mx = fmaxf(mg, sn); mx = fmaxf(mx, __shfl_xor(mx, 1)); mx = fmaxf(mx, __shfl_xor(mx, 2)); mx = fmaxf(mx, __shfl_xor(mx, 4));
    const float wg = __builtin_amdgcn_exp2f(mg - mx), pn = (x > t) ? 0.f : __builtin_amdgcn_exp2f(sn - mx);
    float L = lg * wg + pn; L += __shfl_xor(L, 1); L += __shfl_xor(L, 2); L += __shfl_xor(L, 4);
    wl[lane] = wg; pl[lane] = pn; if (x == 0) Ll[t] = L;
    asm volatile("s_waitcnt lgkmcnt(0)" ::: "memory");
    f32x16 D0 = {}, D1 = {};
    float wr8[8];
#pragma unroll
    for (int g = 0; g < 8; ++g) wr8[g] = (r31 < 8) ? wl[r31 * 8 + g] : 0.f;
#pragma unroll 2
    for (int ks = 0; ks < 8; ++ks) { f32x4 s0 = {0.f, 0.f, 0.f, 0.f}, s1 = {0.f, 0.f, 0.f, 0.f};
        if (r31 < 8) {
#pragma unroll
            for (int g = 0; g < 8; ++g) { const float* p = part + (g * 64 + h * 8 + r31) * 132 + 4 + 16 * ks + 8 * hi; s0 += wr8[g] * *(const f32x4*)p; s1 += wr8[g] * *(const f32x4*)(p + 4); } }
        const bf16x8 af = pack8(s0, s1);
        const bf16x8 b0 = *(const bf16x8*)(WkvT + (size_t)(128 * h + 64 + r31) * 128 + 16 * ks + 8 * hi), b1 = *(const bf16x8*)(WkvT + (size_t)(128 * h + 96 + r31) * 128 + 16 * ks + 8 * hi);
        D0 = __builtin_amdgcn_mfma_f32_32x32x16_bf16(af, b0, D0, 0, 0, 0); D1 = __builtin_amdgcn_mfma_f32_32x32x16_bf16(af, b1, D1, 0, 0, 0); }
#pragma unroll
    for (int r = 0; r < 4; ++r) { Dl[(r + 4 * hi) * 64 + r31] = D0[r]; Dl[(r + 4 * hi) * 64 + 32 + r31] = D1[r]; }
    asm volatile("s_waitcnt lgkmcnt(0)" ::: "memory");
    float vv[8];
#pragma unroll
    for (int tp = 0; tp < 8; ++tp) vv[tp] = bf1(VM[(((size_t)MP + bs * 8 + tp) * 8 + h) * 64 + lane]);
#pragma unroll
    for (int tt = 0; tt < 8; ++tt) { float o = Dl[tt * 64 + lane];
#pragma unroll
        for (int tp = 0; tp < 8; ++tp) o += pl[tt * 8 + tp] * vv[tp];
        AO[((size_t)MP + bs * 8 + tt) * 1024 + 512 + h * 64 + lane] = (bf16)f2bf(o / Ll[tt]); }
    asm volatile("s_waitcnt lgkmcnt(0)" ::: "memory");
}
__device__ __forceinline__ void item(const Args& a, char* lds, LAS unsigned char* ldsl, int bs, int grp, int half, int wave, int lane) {
    unsigned char* ws = a.ws; int tid_o = wave * 64 + lane_id(); asm volatile("" : "+v"(tid_o)); const int tid = tid_o; lane = tid & 63;
    const int h = wave, rb = wave >> 2, kb = wave & 3, r31 = lane & 31, hi = lane >> 5;
    const int NPG = half < 0 ? 16 : 8, pg0 = grp * 16 + (half > 0 ? 8 : 0);
    const float* cache_c = (const float*)a.in[2]; const float* cache_r = (const float*)a.in[3]; const int* ptab = (const int*)a.in[6];
    const bf16* WkvT = (const bf16*)(ws + WS_WKVUP); const bf16* QM = (const bf16*)(ws + WS_QM);
    const int myphys = (lane < NPG) ? ptab[bs * 128 + pg0 + lane] : 0;
    typedef __attribute__((address_space(3))) unsigned lds_u32;
#define PAGE_LOAD(pg_) do { const int phys_ = __builtin_amdgcn_readlane(myphys, (pg_)); const char* sc_ = (const char*)(cache_c + (size_t)phys_ * 16384); \
        _Pragma("unroll") for (int i = 0; i < 8; ++i) __builtin_amdgcn_global_load_lds((const unsigned*)(sc_ + (i * 8 + wave) * 1024 + lane * 16), (lds_u32*)(ldsl + L_SC + (i * 8 + wave) * 1024), 16, 0, 2); \
        } while (0)
#define R_LOAD(pg_) do { const int phys_ = __builtin_amdgcn_readlane(myphys, (pg_)); const f32x4* sr_ = (const f32x4*)(cache_r + (size_t)phys_ * 4096); rq0 = __builtin_nontemporal_load(sr_ + tid * 2); rq1 = __builtin_nontemporal_load(sr_ + tid * 2 + 1); } while (0)
#define PAGE_CONVERT() do { _Pragma("unroll") for (int i = 0; i < 4; ++i) { const int id = i * 512 + tid; const unsigned key_ = id >> 4, ch_ = id & 15; const f32x4 x0 = *(const f32x4*)(lds + L_SC + id * 32), x1 = *(const f32x4*)(lds + L_SC + id * 32 + 16); \
            *(bf16x8*)(lds + L_CT + off_b(key_, ch_)) = pack8(x0, x1); \
            const float mx_ = rowmax16(amax8(x0, x1)); \
            const float sc_ = mx_ > 0.f ? 127.f * __builtin_amdgcn_rcpf(mx_) : 0.f; \
            *(uint2*)(lds + L_C8 + off_c8(key_, ch_ >> 1) + 8 * (ch_ & 1)) = make_uint2(q4(x0[0], x0[1], x0[2], x0[3], sc_), q4(x1[0], x1[1], x1[2], x1[3], sc_)); \
            if (ch_ == 0) ((float*)(lds + L_KI))[key_] = mx_ * (1.f / 127.f); } \
        *(bf16x8*)(lds + L_RT + (tid >> 2) * 64 + (tid & 3) * 16) = pack8(rq0, rq1); } while (0)
    f32x4 rq0, rq1;
    i32x4 wk8[2][4]; float winv;
    { bf16x8 wk[2][8];
#pragma unroll
      for (int jb = 0; jb < 2; ++jb)
#pragma unroll
          for (int ks = 0; ks < 8; ++ks) wk[jb][ks] = *(const bf16x8*)(WkvT + (size_t)(128 * h + 32 * jb + r31) * 128 + 32 * (ks >> 1) + 16 * hi + 8 * (ks & 1));
      PAGE_LOAD(0); R_LOAD(0);
      float wm = 0.f;
#pragma unroll
      for (int jb = 0; jb < 2; ++jb)
#pragma unroll
          for (int ks = 0; ks < 8; ++ks)
#pragma unroll
              for (int e = 0; e < 8; ++e) wm = fmaxf(wm, __builtin_fabsf(bf1((bf16)wk[jb][ks][e])));
      wm = rowmax16(wm); wm = fmaxf(wm, __shfl_xor(wm, 16)); wm = fmaxf(wm, __shfl_xor(wm, 32));
      const float wsc = wm > 0.f ? 127.f * __builtin_amdgcn_rcpf(wm) : 0.f; winv = wm * (1.f / 127.f);
#pragma unroll
      for (int jb = 0; jb < 2; ++jb)
#pragma unroll
          for (int k8 = 0; k8 < 4; ++k8) { const bf16x8 lo_ = wk[jb][2 * k8], hi_ = wk[jb][2 * k8 + 1];
              wk8[jb][k8] = (i32x4){(int)q4(bf1((bf16)lo_[0]), bf1((bf16)lo_[1]), bf1((bf16)lo_[2]), bf1((bf16)lo_[3]), wsc), (int)q4(bf1((bf16)lo_[4]), bf1((bf16)lo_[5]), bf1((bf16)lo_[6]), bf1((bf16)lo_[7]), wsc),
                                    (int)q4(bf1((bf16)hi_[0]), bf1((bf16)hi_[1]), bf1((bf16)hi_[2]), bf1((bf16)hi_[3]), wsc), (int)q4(bf1((bf16)hi_[4]), bf1((bf16)hi_[5]), bf1((bf16)hi_[6]), bf1((bf16)hi_[7]), wsc)}; } }
    { const bf16* WkvN = (const bf16*)(ws + WS_WKVN); const float* g_kn = (const float*)a.in[21];
      bf16x8 qb[4];
#pragma unroll
      for (int ks = 0; ks < 4; ++ks) { const int j0 = 16 * ks + 8 * hi; u32x4 w = {0u, 0u, 0u, 0u};
          if (r31 < 8) { const bf16x8 qv = *(const bf16x8*)(QM + (((size_t)(MP + bs * 8 + r31)) * 8 + h) * 96 + j0); const f32x4 g0 = *(const f32x4*)(g_kn + j0), g1 = *(const f32x4*)(g_kn + j0 + 4);
              w.x = cvtpk(bf1((bf16)qv[0]) * g0[0], bf1((bf16)qv[1]) * g0[1]); w.y = cvtpk(bf1((bf16)qv[2]) * g0[2], bf1((bf16)qv[3]) * g0[3]);
              w.z = cvtpk(bf1((bf16)qv[4]) * g1[0], bf1((bf16)qv[5]) * g1[1]); w.w = cvtpk(bf1((bf16)qv[6]) * g1[2], bf1((bf16)qv[7]) * g1[3]); }
          qb[ks] = *reinterpret_cast<bf16x8*>(&w); }
#pragma unroll
      for (int cb = 0; cb < 4; ++cb) { f32x16 dq = {};
#pragma unroll
          for (int ks = 0; ks < 4; ++ks) { const bf16x8 wa_ = *(const bf16x8*)(WkvN + (size_t)(32 * cb + r31) * 1024 + 128 * h + 16 * ks + 8 * hi); dq = __builtin_amdgcn_mfma_f32_32x32x16_bf16(wa_, qb[ks], dq, 0, 0, 0); }
          if (r31 < 8) {
#pragma unroll
              for (int r = 0; r < 16; ++r) { const int c = 32 * cb + crow(r, hi); *(bf16*)(lds + L_QA + off_b(h * 8 + r31, c >> 3) + (c & 7) * 2) = (bf16)f2bf(dq[r]); } } } }
    if (tid < 256) { const int row = tid >> 2, ch = tid & 3, hh = row >> 3, t = row & 7;
        *(u32x4*)(lds + L_QR + row * 64 + ch * 16) = *(const u32x4*)(QM + (((size_t)(MP + bs * 8 + t)) * 8 + hh) * 96 + 64 + ch * 8); }
    asm volatile("s_waitcnt vmcnt(0)" ::: "memory"); DBAR(); PAGE_CONVERT();
    float* rtab = (float*)(lds + L_RTAB); float* al = (float*)(lds + L_AL) + wave * 64;
    float m_reg = -1e30f, l_reg = 0.f; f32x16 O[4] = {};
    const int hh = 4 * rb + (r31 >> 3);
    const unsigned q_ = (lane & 15) >> 2, p_ = lane & 3, blk_ = (lane >> 4) & 1;
    DBAR();
    for (int pg = 0; pg < NPG; ++pg) {
        const char* Cb = lds + L_CT; const char* Rb = lds + L_RT;
        if (pg + 1 < NPG) PAGE_LOAD(pg + 1);
        { const float* kiv = (const float*)(lds + L_KI);
          i32x4 cf[4];
#pragma unroll
          for (int ks = 0; ks < 4; ++ks) cf[ks] = *(const i32x4*)(lds + L_C8 + off_c8(r31, 2 * ks + hi));
          i32x16 X, Y; float sa0 = 0.f, sa1 = 0.f, kvs = 0.f;
#define FMAC1(S, A) asm("v_fmac_f32 %0, %1, %1" : "+v"(S) : "v"(A))
#define SSQ1(D, G) do { const float a0_ = (float)D[4 * G], a1_ = (float)D[4 * G + 1], a2_ = (float)D[4 * G + 2], a3_ = (float)D[4 * G + 3]; FMAC1(sa0, a0_); FMAC1(sa1, a1_); FMAC1(sa0, a2_); FMAC1(sa1, a3_); } while (0)
#define HCHUNK(KS, JB, DN, HASPREV, DP, RELOAD, NEXTOFF) do { \
            DN = __builtin_amdgcn_mfma_i32_32x32x32_i8(wk8[JB][KS], cf[KS], DN, 0, 0, 0); \
            if (RELOAD) cf[KS] = *(const i32x4*)(lds + L_C8 + (NEXTOFF)); \
            if (HASPREV) { SSQ1(DP, KS); } __builtin_amdgcn_sched_barrier(0); } while (0)
#define NFIN(KP) do { float ss = sa0 + sa1; \
            { auto rr = __builtin_amdgcn_permlane32_swap(__float_as_uint(ss), __float_as_uint(ss), false, false); ss = __uint_as_float(rr[0]) + __uint_as_float(rr[1]); } \
            const float dq_ = kvs * winv; rtab[h * 128 + 32 * (KP) + r31] = __builtin_amdgcn_rsqf(ss * (dq_ * dq_) * (1.0f / 64.0f) + EPSN); } while (0)
#define HBLK(K2, JB, DN, HASPREV, DP, NEWSQ, DOFIN, FINKP) do { DN = (i32x16){}; \
            if (NEWSQ) { sa0 = 0.f; sa1 = 0.f; } if (DOFIN) kvs = kiv[32 * (FINKP) + r31]; \
            HCHUNK(0, JB, DN, HASPREV, DP, (JB == 1 && K2 < 3), off_c8(32 * ((K2) + 1) + r31, 0 + hi)); \
            HCHUNK(1, JB, DN, HASPREV, DP, (JB == 1 && K2 < 3), off_c8(32 * ((K2) + 1) + r31, 2 + hi)); \
            HCHUNK(2, JB, DN, HASPREV, DP, (JB == 1 && K2 < 3), off_c8(32 * ((K2) + 1) + r31, 4 + hi)); \
            HCHUNK(3, JB, DN, HASPREV, DP, (JB == 1 && K2 < 3), off_c8(32 * ((K2) + 1) + r31, 6 + hi)); \
            if (DOFIN) { NFIN(FINKP); } } while (0)
          HBLK(0, 0, X, 0, Y, 0, 0, 0);
          HBLK(0, 1, Y, 1, X, 1, 0, 0);
          HBLK(1, 0, X, 1, Y, 0, 1, 0);
          HBLK(1, 1, Y, 1, X, 1, 0, 0);
          HBLK(2, 0, X, 1, Y, 0, 1, 1);
          HBLK(2, 1, Y, 1, X, 1, 0, 0);
          HBLK(3, 0, X, 1, Y, 0, 1, 2);
          HBLK(3, 1, Y, 1, X, 1, 0, 0);
          kvs = kiv[96 + r31];
          SSQ1(Y, 0); SSQ1(Y, 1); SSQ1(Y, 2); SSQ1(Y, 3);
          NFIN(3);
#undef HBLK
#undef NFIN
#undef HCHUNK
#undef SSQ1
#undef FMAC1
        }
        DBAR();
        if (pg + 1 < NPG) R_LOAD(pg + 1);
        f32x16 sn = {};
        { bf16x8 cfA = *(const bf16x8*)(Cb + off_b(32 * kb + r31, hi)), qfA = *(const bf16x8*)(lds + L_QA + off_b(32 * rb + r31, hi)), cfB, qfB;
#pragma unroll
          for (int ks = 0; ks < 8; ks += 2) {
              cfB = *(const bf16x8*)(Cb + off_b(32 * kb + r31, 2 * (ks + 1) + hi)); qfB = *(const bf16x8*)(lds + L_QA + off_b(32 * rb + r31, 2 * (ks + 1) + hi)); __builtin_amdgcn_sched_barrier(0);
              sn = __builtin_amdgcn_mfma_f32_32x32x16_bf16(cfA, qfA, sn, 0, 0, 0); __builtin_amdgcn_sched_barrier(0);
              if (ks + 2 < 8) { cfA = *(const bf16x8*)(Cb + off_b(32 * kb + r31, 2 * (ks + 2) + hi)); qfA = *(const bf16x8*)(lds + L_QA + off_b(32 * rb + r31, 2 * (ks + 2) + hi)); } __builtin_amdgcn_sched_barrier(0);
              sn = __builtin_amdgcn_mfma_f32_32x32x16_bf16(cfB, qfB, sn, 0, 0, 0); __builtin_amdgcn_sched_barrier(0); } }
#pragma unroll
        for (int q = 0; q < 4; ++q) { const f32x4 rv = *(const f32x4*)(rtab + hh * 128 + 32 * kb + 8 * q + 4 * hi);
#pragma unroll
            for (int e = 0; e < 4; ++e) sn[4 * q + e] = sn[4 * q + e] * rv[e]; }
#pragma unroll
        for (int ks = 0; ks < 2; ++ks) { const bf16x8 rf = *(const bf16x8*)(Rb + (32 * kb + r31) * 64 + (2 * ks + hi) * 16); const bf16x8 qf = *(const bf16x8*)(lds + L_QR + (32 * rb + r31) * 64 + (2 * ks + hi) * 16);
            sn = __builtin_amdgcn_mfma_f32_32x32x16_bf16(rf, qf, sn, 0, 0, 0); }
        float pmax = sn[0];
#pragma unroll
        for (int r = 1; r < 16; ++r) pmax = fmaxf(pmax, sn[r]);
        { auto rr = __builtin_amdgcn_permlane32_swap(__float_as_uint(pmax), __float_as_uint(pmax), false, false); pmax = fmaxf(__uint_as_float(rr[0]), __uint_as_float(rr[1])); }
        float mn, alpha;
        if (__all((pmax - m_reg) <= THR)) { mn = m_reg; alpha = 1.f; } else { mn = fmaxf(m_reg, pmax); alpha = __builtin_amdgcn_exp2f(m_reg - mn); m_reg = mn; }
        float ps = 0.f;
#pragma unroll
        for (int r = 0; r < 16; ++r) { sn[r] = __builtin_amdgcn_exp2f(sn[r] - mn); ps += sn[r]; }
        { auto rr = __builtin_amdgcn_permlane32_swap(__float_as_uint(ps), __float_as_uint(ps), false, false); ps = __uint_as_float(rr[0]) + __uint_as_float(rr[1]); }
        l_reg = l_reg * alpha + ps;
        bf16x8 pa0, pa1;
#define PK4(P, B_, OUT) do { unsigned a0 = cvtpk(P[B_+0], P[B_+1]), a1 = cvtpk(P[B_+2], P[B_+3]); unsigned b0 = cvtpk(P[B_+4], P[B_+5]), b1 = cvtpk(P[B_+6], P[B_+7]); \
        auto r0 = __builtin_amdgcn_permlane32_swap(a0, b0, false, false); auto r1 = __builtin_amdgcn_permlane32_swap(a1, b1, false, false); \
        u32x4 w = {r0[0], r1[0], r0[1], r1[1]}; OUT = *reinterpret_cast<bf16x8*>(&w); } while (0)
        PK4(sn, 0, pa0); PK4(sn, 8, pa1);
#undef PK4
        if (__any(alpha < 1.f)) { if (hi == 0) al[r31] = alpha; asm volatile("s_waitcnt lgkmcnt(0)" ::: "memory");
#pragma unroll
            for (int cb = 0; cb < 4; ++cb)
#pragma unroll
                for (int r = 0; r < 16; ++r) O[cb][r] *= al[crow(r, hi)]; }
        { const unsigned cbase = (unsigned)(uintptr_t)Cb;
#pragma unroll 1
          for (int s2 = 0; s2 < 2; ++s2) { s16x4 lo[4], hi4[4];
              unsigned a0[4], a1[4];
#pragma unroll
              for (int cb = 0; cb < 4; ++cb) { a0[cb] = cbase + off_b(32 * kb + 16 * s2 + 8 * hi + q_, 4 * cb + 2 * blk_ + (p_ >> 1)) + 8 * (p_ & 1);
                  a1[cb] = cbase + off_b(32 * kb + 16 * s2 + 8 * hi + 4 + q_, 4 * cb + 2 * blk_ + (p_ >> 1)) + 8 * (p_ & 1); }
              asm volatile("ds_read_b64_tr_b16 %0, %8\n\tds_read_b64_tr_b16 %1, %9\n\tds_read_b64_tr_b16 %2, %10\n\tds_read_b64_tr_b16 %3, %11\n\t"
                           "ds_read_b64_tr_b16 %4, %12\n\tds_read_b64_tr_b16 %5, %13\n\tds_read_b64_tr_b16 %6, %14\n\tds_read_b64_tr_b16 %7, %15\n\ts_waitcnt lgkmcnt(0)"
                           : "=&v"(lo[0]), "=&v"(hi4[0]), "=&v"(lo[1]), "=&v"(hi4[1]), "=&v"(lo[2]), "=&v"(hi4[2]), "=&v"(lo[3]), "=&v"(hi4[3])
                           : "v"(a0[0]), "v"(a1[0]), "v"(a0[1]), "v"(a1[1]), "v"(a0[2]), "v"(a1[2]), "v"(a0[3]), "v"(a1[3]) : "memory");
              __builtin_amdgcn_sched_barrier(0);
              const bf16x8 pa = s2 == 0 ? pa0 : pa1;
#pragma unroll
              for (int cb = 0; cb < 4; ++cb) { const bf16x8 bfr = (bf16x8){lo[cb][0], lo[cb][1], lo[cb][2], lo[cb][3], hi4[cb][0], hi4[cb][1], hi4[cb][2], hi4[cb][3]};
                  O[cb] = __builtin_amdgcn_mfma_f32_32x32x16_bf16(pa, bfr, O[cb], 0, 0, 0); } } }
        asm volatile("s_waitcnt vmcnt(0)" ::: "memory"); DBAR();
        if (pg + 1 < NPG) PAGE_CONVERT();
        DBAR();
    }
#undef PAGE_LOAD
#undef R_LOAD
#undef PAGE_CONVERT
    float* ML = (float*)(lds + L_ML);
    float* OB = (float*)lds;
    if (hi == 0) { ML[(wave * 32 + r31) * 2] = m_reg; ML[(wave * 32 + r31) * 2 + 1] = l_reg; }
    DBAR();
    float fsc[16];
#pragma unroll
    for (int r = 0; r < 16; ++r) { const int row = crow(r, hi); float M = ML[((rb * 4 + 0) * 32 + row) * 2];
#pragma unroll
        for (int k2 = 1; k2 < 4; ++k2) M = fmaxf(M, ML[((rb * 4 + k2) * 32 + row) * 2]);
        fsc[r] = __builtin_amdgcn_exp2f(ML[((rb * 4 + kb) * 32 + row) * 2] - M); }
    { float* OW = (float*)lds + wave * 4096;
#pragma unroll
      for (int cb = 0; cb < 4; ++cb)
#pragma unroll
          for (int r = 0; r < 16; ++r) OW[crow(r, hi) * 128 + cb * 32 + r31] = O[cb][r] * fsc[r]; }
    DBAR();
    float* const partG = (float*)(ws + WS_PART) + ((size_t)(bs * 8 + grp) * 64) * 132;
    float* const pairT = (float*)(ws + WS_G) + ((size_t)((bs & 3) * 8 + grp) * 2 * 64) * 132;
    { float* part = half < 0 ? partG : pairT + (size_t)half * 64 * 132; const float* OWs = (const float*)lds;
#pragma unroll 4
      for (int i = tid; i < 64 * 32; i += 512) { const int row = i >> 5, c4 = (i & 31) * 4, rbb = row >> 5, rr = row & 31; const float* p0 = OWs + (size_t)(rbb * 4) * 4096 + rr * 128 + c4;
          const f32x4 v = ((*(const f32x4*)p0 + *(const f32x4*)(p0 + 4096)) + *(const f32x4*)(p0 + 2 * 4096)) + *(const f32x4*)(p0 + 3 * 4096);
          *(f32x4*)(part + row * 132 + 4 + c4) = v; }
      if (tid < 64) { const int row = tid, rbb = row >> 5, rr = row & 31; float M = ML[((rbb * 4) * 32 + rr) * 2];
#pragma unroll
          for (int k2 = 1; k2 < 4; ++k2) M = fmaxf(M, ML[((rbb * 4 + k2) * 32 + rr) * 2]);
          float L = 0.f;
#pragma unroll
          for (int k2 = 0; k2 < 4; ++k2) L += ML[((rbb * 4 + k2) * 32 + rr) * 2 + 1] * __builtin_amdgcn_exp2f(ML[((rbb * 4 + k2) * 32 + rr) * 2] - M);
          part[row * 132] = M; part[row * 132 + 1] = L; } }
    asm volatile("s_waitcnt vmcnt(0)" ::: "memory");
    __syncthreads();
    unsigned* flagw = (unsigned*)(lds + L_ML);
    if (half >= 0) {
        if (tid == 0) { __builtin_amdgcn_fence(__ATOMIC_RELEASE, "agent"); asm volatile("s_waitcnt vmcnt(0)" ::: "memory");
            flagw[0] = __hip_atomic_fetch_add((unsigned*)(ws + WS_CTL) + CW_DCNT + 64 * bs + 16 + grp, 1u, __ATOMIC_RELAXED, __HIP_MEMORY_SCOPE_AGENT); }
        __syncthreads();
        const bool second = flagw[0] == 1u;
        __syncthreads();
        if (!second) return;
        if (tid == 0) { __builtin_amdgcn_fence(__ATOMIC_ACQUIRE, "agent"); asm volatile("s_waitcnt vmcnt(0)" ::: "memory"); }
        __syncthreads();
        const float* TA = pairT; const float* TB = pairT + 64 * 132;
#pragma unroll 4
        for (int i = tid; i < 64 * 32; i += 512) { const int row = i >> 5, c4 = (i & 31) * 4;
            const float MA = TA[row * 132], MB = TB[row * 132], M = fmaxf(MA, MB), sA = __builtin_amdgcn_exp2f(MA - M), sB = __builtin_amdgcn_exp2f(MB - M);
            const f32x4 va = *(const f32x4*)(TA + row * 132 + 4 + c4), vb = *(const f32x4*)(TB + row * 132 + 4 + c4); f32x4 v;
#pragma unroll
            for (int e = 0; e < 4; ++e) v[e] = __fadd_rn(__fmul_rn(va[e], sA), __fmul_rn(vb[e], sB));
            *(f32x4*)(partG + row * 132 + 4 + c4) = v;
            if (c4 == 0) { partG[row * 132] = M; partG[row * 132 + 1] = __fadd_rn(__fmul_rn(TA[row * 132 + 1], sA), __fmul_rn(TB[row * 132 + 1], sB)); } }
        asm volatile("s_waitcnt vmcnt(0)" ::: "memory");
        __syncthreads();
    }
    if (tid == 0) { __builtin_amdgcn_fence(__ATOMIC_RELEASE, "agent"); asm volatile("s_waitcnt vmcnt(0)" ::: "memory");
        flagw[0] = __hip_atomic_fetch_add((unsigned*)(ws + WS_CTL) + CW_DCNT + 64 * bs, 1u, __ATOMIC_RELAXED, __HIP_MEMORY_SCOPE_AGENT); }
    __syncthreads();
    const bool lastone = flagw[0] == 7u;
    __syncthreads();
    if (lastone) {
        if (tid == 0) { __builtin_amdgcn_fence(__ATOMIC_ACQUIRE, "agent"); asm volatile("s_waitcnt vmcnt(0)" ::: "memory"); }
        __syncthreads();
        combine(a, lds, bs, wave, lane);
        __syncthreads();
    }
}
#undef DBAR
}
__device__ __forceinline__ void post_tokens(const Args& a, int gw, int NGW, int lane_in) {
    unsigned char* ws = a.ws; int ln = lane_id(); asm volatile("" : "+v"(ln)); (void)lane_in; const int lane = ln;
    const bf16* U = (const bf16*)(ws + WS_U); const f32x2* ROPE = (const f32x2*)(ws + WS_ROPE); bf16* KM = (bf16*)(ws + WS_KM);
    const float* rsqkv = (const float*)(ws + WS_CTL) + CW_RSQKV; const float* rsqkr = (const float*)(ws + WS_CTL) + CW_RSQKR;
    const float* g_kva = (const float*)a.in[18]; const float* g_kr = (const float*)a.in[19];
    const f32x2 gk = *(const f32x2*)(g_kva + 2 * lane); const float gr = g_kr[lane & 31];
#pragma unroll 1
    for (int m0 = gw; m0 < MT; m0 += 4 * NGW) {
        unsigned raw[4]; float xr[4], sv[4], sr[4]; f32x2 cr[4];
#pragma unroll
        for (int i = 0; i < 4; ++i) { const int m = m0 + i * NGW; const bool ok = m < MT; const int mm = ok ? m : gw; const bf16* Urow = U + (size_t)mm * NU;
            raw[i] = *(const unsigned*)(Urow + U_MKV + 2 * lane); xr[i] = bf1(Urow[U_MKR + (lane & 31)]); sv[i] = rsqkv[mm]; sr[i] = rsqkr[mm];
            const int pidx = (mm < MP) ? (mm & 2047) : 2048 + ((mm - MP) & 7); cr[i] = ROPE[pidx * 16 + (lane & 15)]; }
#pragma unroll
        for (int i = 0; i < 4; ++i) { const int m = m0 + i * NGW; if (m < MT) {
            const float rs = __builtin_amdgcn_rsqf(sv[i] * (1.0f / 128.0f) + EPSN), rr = __builtin_amdgcn_rsqf(sr[i] * (1.0f / 32.0f) + EPSN);
            float* ck = (m < MP) ? a.out + O_CKVP + (size_t)m * 128 : a.out + O_CKVS + (size_t)(m - MP) * 128;
            *(f32x2*)(ck + 2 * lane) = (f32x2){blo(raw[i]) * rs * gk.x, bhi(raw[i]) * rs * gk.y};
            const float x = xr[i] * rr * gr, y = __shfl_xor(x, 16); const f32x2 c = cr[i];
            const float o = (lane & 16) ? (x * c.x + y * c.y) : (x * c.x - y * c.y);
            if (lane < 32) { float* kr = (m < MP) ? a.out + O_KRP + (size_t)m * 32 : a.out + O_KRS + (size_t)(m - MP) * 32; kr[lane] = o; }
            const int hh = lane >> 3, part = lane & 7;
            const float o0 = __shfl(o, 4 * part), o1 = __shfl(o, 4 * part + 1), o2 = __shfl(o, 4 * part + 2), o3 = __shfl(o, 4 * part + 3);
            u32x2 w; w.x = pk2(o0, o1); w.y = pk2(o2, o3); *(u32x2*)(KM + ((size_t)m * 8 + hh) * 96 + 64 + 4 * part) = w; } }
    }
}
namespace gla {
typedef short bf16x8 __attribute__((ext_vector_type(8)));
typedef float f32x16 __attribute__((ext_vector_type(16)));
typedef unsigned u32x4 __attribute__((ext_vector_type(4)));
__device__ __forceinline__ unsigned cvtpk(float lo, float hi) { unsigned r; asm volatile("v_cvt_pk_bf16_f32 %0, %1, %2" : "=v"(r) : "v"(lo), "v"(hi)); return r; }
__device__ __forceinline__ int crow(int r, int hi) { return (r & 3) + 8 * (r >> 2) + 4 * hi; }
__device__ __forceinline__ void prep_tile(const Args& a, char* lds, int tileidx, const int wave_s) {
    unsigned char* ws = a.ws; int tid_o = wave_s * 64 + lane_id(); asm volatile("" : "+v"(tid_o)); const int tid = tid_o, c = tid & 255, h = c >> 6, dk = c & 63;
    const int half = wave_s >> 2;
    const bf16* U = (const bf16*)(ws + WS_U); const float* w_a2 = (const float*)a.in[11]; const float* b_a = (const float*)a.in[12];
    bf16* QDEC = (bf16*)(ws + WS_QDEC); bf16* KINV = (bf16*)(ws + WS_KINV); bf16* KENDT = (bf16*)(ws + WS_KENDT); bf16* VT = (bf16*)(ws + WS_VT); float* ELAST = (float*)(ws + WS_ELAST);
    const int m0 = tileidx * 64 + half * 32; const bool is_p = m0 < MP;
    float* gaf = (float*)lds;
    __syncthreads();
    if (tid < 128) { const int t = tid >> 1, hh = tid & 1; const v4u g = *(const v4u*)(U + (size_t)(tileidx * 64 + t) * NU + U_GA + 8 * hh);
        *(f32x4*)(gaf + t * 16 + 8 * hh) = (f32x4){blo(g.x), bhi(g.x), blo(g.y), bhi(g.y)}; *(f32x4*)(gaf + t * 16 + 8 * hh + 4) = (f32x4){blo(g.z), bhi(g.z), blo(g.w), bhi(g.w)}; }
    float wa[16];
#pragma unroll
    for (int r = 0; r < 16; ++r) wa[r] = w_a2[r * 256 + c];
    const float ba = b_a[c];
    __syncthreads();
    float la[32];
#pragma unroll
    for (int t = 0; t < 32; ++t) { const float* gp = gaf + (half * 32 + t) * 16; const f32x4 g0 = *(const f32x4*)gp, g1 = *(const f32x4*)(gp + 4), g2 = *(const f32x4*)(gp + 8), g3 = *(const f32x4*)(gp + 12);
        const float z = ba + (g0[0] * wa[0] + g0[1] * wa[1] + g0[2] * wa[2] + g0[3] * wa[3]) + (g1[0] * wa[4] + g1[1] * wa[5] + g1[2] * wa[6] + g1[3] * wa[7])
                           + (g2[0] * wa[8] + g2[1] * wa[9] + g2[2] * wa[10] + g2[3] * wa[11]) + (g3[0] * wa[12] + g3[1] * wa[13] + g3[2] * wa[14] + g3[3] * wa[15]);
        la[t] = (fminf(z, 0.f) - __logf(1.0f + __expf(-fabsf(z)))) * (1.0f / 16.0f); }
#define PROC_SEG(T0, NG) do { const int ms = m0 + (T0); const int cid = is_p ? (ms >> 5) : 512 + ((ms - MP) >> 3); \
        float blast = 0.f; _Pragma("unroll") for (int t = 0; t < 8 * (NG); ++t) blast += la[(T0) + t]; \
        bf16* kt = KENDT + ((size_t)(cid * 4 + h) * 2 + (dk >> 5)) * 1024 + (dk & 31) * 8; \
        const size_t fbase = (((size_t)(cid * 4 + h) * 4 + (dk >> 4)) * 2 + ((dk >> 3) & 1)) * 256 + (dk & 7); \
        float b = 0.f; \
        _Pragma("unroll") for (int g = 0; g < (NG); ++g) { unsigned short qv[8], kv[8]; \
            _Pragma("unroll") for (int j = 0; j < 8; ++j) { const size_t m = (size_t)(ms + g * 8 + j); qv[j] = U[m * NU + U_GQ + c]; kv[j] = U[m * NU + U_GK + c]; } \
            unsigned pk[4]; \
            _Pragma("unroll") for (int j = 0; j < 8; j += 2) { float ke[2]; \
                _Pragma("unroll") for (int jj = 0; jj < 2; ++jj) { b += la[(T0) + g * 8 + j + jj]; const float eb = __expf(b), q = bf1(qv[j + jj]), k = bf1(kv[j + jj]); \
                    const size_t fo = fbase + (size_t)(g * 8 + j + jj) * 8; \
                    QDEC[fo] = (bf16)f2bf(q * 0.125f * eb); KINV[fo] = (bf16)f2bf(k * __builtin_amdgcn_rcpf(eb)); ke[jj] = k * __expf(blast - b); } \
                pk[j >> 1] = cvtpk(ke[0], ke[1]); } \
            *(v4u*)(kt + g * 256) = (v4u){pk[0], pk[1], pk[2], pk[3]}; } \
        if ((NG) == 1) { *(v4u*)(kt + 256) = (v4u){0u, 0u, 0u, 0u}; *(v4u*)(kt + 512) = (v4u){0u, 0u, 0u, 0u}; *(v4u*)(kt + 768) = (v4u){0u, 0u, 0u, 0u}; } \
        ELAST[(size_t)cid * 256 + c] = __expf(blast); } while (0)
    if (is_p) { PROC_SEG(0, 4); } else { PROC_SEG(0, 1); PROC_SEG(8, 1); PROC_SEG(16, 1); PROC_SEG(24, 1); }
#undef PROC_SEG
    bf16* GGF = (bf16*)(ws + WS_GGF);
    const int nseg = is_p ? 1 : 4, ng = is_p ? 4 : 1;
#pragma unroll 1
    for (int cc = 0; cc < 2; ++cc) { const int col = (tid & 255) + 256 * cc, hv = col >> 7, dv = col & 127, dvl = dv & 31;
        for (int seg = 0; seg < nseg; ++seg) { const int ms = m0 + seg * 8 * ng; const int cid = is_p ? (ms >> 5) : 512 + ((ms - MP) >> 3);
            bf16* vt = VT + (((size_t)(cid * 4 + hv) * 4 + (dv >> 5)) * 4) * 256 + dvl * 8;
            bf16* gf = GGF + (((((size_t)(cid * 4 + hv) * 4 + (dv >> 5)) * 4 + (dvl >> 3)) * 2 + ((dvl >> 2) & 1)) * 32) * 4 + (dvl & 3);
            for (int g = 0; g < ng; ++g) { unsigned short e[8], gg[8];
#pragma unroll
                for (int j = 0; j < 8; ++j) { e[j] = U[(size_t)(ms + g * 8 + j) * NU + U_GV + col]; gg[j] = U[(size_t)(ms + g * 8 + j) * NU + U_GG + col]; }
#pragma unroll
                for (int j = 0; j < 8; ++j) gf[(g * 8 + j) * 4] = gg[j];
                *(v4u*)(vt + g * 256) = (v4u){(unsigned)e[0] | ((unsigned)e[1] << 16), (unsigned)e[2] | ((unsigned)e[3] << 16), (unsigned)e[4] | ((unsigned)e[5] << 16), (unsigned)e[6] | ((unsigned)e[7] << 16)}; }
            if (!is_p) { *(v4u*)(vt + 256) = (v4u){0u, 0u, 0u, 0u}; *(v4u*)(vt + 512) = (v4u){0u, 0u, 0u, 0u}; *(v4u*)(vt + 768) = (v4u){0u, 0u, 0u, 0u}; } } }
    __syncthreads();
}
__device__ __forceinline__ void prep_tile_p(const Args& a, char* lds, LAS unsigned char* ldsl, int tileidx, const int wave_s) {
    typedef __attribute__((address_space(3))) unsigned lds_u32;
    constexpr int RS = 1040, RH = RS / 2, S1 = 4096, S2 = 4096 + 64 * RS;
    unsigned char* ws = a.ws; int tid_o = wave_s * 64 + lane_id(); asm volatile("" : "+v"(tid_o)); const int tid = tid_o, lane = tid & 63, c = tid & 255, h = c >> 6, dk = c & 63;
    const int half = wave_s >> 2, cid = tileidx * 2 + half;
    const bf16* U = (const bf16*)(ws + WS_U); const float* w_a2 = (const float*)a.in[11]; const float* b_a = (const float*)a.in[12];
    bf16* QDEC = (bf16*)(ws + WS_QDEC); bf16* KINV = (bf16*)(ws + WS_KINV); bf16* KENDT = (bf16*)(ws + WS_KENDT); bf16* VT = (bf16*)(ws + WS_VT); float* ELAST = (float*)(ws + WS_ELAST); bf16* GGF = (bf16*)(ws + WS_GGF);
    float* gaf = (float*)lds;
    __syncthreads();
    const char* rowb = (const char*)(U + (size_t)(tileidx * 64 + wave_s * 8) * NU) + lane * 16;
#pragma unroll
    for (int i = 0; i < 8; ++i) { __builtin_amdgcn_global_load_lds((const unsigned*)(rowb + (size_t)i * NU * 2), (lds_u32*)(ldsl + S1 + (wave_s * 8 + i) * RS), 16, 0, 0);
                                  __builtin_amdgcn_global_load_lds((const unsigned*)(rowb + (size_t)i * NU * 2 + 1024), (lds_u32*)(ldsl + S2 + (wave_s * 8 + i) * RS), 16, 0, 0); }
    if (tid < 128) { const int t = tid >> 1, hh = tid & 1; const v4u g = *(const v4u*)(U + (size_t)(tileidx * 64 + t) * NU + U_GA + 8 * hh);
        *(f32x4*)(gaf + t * 16 + 8 * hh) = (f32x4){blo(g.x), bhi(g.x), blo(g.y), bhi(g.y)}; *(f32x4*)(gaf + t * 16 + 8 * hh + 4) = (f32x4){blo(g.z), bhi(g.z), blo(g.w), bhi(g.w)}; }
    float wa[16];
#pragma unroll
    for (int r = 0; r < 16; ++r) wa[r] = w_a2[r * 256 + c];
    const float ba = b_a[c];
    __syncthreads();
    float la[32];
#pragma unroll
    for (int t = 0; t < 32; ++t) { const float* gp = gaf + (half * 32 + t) * 16; const f32x4 g0 = *(const f32x4*)gp, g1 = *(const f32x4*)(gp + 4), g2 = *(const f32x4*)(gp + 8), g3 = *(const f32x4*)(gp + 12);
        const float z = ba + (g0[0] * wa[0] + g0[1] * wa[1] + g0[2] * wa[2] + g0[3] * wa[3]) + (g1[0] * wa[4] + g1[1] * wa[5] + g1[2] * wa[6] + g1[3] * wa[7])
                           + (g2[0] * wa[8] + g2[1] * wa[9] + g2[2] * wa[10] + g2[3] * wa[11]) + (g3[0] * wa[12] + g3[1] * wa[13] + g3[2] * wa[14] + g3[3] * wa[15]);
        la[t] = (fminf(z, 0.f) - __logf(1.0f + __expf(-fabsf(z)))) * (1.0f / 16.0f); }
    asm volatile("s_waitcnt vmcnt(0)" ::: "memory");
    __syncthreads();
    { unsigned short* s1 = (unsigned short*)(lds + S1) + (half * 32) * RH + c;
      float blast = 0.f;
#pragma unroll
      for (int t = 0; t < 32; ++t) blast += la[t];
      bf16* kt = KENDT + ((size_t)(cid * 4 + h) * 2 + (dk >> 5)) * 1024 + (dk & 31) * 8;
      float b = 0.f;
#pragma unroll
      for (int g = 0; g < 4; ++g) { unsigned pk[4];
#pragma unroll
          for (int j = 0; j < 8; j += 2) { float ke[2];
#pragma unroll
              for (int jj = 0; jj < 2; ++jj) { const int t = g * 8 + j + jj; b += la[t]; const float eb = __expf(b), q = bf1(s1[t * RH]), k = bf1(s1[t * RH + 256]);
                  s1[t * RH] = (unsigned short)f2bf(q * 0.125f * eb); s1[t * RH + 256] = (unsigned short)f2bf(k * __builtin_amdgcn_rcpf(eb)); ke[jj] = k * __expf(blast - b); }
              pk[j >> 1] = cvtpk(ke[0], ke[1]); }
          *(v4u*)(kt + g * 256) = (v4u){pk[0], pk[1], pk[2], pk[3]}; }
      ELAST[(size_t)cid * 256 + c] = __expf(blast); }
    __syncthreads();
#pragma unroll
    for (int i = 0; i < 8; ++i) { const int u = i * 512 + tid, arr = u >> 11, r = u & 2047, hf = r >> 10, hh = (r >> 8) & 3, g8 = (r >> 5) & 7, t = r & 31;
        const v4u val = *(const v4u*)(lds + S1 + (hf * 32 + t) * RS + arr * 512 + (hh * 64 + g8 * 8) * 2);
        bf16* dst = (arr ? KINV : QDEC) + ((size_t)((tileidx * 2 + hf) * 4 + hh) * 8 + g8) * 256 + t * 8;
        *(v4u*)dst = val; }
    __syncthreads();
#pragma unroll
    for (int i = 0; i < 8; ++i) __builtin_amdgcn_global_load_lds((const unsigned*)(rowb + (size_t)i * NU * 2 + 2048), (lds_u32*)(ldsl + S1 + (wave_s * 8 + i) * RS), 16, 0, 0);
#pragma unroll
    for (int cc = 0; cc < 2; ++cc) { const int col = c + 256 * cc, hv = col >> 7, dv = col & 127, dvl = dv & 31;
        bf16* vt = VT + (((size_t)(cid * 4 + hv) * 4 + (dv >> 5)) * 4) * 256 + dvl * 8;
        const unsigned short* s2 = (const unsigned short*)(lds + S2) + (half * 32) * RH + col;
#pragma unroll
        for (int g = 0; g < 4; ++g) { unsigned e[8];
#pragma unroll
            for (int j = 0; j < 8; ++j) e[j] = s2[(g * 8 + j) * RH];
            *(v4u*)(vt + g * 256) = (v4u){e[0] | (e[1] << 16), e[2] | (e[3] << 16), e[4] | (e[5] << 16), e[6] | (e[7] << 16)}; } }
    asm volatile("s_waitcnt vmcnt(0)" ::: "memory");
    __syncthreads();
#pragma unroll
    for (int i = 0; i < 8; ++i) { const int u = i * 512 + tid, tp = u & 15, quad = (u >> 4) & 127, hf = u >> 11, hv = quad >> 5, dvb = (quad & 31) >> 3, q = (quad & 7) >> 1, hi = quad & 1;
        const u32x2 x0 = *(const u32x2*)(lds + S1 + (hf * 32 + 2 * tp) * RS + quad * 8), x1 = *(const u32x2*)(lds + S1 + (hf * 32 + 2 * tp + 1) * RS + quad * 8);
        bf16* dst = GGF + ((((((size_t)((tileidx * 2 + hf) * 4 + hv) * 4 + dvb) * 4 + q) * 2 + hi) * 32) + 2 * tp) * 4;
        *(v4u*)dst = (v4u){x0.x, x0.y, x1.x, x1.y}; }
    __syncthreads();
}
#define GBAR() asm volatile("s_waitcnt lgkmcnt(0)\n\ts_barrier" ::: "memory")
__device__ __forceinline__ void scan_unit(const Args& a, char* lds, int unit, int wave, int lane_in) {
    unsigned char* ws = a.ws; int ln = lane_id(); asm volatile("" : "+v"(ln)); (void)lane_in; const int lane = ln, r31 = lane & 31, hi = lane >> 5, sub = wave >> 2, dvb = wave & 3;
    const bool is_p = unit < 32; const int item = is_p ? unit : unit - 32; const int seq = item >> 2, h = item & 3;
    const int nch = is_p ? 64 : 1, tvalid = is_p ? 32 : 8;
    const size_t row0 = is_p ? (size_t)seq * 2048 : (size_t)MP + seq * 8; const int cid0 = is_p ? seq * 64 : 512 + seq;
    const bf16* U = (const bf16*)(ws + WS_U); const bf16* QDEC = (const bf16*)(ws + WS_QDEC); const bf16* KINV = (const bf16*)(ws + WS_KINV); const bf16* KENDT = (const bf16*)(ws + WS_KENDT); const bf16* VT = (const bf16*)(ws + WS_VT);
    const float* ELAST = (const float*)(ws + WS_ELAST); bf16* AO = (bf16*)(ws + WS_AO); const float* g_out = (const float*)a.in[13]; const bf16* GGF = (const bf16*)(ws + WS_GGF);
    if (sub) {
        const int hl = (wave & 3) * 64 + lane; const size_t ch0 = (size_t)cid0 * 4 + h;
        const bf16* p = KINV + ch0 * 2048; size_t stride = 0;
        if (hl < 32) { p = KINV + ch0 * 2048 + hl * 64; stride = 8192; } else if (hl < 64) { p = QDEC + ch0 * 2048 + (hl - 32) * 64; stride = 8192; }
        else if (hl < 96) { p = KENDT + ch0 * 2048 + (hl - 64) * 64; stride = 8192; } else if (hl < 160) { p = VT + ch0 * 4096 + (hl - 96) * 64; stride = 16384; }
        else if (hl < 224) { p = GGF + ch0 * 4096 + (hl - 160) * 64; stride = 16384; }
        unsigned accp = 0u, v0 = 0u, v1 = 0u, v2 = 0u, v3 = 0u;
        if (1 < nch) v1 = *(const unsigned*)(p + 1 * stride);
        if (2 < nch) v2 = *(const unsigned*)(p + 2 * stride);
        if (3 < nch) v3 = *(const unsigned*)(p + 3 * stride);
        GBAR();
#pragma unroll 1
        for (int n = 0; n < nch; n += 4) {
#define PF(V, k_) do { if (n + (k_) < nch) { accp += V; if (n + (k_) + 4 < nch) V = *(const unsigned*)(p + (size_t)(n + (k_) + 4) * stride); GBAR(); } } while (0)
            PF(v0, 0); PF(v1, 1); PF(v2, 2); PF(v3, 3);
#undef PF
        }
        if (accp == 0x9e3779b9u) ((unsigned*)(ws + WS_PFSINK))[wave * 64 + lane] = accp;
        GBAR(); return; }
    f32x16 S[2];
    if (is_p) { S[0] = f32x16{}; S[1] = f32x16{}; }
    else { const float* s0 = (const float*)a.in[4] + ((size_t)seq * 4 + h) * 8192;
#pragma unroll
        for (int blk = 0; blk < 2; ++blk)
#pragma unroll
            for (int r = 0; r < 16; ++r) S[blk][r] = s0[(32 * blk + crow(r, hi)) * 128 + 32 * dvb + r31]; }
#define PK4(P, B_, OUT) do { unsigned a0 = cvtpk(P[B_+0], P[B_+1]), a1 = cvtpk(P[B_+2], P[B_+3]); unsigned b0 = cvtpk(P[B_+4], P[B_+5]), b1 = cvtpk(P[B_+6], P[B_+7]); \
        auto r0 = __builtin_amdgcn_permlane32_swap(a0, b0, false, false); auto r1 = __builtin_amdgcn_permlane32_swap(a1, b1, false, false); \
        u32x4 w = {r0[0], r1[0], r0[1], r1[1]}; OUT = *reinterpret_cast<bf16x8*>(&w); } while (0)
    f32x4 gout[4];
#pragma unroll
    for (int q = 0; q < 4; ++q) gout[q] = *(const f32x4*)(g_out + 32 * dvb + 8 * q + 4 * hi);
    float* ELT = (float*)(lds + 65536) + sub * 4096;
    float* SS = (float*)lds;
    { const int l4 = (wave & 3) * 64 + lane;
      for (int i = l4; i < nch * 16; i += 256) { const int n = i >> 4, q4 = (i & 15) * 4; *(f32x4*)(ELT + n * 64 + q4) = *(const f32x4*)(ELAST + (size_t)(cid0 + n) * 256 + h * 64 + q4); } }
    GBAR();
    bf16x8 kiA[4], qdA[4], vtA[2], keA[2][2], kiB[4], qdB[4], vtB[2], keB[2][2]; u32x2 ggA[4], ggB[4];
#define LOADQ(KI, QD, VTX, KE, GG, n_) do { const size_t ch_ = (size_t)(cid0 + (n_)) * 4 + h; \
        _Pragma("unroll") for (int ks = 0; ks < 4; ++ks) { KI[ks] = *(const bf16x8*)(KINV + (((ch_ * 4 + ks) * 2 + hi) * 32 + r31) * 8); QD[ks] = *(const bf16x8*)(QDEC + (((ch_ * 4 + ks) * 2 + hi) * 32 + r31) * 8); } \
        _Pragma("unroll") for (int ks = 0; ks < 2; ++ks) VTX[ks] = *(const bf16x8*)(VT + ((((ch_ * 4 + dvb) * 2 + ks) * 2 + hi) * 32 + r31) * 8); \
        _Pragma("unroll") for (int blk = 0; blk < 2; ++blk) _Pragma("unroll") for (int ks = 0; ks < 2; ++ks) KE[blk][ks] = *(const bf16x8*)(KENDT + ((((ch_ * 2 + blk) * 2 + ks) * 2 + hi) * 32 + r31) * 8); \
        _Pragma("unroll") for (int q = 0; q < 4; ++q) GG[q] = *(const u32x2*)(GGF + ((((ch_ * 4 + dvb) * 4 + q) * 2 + hi) * 32 + r31) * 4); } while (0)
#define BODY(KI, QD, VTX, KE, GG, KIN, QDN, VTN, KEN, GGN, n_) do { const int n = (n_); const size_t rb = row0 + 32 * (size_t)n; \
        if (n + 1 < nch) LOADQ(KIN, QDN, VTN, KEN, GGN, n + 1); \
        f32x16 X = {}; \
        _Pragma("unroll") for (int ks = 0; ks < 4; ++ks) X = __builtin_amdgcn_mfma_f32_32x32x16_bf16(KI[ks], QD[ks], X, 0, 0, 0); \
        _Pragma("unroll") for (int r = 0; r < 16; ++r) if (crow(r, hi) > r31) X[r] = 0.f; \
        bf16x8 xb0, xb1; PK4(X, 0, xb0); PK4(X, 8, xb1); \
        f32x16 o = {}; \
        o = __builtin_amdgcn_mfma_f32_32x32x16_bf16(VTX[0], xb0, o, 0, 0, 0); o = __builtin_amdgcn_mfma_f32_32x32x16_bf16(VTX[1], xb1, o, 0, 0, 0); \
        _Pragma("unroll") for (int blk = 0; blk < 2; ++blk) { bf16x8 sb0, sb1; PK4(S[blk], 0, sb0); PK4(S[blk], 8, sb1); \
            o = __builtin_amdgcn_mfma_f32_32x32x16_bf16(sb0, QD[2 * blk], o, 0, 0, 0); o = __builtin_amdgcn_mfma_f32_32x32x16_bf16(sb1, QD[2 * blk + 1], o, 0, 0, 0); } \
        _Pragma("unroll") for (int blk = 0; blk < 2; ++blk) { \
            _Pragma("unroll") for (int q = 0; q < 4; ++q) { const f32x4 e4 = *(const f32x4*)(ELT + n * 64 + 32 * blk + 8 * q + 4 * hi); \
                S[blk][4 * q] *= e4[0]; S[blk][4 * q + 1] *= e4[1]; S[blk][4 * q + 2] *= e4[2]; S[blk][4 * q + 3] *= e4[3]; } \
            S[blk] = __builtin_amdgcn_mfma_f32_32x32x16_bf16(KE[blk][0], VTX[0], S[blk], 0, 0, 0); S[blk] = __builtin_amdgcn_mfma_f32_32x32x16_bf16(KE[blk][1], VTX[1], S[blk], 0, 0, 0); } \
        float ss = 0.f; \
        _Pragma("unroll") for (int r = 0; r < 16; ++r) ss += o[r] * o[r]; \
        { auto rr = __builtin_amdgcn_permlane32_swap(__float_as_uint(ss), __float_as_uint(ss), false, false); ss = __uint_as_float(rr[0]) + __uint_as_float(rr[1]); } \
        float* ssl = SS + ((n & 1) * 2 + sub) * 128; \
        if (hi == 0) ssl[dvb * 32 + r31] = ss; \
        GBAR(); \
        const float tot = (ssl[r31] + ssl[32 + r31]) + (ssl[64 + r31] + ssl[96 + r31]); const float rn = __builtin_amdgcn_rsqf(tot * (1.0f / 128.0f) + EPSN); \
        if (r31 < tvalid) { bf16* ao = AO + (rb + r31) * 1024 + h * 128 + 32 * dvb + 4 * hi; \
            _Pragma("unroll") for (int q = 0; q < 4; ++q) { u32x2 w; \
                w.x = cvtpk(o[4 * q] * rn * gout[q][0] * silu_f(blo(GG[q].x)), o[4 * q + 1] * rn * gout[q][1] * silu_f(bhi(GG[q].x))); \
                w.y = cvtpk(o[4 * q + 2] * rn * gout[q][2] * silu_f(blo(GG[q].y)), o[4 * q + 3] * rn * gout[q][3] * silu_f(bhi(GG[q].y))); \
                *(u32x2*)(ao + 8 * q) = w; } } \
    } while (0)
    LOADQ(kiA, qdA, vtA, keA, ggA, 0);
#pragma unroll 1
    for (int n2 = 0; n2 < nch; n2 += 2) {
        BODY(kiA, qdA, vtA, keA, ggA, kiB, qdB, vtB, keB, ggB, n2);
        if (n2 + 1 < nch) BODY(kiB, qdB, vtB, keB, ggB, kiA, qdA, vtA, keA, ggA, n2 + 1);
    }
#undef LOADQ
#undef BODY
#undef PK4
    float* so = is_p ? a.out + O_GLAP + ((size_t)seq * 4 + h) * 8192 : a.out + O_GLAS + ((size_t)seq * 4 + h) * 8192;
#pragma unroll
    for (int blk = 0; blk < 2; ++blk)
#pragma unroll
        for (int r = 0; r < 16; ++r) so[(32 * blk + crow(r, hi)) * 128 + 32 * dvb + r31] = S[blk][r];
    GBAR();
}
#undef GBAR
}
namespace skinny {
typedef short bf16x8 __attribute__((ext_vector_type(8)));
typedef float f32x16 __attribute__((ext_vector_type(16)));
__device__ __forceinline__ int crow(int r, int hi) { return (r & 3) + 8 * (r >> 2) + 4 * hi; }
template <int K, class F>
__device__ __forceinline__ void run(char* lds, const bf16* A, const bf16* Bt, int N, int vcu, int G, int wave, int lane_in, const F& f) {
    int tid_o = wave * 64 + lane_id(); asm volatile("" : "+v"(tid_o)); const int tid = tid_o, lane = tid & 63, r31 = lane & 31, hi = lane >> 5; (void)lane_in;
    constexpr int KS = K / 8 / 16;
    float* red = (float*)lds;
    const int ntiles = 8 * (N / 32);
    for (int tile = vcu; tile < ntiles; tile += G) { const int rt = tile & 7, ct = tile >> 3;
        const bf16* ap = A + (size_t)(MP + 32 * rt + r31) * K + wave * (K / 8) + 8 * hi; const bf16* bp = Bt + (size_t)(32 * ct + r31) * K + wave * (K / 8) + 8 * hi;
        const int prow = MP + 32 * rt + (tid >> 4), pcol = 32 * ct + (tid & 15) * 2;
        const typename F::Pre pre = f.pre(prow, pcol);
        f32x16 acc = {};
#pragma unroll
        for (int ks = 0; ks < KS; ++ks) { const bf16x8 av = *(const bf16x8*)(ap + 16 * ks), bv = *(const bf16x8*)(bp + 16 * ks); acc = __builtin_amdgcn_mfma_f32_32x32x16_bf16(av, bv, acc, 0, 0, 0); }
#pragma unroll
        for (int r = 0; r < 16; ++r) red[(wave * 32 + crow(r, hi)) * 32 + r31] = acc[r];
        __syncthreads();
        { const int row = tid >> 4, col = (tid & 15) * 2; float v0 = 0.f, v1 = 0.f;
#pragma unroll
          for (int w = 0; w < 8; ++w) { const f32x2 p = *(const f32x2*)(red + (w * 32 + row) * 32 + col); v0 += p.x; v1 += p.y; }
          f(MP + 32 * rt + row, 32 * ct + col, v0, v1, pre); }
        __syncthreads();
    }
}
struct FScaleBf16 { bf16* O; int ldc; const float* rs; typedef float Pre;
    __device__ __forceinline__ Pre pre(int row, int) const { return rs ? rs[row] : 1.f; }
    __device__ __forceinline__ void operator()(int row, int col, float v0, float v1, Pre s) const { *(unsigned*)(O + (size_t)row * ldc + col) = pk2(v0 * s, v1 * s); } };
struct FU { bf16* O; const float* rs; float* rsqb;
    typedef float Pre;
    __device__ __forceinline__ Pre pre(int row, int) const { return rs[row]; }
    __device__ __forceinline__ void operator()(int row, int col, float v0, float v1, Pre s) const { v0 *= s; v1 *= s; *(unsigned*)(O + (size_t)row * 2048 + col) = pk2(v0, v1);
        if (col >= 1536 && col < 1952) { float ss = v0 * v0 + v1 * v1; ss += __shfl_xor(ss, 1); ss += __shfl_xor(ss, 2); ss += __shfl_xor(ss, 4); ss += __shfl_xor(ss, 8);
            const int seg = (col >= 1792) + (col >= 1920);
            if ((lane_id() & 15) == 0) atomicAdd(rsqb + seg * 16640 + row, ss); } } };
template <bool BF> struct FResid { const void* base; bf16* hb; float* rsq;
    typedef f32x2 Pre;
    __device__ __forceinline__ Pre pre(int row, int col) const { const size_t off = (size_t)row * 1024 + col;
        if (BF) { const unsigned bw = *(const unsigned*)((const bf16*)base + off); return (f32x2){blo(bw), bhi(bw)}; } else return *(const f32x2*)((const float*)base + off); }
    __device__ __forceinline__ void operator()(int row, int col, float v0, float v1, Pre b) const { const size_t off = (size_t)row * 1024 + col; const float o0 = b.x + v0, o1 = b.y + v1;
        *(unsigned*)(hb + off) = pk2(o0, o1);
        float ss = o0 * o0 + o1 * o1; ss += __shfl_xor(ss, 1); ss += __shfl_xor(ss, 2); ss += __shfl_xor(ss, 4); ss += __shfl_xor(ss, 8);
        if ((lane_id() & 15) == 0) atomicAdd(rsq + row, ss); } };
struct FPle { const bf16* h2; const bf16* PP; const float* rsq; float* out;
    struct Pre { unsigned hw, pw; float rq; };
    __device__ __forceinline__ Pre pre(int row, int col) const { const size_t off = (size_t)row * 1024 + col; Pre p; p.hw = *(const unsigned*)(h2 + off); p.pw = *(const unsigned*)(PP + off); p.rq = rsq[row]; return p; }
    __device__ __forceinline__ void operator()(int row, int col, float v0, float v1, const Pre& p) const { const size_t off = (size_t)row * 1024 + col; const float rs = __builtin_amdgcn_rsqf(p.rq * (1.0f / 1024.0f) + 1e-6f);
        const unsigned hw = p.hw; const f32x2 hv = {blo(hw), bhi(hw)}; const unsigned pw = p.pw;
        *(f32x2*)(out + off) = (f32x2){hv.x + blo(pw) / (1.0f + __expf(-v0 * rs)), hv.y + bhi(pw) / (1.0f + __expf(-v1 * rs))}; } };
}
#ifndef MK_PER_PHASE
#define MK_PER_PHASE 0
#endif
constexpr int N_PHASES = 10;
__global__ void __launch_bounds__(NWAVES * 64, 2) hymba_fwd(Args args) {
    extern __shared__ __attribute__((aligned(16))) unsigned char lds_raw[];
    LAS unsigned char* lds = (LAS unsigned char*)lds_raw;
    volatile LAS unsigned* MISC = (volatile LAS unsigned*)(lds + MISC_OFF);
    const int tid = threadIdx.x, lane = tid & 63, wave = __builtin_amdgcn_readfirstlane(tid >> 6);
    const int G = gridDim.x; const int bx = blockIdx.x; const int vcu = (G % 8 == 0) ? (bx % 8) * (G / 8) + bx / 8 : bx;
    const int gw = vcu * NWAVES + wave, NGW = G * NWAVES;
    unsigned char* ws = args.ws;
    gu32* ctl = (gu32*)(ws + WS_CTL);
    for (int u = tid; u < (LDS_BYTES - LDSCTL_OFF) / 4; u += NWAVES * 64) ((LAS unsigned*)(lds + LDSCTL_OFF))[u] = 0u;
    __syncthreads();
    XcdBarrier bar; bar.bar = (unsigned*)(ctl + CW_BAR); bar.x = 0; bar.st = nullptr;
    if (!MK_PER_PHASE) bar = xcd_barrier_post((unsigned*)(ctl + CW_BAR), MISC + 8);
    const int lo = args.ph_lo, hi = args.ph_hi;
#define IN(k) (lo <= (k) && (k) < hi)
#define SEAM(k) do { if (IN(k) && IN((k) + 1)) xcd_barrier(bar, wave); } while (0)
    float* rsq2 = (float*)(ctl + CW_RSQ2); float* rsq3 = (float*)(ctl + CW_RSQ3); float* rsqq = (float*)(ctl + CW_RSQQ); float* rsqkv = (float*)(ctl + CW_RSQKV); float* rsqkr = (float*)(ctl + CW_RSQKR);

    if (IN(0)) { prep_phase(args, lds, gw, NGW, wave, lane_id()); }
    SEAM(0);
    if (IN(1)) {
        { pg8::Gemm g{(const bf16*)(ws + WS_XB), (const bf16*)(ws + WS_WIN), MP, NU, DM}; pg8::StaticOrder S; S.init(MP, NU, G, bx);
          pg8::EpiU E{(bf16*)(ws + WS_U), (const float*)(ws + WS_RS1), rsqq, rsqkv, rsqkr};
          pg8::gemm_phase<pg8::EpiU, pg8::StaticOrder, true, true>(lds, g, S, E, wave); }
        skinny::run<1024>((char*)lds_raw, (const bf16*)(ws + WS_XB), (const bf16*)(ws + WS_WIN), NU, vcu, G, wave, 0, skinny::FU{(bf16*)(ws + WS_U), (const float*)(ws + WS_RS1), rsqq});
        skinny::run<256>((char*)lds_raw, (const bf16*)(ws + WS_PB), (const bf16*)(ws + WS_WPP), DM, vcu, G, wave, 0, skinny::FScaleBf16{(bf16*)(ws + WS_PP), DM, nullptr});
    }
    SEAM(1);
    if (IN(2)) {
        if (bx < 110) { pg8::Gemm g{(const bf16*)(ws + WS_U) + U_MQ, (const bf16*)(ws + WS_WQUP), MT, 768, 256, NU}; pg8::StaticOrder S; S.init(MT, 768, 110, bx);
          pg8::EpiQ E{rsqq, (const float*)(ws + WS_ROPE), (const float*)args.in[16], (const float*)args.in[17], (bf16*)(ws + WS_QM)};
          pg8::gemm_phase<pg8::EpiQ, pg8::StaticOrder, true, true>(lds, g, S, E, wave); }
        else { pg8::Gemm g{(const bf16*)(ws + WS_U) + U_MKV, (const bf16*)(ws + WS_WKVP), MT, 1024, 128, NU}; pg8::StaticOrder S; S.init(MT, 1024, G - 110, bx - 110);
          pg8::EpiKV E{rsqkv, (const float*)args.in[21], (bf16*)(ws + WS_KM), (bf16*)(ws + WS_VM)};
          pg8::gemm_phase<pg8::EpiKV, pg8::StaticOrder, true, true>(lds, g, S, E, wave); }
        post_tokens(args, gw, NGW, 0);
        { volatile LAS unsigned* qs2 = MISC + 20;
          for (;;) {
              __syncthreads();
              if (wave == 0 && lane_id() == 0) qs2[0] = __hip_atomic_fetch_add((unsigned*)(ctl + CW_Q + 128), 1u, __ATOMIC_RELAXED, __HIP_MEMORY_SCOPE_AGENT);
              __syncthreads();
              const int tl = __builtin_amdgcn_readfirstlane((int)qs2[0]);
              if (tl >= MT / 64) break;
              if (tl < MP / 64) gla::prep_tile_p(args, (char*)lds_raw, lds, tl, wave); else gla::prep_tile(args, (char*)lds_raw, tl, wave);
          } }
    }
    SEAM(2);
    if (IN(3)) {
        volatile LAS unsigned* qs = MISC + 16;
        bool first = true;
        for (;;) {
            __syncthreads();
            if (!first && wave == 0 && lane_id() == 0) qs[0] = (unsigned)G + __hip_atomic_fetch_add((unsigned*)(ctl + CW_Q), 1u, __ATOMIC_RELAXED, __HIP_MEMORY_SCOPE_AGENT);
            __syncthreads();
            const int it = first ? bx : __builtin_amdgcn_readfirstlane((int)qs[0]);
            first = false;
            constexpr int TF0 = 768, TFW = TF0 + PREP_LATE_TICKETS, TF1 = TFW + PREP_P_TICKETS, TA2 = TF1 + 64, TEND = TA2 + 128;
            if (it >= TEND) break;
            if (it < 32) gla::scan_unit(args, (char*)lds_raw, it, wave, 0);
            else if (it < 432 && !(it >= 144 && it < 256)) { const bool whole = it < 368; const int d = it < 144 ? it - 32 : it - 144, j = it - 368;
                dec::item(args, (char*)lds_raw, lds, whole ? d >> 3 : 28 + (j >> 4), whole ? d & 7 : (j >> 1) & 7, whole ? -1 : (j & 1), wave, 0); }
            else if (it < TF0 || (it >= TF1 && it < TA2)) pattn::one((char*)lds_raw, (const bf16*)(ws + WS_QM), (const bf16*)(ws + WS_KM), (const bf16*)(ws + WS_VM), (bf16*)(ws + WS_AO), it < 256 ? it - 144 : (it < TF0 ? it - 320 : it - TF1 + 448), wave);
            else if (it < TFW) prep_late(args, lds, it - TF0, wave, lane_id());
            else if (it < TF1) prep_late_p(args, it - TFW, wave, lane_id());
            else gla::scan_unit(args, (char*)lds_raw, it - TA2 + 32, wave, 0);
        }
    }
    SEAM(3);
    if (IN(5)) {
        pg8::Gemm g{(const bf16*)(ws + WS_AO), (const bf16*)(ws + WS_WO), MP, DM, DM}; pg8::StaticOrder S; S.init(MP, DM, G, bx);
        pg8::EpiResid<false> E{args.in[0], (bf16*)(ws + WS_HB), rsq2};
        pg8::gemm_phase<pg8::EpiResid<false>, pg8::StaticOrder, true, true>(lds, g, S, E, wave);
        skinny::run<1024>((char*)lds_raw, (const bf16*)(ws + WS_AO), (const bf16*)(ws + WS_WO), DM, vcu, G, wave, 0, skinny::FResid<false>{(const float*)args.in[1] - (size_t)MP * DM, (bf16*)(ws + WS_HB), rsq2});
    }
    SEAM(5);
    if (IN(6)) {
        pg8::Gemm g{(const bf16*)(ws + WS_HB), (const bf16*)(ws + WS_WGU), MT, 2 * FF, DM, 0, 254, -2}; pg8::StaticOrder S; S.init_tiles(66, 22, G, bx);
        pg8::EpiConv E{rsq2, (PG8_LAS float*)(lds + 131072), (const float*)args.in[26], (const float*)args.in[27], (const float*)args.in[5], (bf16*)(ws + WS_G), args.out + O_CONVP, args.out + O_CONVS};
        pg8::gemm_phase<pg8::EpiConv, pg8::StaticOrder, true, true>(lds, g, S, E, wave);
        if (bx >= 1452 - 5 * G && G == 256) {
            pg8::Gemm g2{(const bf16*)(ws + WS_PB), (const bf16*)(ws + WS_WPP), MP, DM, 256}; pg8::StaticOrder S2; S2.init(MP, DM, G - (1452 - 5 * G), bx - (1452 - 5 * G));
            pg8::EpiScaleBf16 E2{(bf16*)(ws + WS_PP), DM, nullptr};
            pg8::gemm_phase<pg8::EpiScaleBf16, pg8::StaticOrder, true, true>(lds, g2, S2, E2, wave); }
        else if (G != 256) { pg8::Gemm g2{(const bf16*)(ws + WS_PB), (const bf16*)(ws + WS_WPP), MP, DM, 256}; pg8::StaticOrder S2; S2.init(MP, DM, G, bx);
            pg8::EpiScaleBf16 E2{(bf16*)(ws + WS_PP), DM, nullptr};
            pg8::gemm_phase<pg8::EpiScaleBf16, pg8::StaticOrder, true, true>(lds, g2, S2, E2, wave); }
    }
    SEAM(6);
    if (IN(8)) {
        pg8::Gemm g{(const bf16*)(ws + WS_G), (const bf16*)(ws + WS_WD), MP, DM, FF}; pg8::StaticOrder S; S.init(MP, DM, G, bx);
        pg8::EpiResid<true> E{(const void*)(ws + WS_HB), (bf16*)(ws + WS_H2B), rsq3};
        pg8::gemm_phase<pg8::EpiResid<true>, pg8::StaticOrder, true, true>(lds, g, S, E, wave);
        skinny::run<2816>((char*)lds_raw, (const bf16*)(ws + WS_G), (const bf16*)(ws + WS_WD), DM, vcu, G, wave, 0, skinny::FResid<true>{(const void*)(ws + WS_HB), (bf16*)(ws + WS_H2B), rsq3});
    }
    SEAM(8);
    if (IN(9)) {
        pg8::Gemm g{(const bf16*)(ws + WS_H2B), (const bf16*)(ws + WS_WPG), MP, DM, DM}; pg8::StaticOrder S; S.init(MP, DM, G, bx);
        pg8::EpiPle E{(const bf16*)(ws + WS_H2B), (const bf16*)(ws + WS_PP), rsq3, args.out + O_YP};
        pg8::gemm_phase<pg8::EpiPle, pg8::StaticOrder, true, true>(lds, g, S, E, wave);
        skinny::run<1024>((char*)lds_raw, (const bf16*)(ws + WS_H2B), (const bf16*)(ws + WS_WPG), DM, vcu, G, wave, 0, skinny::FPle{(const bf16*)(ws + WS_H2B), (const bf16*)(ws + WS_PP), rsq3, args.out + O_YP});
    }
#undef IN
#undef SEAM
}

extern "C" void kernel_launch(void* const* d_in, const int* in_sizes, int n_in, void* d_out, int out_size, void* d_ws, size_t ws_size, hipStream_t stream) {
    static int grid = 0;
    if (grid == 0) {
        if (n_in != 32 || out_size != (int)O_END || ws_size < WS_END) { fprintf(stderr, "kernel_launch: unexpected shapes: n_in %d out %d ws %zu; nothing launched\n", n_in, out_size, ws_size); grid = -1; return; }
        int dev = 0, cus = 0, per_cu = 0;
        if (hipGetDevice(&dev) != hipSuccess || hipDeviceGetAttribute(&cus, hipDeviceAttributeMultiprocessorCount, dev) != hipSuccess) { fprintf(stderr, "kernel_launch: device query failed\n"); grid = -1; return; }
        if (hipFuncSetAttribute((const void*)hymba_fwd, hipFuncAttributeMaxDynamicSharedMemorySize, LDS_BYTES) != hipSuccess) { fprintf(stderr, "kernel_launch: hipFuncSetAttribute failed\n"); grid = -1; return; }
        if (hipOccupancyMaxActiveBlocksPerMultiprocessor(&per_cu, (const void*)hymba_fwd, NWAVES * 64, LDS_BYTES) != hipSuccess || per_cu < 1)
            fprintf(stderr, "kernel_launch: note: occupancy query reports %d workgroups per CU\n", per_cu);
        (void)hipGetLastError();
        grid = cus;
        if (grid != 256) fprintf(stderr, "kernel_launch: note: %d CUs (built for 256)\n", grid);
    }
    if (grid < 0) return;
    (void)hipMemsetAsync((char*)d_ws + WS_CTL, 0, CTL_ZERO_BYTES, stream);
    Args a{};
    for (int i = 0; i < 32; ++i) a.in[i] = d_in[i];
    a.out = (float*)d_out; a.ws = (unsigned char*)d_ws;
#if MK_PER_PHASE
    for (int p = 0; p < N_PHASES; ++p) { a.ph_lo = p; a.ph_hi = p + 1; hipLaunchKernelGGL(hymba_fwd, dim3(grid), dim3(NWAVES * 64), LDS_BYTES, stream, a); }
#else
    a.ph_lo = 0; a.ph_hi = N_PHASES;
    hipLaunchKernelGGL(hymba_fwd, dim3(grid), dim3(NWAVES * 64), LDS_BYTES, stream, a);
#endif
    const hipError_t le = hipPeekAtLastError();
    if (le != hipSuccess) fprintf(stderr, "kernel_launch: launch failed: %s\n", hipGetErrorName(le));
}
```
